# Optimizing an MI355X kernel written in HIP

```python
import math
import jax
import jax.numpy as jnp
from jax import lax
import numpy as np

D_MODEL = 1024
BATCH = 8
SEQ = 2048
DEPTH = 2

GRID_W = 64
CTX_LEN = 256

NA_HEADS = 8
NA_DIM = 64
NA_W = NA_HEADS * NA_DIM
WIN_R = 8
WIN_C = 16
NA_QCB = 16
NA_KCS = 32

DN_HEADS = 8
DN_DK = 64
DN_DV = 64
DN_KW = DN_HEADS * DN_DK
DN_VW = DN_HEADS * DN_DV
DN_CHUNK = 64

SSD_HEADS = 16
SSD_P = 64
SSD_GROUPS = 2
SSD_N = 128
SSD_DI = SSD_HEADS * SSD_P
SSD_BC = SSD_GROUPS * SSD_N
SSD_XBC = SSD_DI + 2 * SSD_BC
SSD_CHUNK = 64

CONV_W = 5
D_FF = 4 * D_MODEL
ROPE_THETA = 10000.0
EPS = 1e-6

IN_SPLITS = (3 * NA_W, 2 * DN_KW + DN_VW, DN_VW, 2 * DN_HEADS, 2 * DN_HEADS,
             SSD_DI, SSD_XBC, 2 * SSD_HEADS, 3 * D_MODEL)
D_IN = sum(IN_SPLITS)

F32 = jnp.float32

kernel_name = 'hybrid_na_gdn_ssd_dit_block'


def rms_norm(x, gain):
    xf = x.astype(F32)
    y = xf * lax.rsqrt(jnp.mean(xf * xf, axis=-1, keepdims=True) + EPS)
    return (y * gain.astype(F32)).astype(x.dtype)


def l2_norm(x):
    xf = x.astype(F32)
    return xf * lax.rsqrt(jnp.sum(xf * xf, axis=-1, keepdims=True) + EPS)


def modulate(x, shift, scale):
    return x * (1.0 + scale) + shift


def _flip(t):
    return None if t is None else jnp.flip(t, axis=1)


def dwconv_centred(x, w, b=None):
    y = lax.conv_general_dilated(
        x, w[:, None, :].astype(x.dtype), window_strides=(1,),
        padding=[(CONV_W // 2, CONV_W // 2)],
        dimension_numbers=('NWC', 'WIO', 'NWC'), feature_group_count=x.shape[-1])
    return y if b is None else y + b.astype(y.dtype)


def axial_rope(x):
    seq_len, dh = x.shape[1], x.shape[-1]
    half, quarter = dh // 2, dh // 4
    pos = jnp.arange(seq_len)
    inv_freq = ROPE_THETA ** (-jnp.arange(quarter, dtype=F32) / quarter)

    def rotate(xa, p):
        ang = p.astype(F32)[:, None] * inv_freq
        cos, sin = jnp.cos(ang)[None, :, None, :], jnp.sin(ang)[None, :, None, :]
        x1, x2 = xa[..., :quarter], xa[..., quarter:]
        return jnp.concatenate([x1 * cos - x2 * sin, x1 * sin + x2 * cos], axis=-1)

    return jnp.concatenate([rotate(x[..., :half], pos // GRID_W),
                            rotate(x[..., half:], pos % GRID_W)], axis=-1)


def split_cols(u):
    return jnp.split(u, [int(i) for i in np.cumsum(IN_SPLITS)[:-1]], axis=-1)


def neighbourhood_attention(qkv, qkv_c, q_gain, k_gain, rpb, need_ctx):
    bsz, seq_len, _ = qkv.shape
    ctx_len = qkv_c.shape[1]
    t = qkv.reshape(bsz, seq_len, 3, NA_HEADS, NA_DIM)
    tc = qkv_c.reshape(bsz, ctx_len, 3, NA_HEADS, NA_DIM)
    scale = NA_DIM ** -0.5
    q = rms_norm(t[:, :, 0], q_gain) * scale
    k = rms_norm(t[:, :, 1], k_gain)
    v = t[:, :, 2]
    kc = rms_norm(tc[:, :, 1], k_gain)
    vc = tc[:, :, 2]

    rows = seq_len // GRID_W
    wr = min(WIN_R, rows)
    ncb = GRID_W // NA_QCB
    r = np.arange(rows)
    row_idx = np.clip(r - wr // 2, 0, rows - wr)[:, None] + np.arange(wr)
    qcol = np.arange(ncb)[:, None] * NA_QCB + np.arange(NA_QCB)
    kcol = (np.clip(np.arange(ncb) * NA_QCB - WIN_C // 2, 0, GRID_W - NA_KCS)[:, None]
            + np.arange(NA_KCS))
    wstart = np.clip(qcol - WIN_C // 2, 0, GRID_W - WIN_C)
    col_ok = (kcol[:, None, :] >= wstart[..., None]) & (kcol[:, None, :] < wstart[..., None] + WIN_C)
    dr = row_idx - r[:, None] + (WIN_R - 1)
    dc = np.clip(kcol[:, None, :] - qcol[..., None], 1 - WIN_C, WIN_C - 1) + (WIN_C - 1)
    bias = rpb.astype(F32)[:, dr[None, :, None, :, None], dc[:, None, :, None, :]]
    bias = jnp.where(col_ok[:, None, :, None, :], bias, -jnp.inf)
    bias = jnp.moveaxis(bias, 0, 1)

    q_blocks = jnp.moveaxis(q.reshape(bsz, rows, ncb, NA_QCB, NA_HEADS, NA_DIM), 2, 0)
    k_grid = k.reshape(bsz, rows, GRID_W, NA_HEADS, NA_DIM)
    v_grid = v.reshape(bsz, rows, GRID_W, NA_HEADS, NA_DIM)
    row_idx_j = jnp.asarray(row_idx)
    n_win = wr * NA_KCS

    def query_block(args):
        qb, kcol_b, bias_b = args
        kb = jnp.take(k_grid, kcol_b, axis=2)[:, row_idx_j]
        vb = jnp.take(v_grid, kcol_b, axis=2)[:, row_idx_j].reshape(bsz, rows, n_win, NA_HEADS, NA_DIM)
        s_win = jnp.einsum('brqhd,brwkhd->bhrqwk', qb, kb).astype(F32) + bias_b[None]
        s_ctx = jnp.einsum('brqhd,bmhd->bhrqm', qb, kc).astype(F32)
        s = jnp.concatenate([s_win.reshape(bsz, NA_HEADS, rows, NA_QCB, n_win), s_ctx], axis=-1)
        p = jax.nn.softmax(s, axis=-1).astype(v.dtype)
        return (jnp.einsum('bhrqn,brnhd->brqhd', p[..., :n_win], vb)
                + jnp.einsum('bhrqm,bmhd->brqhd', p[..., n_win:], vc))

    o = lax.map(query_block, (q_blocks, jnp.asarray(kcol), bias))
    y = jnp.moveaxis(o, 0, 2).reshape(bsz, seq_len, NA_W)

    yc = None
    if need_ctx:
        qc = rms_norm(tc[:, :, 0], q_gain) * scale
        pc = jax.nn.softmax(jnp.einsum('bmhd,bnhd->bhmn', qc, kc).astype(F32), axis=-1).astype(vc.dtype)
        yc = jnp.einsum('bhmn,bnhd->bmhd', pc, vc).reshape(bsz, ctx_len, NA_W)
    return y, yc


def gdn_chunked(q, k, v, g, beta, s0, with_output):
    bsz, seq_len, n_h, _ = k.shape
    dv = v.shape[-1]
    cl = DN_CHUNK
    nc = seq_len // cl

    def chunks(t):
        return jnp.swapaxes(t.astype(F32).reshape(bsz, nc, cl, n_h, *t.shape[3:]), 2, 3)

    k, v, g, beta = chunks(k), chunks(v), chunks(g), chunks(beta)
    incl = np.tril(np.ones((cl, cl), dtype=bool))
    strict = np.tril(np.ones((cl, cl), dtype=bool), -1)
    gam = jnp.cumsum(g, axis=-1)
    dec = jnp.exp(jnp.where(incl, gam[..., :, None] - gam[..., None, :], -jnp.inf))
    kb = k * beta[..., None]
    a = jnp.where(strict, jnp.einsum('bnhid,bnhjd->bnhij', kb, k) * dec, 0.0)
    eye = jnp.eye(cl, dtype=F32)
    tmat = lax.linalg.triangular_solve(eye + a, jnp.broadcast_to(eye, a.shape),
                                       left_side=True, lower=True, unit_diagonal=True)
    u = tmat @ (v * beta[..., None])
    w = tmat @ (kb * jnp.exp(gam)[..., None])
    gam_last = gam[..., -1]
    kdec = k * jnp.exp(gam_last[..., None] - gam)[..., None]
    xs = [u, w, kdec, gam_last]
    if with_output:
        q = chunks(q)
        xs += [q * jnp.exp(gam)[..., None], jnp.einsum('bnhid,bnhjd->bnhij', q, k) * dec]

    def step(s, inp):
        v_new = inp[0] - inp[1] @ s
        s_next = s * jnp.exp(inp[3])[..., None, None] + jnp.swapaxes(inp[2], -1, -2) @ v_new
        if with_output:
            return s_next, inp[4] @ s + inp[5] @ v_new
        return s_next, None

    s_fin, o = lax.scan(step, s0.astype(F32), [jnp.moveaxis(t, 1, 0) for t in xs])
    if with_output:
        o = jnp.swapaxes(jnp.moveaxis(o, 0, 1), 2, 3).reshape(bsz, seq_len, n_h, dv)
    return o, s_fin


def _gdn_inputs(qkv_s, b_s, a_s, conv_w, a_log, dt_bias, use_rope, need_q):
    bsz, n, _ = qkv_s.shape
    t = jax.nn.silu(dwconv_centred(qkv_s, conv_w)).astype(F32)
    q, k, v = jnp.split(t, [DN_KW, 2 * DN_KW], axis=-1)
    k = l2_norm(k.reshape(bsz, n, DN_HEADS, DN_DK))
    if use_rope:
        k = axial_rope(k)
    if need_q:
        q = l2_norm(q.reshape(bsz, n, DN_HEADS, DN_DK))
        if use_rope:
            q = axial_rope(q)
        q = q * DN_DK ** -0.5
    else:
        q = None
    v = v.reshape(bsz, n, DN_HEADS, DN_DV)
    beta = jax.nn.sigmoid(b_s.astype(F32)).reshape(bsz, n, 2, DN_HEADS)
    g = -jnp.exp(a_log.astype(F32)) * jax.nn.softplus(
        a_s.astype(F32).reshape(bsz, n, 2, DN_HEADS) + dt_bias.astype(F32))
    return q, k, v, beta, g


def gated_deltanet(qkv, z, b_raw, a_raw, qkv_c, z_c, b_raw_c, a_raw_c,
                   conv_w, a_log, dt_bias, o_gain, need_ctx):
    bsz = qkv.shape[0]
    q, k, v, beta, g = _gdn_inputs(qkv, b_raw, a_raw, conv_w, a_log, dt_bias, True, True)
    qc, kc, vc, betac, gc = _gdn_inputs(qkv_c, b_raw_c, a_raw_c, conv_w, a_log, dt_bias, False, need_ctx)
    s0 = jnp.zeros((bsz, DN_HEADS, DN_DK, DN_DV), F32)
    oc_f, sc_f = gdn_chunked(qc, kc, vc, gc[:, :, 0], betac[:, :, 0], s0, need_ctx)
    oc_b, sc_b = gdn_chunked(_flip(qc), _flip(kc), _flip(vc), _flip(gc[:, :, 1]), _flip(betac[:, :, 1]), s0, need_ctx)
    o_f, _ = gdn_chunked(q, k, v, g[:, :, 0], beta[:, :, 0], sc_f, True)
    o_b, _ = gdn_chunked(_flip(q), _flip(k), _flip(v), _flip(g[:, :, 1]), _flip(beta[:, :, 1]), sc_b, True)

    def gated_out(o, zs):
        n = zs.shape[1]
        zh = zs.astype(F32).reshape(bsz, n, DN_HEADS, DN_DV)
        return (rms_norm(o, o_gain) * jax.nn.silu(zh)).reshape(bsz, n, DN_VW)

    y = gated_out(o_f + _flip(o_b), z)
    yc = gated_out(oc_f + _flip(oc_b), z_c) if need_ctx else None
    return y, yc


def ssd_chunked(xs, dt, a, bm, cm, h0, with_output):
    bsz, seq_len, n_h, hp = xs.shape
    n_g, n_s = bm.shape[2], bm.shape[3]
    n_r = n_h // n_g
    cl = SSD_CHUNK
    nc = seq_len // cl
    x = xs.reshape(bsz, nc, cl, n_g, n_r, hp)
    dtc = dt.reshape(bsz, nc, cl, n_g, n_r)
    bc = bm.reshape(bsz, nc, cl, n_g, n_s)
    lam = jnp.cumsum(dtc * a.reshape(n_g, n_r), axis=2)
    lam_last = lam[:, :, -1]
    st = jnp.einsum('bcjgn,bcjgr,bcjgrp->bcgrpn', bc, jnp.exp(lam_last[:, :, None] - lam) * dtc, x)

    def step(h, inp):
        st_c, dec_c = inp
        h_next = h * jnp.exp(dec_c)[..., None, None] + st_c
        return h_next, (h if with_output else None)

    h_fin, h_prev = lax.scan(step, h0.reshape(bsz, n_g, n_r, hp, n_s),
                             (jnp.moveaxis(st, 1, 0), jnp.moveaxis(lam_last, 1, 0)))
    h_fin = h_fin.reshape(bsz, n_h, hp, n_s)
    if not with_output:
        return None, h_fin
    cc = cm.reshape(bsz, nc, cl, n_g, n_s)
    y_inter = jnp.einsum('bcign,bcigr,bcgrpn->bcigrp', cc, jnp.exp(lam), jnp.moveaxis(h_prev, 0, 1))
    incl = np.tril(np.ones((cl, cl), dtype=bool))
    lam_t = jnp.moveaxis(lam, 2, -1)
    dec = jnp.exp(jnp.where(incl, lam_t[..., :, None] - lam_t[..., None, :], -jnp.inf))
    cb = jnp.einsum('bcign,bcjgn->bcgij', cc, bc)
    wgt = cb[:, :, :, None] * dec * jnp.moveaxis(dtc, 2, -1)[..., None, :]
    y_intra = jnp.einsum('bcgrij,bcjgrp->bcigrp', wgt, x)
    return (y_inter + y_intra).reshape(bsz, seq_len, n_h, hp), h_fin


def _ssd_inputs(xbc_s, dt_s, conv_w, conv_b, dt_bias):
    bsz, n, _ = xbc_s.shape
    t = jax.nn.silu(dwconv_centred(xbc_s, conv_w, conv_b)).astype(F32)
    xs, bm, cm = jnp.split(t, [SSD_DI, SSD_DI + SSD_BC], axis=-1)
    dt = jax.nn.softplus(dt_s.astype(F32).reshape(bsz, n, 2, SSD_HEADS) + dt_bias.astype(F32))
    return (xs.reshape(bsz, n, SSD_HEADS, SSD_P), bm.reshape(bsz, n, SSD_GROUPS, SSD_N),
            cm.reshape(bsz, n, SSD_GROUPS, SSD_N), dt)


def mamba2_ssd(z, xbc, dt_raw, z_c, xbc_c, dt_raw_c, conv_w, conv_b, a_log, dt_bias,
               d_skip, o_gain, need_ctx):
    bsz = z.shape[0]
    a = -jnp.exp(a_log.astype(F32))
    xs, bm, cm, dt = _ssd_inputs(xbc, dt_raw, conv_w, conv_b, dt_bias)
    xsc, bmc, cmc, dtc = _ssd_inputs(xbc_c, dt_raw_c, conv_w, conv_b, dt_bias)
    h0 = jnp.zeros((bsz, SSD_HEADS, SSD_P, SSD_N), F32)
    yc_f, hc_f = ssd_chunked(xsc, dtc[:, :, 0], a[0], bmc, cmc, h0, need_ctx)
    yc_b, hc_b = ssd_chunked(_flip(xsc), _flip(dtc[:, :, 1]), a[1], _flip(bmc), _flip(cmc), h0, need_ctx)
    y_f, _ = ssd_chunked(xs, dt[:, :, 0], a[0], bm, cm, hc_f, True)
    y_b, _ = ssd_chunked(_flip(xs), _flip(dt[:, :, 1]), a[1], _flip(bm), _flip(cm), hc_b, True)

    def gated_out(ys, xss, zs):
        n = zs.shape[1]
        yy = (ys + d_skip.astype(F32)[:, None] * xss).reshape(bsz, n, SSD_DI) * jax.nn.silu(zs.astype(F32))
        grp = yy.reshape(bsz, n, SSD_GROUPS, SSD_DI // SSD_GROUPS)
        return rms_norm(grp, o_gain.reshape(SSD_GROUPS, SSD_DI // SSD_GROUPS)).reshape(bsz, n, SSD_DI)

    y = gated_out(y_f + _flip(y_b), xs, z)
    yc = gated_out(yc_f + _flip(yc_b), xsc, z_c) if need_ctx else None
    return y, yc


def token_mixer(h, hc, w_in, na_q_gain, na_k_gain, na_rpb, dn_conv_w, dn_a_log, dn_dt_bias, dn_o_gain,
                ssd_conv_w, ssd_conv_b, ssd_a_log, ssd_dt_bias, ssd_d, ssd_o_gain,
                w_pa, w_pb, w_pc, w_out, need_ctx):
    (na_qkv, dn_qkv, dn_z, dn_b, dn_a, ssd_z, ssd_xbc, ssd_dt, gate_raw) = split_cols(h @ w_in)
    (na_qkv_c, dn_qkv_c, dn_z_c, dn_b_c, dn_a_c, ssd_z_c, ssd_xbc_c, ssd_dt_c, gate_raw_c) = split_cols(hc @ w_in)
    y_a, yc_a = neighbourhood_attention(na_qkv, na_qkv_c, na_q_gain, na_k_gain, na_rpb, need_ctx)
    y_b, yc_b = gated_deltanet(dn_qkv, dn_z, dn_b, dn_a, dn_qkv_c, dn_z_c, dn_b_c, dn_a_c,
                               dn_conv_w, dn_a_log, dn_dt_bias, dn_o_gain, need_ctx)
    y_c, yc_c = mamba2_ssd(ssd_z, ssd_xbc, ssd_dt, ssd_z_c, ssd_xbc_c, ssd_dt_c, ssd_conv_w, ssd_conv_b,
                           ssd_a_log, ssd_dt_bias, ssd_d, ssd_o_gain, need_ctx)

    def merge(ya, yb, ycc, g_raw):
        dtype = g_raw.dtype
        gts = jax.nn.sigmoid(g_raw.astype(F32)).astype(dtype).reshape(*g_raw.shape[:2], 3, D_MODEL)
        m = (gts[:, :, 0] * (ya.astype(dtype) @ w_pa)
             + gts[:, :, 1] * (yb.astype(dtype) @ w_pb)
             + gts[:, :, 2] * (ycc.astype(dtype) @ w_pc))
        return m @ w_out

    y = merge(y_a, y_b, y_c, gate_raw)
    yc = merge(yc_a, yc_b, yc_c, gate_raw_c) if need_ctx else None
    return y, yc


def squared_relu_mlp(h, w1, w2):
    return jnp.square(jax.nn.relu(h @ w1)) @ w2


def setup_inputs(seed: int = 0) -> dict:
    key = jax.random.key(seed)
    keys = iter(jax.random.split(key, 32))

    def normal(shape, scale):
        return scale * jax.random.normal(next(keys), shape, F32)

    def gain(shape):
        return 1.0 + 0.02 * jax.random.normal(next(keys), shape, F32)

    def a_log(shape):
        return jnp.log(jax.random.uniform(next(keys), shape, F32, 1.0, 16.0))

    def dt_bias(shape):
        dt = jnp.exp(jax.random.uniform(next(keys), shape, F32, math.log(1e-3), math.log(1e-1)))
        return dt + jnp.log(-jnp.expm1(-dt))

    L, D = DEPTH, D_MODEL
    return {
        'x': normal((BATCH, SEQ, D), 1.0),
        'c': normal((BATCH, D), 1.0),
        'ctx': normal((BATCH, CTX_LEN, D), 1.0),
        'c_ctx': normal((D,), 1.0),
        'w_ada': normal((L, D, 6 * D), D ** -0.5),
        'b_ada': normal((L, 6 * D), 0.02),
        'norm1_g': gain((L, D)),
        'norm2_g': gain((L, D)),
        'w_in': normal((L, D, D_IN), D ** -0.5),
        'na_q_gain': gain((L, NA_DIM)),
        'na_k_gain': gain((L, NA_DIM)),
        'na_rpb': normal((L, NA_HEADS, 2 * WIN_R - 1, 2 * WIN_C - 1), 0.1),
        'dn_conv_w': normal((L, CONV_W, 2 * DN_KW + DN_VW), CONV_W ** -0.5),
        'dn_a_log': a_log((L, 2, DN_HEADS)),
        'dn_dt_bias': dt_bias((L, 2, DN_HEADS)),
        'dn_o_gain': gain((L, DN_DV)),
        'ssd_conv_w': normal((L, CONV_W, SSD_XBC), CONV_W ** -0.5),
        'ssd_conv_b': normal((L, SSD_XBC), 0.02),
        'ssd_a_log': a_log((L, 2, SSD_HEADS)),
        'ssd_dt_bias': dt_bias((L, 2, SSD_HEADS)),
        'ssd_d': gain((L, SSD_HEADS)),
        'ssd_o_gain': gain((L, SSD_DI)),
        'w_pa': normal((L, NA_W, D), NA_W ** -0.5),
        'w_pb': normal((L, DN_VW, D), DN_VW ** -0.5),
        'w_pc': normal((L, SSD_DI, D), SSD_DI ** -0.5),
        'w_out': normal((L, D, D), D ** -0.5),
        'w_ff1': normal((L, D, D_FF), D ** -0.5),
        'w_ff2': normal((L, D_FF, D), D_FF ** -0.5),
    }


def reference(x, c, ctx, c_ctx, w_ada, b_ada, norm1_g, norm2_g, w_in, na_q_gain, na_k_gain, na_rpb,
              dn_conv_w, dn_a_log, dn_dt_bias, dn_o_gain, ssd_conv_w, ssd_conv_b, ssd_a_log,
              ssd_dt_bias, ssd_d, ssd_o_gain, w_pa, w_pb, w_pc, w_out, w_ff1, w_ff2):
    xc = ctx
    for l in range(DEPTH):
        need_ctx = l < DEPTH - 1
        mod = jnp.split((jax.nn.silu(c) @ w_ada[l] + b_ada[l])[:, None, :], 6, axis=-1)
        mod_c = jnp.split(jax.nn.silu(c_ctx) @ w_ada[l] + b_ada[l], 6, axis=-1)
        h = modulate(rms_norm(x, norm1_g[l]), mod[0], mod[1])
        hc = modulate(rms_norm(xc, norm1_g[l]), mod_c[0], mod_c[1])
        y, yc = token_mixer(h, hc, w_in[l], na_q_gain[l], na_k_gain[l], na_rpb[l],
                            dn_conv_w[l], dn_a_log[l], dn_dt_bias[l], dn_o_gain[l],
                            ssd_conv_w[l], ssd_conv_b[l], ssd_a_log[l], ssd_dt_bias[l], ssd_d[l], ssd_o_gain[l],
                            w_pa[l], w_pb[l], w_pc[l], w_out[l], need_ctx)
        x = x + mod[2] * y
        x = x + mod[5] * squared_relu_mlp(modulate(rms_norm(x, norm2_g[l]), mod[3], mod[4]), w_ff1[l], w_ff2[l])
        if need_ctx:
            xc = xc + mod_c[2] * yc
            xc = xc + mod_c[5] * squared_relu_mlp(
                modulate(rms_norm(xc, norm2_g[l]), mod_c[3], mod_c[4]), w_ff1[l], w_ff2[l])
    return x
```

```cpp
#include <hip/hip_runtime.h>
#include <hip/hip_cooperative_groups.h>
#include <cstdio>
#include <cstdint>

typedef unsigned short bf16_t;
typedef short bf16x8 __attribute__((ext_vector_type(8)));
typedef short s16x4 __attribute__((ext_vector_type(4)));
typedef float f32x4 __attribute__((ext_vector_type(4)));
#define LDS_AS __attribute__((address_space(3)))

constexpr int TL = 16384;
constexpr int TC = 2048;
constexpr int TT = TL + TC;
constexpr int DM = 1024;
constexpr int UW = 6144;
constexpr int SWD = 64;
constexpr int DIN = 9280;
constexpr int DFF = 4096;
constexpr float EPS = 1e-6f;
constexpr int U_NAQ = 0, U_NAK = 512, U_NAV = 1024;
constexpr int U_DNQ = 1536, U_DNK = 2048, U_DNV = 2560, U_DNZ = 3072;
constexpr int U_SZ = 3584, U_SX = 4608, U_SB = 5632, U_SC = 5888;
constexpr int U_YA = 0, U_YB = 512, U_YC = 1024, U_GATE = 2048, U_M = 5120;

struct Params {
  const float *x, *c, *ctx, *c_ctx, *w_ada, *b_ada, *norm1_g, *norm2_g, *w_in, *na_q_gain, *na_k_gain, *na_rpb,
      *dn_conv_w, *dn_a_log, *dn_dt_bias, *dn_o_gain, *ssd_conv_w, *ssd_conv_b, *ssd_a_log, *ssd_dt_bias, *ssd_d,
      *ssd_o_gain, *w_pa, *w_pb, *w_pc, *w_out, *w_ff1, *w_ff2;
  float* out;
  bf16_t* U;
  float* S;
  bf16_t* P;
  float* XC;
  float* MOD;
  float* SS;
  float* ROPE;
  bf16_t* OG0;
  bf16_t* OG1;
};

__device__ __forceinline__ float bf2f(bf16_t v) { return __uint_as_float(((unsigned)v) << 16); }
__device__ __forceinline__ bf16_t f2bf(float f) {
  unsigned u = __float_as_uint(f);
  u += 0x7fffu + ((u >> 16) & 1u);
  return (bf16_t)(u >> 16);
}
__device__ __forceinline__ unsigned pack2(float a, float b) { return (unsigned)f2bf(a) | ((unsigned)f2bf(b) << 16); }
__device__ __forceinline__ float bflo(unsigned w) { return __uint_as_float(w << 16); }
__device__ __forceinline__ float bfhi(unsigned w) { return __uint_as_float(w & 0xffff0000u); }
__device__ __forceinline__ float wave_sum(float v) {
#pragma unroll
  for (int o = 32; o; o >>= 1) v += __shfl_xor(v, o);
  return v;
}
__device__ __forceinline__ float wave_max(float v) {
#pragma unroll
  for (int o = 32; o; o >>= 1) v = fmaxf(v, __shfl_xor(v, o));
  return v;
}
__device__ __forceinline__ float siluf(float v) { return v / (1.f + expf(-v)); }
__device__ __forceinline__ float sigmoidf_(float v) { return 1.f / (1.f + expf(-v)); }
__device__ __forceinline__ float softplusf_(float v) { return v > 20.f ? v : log1pf(expf(v)); }

__device__ __forceinline__ const float* xrow_in(const Params& p, int layer, int row) {
  if (layer == 0) return row < TL ? p.x + (size_t)row * DM : p.ctx + (size_t)(row - TL) * DM;
  return row < TL ? p.out + (size_t)row * DM : p.XC + (size_t)(row - TL) * DM;
}
__device__ __forceinline__ float* xrow_out(const Params& p, int row) {
  return row < TL ? p.out + (size_t)row * DM : p.XC + (size_t)(row - TL) * DM;
}
__device__ __forceinline__ int modrow(int row) { return row < TL ? (row >> 11) : 8; }

constexpr int BK = 32;
constexpr int ASTR = BK + 8;
constexpr int BSTR = 128 + 16;
constexpr int A_TILE = 128 * ASTR;
constexpr int B_TILE = BK * BSTR;
constexpr int GEMM_LDS_BYTES = 2 * (A_TILE + B_TILE) * 2;

struct ALoadBf16 {
  const bf16_t* base; int stride;
  __device__ __forceinline__ uint4 load8(int row, int k) const { return *(const uint4*)(base + (size_t)row * stride + k); }
};
struct ALoadNorm {
  const float* xl; const float* xc; const float* ss; const float* alpha_base; const float* shift_base;
  __device__ __forceinline__ uint4 load8(int row, int k) const {
    const float* xr = (row < TL ? xl + (size_t)row * DM : xc + (size_t)(row - TL) * DM) + k;
    const float4 a = *(const float4*)xr, b = *(const float4*)(xr + 4);
    const float rs = rsqrtf(ss[row] * (1.f / DM) + EPS);
    const int mr = modrow(row) * 6144 + k;
    const float4 g0 = *(const float4*)(alpha_base + mr), g1 = *(const float4*)(alpha_base + mr + 4);
    const float4 s0 = *(const float4*)(shift_base + mr), s1 = *(const float4*)(shift_base + mr + 4);
    uint4 o;
    o.x = pack2(a.x * rs * g0.x + s0.x, a.y * rs * g0.y + s0.y);
    o.y = pack2(a.z * rs * g0.z + s0.z, a.w * rs * g0.w + s0.w);
    o.z = pack2(b.x * rs * g1.x + s1.x, b.y * rs * g1.y + s1.y);
    o.w = pack2(b.z * rs * g1.z + s1.z, b.w * rs * g1.w + s1.w);
    return o;
  }
};
struct BLoadW {
  const float* w; int ldw; int col0;
  __device__ __forceinline__ uint4 load8(int k, int n) const {
    const float* s = w + (size_t)k * ldw + col0 + n;
    const float4 a = *(const float4*)s, b = *(const float4*)(s + 4);
    uint4 o; o.x = pack2(a.x, a.y); o.y = pack2(a.z, a.w); o.z = pack2(b.x, b.y); o.w = pack2(b.z, b.w);
    return o;
  }
};
struct BLoadWin {
  const float* w; int n0;
  __device__ __forceinline__ uint4 load8(int k, int n) const {
    const int nn = n0 + n;
    int src;
    if (nn < 3584) src = nn;
    else if (nn < 6144) src = nn + 32;
    else { const int o = nn - 6144; src = o < 32 ? 3584 + o : (o < 64 ? 6176 + (o - 32) : -1); }
    if (src < 0) return make_uint4(0, 0, 0, 0);
    const float* s = w + (size_t)k * DIN + src;
    const float4 a = *(const float4*)s, b = *(const float4*)(s + 4);
    uint4 o; o.x = pack2(a.x, a.y); o.y = pack2(a.z, a.w); o.z = pack2(b.x, b.y); o.w = pack2(b.z, b.w);
    return o;
  }
};

template <class AL, class BL>
__device__ __forceinline__ void gemm_mainloop(f32x4 (&acc)[4][4], const AL& al, const BL& bl, int m0, int K, bf16_t* lds) {
  const int tid = threadIdx.x, lane = tid & 63, wave = tid >> 6, wm = wave >> 1, wn = wave & 1;
  const int g = lane >> 4, l15 = lane & 15;
  bf16_t* As = lds;
  bf16_t* Bs = lds + 2 * A_TILE;
  const int ar0 = tid >> 2, ak0 = (tid & 3) * 8;
  const int ar1 = ar0 + 64;
  const int bk0 = tid >> 4, bn0 = (tid & 15) * 8;
  const int bk1 = bk0 + 16;
  auto rho = [](int k) { return (k & 3) + 4 * ((k >> 3) & 3) + 16 * ((k >> 2) & 1); };
  const int brow0 = rho(bk0), brow1 = rho(bk1);
  uint4 ra0, ra1, rb0, rb1;
  ra0 = al.load8(m0 + ar0, ak0); ra1 = al.load8(m0 + ar1, ak0);
  rb0 = bl.load8(bk0, bn0);      rb1 = bl.load8(bk1, bn0);
  *(uint4*)(As + ar0 * ASTR + ak0) = ra0; *(uint4*)(As + ar1 * ASTR + ak0) = ra1;
  *(uint4*)(Bs + brow0 * BSTR + bn0) = rb0; *(uint4*)(Bs + brow1 * BSTR + bn0) = rb1;
  __syncthreads();
  const int nk = K / BK;
  const int q4 = l15 >> 2, p4 = lane & 3;
  for (int kt = 0; kt < nk; ++kt) {
    const int cur = kt & 1;
    if (kt + 1 < nk) {
      const int k1 = (kt + 1) * BK;
      ra0 = al.load8(m0 + ar0, k1 + ak0); ra1 = al.load8(m0 + ar1, k1 + ak0);
      rb0 = bl.load8(k1 + bk0, bn0);      rb1 = bl.load8(k1 + bk1, bn0);
    }
    const bf16_t* Ac = As + cur * A_TILE + (64 * wm + l15) * ASTR + 8 * g;
    const bf16_t* Bc = Bs + cur * B_TILE + (4 * g + q4) * BSTR + 64 * wn + 4 * p4;
    bf16x8 af[4], bfr[4];
#pragma unroll
    for (int mi = 0; mi < 4; ++mi) af[mi] = *(const bf16x8*)(Ac + mi * 16 * ASTR);
#pragma unroll
    for (int ni = 0; ni < 4; ++ni) {
      const s16x4 lo = __builtin_amdgcn_ds_read_tr16_b64_v4i16((LDS_AS s16x4*)(Bc + ni * 16));
      const s16x4 hi = __builtin_amdgcn_ds_read_tr16_b64_v4i16((LDS_AS s16x4*)(Bc + 16 * BSTR + ni * 16));
      bfr[ni] = (bf16x8){lo[0], lo[1], lo[2], lo[3], hi[0], hi[1], hi[2], hi[3]};
    }
#pragma unroll
    for (int mi = 0; mi < 4; ++mi)
#pragma unroll
      for (int ni = 0; ni < 4; ++ni)
        acc[mi][ni] = __builtin_amdgcn_mfma_f32_16x16x32_bf16(bfr[ni], af[mi], acc[mi][ni], 0, 0, 0);
    if (kt + 1 < nk) {
      const int nx = cur ^ 1;
      *(uint4*)(As + nx * A_TILE + ar0 * ASTR + ak0) = ra0; *(uint4*)(As + nx * A_TILE + ar1 * ASTR + ak0) = ra1;
      *(uint4*)(Bs + nx * B_TILE + brow0 * BSTR + bn0) = rb0; *(uint4*)(Bs + nx * B_TILE + brow1 * BSTR + bn0) = rb1;
    }
    __syncthreads();
  }
}
__device__ __forceinline__ void acc_zero(f32x4 (&acc)[4][4]) {
#pragma unroll
  for (int i = 0; i < 4; ++i)
#pragma unroll
    for (int j = 0; j < 4; ++j) acc[i][j] = (f32x4){0.f, 0.f, 0.f, 0.f};
}
__device__ __forceinline__ void tile_coord(int t, int nMt, int nNt, int& mt, int& nt) {
  const int per = 8 * nNt;
  const int grp = t / per, r = t % per;
  const int gsz = (nMt - grp * 8) < 8 ? (nMt - grp * 8) : 8;
  mt = grp * 8 + r % gsz; nt = r / gsz;
}

__device__ void phase_pro(const Params& p, int bid, int nb) {
  const int tid = threadIdx.x, lane = tid & 63, wave = tid >> 6;
  for (int row = bid * 4 + wave; row < TT; row += nb * 4) {
    const float* xr = xrow_in(p, 0, row);
    float s = 0.f;
#pragma unroll
    for (int i = 0; i < 4; ++i) { const float4 v = *(const float4*)(xr + lane * 4 + 256 * i); s += v.x * v.x + v.y * v.y + v.z * v.z + v.w * v.w; }
    s = wave_sum(s);
    if (lane == 0) { p.SS[row] = s; p.SS[TT + row] = 0.f; p.SS[2 * TT + row] = 0.f; p.SS[3 * TT + row] = 0.f; }
  }
  for (int i = bid * 256 + tid; i < 64 * 16; i += nb * 256) {
    const int pos = i >> 4, fi = i & 15;
    const float inv = powf(10000.f, -(float)fi / 16.f);
    const float ang = (float)pos * inv;
    p.ROPE[2 * i] = cosf(ang); p.ROPE[2 * i + 1] = sinf(ang);
  }
}
__device__ void phase_mod(const Params& p, int bid, int nb, float* lds) {
  const int tid = threadIdx.x;
  for (int u = bid; u < 48; u += nb) {
    const int l = u / 24, cb = u % 24, n = cb * 256 + tid;
    for (int i = tid; i < 9 * 1024; i += 256) { const int r = i >> 10, k = i & 1023; const float v = r < 8 ? p.c[r * 1024 + k] : p.c_ctx[k]; lds[i] = siluf(v); }
    __syncthreads();
    float acc[9];
#pragma unroll
    for (int r = 0; r < 9; ++r) acc[r] = 0.f;
    const float* w = p.w_ada + (size_t)l * 1024 * 6144 + n;
    for (int k = 0; k < 1024; ++k) {
      const float wv = w[(size_t)k * 6144];
#pragma unroll
      for (int r = 0; r < 9; ++r) acc[r] += lds[r * 1024 + k] * wv;
    }
    const float bias = p.b_ada[l * 6144 + n];
    const int chunk = n >> 10, kk = n & 1023;
#pragma unroll
    for (int r = 0; r < 9; ++r) {
      float v = acc[r] + bias;
      if (chunk == 1) v = p.norm1_g[l * 1024 + kk] * (1.f + v);
      if (chunk == 4) v = p.norm2_g[l * 1024 + kk] * (1.f + v);
      p.MOD[(size_t)(l * 9 + r) * 6144 + n] = v;
    }
    __syncthreads();
  }
}

__device__ void phase_g1(const Params& p, int layer, int bid, int nb, bf16_t* lds) {
  const int nMt = TT / 128, nNt = 49, total = nMt * nNt;
  const int lane = threadIdx.x & 63, wave = threadIdx.x >> 6, wm = wave >> 1, wn = wave & 1, g = lane >> 4, l15 = lane & 15;
  const float* modl = p.MOD + (size_t)layer * 9 * 6144;
  ALoadNorm al{layer == 0 ? p.x : p.out, layer == 0 ? p.ctx : p.XC, p.SS + (size_t)(2 * layer) * TT, modl + 1024, modl};
  for (int t = bid; t < total; t += nb) {
    int mt, nt; tile_coord(t, nMt, nNt, mt, nt);
    const int m0 = mt * 128, n0 = nt * 128;
    BLoadWin bl{p.w_in + (size_t)layer * 1024 * DIN, n0};
    f32x4 acc[4][4]; acc_zero(acc);
    gemm_mainloop(acc, al, bl, m0, 1024, lds);
    if (n0 < 1024) {
      const float* gain = (n0 < 512 ? p.na_q_gain : p.na_k_gain) + layer * 64;
      const float mul = n0 < 512 ? 0.125f : 1.f;
#pragma unroll
      for (int mi = 0; mi < 4; ++mi) {
        float ss = 0.f;
#pragma unroll
        for (int ni = 0; ni < 4; ++ni) ss += acc[mi][ni][0] * acc[mi][ni][0] + acc[mi][ni][1] * acc[mi][ni][1] + acc[mi][ni][2] * acc[mi][ni][2] + acc[mi][ni][3] * acc[mi][ni][3];
        ss += __shfl_xor(ss, 16); ss += __shfl_xor(ss, 32);
        const float rs = rsqrtf(ss * (1.f / 64.f) + EPS) * mul;
        const int row = m0 + 64 * wm + 16 * mi + l15;
#pragma unroll
        for (int ni = 0; ni < 4; ++ni) {
          const int cl = 16 * ni + 4 * g;
          const float4 gv = *(const float4*)(gain + cl);
          uint2 o; o.x = pack2(acc[mi][ni][0] * rs * gv.x, acc[mi][ni][1] * rs * gv.y); o.y = pack2(acc[mi][ni][2] * rs * gv.z, acc[mi][ni][3] * rs * gv.w);
          *(uint2*)(p.U + (size_t)row * UW + n0 + 64 * wn + cl) = o;
        }
      }
    } else if (n0 < 6144) {
#pragma unroll
      for (int mi = 0; mi < 4; ++mi) {
        const int row = m0 + 64 * wm + 16 * mi + l15;
#pragma unroll
        for (int ni = 0; ni < 4; ++ni) {
          uint2 o; o.x = pack2(acc[mi][ni][0], acc[mi][ni][1]); o.y = pack2(acc[mi][ni][2], acc[mi][ni][3]);
          *(uint2*)(p.U + (size_t)row * UW + n0 + 64 * wn + 16 * ni + 4 * g) = o;
        }
      }
    } else if (wn == 0) {
#pragma unroll
      for (int mi = 0; mi < 4; ++mi) {
        const int row = m0 + 64 * wm + 16 * mi + l15;
#pragma unroll
        for (int ni = 0; ni < 4; ++ni) *(f32x4*)(p.S + (size_t)row * SWD + 16 * ni + 4 * g) = acc[mi][ni];
      }
    }
  }
}

__device__ void phase_g2a(const Params& p, int layer, int bid, int nb, bf16_t* lds) {
  const int nMt = (layer == 0 ? TT : TL) / 128, nNt = 24, total = nMt * nNt;
  const int lane = threadIdx.x & 63, wave = threadIdx.x >> 6, wm = wave >> 1, wn = wave & 1, g = lane >> 4, l15 = lane & 15;
  const float* modl = p.MOD + (size_t)layer * 9 * 6144;
  ALoadNorm al{layer == 0 ? p.x : p.out, layer == 0 ? p.ctx : p.XC, p.SS + (size_t)(2 * layer) * TT, modl + 1024, modl};
  for (int t = bid; t < total; t += nb) {
    int mt, nt; tile_coord(t, nMt, nNt, mt, nt);
    const int m0 = mt * 128, n0 = nt * 128;
    BLoadW bl{p.w_in + (size_t)layer * 1024 * DIN, DIN, 6208 + n0};
    f32x4 acc[4][4]; acc_zero(acc);
    gemm_mainloop(acc, al, bl, m0, 1024, lds);
#pragma unroll
    for (int mi = 0; mi < 4; ++mi) {
      const int row = m0 + 64 * wm + 16 * mi + l15;
#pragma unroll
      for (int ni = 0; ni < 4; ++ni) {
        uint2 o; o.x = pack2(sigmoidf_(acc[mi][ni][0]), sigmoidf_(acc[mi][ni][1])); o.y = pack2(sigmoidf_(acc[mi][ni][2]), sigmoidf_(acc[mi][ni][3]));
        *(uint2*)(p.U + (size_t)row * UW + U_GATE + n0 + 64 * wn + 16 * ni + 4 * g) = o;
      }
    }
  }
}
__device__ void phase_g2b(const Params& p, int layer, int bid, int nb, bf16_t* lds) {
  const int nMt = (layer == 0 ? TT : TL) / 128, nNt = 8, total = nMt * nNt;
  const int lane = threadIdx.x & 63, wave = threadIdx.x >> 6, wm = wave >> 1, wn = wave & 1, g = lane >> 4, l15 = lane & 15;
  for (int t = bid; t < total; t += nb) {
    int mt, nt; tile_coord(t, nMt, nNt, mt, nt);
    const int m0 = mt * 128, n0 = nt * 128;
    f32x4 accm[4][4]; acc_zero(accm);
#pragma unroll 1
    for (int i = 0; i < 3; ++i) {
      const int ycol = i == 0 ? U_YA : (i == 1 ? U_YB : U_YC);
      const int Ki = i == 2 ? 1024 : 512;
      const float* w = i == 0 ? p.w_pa + (size_t)layer * 512 * 1024 : (i == 1 ? p.w_pb + (size_t)layer * 512 * 1024 : p.w_pc + (size_t)layer * 1024 * 1024);
      ALoadBf16 al{p.U + ycol, UW};
      BLoadW bl{w, 1024, n0};
      f32x4 acc[4][4]; acc_zero(acc);
      gemm_mainloop(acc, al, bl, m0, Ki, lds);
#pragma unroll
      for (int mi = 0; mi < 4; ++mi) {
        const int row = m0 + 64 * wm + 16 * mi + l15;
#pragma unroll
        for (int ni = 0; ni < 4; ++ni) {
          const uint2 gt = *(const uint2*)(p.U + (size_t)row * UW + U_GATE + 1024 * i + n0 + 64 * wn + 16 * ni + 4 * g);
          accm[mi][ni][0] += bflo(gt.x) * acc[mi][ni][0]; accm[mi][ni][1] += bfhi(gt.x) * acc[mi][ni][1];
          accm[mi][ni][2] += bflo(gt.y) * acc[mi][ni][2]; accm[mi][ni][3] += bfhi(gt.y) * acc[mi][ni][3];
        }
      }
    }
#pragma unroll
    for (int mi = 0; mi < 4; ++mi) {
      const int row = m0 + 64 * wm + 16 * mi + l15;
#pragma unroll
      for (int ni = 0; ni < 4; ++ni) {
        uint2 o; o.x = pack2(accm[mi][ni][0], accm[mi][ni][1]); o.y = pack2(accm[mi][ni][2], accm[mi][ni][3]);
        *(uint2*)(p.U + (size_t)row * UW + U_M + n0 + 64 * wn + 16 * ni + 4 * g) = o;
      }
    }
  }
}
__device__ __forceinline__ void epi_residual(const Params& p, const f32x4 (&acc)[4][4], int layer_in, int m0, int n0, const float* gate, float* ssacc) {
  const int lane = threadIdx.x & 63, wave = threadIdx.x >> 6, wm = wave >> 1, wn = wave & 1, g = lane >> 4, l15 = lane & 15;
#pragma unroll
  for (int mi = 0; mi < 4; ++mi) {
    const int row = m0 + 64 * wm + 16 * mi + l15;
    const float* xi = xrow_in(p, layer_in, row);
    float* xo = xrow_out(p, row);
    const float* gr = gate + modrow(row) * 6144;
    float ss = 0.f;
#pragma unroll
    for (int ni = 0; ni < 4; ++ni) {
      const int col = n0 + 64 * wn + 16 * ni + 4 * g;
      const float4 xv = *(const float4*)(xi + col);
      const float4 gv = *(const float4*)(gr + col);
      float4 o;
      o.x = xv.x + gv.x * acc[mi][ni][0]; o.y = xv.y + gv.y * acc[mi][ni][1]; o.z = xv.z + gv.z * acc[mi][ni][2]; o.w = xv.w + gv.w * acc[mi][ni][3];
      *(float4*)(xo + col) = o;
      ss += o.x * o.x + o.y * o.y + o.z * o.z + o.w * o.w;
    }
    if (ssacc) {
      ss += __shfl_xor(ss, 16); ss += __shfl_xor(ss, 32);
      if (g == 0) atomicAdd(ssacc + row, ss);
    }
  }
}
__device__ void phase_g3(const Params& p, int layer, int bid, int nb, bf16_t* lds) {
  const int nMt = (layer == 0 ? TT : TL) / 128, nNt = 8, total = nMt * nNt;
  const float* modl = p.MOD + (size_t)layer * 9 * 6144;
  ALoadBf16 al{p.U + U_M, UW};
  for (int t = bid; t < total; t += nb) {
    int mt, nt; tile_coord(t, nMt, nNt, mt, nt);
    const int m0 = mt * 128, n0 = nt * 128;
    BLoadW bl{p.w_out + (size_t)layer * 1024 * 1024, 1024, n0};
    f32x4 acc[4][4]; acc_zero(acc);
    gemm_mainloop(acc, al, bl, m0, 1024, lds);
    epi_residual(p, acc, layer, m0, n0, modl + 2048, p.SS + (size_t)(2 * layer + 1) * TT);
  }
}
__device__ void phase_g4(const Params& p, int layer, int bid, int nb, bf16_t* lds) {
  const int nMt = (layer == 0 ? TT : TL) / 128, nNt = 32, total = nMt * nNt;
  const int lane = threadIdx.x & 63, wave = threadIdx.x >> 6, wm = wave >> 1, wn = wave & 1, g = lane >> 4, l15 = lane & 15;
  const float* modl = p.MOD + (size_t)layer * 9 * 6144;
  ALoadNorm al{p.out, p.XC, p.SS + (size_t)(2 * layer + 1) * TT, modl + 4096, modl + 3072};
  for (int t = bid; t < total; t += nb) {
    int mt, nt; tile_coord(t, nMt, nNt, mt, nt);
    const int m0 = mt * 128, n0 = nt * 128;
    BLoadW bl{p.w_ff1 + (size_t)layer * 1024 * DFF, DFF, n0};
    f32x4 acc[4][4]; acc_zero(acc);
    gemm_mainloop(acc, al, bl, m0, 1024, lds);
#pragma unroll
    for (int mi = 0; mi < 4; ++mi) {
      const int row = m0 + 64 * wm + 16 * mi + l15;
#pragma unroll
      for (int ni = 0; ni < 4; ++ni) {
        float v0 = fmaxf(acc[mi][ni][0], 0.f), v1 = fmaxf(acc[mi][ni][1], 0.f), v2 = fmaxf(acc[mi][ni][2], 0.f), v3 = fmaxf(acc[mi][ni][3], 0.f);
        uint2 o; o.x = pack2(v0 * v0, v1 * v1); o.y = pack2(v2 * v2, v3 * v3);
        *(uint2*)(p.U + (size_t)row * DFF + n0 + 64 * wn + 16 * ni + 4 * g) = o;
      }
    }
  }
}
__device__ void phase_g5(const Params& p, int layer, int bid, int nb, bf16_t* lds) {
  const int nMt = (layer == 0 ? TT : TL) / 128, nNt = 8, total = nMt * nNt;
  const float* modl = p.MOD + (size_t)layer * 9 * 6144;
  ALoadBf16 al{p.U, DFF};
  for (int t = bid; t < total; t += nb) {
    int mt, nt; tile_coord(t, nMt, nNt, mt, nt);
    const int m0 = mt * 128, n0 = nt * 128;
    BLoadW bl{p.w_ff2 + (size_t)layer * DFF * 1024, 1024, n0};
    f32x4 acc[4][4]; acc_zero(acc);
    gemm_mainloop(acc, al, bl, m0, DFF, lds);
    epi_residual(p, acc, 1, m0, n0, modl + 5120, layer == 0 ? p.SS + (size_t)2 * TT : nullptr);
  }
}

__device__ void phase_na_naive(const Params& p, int layer, int bid, int nb) {
  const int lane = threadIdx.x & 63, wave = threadIdx.x >> 6;
  const int ntok = layer == 0 ? TT : TL;
  const float* rpb = p.na_rpb + (size_t)layer * 8 * 15 * 31;
  for (int w = bid * 4 + wave; w < ntok * 8; w += nb * 4) {
    const int tok = w >> 3, h = w & 7;
    const float qv = bf2f(p.U[(size_t)tok * UW + U_NAQ + 64 * h + lane]);
    const bool lat = tok < TL;
    const int b = lat ? tok >> 11 : (tok - TL) >> 8;
    int r = 0, cq = 0, R0 = 0, ws = 0;
    if (lat) { const int tt = tok & 2047; r = tt >> 6; cq = tt & 63; R0 = min(max(r - 4, 0), 24); ws = min(max(cq - 8, 0), 48); }
    const int npass = lat ? 6 : 4;
    float sc[6];
#pragma unroll
    for (int ps = 0; ps < 6; ++ps) {
      sc[ps] = -INFINITY;
      if (ps < npass) {
        int ktok; float bias = 0.f;
        const int pw = lat ? ps : ps + 2;
        if (pw < 2) { const int idx = pw * 64 + lane, i = idx >> 4, j = idx & 15; const int kr = R0 + i, kc = ws + j; ktok = b * 2048 + kr * 64 + kc; bias = rpb[(h * 15 + (kr - r + 7)) * 31 + (kc - cq + 15)]; }
        else ktok = TL + b * 256 + (pw - 2) * 64 + lane;
        const bf16_t* kp = p.U + (size_t)ktok * UW + U_NAK + 64 * h;
        float dot = 0.f;
#pragma unroll
        for (int c = 0; c < 8; ++c) {
          const uint4 kk = *(const uint4*)(kp + 8 * c);
          dot += bflo(kk.x) * __shfl(qv, 8 * c + 0) + bfhi(kk.x) * __shfl(qv, 8 * c + 1) + bflo(kk.y) * __shfl(qv, 8 * c + 2) + bfhi(kk.y) * __shfl(qv, 8 * c + 3)
               + bflo(kk.z) * __shfl(qv, 8 * c + 4) + bfhi(kk.z) * __shfl(qv, 8 * c + 5) + bflo(kk.w) * __shfl(qv, 8 * c + 6) + bfhi(kk.w) * __shfl(qv, 8 * c + 7);
        }
        sc[ps] = dot + bias;
      }
    }
    float mx = sc[0];
#pragma unroll
    for (int ps = 1; ps < 6; ++ps) mx = fmaxf(mx, sc[ps]);
    mx = wave_max(mx);
    float sum = 0.f;
#pragma unroll
    for (int ps = 0; ps < 6; ++ps) { sc[ps] = ps < npass ? expf(sc[ps] - mx) : 0.f; sum += sc[ps]; }
    sum = wave_sum(sum);
    const float inv = 1.f / sum;
    float o = 0.f;
#pragma unroll
    for (int ps = 0; ps < 6; ++ps) {
      if (ps < npass) {
        const int pw = lat ? ps : ps + 2;
        for (int src = 0; src < 64; ++src) {
          const float pk = __shfl(sc[ps], src);
          int ktok;
          if (pw < 2) { const int idx = pw * 64 + src, i = idx >> 4, j = idx & 15; ktok = b * 2048 + (R0 + i) * 64 + ws + j; }
          else ktok = TL + b * 256 + (pw - 2) * 64 + src;
          o += pk * bf2f(p.U[(size_t)ktok * UW + U_NAV + 64 * h + lane]);
        }
      }
    }
    p.U[(size_t)tok * UW + U_YA + 64 * h + lane] = f2bf(o * inv);
  }
}

__device__ void phase_gdn_naive(const Params& p, int layer, int bid, int nb) {
  const int lane = threadIdx.x & 63, wave = threadIdx.x >> 6;
  const bool need_ctx = layer == 0;
  for (int ch = bid * 4 + wave; ch < 128; ch += nb * 4) {
    const int dir = ch & 1, h = (ch >> 1) & 7, b = ch >> 4;
    const float* cwp = p.dn_conv_w + (size_t)layer * 5 * 1536;
    float cwq[5], cwk[5], cwv[5];
#pragma unroll
    for (int m = 0; m < 5; ++m) {
      const int j = dir ? 4 - m : m;
      cwq[m] = cwp[j * 1536 + 64 * h + lane]; cwk[m] = cwp[j * 1536 + 512 + 64 * h + lane]; cwv[m] = cwp[j * 1536 + 1024 + 64 * h + lane];
    }
    const float Aneg = -expf(p.dn_a_log[layer * 16 + dir * 8 + h]);
    const float dtb = p.dn_dt_bias[layer * 16 + dir * 8 + h];
    bf16_t* Og = layer == 0 ? p.OG0 + (size_t)dir * TT * 512 : p.OG1 + (size_t)dir * TL * 512;
    float S[64];
#pragma unroll
    for (int d = 0; d < 64; ++d) S[d] = 0.f;
    for (int seg = 0; seg < 2; ++seg) {
      const int L = seg ? 2048 : 256, base = seg ? b * 2048 : TL + b * 256;
      const int start = dir ? L - 1 : 0, step = dir ? -1 : 1;
      const bool want_o = seg == 1 || need_ctx;
      float wq[5], wk[5], wv[5];
#pragma unroll
      for (int m = 0; m < 5; ++m) {
        const int t = start + step * (m - 2);
        const bool ok = t >= 0 && t < L;
        const bf16_t* ur = p.U + (size_t)(base + (ok ? t : 0)) * UW + 64 * h + lane;
        wq[m] = ok ? bf2f(ur[U_DNQ]) : 0.f; wk[m] = ok ? bf2f(ur[U_DNK]) : 0.f; wv[m] = ok ? bf2f(ur[U_DNV]) : 0.f;
      }
      for (int n = 0; n < L; ++n) {
        const int t = start + step * n, row = base + t;
        float q = 0.f, k = 0.f, v = 0.f;
#pragma unroll
        for (int m = 0; m < 5; ++m) { q += cwq[m] * wq[m]; k += cwk[m] * wk[m]; v += cwv[m] * wv[m]; }
        q = siluf(q); k = siluf(k); v = siluf(v);
        {
          const int tn = t + 3 * step;
          const bool ok = tn >= 0 && tn < L;
          const bf16_t* ur = p.U + (size_t)(base + (ok ? tn : 0)) * UW + 64 * h + lane;
#pragma unroll
          for (int m = 0; m < 4; ++m) { wq[m] = wq[m + 1]; wk[m] = wk[m + 1]; wv[m] = wv[m + 1]; }
          wq[4] = ok ? bf2f(ur[U_DNQ]) : 0.f; wk[4] = ok ? bf2f(ur[U_DNK]) : 0.f; wv[4] = ok ? bf2f(ur[U_DNV]) : 0.f;
        }
        k *= rsqrtf(wave_sum(k * k) + EPS);
        q *= rsqrtf(wave_sum(q * q) + EPS);
        if (seg == 1) {
          const int pos = lane < 32 ? (t >> 6) : (t & 63);
          const float cs = p.ROPE[(pos * 16 + (lane & 15)) * 2], sn = p.ROPE[(pos * 16 + (lane & 15)) * 2 + 1];
          const float kp = __shfl_xor(k, 16), qp = __shfl_xor(q, 16);
          k = k * cs + ((lane & 16) ? kp : -kp) * sn;
          q = q * cs + ((lane & 16) ? qp : -qp) * sn;
        }
        q *= 0.125f;
        const float beta = sigmoidf_(p.S[(size_t)row * SWD + dir * 8 + h]);
        const float gl = Aneg * softplusf_(p.S[(size_t)row * SWD + 16 + dir * 8 + h] + dtb);
        const float eg = expf(gl);
        float dot = 0.f;
#pragma unroll
        for (int d = 0; d < 64; ++d) dot += S[d] * __shfl(k, d);
        const float vn = beta * (v - eg * dot);
        float o = 0.f;
#pragma unroll
        for (int d = 0; d < 64; ++d) { S[d] = eg * S[d] + __shfl(k, d) * vn; o += S[d] * __shfl(q, d); }
        if (want_o) Og[(size_t)(seg ? b * 2048 + t : row) * 512 + 64 * h + lane] = f2bf(o);
      }
    }
  }
}

__device__ void phase_ssd_naive(const Params& p, int layer, int dir, int bid, int nb, float* lds) {
  const int tid = threadIdx.x;
  const bool need_ctx = layer == 0;
  float* xs = lds;
  float* Bs = lds + 32 * 64;
  float* Cs = Bs + 32 * 128;
  float* dts = Cs + 32 * 128;
  const float* cw = p.ssd_conv_w + (size_t)layer * 5 * 1536;
  const float* cb = p.ssd_conv_b + (size_t)layer * 1536;
  for (int ch = bid; ch < 128; ch += nb) {
    const int head = ch & 15, b = ch >> 4, grp = head >> 3;
    const float a = -expf(p.ssd_a_log[layer * 32 + dir * 16 + head]);
    const float dtb = p.ssd_dt_bias[layer * 32 + dir * 16 + head];
    const float dsk = p.ssd_d[layer * 16 + head];
    const int pp = tid >> 2, nq = tid & 3;
    float hst[32];
#pragma unroll
    for (int i = 0; i < 32; ++i) hst[i] = 0.f;
    for (int seg = 0; seg < 2; ++seg) {
      const int L = seg ? 2048 : 256, base = seg ? b * 2048 : TL + b * 256;
      const int start = dir ? L - 1 : 0, step = dir ? -1 : 1;
      const bool want_o = seg == 1 || need_ctx;
      for (int n0 = 0; n0 < L; n0 += 32) {
        __syncthreads();
        for (int e = tid; e < 32 * 320; e += 256) {
          const int i = e / 320, cid = e % 320;
          const int t = start + step * (n0 + i);
          int ucol, cch;
          if (cid < 64) { ucol = U_SX + 64 * head + cid; cch = 64 * head + cid; }
          else if (cid < 192) { ucol = U_SB + 128 * grp + (cid - 64); cch = 1024 + 128 * grp + (cid - 64); }
          else { ucol = U_SC + 128 * grp + (cid - 192); cch = 1280 + 128 * grp + (cid - 192); }
          float acc = cb[cch];
#pragma unroll
          for (int j = 0; j < 5; ++j) { const int tj = t - 2 + j; if (tj >= 0 && tj < L) acc += cw[j * 1536 + cch] * bf2f(p.U[(size_t)(base + tj) * UW + ucol]); }
          acc = siluf(acc);
          if (cid < 64) xs[i * 64 + cid] = acc; else if (cid < 192) Bs[i * 128 + cid - 64] = acc; else Cs[i * 128 + cid - 192] = acc;
        }
        if (tid < 32) { const int t = start + step * (n0 + tid); dts[tid] = softplusf_(p.S[(size_t)(base + t) * SWD + 32 + dir * 16 + head] + dtb); }
        __syncthreads();
        for (int i = 0; i < 32; ++i) {
          const int t = start + step * (n0 + i), row = base + t;
          const float dt = dts[i], da = expf(dt * a), xv = xs[i * 64 + pp], dx = dt * xv;
          float y = 0.f;
#pragma unroll
          for (int j = 0; j < 32; ++j) { hst[j] = da * hst[j] + dx * Bs[i * 128 + 32 * nq + j]; y += hst[j] * Cs[i * 128 + 32 * nq + j]; }
          y += __shfl_xor(y, 1); y += __shfl_xor(y, 2);
          if (want_o && nq == 0) {
            bf16_t* dst = p.P + (size_t)row * 1024 + 64 * head + pp;
            if (dir == 0) *dst = f2bf(y + dsk * xv); else *dst = f2bf(bf2f(*dst) + y);
          }
        }
      }
    }
  }
}

__device__ void phase_fin(const Params& p, int layer, int bid, int nb) {
  const int lane = threadIdx.x & 63, wave = threadIdx.x >> 6;
  const int ntok = layer == 0 ? TT : TL;
  for (int tok = bid * 4 + wave; tok < ntok; tok += nb * 4) {
    bf16_t* ur = p.U + (size_t)tok * UW;
    {
      const bf16_t* of = (layer == 0 ? p.OG0 : p.OG1) + (size_t)tok * 512 + 8 * lane;
      const bf16_t* ob = of + (size_t)(layer == 0 ? TT : TL) * 512;
      const uint4 a = *(const uint4*)of, bq = *(const uint4*)ob, z = *(const uint4*)(ur + U_DNZ + 8 * lane);
      float o[8] = {bflo(a.x) + bflo(bq.x), bfhi(a.x) + bfhi(bq.x), bflo(a.y) + bflo(bq.y), bfhi(a.y) + bfhi(bq.y), bflo(a.z) + bflo(bq.z), bfhi(a.z) + bfhi(bq.z), bflo(a.w) + bflo(bq.w), bfhi(a.w) + bfhi(bq.w)};
      const float zz[8] = {bflo(z.x), bfhi(z.x), bflo(z.y), bfhi(z.y), bflo(z.z), bfhi(z.z), bflo(z.w), bfhi(z.w)};
      float ss = 0.f;
#pragma unroll
      for (int i = 0; i < 8; ++i) ss += o[i] * o[i];
      ss += __shfl_xor(ss, 1); ss += __shfl_xor(ss, 2); ss += __shfl_xor(ss, 4);
      const float rs = rsqrtf(ss * (1.f / 64.f) + EPS);
      const float* gn = p.dn_o_gain + layer * 64 + 8 * (lane & 7);
#pragma unroll
      for (int i = 0; i < 8; ++i) o[i] = o[i] * rs * gn[i] * siluf(zz[i]);
      uint4 w; w.x = pack2(o[0], o[1]); w.y = pack2(o[2], o[3]); w.z = pack2(o[4], o[5]); w.w = pack2(o[6], o[7]);
      *(uint4*)(ur + U_YB + 8 * lane) = w;
    }
    {
      float yv[16];
      float ss = 0.f;
#pragma unroll
      for (int hf = 0; hf < 2; ++hf) {
        const uint4 a = *(const uint4*)(p.P + (size_t)tok * 1024 + 16 * lane + 8 * hf), z = *(const uint4*)(ur + U_SZ + 16 * lane + 8 * hf);
        const float av[8] = {bflo(a.x), bfhi(a.x), bflo(a.y), bfhi(a.y), bflo(a.z), bfhi(a.z), bflo(a.w), bfhi(a.w)};
        const float zz[8] = {bflo(z.x), bfhi(z.x), bflo(z.y), bfhi(z.y), bflo(z.z), bfhi(z.z), bflo(z.w), bfhi(z.w)};
#pragma unroll
        for (int i = 0; i < 8; ++i) { const float v = av[i] * siluf(zz[i]); yv[8 * hf + i] = v; ss += v * v; }
      }
      ss += __shfl_xor(ss, 1); ss += __shfl_xor(ss, 2); ss += __shfl_xor(ss, 4); ss += __shfl_xor(ss, 8); ss += __shfl_xor(ss, 16);
      const float rs = rsqrtf(ss * (1.f / 512.f) + EPS);
      const float* gn = p.ssd_o_gain + layer * 1024 + 16 * lane;
#pragma unroll
      for (int hf = 0; hf < 2; ++hf) {
        uint4 w;
        w.x = pack2(yv[8 * hf + 0] * rs * gn[8 * hf + 0], yv[8 * hf + 1] * rs * gn[8 * hf + 1]);
        w.y = pack2(yv[8 * hf + 2] * rs * gn[8 * hf + 2], yv[8 * hf + 3] * rs * gn[8 * hf + 3]);
        w.z = pack2(yv[8 * hf + 4] * rs * gn[8 * hf + 4], yv[8 * hf + 5] * rs * gn[8 * hf + 5]);
        w.w = pack2(yv[8 * hf + 6] * rs * gn[8 * hf + 6], yv[8 * hf + 7] * rs * gn[8 * hf + 7]);
        *(uint4*)(ur + U_YC + 16 * lane + 8 * hf) = w;
      }
    }
  }
}

__global__ void __launch_bounds__(256) k_pro(Params p) { phase_pro(p, blockIdx.x, gridDim.x); }
__global__ void __launch_bounds__(256) k_mod(Params p) { __shared__ float lds[9 * 1024]; phase_mod(p, blockIdx.x, gridDim.x, lds); }
template <int W> __global__ void __launch_bounds__(256) k_gemm(Params p, int layer) {
  __shared__ __attribute__((aligned(16))) bf16_t lds[GEMM_LDS_BYTES / 2];
  if (W == 1) phase_g1(p, layer, blockIdx.x, gridDim.x, lds);
  if (W == 2) phase_g2a(p, layer, blockIdx.x, gridDim.x, lds);
  if (W == 3) phase_g2b(p, layer, blockIdx.x, gridDim.x, lds);
  if (W == 4) phase_g3(p, layer, blockIdx.x, gridDim.x, lds);
  if (W == 5) phase_g4(p, layer, blockIdx.x, gridDim.x, lds);
  if (W == 6) phase_g5(p, layer, blockIdx.x, gridDim.x, lds);
}
__global__ void __launch_bounds__(256) k_na(Params p, int layer) { phase_na_naive(p, layer, blockIdx.x, gridDim.x); }
__global__ void __launch_bounds__(256) k_gdn(Params p, int layer) { phase_gdn_naive(p, layer, blockIdx.x, gridDim.x); }
__global__ void __launch_bounds__(256) k_ssd(Params p, int layer, int dir) { __shared__ float lds[32 * 64 + 2 * 32 * 128 + 32]; phase_ssd_naive(p, layer, dir, blockIdx.x, gridDim.x, lds); }
__global__ void __launch_bounds__(256) k_fin(Params p, int layer) { phase_fin(p, layer, blockIdx.x, gridDim.x); }

extern "C" void kernel_launch(void* const* d_in, const int* in_sizes, int n_in, void* d_out, int out_size, void* d_ws, size_t ws_size,
                              hipStream_t stream) {
  Params p{};
  const float** fp = (const float**)&p;
  for (int i = 0; i < 28; ++i) fp[i] = (const float*)d_in[i];
  p.out = (float*)d_out;
  char* ws = (char*)d_ws;
  size_t off = 0;
  auto take = [&](size_t bytes) { char* r = ws + off; off += (bytes + 255) & ~(size_t)255; return r; };
  p.U = (bf16_t*)take((size_t)TT * UW * 2);
  p.S = (float*)take((size_t)TT * SWD * 4);
  p.MOD = (float*)take((size_t)2 * 9 * 6144 * 4);
  p.SS = (float*)take((size_t)4 * TT * 4);
  p.ROPE = (float*)take(64 * 16 * 2 * 4);
  p.P = (bf16_t*)take((size_t)TT * 1024 * 2);
  p.XC = (float*)take((size_t)TC * 1024 * 4);
  p.OG0 = (bf16_t*)d_out;
  p.OG1 = (bf16_t*)((char*)p.P + (size_t)TL * 1024 * 2);
  const size_t need = (size_t)((char*)p.OG1 - ws) + (size_t)2 * TL * 512 * 2;
  if (need > ws_size) { fprintf(stderr, "workspace too small: need %zu have %zu\n", need, ws_size); return; }
  const int G = 1024;
  k_pro<<<G, 256, 0, stream>>>(p);
  k_mod<<<48, 256, 0, stream>>>(p);
  for (int layer = 0; layer < 2; ++layer) {
    k_gemm<1><<<G, 256, 0, stream>>>(p, layer);
    k_na<<<2048, 256, 0, stream>>>(p, layer);
    k_gdn<<<32, 256, 0, stream>>>(p, layer);
    k_ssd<<<128, 256, 0, stream>>>(p, layer, 0);
    k_ssd<<<128, 256, 0, stream>>>(p, layer, 1);
    k_fin<<<2048, 256, 0, stream>>>(p, layer);
    k_gemm<2><<<G, 256, 0, stream>>>(p, layer);
    k_gemm<3><<<G, 256, 0, stream>>>(p, layer);
    k_gemm<4><<<G, 256, 0, stream>>>(p, layer);
    k_gemm<5><<<G, 256, 0, stream>>>(p, layer);
    k_gemm<6><<<G, 256, 0, stream>>>(p, layer);
  }
}
```

```cpp
#include <hip/hip_runtime.h>
#include <hip/hip_cooperative_groups.h>
#include <cstdio>
#include <cstdint>

typedef unsigned short bf16_t;
typedef short bf16x8 __attribute__((ext_vector_type(8)));
typedef short s16x4 __attribute__((ext_vector_type(4)));
typedef float f32x4 __attribute__((ext_vector_type(4)));
#define LDS_AS __attribute__((address_space(3)))

constexpr int TL = 16384;
constexpr int TC = 2048;
constexpr int TT = TL + TC;
constexpr int DM = 1024;
constexpr int UW = 6144;
constexpr int SWD = 64;
constexpr int DIN = 9280;
constexpr int DFF = 4096;
constexpr float EPS = 1e-6f;
constexpr int U_NAQ = 0, U_NAK = 512, U_NAV = 1024;
constexpr int U_DNQ = 1536, U_DNK = 2048, U_DNV = 2560, U_DNZ = 3072;
constexpr int U_SZ = 3584, U_SX = 4608, U_SB = 5632, U_SC = 5888;
constexpr int U_YA = 0, U_YB = 512, U_YC = 1024, U_GATE = 2048, U_M = 5120;

struct Params {
  const float *x, *c, *ctx, *c_ctx, *w_ada, *b_ada, *norm1_g, *norm2_g, *w_in, *na_q_gain, *na_k_gain, *na_rpb,
      *dn_conv_w, *dn_a_log, *dn_dt_bias, *dn_o_gain, *ssd_conv_w, *ssd_conv_b, *ssd_a_log, *ssd_dt_bias, *ssd_d,
      *ssd_o_gain, *w_pa, *w_pb, *w_pc, *w_out, *w_ff1, *w_ff2;
  float* out;
  bf16_t* U;
  float* S;
  bf16_t* P;
  float* XC;
  float* MOD;
  float* SS;
  float* ROPE;
  unsigned* CTR;
  bf16_t* OG0;
  bf16_t* OG1;
};

__device__ __forceinline__ float bf2f(bf16_t v) { return __uint_as_float(((unsigned)v) << 16); }
__device__ __forceinline__ bf16_t f2bf(float f) {
  unsigned u = __float_as_uint(f);
  u += 0x7fffu + ((u >> 16) & 1u);
  return (bf16_t)(u >> 16);
}
__device__ __forceinline__ unsigned pack2(float a, float b) { return (unsigned)f2bf(a) | ((unsigned)f2bf(b) << 16); }
__device__ __forceinline__ float bflo(unsigned w) { return __uint_as_float(w << 16); }
__device__ __forceinline__ float bfhi(unsigned w) { return __uint_as_float(w & 0xffff0000u); }
__device__ __forceinline__ float wave_sum(float v) {
#pragma unroll
  for (int o = 32; o; o >>= 1) v += __shfl_xor(v, o);
  return v;
}
__device__ __forceinline__ float wave_max(float v) {
#pragma unroll
  for (int o = 32; o; o >>= 1) v = fmaxf(v, __shfl_xor(v, o));
  return v;
}
__device__ __forceinline__ float siluf(float v) { return v / (1.f + expf(-v)); }
__device__ __forceinline__ float sigmoidf_(float v) { return 1.f / (1.f + expf(-v)); }
__device__ __forceinline__ float softplusf_(float v) { return v > 20.f ? v : log1pf(expf(v)); }

__device__ __forceinline__ const float* xrow_in(const Params& p, int layer, int row) {
  if (layer == 0) return row < TL ? p.x + (size_t)row * DM : p.ctx + (size_t)(row - TL) * DM;
  return row < TL ? p.out + (size_t)row * DM : p.XC + (size_t)(row - TL) * DM;
}
__device__ __forceinline__ float* xrow_out(const Params& p, int row) {
  return row < TL ? p.out + (size_t)row * DM : p.XC + (size_t)(row - TL) * DM;
}
__device__ __forceinline__ int modrow(int row) { return row < TL ? (row >> 11) : 8; }

constexpr int BK = 32;
constexpr int ASTR = BK + 8;
constexpr int BSTR = 128 + 16;
constexpr int A_TILE = 128 * ASTR;
constexpr int B_TILE = BK * BSTR;
constexpr int GEMM_LDS_BYTES = 2 * (A_TILE + B_TILE) * 2;

struct ALoadBf16 {
  const bf16_t* base; int stride;
  __device__ __forceinline__ uint4 load8(int row, int k) const { return *(const uint4*)(base + (size_t)row * stride + k); }
};
struct ALoadNorm {
  const float* xl; const float* xc; const float* ss; const float* alpha_base; const float* shift_base;
  __device__ __forceinline__ uint4 load8(int row, int k) const {
    const float* xr = (row < TL ? xl + (size_t)row * DM : xc + (size_t)(row - TL) * DM) + k;
    const float4 a = *(const float4*)xr, b = *(const float4*)(xr + 4);
    const float rs = rsqrtf(ss[row] * (1.f / DM) + EPS);
    const int mr = modrow(row) * 6144 + k;
    const float4 g0 = *(const float4*)(alpha_base + mr), g1 = *(const float4*)(alpha_base + mr + 4);
    const float4 s0 = *(const float4*)(shift_base + mr), s1 = *(const float4*)(shift_base + mr + 4);
    uint4 o;
    o.x = pack2(a.x * rs * g0.x + s0.x, a.y * rs * g0.y + s0.y);
    o.y = pack2(a.z * rs * g0.z + s0.z, a.w * rs * g0.w + s0.w);
    o.z = pack2(b.x * rs * g1.x + s1.x, b.y * rs * g1.y + s1.y);
    o.w = pack2(b.z * rs * g1.z + s1.z, b.w * rs * g1.w + s1.w);
    return o;
  }
};
struct BLoadW {
  const float* w; int ldw; int col0;
  __device__ __forceinline__ uint4 load8(int k, int n) const {
    const float* s = w + (size_t)k * ldw + col0 + n;
    const float4 a = *(const float4*)s, b = *(const float4*)(s + 4);
    uint4 o; o.x = pack2(a.x, a.y); o.y = pack2(a.z, a.w); o.z = pack2(b.x, b.y); o.w = pack2(b.z, b.w);
    return o;
  }
};
struct BLoadWin {
  const float* w; int n0;
  __device__ __forceinline__ uint4 load8(int k, int n) const {
    const int nn = n0 + n;
    int src;
    if (nn < 3584) src = nn;
    else if (nn < 6144) src = nn + 32;
    else { const int o = nn - 6144; src = o < 32 ? 3584 + o : (o < 64 ? 6176 + (o - 32) : -1); }
    if (src < 0) return make_uint4(0, 0, 0, 0);
    const float* s = w + (size_t)k * DIN + src;
    const float4 a = *(const float4*)s, b = *(const float4*)(s + 4);
    uint4 o; o.x = pack2(a.x, a.y); o.y = pack2(a.z, a.w); o.z = pack2(b.x, b.y); o.w = pack2(b.z, b.w);
    return o;
  }
};

template <class AL, class BL>
__device__ __forceinline__ void gemm_mainloop(f32x4 (&acc)[4][4], const AL& al, const BL& bl, int m0, int K, bf16_t* lds) {
  const int tid = threadIdx.x, lane = tid & 63, wave = tid >> 6, wm = wave >> 1, wn = wave & 1;
  const int g = lane >> 4, l15 = lane & 15;
  bf16_t* As = lds;
  bf16_t* Bs = lds + 2 * A_TILE;
  const int ar0 = tid >> 2, ak0 = (tid & 3) * 8;
  const int ar1 = ar0 + 64;
  const int bk0 = tid >> 4, bn0 = (tid & 15) * 8;
  const int bk1 = bk0 + 16;
  auto rho = [](int k) { return (k & 3) + 4 * ((k >> 3) & 3) + 16 * ((k >> 2) & 1); };
  const int brow0 = rho(bk0), brow1 = rho(bk1);
  uint4 ra0, ra1, rb0, rb1;
  ra0 = al.load8(m0 + ar0, ak0); ra1 = al.load8(m0 + ar1, ak0);
  rb0 = bl.load8(bk0, bn0);      rb1 = bl.load8(bk1, bn0);
  *(uint4*)(As + ar0 * ASTR + ak0) = ra0; *(uint4*)(As + ar1 * ASTR + ak0) = ra1;
  *(uint4*)(Bs + brow0 * BSTR + bn0) = rb0; *(uint4*)(Bs + brow1 * BSTR + bn0) = rb1;
  __syncthreads();
  const int nk = K / BK;
  const int q4 = l15 >> 2, p4 = lane & 3;
  for (int kt = 0; kt < nk; ++kt) {
    const int cur = kt & 1;
    if (kt + 1 < nk) {
      const int k1 = (kt + 1) * BK;
      ra0 = al.load8(m0 + ar0, k1 + ak0); ra1 = al.load8(m0 + ar1, k1 + ak0);
      rb0 = bl.load8(k1 + bk0, bn0);      rb1 = bl.load8(k1 + bk1, bn0);
    }
    const bf16_t* Ac = As + cur * A_TILE + (64 * wm + l15) * ASTR + 8 * g;
    const bf16_t* Bc = Bs + cur * B_TILE + (4 * g + q4) * BSTR + 64 * wn + 4 * p4;
    bf16x8 af[4], bfr[4];
#pragma unroll
    for (int mi = 0; mi < 4; ++mi) af[mi] = *(const bf16x8*)(Ac + mi * 16 * ASTR);
#pragma unroll
    for (int ni = 0; ni < 4; ++ni) {
      const s16x4 lo = __builtin_amdgcn_ds_read_tr16_b64_v4i16((LDS_AS s16x4*)(Bc + ni * 16));
      const s16x4 hi = __builtin_amdgcn_ds_read_tr16_b64_v4i16((LDS_AS s16x4*)(Bc + 16 * BSTR + ni * 16));
      bfr[ni] = (bf16x8){lo[0], lo[1], lo[2], lo[3], hi[0], hi[1], hi[2], hi[3]};
    }
#pragma unroll
    for (int mi = 0; mi < 4; ++mi)
#pragma unroll
      for (int ni = 0; ni < 4; ++ni)
        acc[mi][ni] = __builtin_amdgcn_mfma_f32_16x16x32_bf16(bfr[ni], af[mi], acc[mi][ni], 0, 0, 0);
    if (kt + 1 < nk) {
      const int nx = cur ^ 1;
      *(uint4*)(As + nx * A_TILE + ar0 * ASTR + ak0) = ra0; *(uint4*)(As + nx * A_TILE + ar1 * ASTR + ak0) = ra1;
      *(uint4*)(Bs + nx * B_TILE + brow0 * BSTR + bn0) = rb0; *(uint4*)(Bs + nx * B_TILE + brow1 * BSTR + bn0) = rb1;
    }
    __syncthreads();
  }
}
__device__ __forceinline__ void acc_zero(f32x4 (&acc)[4][4]) {
#pragma unroll
  for (int i = 0; i < 4; ++i)
#pragma unroll
    for (int j = 0; j < 4; ++j) acc[i][j] = (f32x4){0.f, 0.f, 0.f, 0.f};
}
__device__ __forceinline__ void tile_coord(int t, int nMt, int nNt, int& mt, int& nt) {
  const int per = 8 * nNt;
  const int grp = t / per, r = t % per;
  const int gsz = (nMt - grp * 8) < 8 ? (nMt - grp * 8) : 8;
  mt = grp * 8 + r % gsz; nt = r / gsz;
}

__device__ __forceinline__ void phase_pro(const Params& p, int bid, int nb) {
  const int tid = threadIdx.x, lane = tid & 63, wave = tid >> 6;
  for (int row = bid * 4 + wave; row < TT; row += nb * 4) {
    const float* xr = xrow_in(p, 0, row);
    float s = 0.f;
#pragma unroll
    for (int i = 0; i < 4; ++i) { const float4 v = *(const float4*)(xr + lane * 4 + 256 * i); s += v.x * v.x + v.y * v.y + v.z * v.z + v.w * v.w; }
    s = wave_sum(s);
    if (lane == 0) { p.SS[row] = s; p.SS[TT + row] = 0.f; p.SS[2 * TT + row] = 0.f; p.SS[3 * TT + row] = 0.f; }
  }
  if (bid == 0 && tid < 16) p.CTR[tid] = 0u;
  for (int i = bid * 256 + tid; i < 64 * 16; i += nb * 256) {
    const int pos = i >> 4, fi = i & 15;
    const float inv = powf(10000.f, -(float)fi / 16.f);
    const float ang = (float)pos * inv;
    p.ROPE[2 * i] = cosf(ang); p.ROPE[2 * i + 1] = sinf(ang);
  }
}
__device__ __forceinline__ void phase_mod(const Params& p, int bid, int nb, float* lds) {
  const int tid = threadIdx.x;
  for (int u = bid; u < 48; u += nb) {
    const int l = u / 24, cb = u % 24, n = cb * 256 + tid;
    for (int i = tid; i < 9 * 1024; i += 256) { const int r = i >> 10, k = i & 1023; const float v = r < 8 ? p.c[r * 1024 + k] : p.c_ctx[k]; lds[i] = siluf(v); }
    __syncthreads();
    float acc[9];
#pragma unroll
    for (int r = 0; r < 9; ++r) acc[r] = 0.f;
    const float* w = p.w_ada + (size_t)l * 1024 * 6144 + n;
    for (int k = 0; k < 1024; ++k) {
      const float wv = w[(size_t)k * 6144];
#pragma unroll
      for (int r = 0; r < 9; ++r) acc[r] += lds[r * 1024 + k] * wv;
    }
    const float bias = p.b_ada[l * 6144 + n];
    const int chunk = n >> 10, kk = n & 1023;
#pragma unroll
    for (int r = 0; r < 9; ++r) {
      float v = acc[r] + bias;
      if (chunk == 1) v = p.norm1_g[l * 1024 + kk] * (1.f + v);
      if (chunk == 4) v = p.norm2_g[l * 1024 + kk] * (1.f + v);
      p.MOD[(size_t)(l * 9 + r) * 6144 + n] = v;
    }
    __syncthreads();
  }
}

__device__ __forceinline__ void phase_g1(const Params& p, int layer, int bid, int nb, bf16_t* lds) {
  const int nMt = TT / 128, nNt = 49, total = nMt * nNt;
  const int lane = threadIdx.x & 63, wave = threadIdx.x >> 6, wm = wave >> 1, wn = wave & 1, g = lane >> 4, l15 = lane & 15;
  const float* modl = p.MOD + (size_t)layer * 9 * 6144;
  ALoadNorm al{layer == 0 ? p.x : p.out, layer == 0 ? p.ctx : p.XC, p.SS + (size_t)(2 * layer) * TT, modl + 1024, modl};
  for (int t = bid; t < total; t += nb) {
    int mt, nt; tile_coord(t, nMt, nNt, mt, nt);
    const int m0 = mt * 128, n0 = nt * 128;
    BLoadWin bl{p.w_in + (size_t)layer * 1024 * DIN, n0};
    f32x4 acc[4][4]; acc_zero(acc);
    gemm_mainloop(acc, al, bl, m0, 1024, lds);
    if (n0 < 1024) {
      const float* gain = (n0 < 512 ? p.na_q_gain : p.na_k_gain) + layer * 64;
      const float mul = n0 < 512 ? 0.125f : 1.f;
#pragma unroll
      for (int mi = 0; mi < 4; ++mi) {
        float ss = 0.f;
#pragma unroll
        for (int ni = 0; ni < 4; ++ni) ss += acc[mi][ni][0] * acc[mi][ni][0] + acc[mi][ni][1] * acc[mi][ni][1] + acc[mi][ni][2] * acc[mi][ni][2] + acc[mi][ni][3] * acc[mi][ni][3];
        ss += __shfl_xor(ss, 16); ss += __shfl_xor(ss, 32);
        const float rs = rsqrtf(ss * (1.f / 64.f) + EPS) * mul;
        const int row = m0 + 64 * wm + 16 * mi + l15;
#pragma unroll
        for (int ni = 0; ni < 4; ++ni) {
          const int cl = 16 * ni + 4 * g;
          const float4 gv = *(const float4*)(gain + cl);
          uint2 o; o.x = pack2(acc[mi][ni][0] * rs * gv.x, acc[mi][ni][1] * rs * gv.y); o.y = pack2(acc[mi][ni][2] * rs * gv.z, acc[mi][ni][3] * rs * gv.w);
          *(uint2*)(p.U + (size_t)row * UW + n0 + 64 * wn + cl) = o;
        }
      }
    } else if (n0 < 6144) {
#pragma unroll
      for (int mi = 0; mi < 4; ++mi) {
        const int row = m0 + 64 * wm + 16 * mi + l15;
#pragma unroll
        for (int ni = 0; ni < 4; ++ni) {
          uint2 o; o.x = pack2(acc[mi][ni][0], acc[mi][ni][1]); o.y = pack2(acc[mi][ni][2], acc[mi][ni][3]);
          *(uint2*)(p.U + (size_t)row * UW + n0 + 64 * wn + 16 * ni + 4 * g) = o;
        }
      }
    } else if (wn == 0) {
#pragma unroll
      for (int mi = 0; mi < 4; ++mi) {
        const int row = m0 + 64 * wm + 16 * mi + l15;
#pragma unroll
        for (int ni = 0; ni < 4; ++ni) *(f32x4*)(p.S + (size_t)row * SWD + 16 * ni + 4 * g) = acc[mi][ni];
      }
    }
  }
}

__device__ __forceinline__ void phase_g2a(const Params& p, int layer, int bid, int nb, bf16_t* lds) {
  const int nMt = (layer == 0 ? TT : TL) / 128, nNt = 24, total = nMt * nNt;
  const int lane = threadIdx.x & 63, wave = threadIdx.x >> 6, wm = wave >> 1, wn = wave & 1, g = lane >> 4, l15 = lane & 15;
  const float* modl = p.MOD + (size_t)layer * 9 * 6144;
  ALoadNorm al{layer == 0 ? p.x : p.out, layer == 0 ? p.ctx : p.XC, p.SS + (size_t)(2 * layer) * TT, modl + 1024, modl};
  for (int t = bid; t < total; t += nb) {
    int mt, nt; tile_coord(t, nMt, nNt, mt, nt);
    const int m0 = mt * 128, n0 = nt * 128;
    BLoadW bl{p.w_in + (size_t)layer * 1024 * DIN, DIN, 6208 + n0};
    f32x4 acc[4][4]; acc_zero(acc);
    gemm_mainloop(acc, al, bl, m0, 1024, lds);
#pragma unroll
    for (int mi = 0; mi < 4; ++mi) {
      const int row = m0 + 64 * wm + 16 * mi + l15;
#pragma unroll
      for (int ni = 0; ni < 4; ++ni) {
        uint2 o; o.x = pack2(sigmoidf_(acc[mi][ni][0]), sigmoidf_(acc[mi][ni][1])); o.y = pack2(sigmoidf_(acc[mi][ni][2]), sigmoidf_(acc[mi][ni][3]));
        *(uint2*)(p.U + (size_t)row * UW + U_GATE + n0 + 64 * wn + 16 * ni + 4 * g) = o;
      }
    }
  }
}
__device__ __forceinline__ void phase_g2b(const Params& p, int layer, int bid, int nb, bf16_t* lds) {
  const int nMt = (layer == 0 ? TT : TL) / 128, nNt = 8, total = nMt * nNt;
  const int lane = threadIdx.x & 63, wave = threadIdx.x >> 6, wm = wave >> 1, wn = wave & 1, g = lane >> 4, l15 = lane & 15;
  for (int t = bid; t < total; t += nb) {
    int mt, nt; tile_coord(t, nMt, nNt, mt, nt);
    const int m0 = mt * 128, n0 = nt * 128;
    f32x4 accm[4][4]; acc_zero(accm);
#pragma unroll 1
    for (int i = 0; i < 3; ++i) {
      const int ycol = i == 0 ? U_YA : (i == 1 ? U_YB : U_YC);
      const int Ki = i == 2 ? 1024 : 512;
      const float* w = i == 0 ? p.w_pa + (size_t)layer * 512 * 1024 : (i == 1 ? p.w_pb + (size_t)layer * 512 * 1024 : p.w_pc + (size_t)layer * 1024 * 1024);
      ALoadBf16 al{p.U + ycol, UW};
      BLoadW bl{w, 1024, n0};
      f32x4 acc[4][4]; acc_zero(acc);
      gemm_mainloop(acc, al, bl, m0, Ki, lds);
#pragma unroll
      for (int mi = 0; mi < 4; ++mi) {
        const int row = m0 + 64 * wm + 16 * mi + l15;
#pragma unroll
        for (int ni = 0; ni < 4; ++ni) {
          const uint2 gt = *(const uint2*)(p.U + (size_t)row * UW + U_GATE + 1024 * i + n0 + 64 * wn + 16 * ni + 4 * g);
          accm[mi][ni][0] += bflo(gt.x) * acc[mi][ni][0]; accm[mi][ni][1] += bfhi(gt.x) * acc[mi][ni][1];
          accm[mi][ni][2] += bflo(gt.y) * acc[mi][ni][2]; accm[mi][ni][3] += bfhi(gt.y) * acc[mi][ni][3];
        }
      }
    }
#pragma unroll
    for (int mi = 0; mi < 4; ++mi) {
      const int row = m0 + 64 * wm + 16 * mi + l15;
#pragma unroll
      for (int ni = 0; ni < 4; ++ni) {
        uint2 o; o.x = pack2(accm[mi][ni][0], accm[mi][ni][1]); o.y = pack2(accm[mi][ni][2], accm[mi][ni][3]);
        *(uint2*)(p.U + (size_t)row * UW + U_M + n0 + 64 * wn + 16 * ni + 4 * g) = o;
      }
    }
  }
}
__device__ __forceinline__ void epi_residual(const Params& p, const f32x4 (&acc)[4][4], int layer_in, int m0, int n0, const float* gate, float* ssacc) {
  const int lane = threadIdx.x & 63, wave = threadIdx.x >> 6, wm = wave >> 1, wn = wave & 1, g = lane >> 4, l15 = lane & 15;
#pragma unroll
  for (int mi = 0; mi < 4; ++mi) {
    const int row = m0 + 64 * wm + 16 * mi + l15;
    const float* xi = xrow_in(p, layer_in, row);
    float* xo = xrow_out(p, row);
    const float* gr = gate + modrow(row) * 6144;
    float ss = 0.f;
#pragma unroll
    for (int ni = 0; ni < 4; ++ni) {
      const int col = n0 + 64 * wn + 16 * ni + 4 * g;
      const float4 xv = *(const float4*)(xi + col);
      const float4 gv = *(const float4*)(gr + col);
      float4 o;
      o.x = xv.x + gv.x * acc[mi][ni][0]; o.y = xv.y + gv.y * acc[mi][ni][1]; o.z = xv.z + gv.z * acc[mi][ni][2]; o.w = xv.w + gv.w * acc[mi][ni][3];
      *(float4*)(xo + col) = o;
      ss += o.x * o.x + o.y * o.y + o.z * o.z + o.w * o.w;
    }
    if (ssacc) {
      ss += __shfl_xor(ss, 16); ss += __shfl_xor(ss, 32);
      if (g == 0) atomicAdd(ssacc + row, ss);
    }
  }
}
__device__ __forceinline__ void phase_g3(const Params& p, int layer, int bid, int nb, bf16_t* lds) {
  const int nMt = (layer == 0 ? TT : TL) / 128, nNt = 8, total = nMt * nNt;
  const float* modl = p.MOD + (size_t)layer * 9 * 6144;
  ALoadBf16 al{p.U + U_M, UW};
  for (int t = bid; t < total; t += nb) {
    int mt, nt; tile_coord(t, nMt, nNt, mt, nt);
    const int m0 = mt * 128, n0 = nt * 128;
    BLoadW bl{p.w_out + (size_t)layer * 1024 * 1024, 1024, n0};
    f32x4 acc[4][4]; acc_zero(acc);
    gemm_mainloop(acc, al, bl, m0, 1024, lds);
    epi_residual(p, acc, layer, m0, n0, modl + 2048, p.SS + (size_t)(2 * layer + 1) * TT);
  }
}
__device__ __forceinline__ void phase_g4(const Params& p, int layer, int bid, int nb, bf16_t* lds) {
  const int nMt = (layer == 0 ? TT : TL) / 128, nNt = 32, total = nMt * nNt;
  const int lane = threadIdx.x & 63, wave = threadIdx.x >> 6, wm = wave >> 1, wn = wave & 1, g = lane >> 4, l15 = lane & 15;
  const float* modl = p.MOD + (size_t)layer * 9 * 6144;
  ALoadNorm al{p.out, p.XC, p.SS + (size_t)(2 * layer + 1) * TT, modl + 4096, modl + 3072};
  for (int t = bid; t < total; t += nb) {
    int mt, nt; tile_coord(t, nMt, nNt, mt, nt);
    const int m0 = mt * 128, n0 = nt * 128;
    BLoadW bl{p.w_ff1 + (size_t)layer * 1024 * DFF, DFF, n0};
    f32x4 acc[4][4]; acc_zero(acc);
    gemm_mainloop(acc, al, bl, m0, 1024, lds);
#pragma unroll
    for (int mi = 0; mi < 4; ++mi) {
      const int row = m0 + 64 * wm + 16 * mi + l15;
#pragma unroll
      for (int ni = 0; ni < 4; ++ni) {
        float v0 = fmaxf(acc[mi][ni][0], 0.f), v1 = fmaxf(acc[mi][ni][1], 0.f), v2 = fmaxf(acc[mi][ni][2], 0.f), v3 = fmaxf(acc[mi][ni][3], 0.f);
        uint2 o; o.x = pack2(v0 * v0, v1 * v1); o.y = pack2(v2 * v2, v3 * v3);
        *(uint2*)(p.U + (size_t)row * DFF + n0 + 64 * wn + 16 * ni + 4 * g) = o;
      }
    }
  }
}
__device__ __forceinline__ void phase_g5(const Params& p, int layer, int bid, int nb, bf16_t* lds) {
  const int nMt = (layer == 0 ? TT : TL) / 128, nNt = 8, total = nMt * nNt;
  const float* modl = p.MOD + (size_t)layer * 9 * 6144;
  ALoadBf16 al{p.U, DFF};
  for (int t = bid; t < total; t += nb) {
    int mt, nt; tile_coord(t, nMt, nNt, mt, nt);
    const int m0 = mt * 128, n0 = nt * 128;
    BLoadW bl{p.w_ff2 + (size_t)layer * DFF * 1024, 1024, n0};
    f32x4 acc[4][4]; acc_zero(acc);
    gemm_mainloop(acc, al, bl, m0, DFF, lds);
    epi_residual(p, acc, 1, m0, n0, modl + 5120, layer == 0 ? p.SS + (size_t)2 * TT : nullptr);
  }
}

__device__ __forceinline__ void phase_na_naive(const Params& p, int layer, unsigned* ctr) {
  const int lane = threadIdx.x & 63;
  const int ntok = layer == 0 ? TT : TL;
  const float* rpb = p.na_rpb + (size_t)layer * 8 * 15 * 31;
  for (;;) {
    int w0 = 0;
    if (lane == 0) w0 = (int)atomicAdd(ctr, 1u);
    const int w = __shfl(w0, 0);
    if (w >= ntok * 8) break;
    const int tok = w >> 3, h = w & 7;
    const bool lat = tok < TL;
    const int b = lat ? tok >> 11 : (tok - TL) >> 8;
    int r = 0, cq = 0, R0 = 0, ws = 0;
    if (lat) { const int tt = tok & 2047; r = tt >> 6; cq = tt & 63; R0 = min(max(r - 4, 0), 24); ws = min(max(cq - 8, 0), 48); }
    const int npass = lat ? 6 : 4;
    float sc[6];
#pragma unroll
    for (int ps = 0; ps < 6; ++ps) {
      sc[ps] = -INFINITY;
      if (ps < npass) {
        int ktok; float bias = 0.f;
        const int pw = lat ? ps : ps + 2;
        if (pw < 2) { const int idx = pw * 64 + lane, i = idx >> 4, j = idx & 15; const int kr = R0 + i, kc = ws + j; ktok = b * 2048 + kr * 64 + kc; bias = rpb[(h * 15 + (kr - r + 7)) * 31 + (kc - cq + 15)]; }
        else ktok = TL + b * 256 + (pw - 2) * 64 + lane;
        const bf16_t* kp = p.U + (size_t)ktok * UW + U_NAK + 64 * h;
        float dot = 0.f;
        const bf16_t* qp = p.U + (size_t)tok * UW + U_NAQ + 64 * h;
#pragma unroll
        for (int c = 0; c < 8; ++c) {
          const uint4 kk = *(const uint4*)(kp + 8 * c);
          const uint4 qq = *(const uint4*)(qp + 8 * c);
          dot += bflo(kk.x) * bflo(qq.x) + bfhi(kk.x) * bfhi(qq.x) + bflo(kk.y) * bflo(qq.y) + bfhi(kk.y) * bfhi(qq.y)
               + bflo(kk.z) * bflo(qq.z) + bfhi(kk.z) * bfhi(qq.z) + bflo(kk.w) * bflo(qq.w) + bfhi(kk.w) * bfhi(qq.w);
        }
        sc[ps] = dot + bias;
      }
    }
    float mx = sc[0];
#pragma unroll
    for (int ps = 1; ps < 6; ++ps) mx = fmaxf(mx, sc[ps]);
    mx = wave_max(mx);
    float sum = 0.f;
#pragma unroll
    for (int ps = 0; ps < 6; ++ps) { sc[ps] = ps < npass ? expf(sc[ps] - mx) : 0.f; sum += sc[ps]; }
    sum = wave_sum(sum);
    const float inv = 1.f / sum;
    float o = 0.f;
#pragma unroll
    for (int ps = 0; ps < 6; ++ps) {
      if (ps < npass) {
        const int pw = lat ? ps : ps + 2;
        for (int src = 0; src < 64; ++src) {
          const float pk = __shfl(sc[ps], src);
          int ktok;
          if (pw < 2) { const int idx = pw * 64 + src, i = idx >> 4, j = idx & 15; ktok = b * 2048 + (R0 + i) * 64 + ws + j; }
          else ktok = TL + b * 256 + (pw - 2) * 64 + src;
          o += pk * bf2f(p.U[(size_t)ktok * UW + U_NAV + 64 * h + lane]);
        }
      }
    }
    p.U[(size_t)tok * UW + U_YA + 64 * h + lane] = f2bf(o * inv);
  }
}

__device__ __forceinline__ void phase_gdn_naive(const Params& p, int layer, int bid, int nb, float* lds) {
  const int lane = threadIdx.x & 63, wave = threadIdx.x >> 6;
  float* kq = lds + wave * 128;
  const bool need_ctx = layer == 0;
  for (int ch = bid * 4 + wave; ch < 128; ch += nb * 4) {
    const int dir = ch & 1, h = (ch >> 1) & 7, b = ch >> 4;
    const float* cwp = p.dn_conv_w + (size_t)layer * 5 * 1536;
    float cwq[5], cwk[5], cwv[5];
#pragma unroll
    for (int m = 0; m < 5; ++m) {
      const int j = dir ? 4 - m : m;
      cwq[m] = cwp[j * 1536 + 64 * h + lane]; cwk[m] = cwp[j * 1536 + 512 + 64 * h + lane]; cwv[m] = cwp[j * 1536 + 1024 + 64 * h + lane];
    }
    const float Aneg = -expf(p.dn_a_log[layer * 16 + dir * 8 + h]);
    const float dtb = p.dn_dt_bias[layer * 16 + dir * 8 + h];
    bf16_t* Og = layer == 0 ? p.OG0 + (size_t)dir * TT * 512 : p.OG1 + (size_t)dir * TL * 512;
    float S[64];
#pragma unroll
    for (int d = 0; d < 64; ++d) S[d] = 0.f;
    for (int seg = 0; seg < 2; ++seg) {
      const int L = seg ? 2048 : 256, base = seg ? b * 2048 : TL + b * 256;
      const int start = dir ? L - 1 : 0, step = dir ? -1 : 1;
      const bool want_o = seg == 1 || need_ctx;
      float wq[5], wk[5], wv[5];
#pragma unroll
      for (int m = 0; m < 5; ++m) {
        const int t = start + step * (m - 2);
        const bool ok = t >= 0 && t < L;
        const bf16_t* ur = p.U + (size_t)(base + (ok ? t : 0)) * UW + 64 * h + lane;
        wq[m] = ok ? bf2f(ur[U_DNQ]) : 0.f; wk[m] = ok ? bf2f(ur[U_DNK]) : 0.f; wv[m] = ok ? bf2f(ur[U_DNV]) : 0.f;
      }
      for (int n = 0; n < L; ++n) {
        const int t = start + step * n, row = base + t;
        float q = 0.f, k = 0.f, v = 0.f;
#pragma unroll
        for (int m = 0; m < 5; ++m) { q += cwq[m] * wq[m]; k += cwk[m] * wk[m]; v += cwv[m] * wv[m]; }
        q = siluf(q); k = siluf(k); v = siluf(v);
        {
          const int tn = t + 3 * step;
          const bool ok = tn >= 0 && tn < L;
          const bf16_t* ur = p.U + (size_t)(base + (ok ? tn : 0)) * UW + 64 * h + lane;
#pragma unroll
          for (int m = 0; m < 4; ++m) { wq[m] = wq[m + 1]; wk[m] = wk[m + 1]; wv[m] = wv[m + 1]; }
          wq[4] = ok ? bf2f(ur[U_DNQ]) : 0.f; wk[4] = ok ? bf2f(ur[U_DNK]) : 0.f; wv[4] = ok ? bf2f(ur[U_DNV]) : 0.f;
        }
        k *= rsqrtf(wave_sum(k * k) + EPS);
        q *= rsqrtf(wave_sum(q * q) + EPS);
        if (seg == 1) {
          const int pos = lane < 32 ? (t >> 6) : (t & 63);
          const float cs = p.ROPE[(pos * 16 + (lane & 15)) * 2], sn = p.ROPE[(pos * 16 + (lane & 15)) * 2 + 1];
          const float kp = __shfl_xor(k, 16), qp = __shfl_xor(q, 16);
          k = k * cs + ((lane & 16) ? kp : -kp) * sn;
          q = q * cs + ((lane & 16) ? qp : -qp) * sn;
        }
        q *= 0.125f;
        const float beta = sigmoidf_(p.S[(size_t)row * SWD + dir * 8 + h]);
        const float gl = Aneg * softplusf_(p.S[(size_t)row * SWD + 16 + dir * 8 + h] + dtb);
        const float eg = expf(gl);
        kq[lane] = k; kq[64 + lane] = q;
        __builtin_amdgcn_fence(__ATOMIC_RELEASE, "workgroup"); __builtin_amdgcn_wave_barrier(); __builtin_amdgcn_fence(__ATOMIC_ACQUIRE, "workgroup");
        float dot = 0.f;
#pragma unroll
        for (int d = 0; d < 64; d += 4) { const float4 kk = *(const float4*)(kq + d); dot += S[d] * kk.x + S[d + 1] * kk.y + S[d + 2] * kk.z + S[d + 3] * kk.w; }
        const float vn = beta * (v - eg * dot);
        float o = 0.f;
#pragma unroll
        for (int d = 0; d < 64; d += 4) {
          const float4 kk = *(const float4*)(kq + d), qq = *(const float4*)(kq + 64 + d);
          S[d] = eg * S[d] + kk.x * vn; o += S[d] * qq.x;
          S[d + 1] = eg * S[d + 1] + kk.y * vn; o += S[d + 1] * qq.y;
          S[d + 2] = eg * S[d + 2] + kk.z * vn; o += S[d + 2] * qq.z;
          S[d + 3] = eg * S[d + 3] + kk.w * vn; o += S[d + 3] * qq.w;
        }
        __builtin_amdgcn_fence(__ATOMIC_RELEASE, "workgroup"); __builtin_amdgcn_wave_barrier(); __builtin_amdgcn_fence(__ATOMIC_ACQUIRE, "workgroup");
        if (want_o) Og[(size_t)(seg ? b * 2048 + t : row) * 512 + 64 * h + lane] = f2bf(o);
      }
    }
  }
}

__device__ __forceinline__ void phase_ssd_naive(const Params& p, int layer, int dir, int bid, int nb, float* lds) {
  const int tid = threadIdx.x;
  const bool need_ctx = layer == 0;
  float* xs = lds;
  float* Bs = lds + 32 * 64;
  float* Cs = Bs + 32 * 128;
  float* dts = Cs + 32 * 128;
  const float* cw = p.ssd_conv_w + (size_t)layer * 5 * 1536;
  const float* cb = p.ssd_conv_b + (size_t)layer * 1536;
  for (int ch = bid; ch < 128; ch += nb) {
    const int head = ch & 15, b = ch >> 4, grp = head >> 3;
    const float a = -expf(p.ssd_a_log[layer * 32 + dir * 16 + head]);
    const float dtb = p.ssd_dt_bias[layer * 32 + dir * 16 + head];
    const float dsk = p.ssd_d[layer * 16 + head];
    const int pp = tid >> 2, nq = tid & 3;
    float hst[32];
#pragma unroll
    for (int i = 0; i < 32; ++i) hst[i] = 0.f;
    for (int seg = 0; seg < 2; ++seg) {
      const int L = seg ? 2048 : 256, base = seg ? b * 2048 : TL + b * 256;
      const int start = dir ? L - 1 : 0, step = dir ? -1 : 1;
      const bool want_o = seg == 1 || need_ctx;
      for (int n0 = 0; n0 < L; n0 += 32) {
        __syncthreads();
        for (int e = tid; e < 32 * 320; e += 256) {
          const int i = e / 320, cid = e % 320;
          const int t = start + step * (n0 + i);
          int ucol, cch;
          if (cid < 64) { ucol = U_SX + 64 * head + cid; cch = 64 * head + cid; }
          else if (cid < 192) { ucol = U_SB + 128 * grp + (cid - 64); cch = 1024 + 128 * grp + (cid - 64); }
          else { ucol = U_SC + 128 * grp + (cid - 192); cch = 1280 + 128 * grp + (cid - 192); }
          float acc = cb[cch];
#pragma unroll
          for (int j = 0; j < 5; ++j) { const int tj = t - 2 + j; if (tj >= 0 && tj < L) acc += cw[j * 1536 + cch] * bf2f(p.U[(size_t)(base + tj) * UW + ucol]); }
          acc = siluf(acc);
          if (cid < 64) xs[i * 64 + cid] = acc; else if (cid < 192) Bs[i * 128 + cid - 64] = acc; else Cs[i * 128 + cid - 192] = acc;
        }
        if (tid < 32) { const int t = start + step * (n0 + tid); dts[tid] = softplusf_(p.S[(size_t)(base + t) * SWD + 32 + dir * 16 + head] + dtb); }
        __syncthreads();
        for (int i = 0; i < 32; ++i) {
          const int t = start + step * (n0 + i), row = base + t;
          const float dt = dts[i], da = expf(dt * a), xv = xs[i * 64 + pp], dx = dt * xv;
          float y = 0.f;
#pragma unroll
          for (int j = 0; j < 32; ++j) { hst[j] = da * hst[j] + dx * Bs[i * 128 + 32 * nq + j]; y += hst[j] * Cs[i * 128 + 32 * nq + j]; }
          y += __shfl_xor(y, 1); y += __shfl_xor(y, 2);
          if (want_o && nq == 0) {
            bf16_t* dst = p.P + (size_t)row * 1024 + 64 * head + pp;
            if (dir == 0) *dst = f2bf(y + dsk * xv); else *dst = f2bf(bf2f(*dst) + y);
          }
        }
      }
    }
  }
}

__device__ __forceinline__ void phase_fin(const Params& p, int layer, int bid, int nb) {
  const int lane = threadIdx.x & 63, wave = threadIdx.x >> 6;
  const int ntok = layer == 0 ? TT : TL;
  for (int tok = bid * 4 + wave; tok < ntok; tok += nb * 4) {
    bf16_t* ur = p.U + (size_t)tok * UW;
    {
      const bf16_t* of = (layer == 0 ? p.OG0 : p.OG1) + (size_t)tok * 512 + 8 * lane;
      const bf16_t* ob = of + (size_t)(layer == 0 ? TT : TL) * 512;
      const uint4 a = *(const uint4*)of, bq = *(const uint4*)ob, z = *(const uint4*)(ur + U_DNZ + 8 * lane);
      float o[8] = {bflo(a.x) + bflo(bq.x), bfhi(a.x) + bfhi(bq.x), bflo(a.y) + bflo(bq.y), bfhi(a.y) + bfhi(bq.y), bflo(a.z) + bflo(bq.z), bfhi(a.z) + bfhi(bq.z), bflo(a.w) + bflo(bq.w), bfhi(a.w) + bfhi(bq.w)};
      const float zz[8] = {bflo(z.x), bfhi(z.x), bflo(z.y), bfhi(z.y), bflo(z.z), bfhi(z.z), bflo(z.w), bfhi(z.w)};
      float ss = 0.f;
#pragma unroll
      for (int i = 0; i < 8; ++i) ss += o[i] * o[i];
      ss += __shfl_xor(ss, 1); ss += __shfl_xor(ss, 2); ss += __shfl_xor(ss, 4);
      const float rs = rsqrtf(ss * (1.f / 64.f) + EPS);
      const float* gn = p.dn_o_gain + layer * 64 + 8 * (lane & 7);
#pragma unroll
      for (int i = 0; i < 8; ++i) o[i] = o[i] * rs * gn[i] * siluf(zz[i]);
      uint4 w; w.x = pack2(o[0], o[1]); w.y = pack2(o[2], o[3]); w.z = pack2(o[4], o[5]); w.w = pack2(o[6], o[7]);
      *(uint4*)(ur + U_YB + 8 * lane) = w;
    }
    {
      float yv[16];
      float ss = 0.f;
#pragma unroll
      for (int hf = 0; hf < 2; ++hf) {
        const uint4 a = *(const uint4*)(p.P + (size_t)tok * 1024 + 16 * lane + 8 * hf), z = *(const uint4*)(ur + U_SZ + 16 * lane + 8 * hf);
        const float av[8] = {bflo(a.x), bfhi(a.x), bflo(a.y), bfhi(a.y), bflo(a.z), bfhi(a.z), bflo(a.w), bfhi(a.w)};
        const float zz[8] = {bflo(z.x), bfhi(z.x), bflo(z.y), bfhi(z.y), bflo(z.z), bfhi(z.z), bflo(z.w), bfhi(z.w)};
#pragma unroll
        for (int i = 0; i < 8; ++i) { const float v = av[i] * siluf(zz[i]); yv[8 * hf + i] = v; ss += v * v; }
      }
      ss += __shfl_xor(ss, 1); ss += __shfl_xor(ss, 2); ss += __shfl_xor(ss, 4); ss += __shfl_xor(ss, 8); ss += __shfl_xor(ss, 16);
      const float rs = rsqrtf(ss * (1.f / 512.f) + EPS);
      const float* gn = p.ssd_o_gain + layer * 1024 + 16 * lane;
#pragma unroll
      for (int hf = 0; hf < 2; ++hf) {
        uint4 w;
        w.x = pack2(yv[8 * hf + 0] * rs * gn[8 * hf + 0], yv[8 * hf + 1] * rs * gn[8 * hf + 1]);
        w.y = pack2(yv[8 * hf + 2] * rs * gn[8 * hf + 2], yv[8 * hf + 3] * rs * gn[8 * hf + 3]);
        w.z = pack2(yv[8 * hf + 4] * rs * gn[8 * hf + 4], yv[8 * hf + 5] * rs * gn[8 * hf + 5]);
        w.w = pack2(yv[8 * hf + 6] * rs * gn[8 * hf + 6], yv[8 * hf + 7] * rs * gn[8 * hf + 7]);
        *(uint4*)(ur + U_YC + 16 * lane + 8 * hf) = w;
      }
    }
  }
}

namespace cg = cooperative_groups;
constexpr int MEGA_LDS = 41088;
__global__ void __launch_bounds__(256) k_mega(Params p) {
  cg::grid_group grid = cg::this_grid();
  __shared__ __attribute__((aligned(16))) char smem[MEGA_LDS];
  const int bid = blockIdx.x, nb = gridDim.x;
  phase_pro(p, bid, nb);
  phase_mod(p, bid, nb, (float*)smem);
  grid.sync();
  for (int layer = 0; layer < 2; ++layer) {
    phase_g1(p, layer, bid, nb, (bf16_t*)smem);
    grid.sync();
    if (bid < 32) phase_gdn_naive(p, layer, bid, 32, (float*)smem);
    else if (bid < 160) phase_ssd_naive(p, layer, 0, bid - 32, 128, (float*)smem);
    phase_na_naive(p, layer, p.CTR + layer);
    grid.sync();
    phase_ssd_naive(p, layer, 1, bid, nb, (float*)smem);
    grid.sync();
    phase_fin(p, layer, bid, nb);
    grid.sync();
    phase_g2a(p, layer, bid, nb, (bf16_t*)smem);
    grid.sync();
    phase_g2b(p, layer, bid, nb, (bf16_t*)smem);
    grid.sync();
    phase_g3(p, layer, bid, nb, (bf16_t*)smem);
    grid.sync();
    phase_g4(p, layer, bid, nb, (bf16_t*)smem);
    grid.sync();
    phase_g5(p, layer, bid, nb, (bf16_t*)smem);
    if (layer == 0) grid.sync();
  }
}

extern "C" void kernel_launch(void* const* d_in, const int* in_sizes, int n_in, void* d_out, int out_size, void* d_ws, size_t ws_size,
                              hipStream_t stream) {
  Params p{};
  const float** fp = (const float**)&p;
  for (int i = 0; i < 28; ++i) fp[i] = (const float*)d_in[i];
  p.out = (float*)d_out;
  char* ws = (char*)d_ws;
  size_t off = 0;
  auto take = [&](size_t bytes) { char* r = ws + off; off += (bytes + 255) & ~(size_t)255; return r; };
  p.U = (bf16_t*)take((size_t)TT * UW * 2);
  p.S = (float*)take((size_t)TT * SWD * 4);
  p.MOD = (float*)take((size_t)2 * 9 * 6144 * 4);
  p.SS = (float*)take((size_t)4 * TT * 4);
  p.ROPE = (float*)take(64 * 16 * 2 * 4);
  p.CTR = (unsigned*)take(256);
  p.P = (bf16_t*)take((size_t)TT * 1024 * 2);
  p.XC = (float*)take((size_t)TC * 1024 * 4);
  p.OG0 = (bf16_t*)d_out;
  p.OG1 = (bf16_t*)((char*)p.P + (size_t)TL * 1024 * 2);
  const size_t need = (size_t)((char*)p.OG1 - ws) + (size_t)2 * TL * 512 * 2;
  if (need > ws_size) { fprintf(stderr, "workspace too small: need %zu have %zu\n", need, ws_size); return; }
  static int grid_blocks = 0;
  if (!grid_blocks) {
    int dev = 0, cus = 0, per_cu = 0;
    hipGetDevice(&dev);
    hipDeviceGetAttribute(&cus, hipDeviceAttributeMultiprocessorCount, dev);
    hipOccupancyMaxActiveBlocksPerMultiprocessor(&per_cu, k_mega, 256, 0);
    if (per_cu > 2) per_cu = 2;
    grid_blocks = cus * per_cu;
  }
  void* args[] = {&p};
  hipError_t e = hipLaunchCooperativeKernel((void*)k_mega, dim3(grid_blocks), dim3(256), args, 0, stream);
  if (e != hipSuccess) fprintf(stderr, "cooperative launch failed: %s (grid %d)\n", hipGetErrorString(e), grid_blocks);
}
```

```cpp
#include <hip/hip_runtime.h>
#include <hip/hip_cooperative_groups.h>
#include <cstdio>
#include <cstdint>

typedef unsigned short bf16_t;
typedef short bf16x8 __attribute__((ext_vector_type(8)));
typedef short s16x4 __attribute__((ext_vector_type(4)));
typedef float f32x4 __attribute__((ext_vector_type(4)));
#define LDS_AS __attribute__((address_space(3)))

constexpr int TL = 16384;
constexpr int TC = 2048;
constexpr int TT = TL + TC;
constexpr int DM = 1024;
constexpr int UW = 6144;
constexpr int SWD = 64;
constexpr int DIN = 9280;
constexpr int DFF = 4096;
constexpr float EPS = 1e-6f;
constexpr int U_NAQ = 0, U_NAK = 512, U_NAV = 1024;
constexpr int U_DNQ = 1536, U_DNK = 2048, U_DNV = 2560, U_DNZ = 3072;
constexpr int U_SZ = 3584, U_SX = 4608, U_SB = 5632, U_SC = 5888;
constexpr int U_YA = 0, U_YB = 512, U_YC = 1024, U_GATE = 2048, U_M = 5120;

struct Params {
  const float *x, *c, *ctx, *c_ctx, *w_ada, *b_ada, *norm1_g, *norm2_g, *w_in, *na_q_gain, *na_k_gain, *na_rpb,
      *dn_conv_w, *dn_a_log, *dn_dt_bias, *dn_o_gain, *ssd_conv_w, *ssd_conv_b, *ssd_a_log, *ssd_dt_bias, *ssd_d,
      *ssd_o_gain, *w_pa, *w_pb, *w_pc, *w_out, *w_ff1, *w_ff2;
  float* out;
  bf16_t* U;
  float* S;
  bf16_t* P;
  float* XC;
  float* MOD;
  float* SS;
  float* ROPE;
  unsigned* CTR;
  bf16_t* HB;
  bf16_t* OG0;
  bf16_t* OG1;
};

__device__ __forceinline__ int tidx() { int t = threadIdx.x; asm volatile("" : "+v"(t)); return t; }
__device__ __forceinline__ float bf2f(bf16_t v) { return __uint_as_float(((unsigned)v) << 16); }
__device__ __forceinline__ bf16_t f2bf(float f) {
  unsigned u = __float_as_uint(f);
  u += 0x7fffu + ((u >> 16) & 1u);
  return (bf16_t)(u >> 16);
}
__device__ __forceinline__ unsigned pack2(float a, float b) { return (unsigned)f2bf(a) | ((unsigned)f2bf(b) << 16); }
__device__ __forceinline__ float bflo(unsigned w) { return __uint_as_float(w << 16); }
__device__ __forceinline__ float bfhi(unsigned w) { return __uint_as_float(w & 0xffff0000u); }
__device__ __forceinline__ float wave_sum(float v) {
#pragma unroll
  for (int o = 32; o; o >>= 1) v += __shfl_xor(v, o);
  return v;
}
__device__ __forceinline__ float wave_max(float v) {
#pragma unroll
  for (int o = 32; o; o >>= 1) v = fmaxf(v, __shfl_xor(v, o));
  return v;
}
__device__ __forceinline__ float siluf(float v) { return v / (1.f + expf(-v)); }
__device__ __forceinline__ float sigmoidf_(float v) { return 1.f / (1.f + expf(-v)); }
__device__ __forceinline__ float softplusf_(float v) { return v > 20.f ? v : log1pf(expf(v)); }

__device__ __forceinline__ const float* xrow_in(const Params& p, int layer, int row) {
  if (layer == 0) return row < TL ? p.x + (size_t)row * DM : p.ctx + (size_t)(row - TL) * DM;
  return row < TL ? p.out + (size_t)row * DM : p.XC + (size_t)(row - TL) * DM;
}
__device__ __forceinline__ float* xrow_out(const Params& p, int row) {
  return row < TL ? p.out + (size_t)row * DM : p.XC + (size_t)(row - TL) * DM;
}
__device__ __forceinline__ int modrow(int row) { return row < TL ? (row >> 11) : 8; }

constexpr int BK = 32;
constexpr int ASTR = BK + 8;
constexpr int BSTR = 128 + 16;
constexpr int A_TILE = 128 * ASTR;
constexpr int B_TILE = BK * BSTR;
constexpr int GEMM_LDS_BYTES = 2 * (A_TILE + B_TILE) * 2;

struct ALoadBf16 {
  const bf16_t* base; int stride;
  __device__ __forceinline__ uint4 load8(int row, int k) const { return *(const uint4*)(base + (size_t)row * stride + k); }
};
struct ALoadNorm {
  const float* xl; const float* xc; const float* ss; const float* alpha_base; const float* shift_base;
  __device__ __forceinline__ uint4 load8(int row, int k) const {
    const float* xr = (row < TL ? xl + (size_t)row * DM : xc + (size_t)(row - TL) * DM) + k;
    const float4 a = *(const float4*)xr, b = *(const float4*)(xr + 4);
    const float rs = rsqrtf(ss[row] * (1.f / DM) + EPS);
    const int mr = modrow(row) * 6144 + k;
    const float4 g0 = *(const float4*)(alpha_base + mr), g1 = *(const float4*)(alpha_base + mr + 4);
    const float4 s0 = *(const float4*)(shift_base + mr), s1 = *(const float4*)(shift_base + mr + 4);
    uint4 o;
    o.x = pack2(a.x * rs * g0.x + s0.x, a.y * rs * g0.y + s0.y);
    o.y = pack2(a.z * rs * g0.z + s0.z, a.w * rs * g0.w + s0.w);
    o.z = pack2(b.x * rs * g1.x + s1.x, b.y * rs * g1.y + s1.y);
    o.w = pack2(b.z * rs * g1.z + s1.z, b.w * rs * g1.w + s1.w);
    return o;
  }
};
struct BLoadW {
  const float* w; int ldw; int col0;
  __device__ __forceinline__ uint4 load8(int k, int n) const {
    const float* s = w + (size_t)k * ldw + col0 + n;
    const float4 a = *(const float4*)s, b = *(const float4*)(s + 4);
    uint4 o; o.x = pack2(a.x, a.y); o.y = pack2(a.z, a.w); o.z = pack2(b.x, b.y); o.w = pack2(b.z, b.w);
    return o;
  }
};
struct BLoadWin {
  const float* w; int n0;
  __device__ __forceinline__ uint4 load8(int k, int n) const {
    const int nn = n0 + n;
    int src;
    if (nn < 3584) src = nn;
    else if (nn < 6144) src = nn + 32;
    else { const int o = nn - 6144; src = o < 32 ? 3584 + o : (o < 64 ? 6176 + (o - 32) : -1); }
    if (src < 0) return make_uint4(0, 0, 0, 0);
    const float* s = w + (size_t)k * DIN + src;
    const float4 a = *(const float4*)s, b = *(const float4*)(s + 4);
    uint4 o; o.x = pack2(a.x, a.y); o.y = pack2(a.z, a.w); o.z = pack2(b.x, b.y); o.w = pack2(b.z, b.w);
    return o;
  }
};

template <class AL, class BL>
__device__ __forceinline__ void gemm_mainloop(f32x4 (&acc)[4][4], const AL& al, const BL& bl, int m0, int K, bf16_t* lds) {
  const int tid = tidx(), lane = tid & 63, wave = tid >> 6, wm = wave >> 1, wn = wave & 1;
  const int g = lane >> 4, l15 = lane & 15;
  bf16_t* As = lds;
  bf16_t* Bs = lds + 2 * A_TILE;
  const int ar0 = tid >> 2, ak0 = (tid & 3) * 8;
  const int ar1 = ar0 + 64;
  const int bk0 = tid >> 4, bn0 = (tid & 15) * 8;
  const int bk1 = bk0 + 16;
  auto rho = [](int k) { return (k & 3) + 4 * ((k >> 3) & 3) + 16 * ((k >> 2) & 1); };
  const int brow0 = rho(bk0), brow1 = rho(bk1);
  uint4 ra0, ra1, rb0, rb1;
  ra0 = al.load8(m0 + ar0, ak0); ra1 = al.load8(m0 + ar1, ak0);
  rb0 = bl.load8(bk0, bn0);      rb1 = bl.load8(bk1, bn0);
  *(uint4*)(As + ar0 * ASTR + ak0) = ra0; *(uint4*)(As + ar1 * ASTR + ak0) = ra1;
  *(uint4*)(Bs + brow0 * BSTR + bn0) = rb0; *(uint4*)(Bs + brow1 * BSTR + bn0) = rb1;
  __syncthreads();
  const int nk = K / BK;
  const int q4 = l15 >> 2, p4 = lane & 3;
  for (int kt = 0; kt < nk; ++kt) {
    const int cur = kt & 1;
    if (kt + 1 < nk) {
      const int k1 = (kt + 1) * BK;
      ra0 = al.load8(m0 + ar0, k1 + ak0); ra1 = al.load8(m0 + ar1, k1 + ak0);
      rb0 = bl.load8(k1 + bk0, bn0);      rb1 = bl.load8(k1 + bk1, bn0);
    }
    const bf16_t* Ac = As + cur * A_TILE + (64 * wm + l15) * ASTR + 8 * g;
    const bf16_t* Bc = Bs + cur * B_TILE + (4 * g + q4) * BSTR + 64 * wn + 4 * p4;
    bf16x8 af[4], bfr[4];
#pragma unroll
    for (int mi = 0; mi < 4; ++mi) af[mi] = *(const bf16x8*)(Ac + mi * 16 * ASTR);
#pragma unroll
    for (int ni = 0; ni < 4; ++ni) {
      const s16x4 lo = __builtin_amdgcn_ds_read_tr16_b64_v4i16((LDS_AS s16x4*)(Bc + ni * 16));
      const s16x4 hi = __builtin_amdgcn_ds_read_tr16_b64_v4i16((LDS_AS s16x4*)(Bc + 16 * BSTR + ni * 16));
      bfr[ni] = (bf16x8){lo[0], lo[1], lo[2], lo[3], hi[0], hi[1], hi[2], hi[3]};
    }
#pragma unroll
    for (int mi = 0; mi < 4; ++mi)
#pragma unroll
      for (int ni = 0; ni < 4; ++ni)
        acc[mi][ni] = __builtin_amdgcn_mfma_f32_16x16x32_bf16(bfr[ni], af[mi], acc[mi][ni], 0, 0, 0);
    if (kt + 1 < nk) {
      const int nx = cur ^ 1;
      *(uint4*)(As + nx * A_TILE + ar0 * ASTR + ak0) = ra0; *(uint4*)(As + nx * A_TILE + ar1 * ASTR + ak0) = ra1;
      *(uint4*)(Bs + nx * B_TILE + brow0 * BSTR + bn0) = rb0; *(uint4*)(Bs + nx * B_TILE + brow1 * BSTR + bn0) = rb1;
    }
    __syncthreads();
  }
}
__device__ __forceinline__ void acc_zero(f32x4 (&acc)[4][4]) {
#pragma unroll
  for (int i = 0; i < 4; ++i)
#pragma unroll
    for (int j = 0; j < 4; ++j) acc[i][j] = (f32x4){0.f, 0.f, 0.f, 0.f};
}
__device__ __forceinline__ void tile_coord(int t, int nMt, int nNt, int& mt, int& nt) {
  const int per = 8 * nNt;
  const int grp = t / per, r = t % per;
  const int gsz = (nMt - grp * 8) < 8 ? (nMt - grp * 8) : 8;
  mt = grp * 8 + r % gsz; nt = r / gsz;
}

__device__ __forceinline__ void phase_pro(const Params& p, int bid, int nb) {
  const int tid = tidx(), lane = tid & 63, wave = tid >> 6;
  for (int row = bid * 4 + wave; row < TT; row += nb * 4) {
    const float* xr = xrow_in(p, 0, row);
    float s = 0.f;
#pragma unroll
    for (int i = 0; i < 4; ++i) { const float4 v = *(const float4*)(xr + lane * 4 + 256 * i); s += v.x * v.x + v.y * v.y + v.z * v.z + v.w * v.w; }
    s = wave_sum(s);
    if (lane == 0) { p.SS[row] = s; p.SS[TT + row] = 0.f; p.SS[2 * TT + row] = 0.f; p.SS[3 * TT + row] = 0.f; }
  }
  if (bid == 0 && tid < 16) p.CTR[tid] = 0u;
  for (int i = bid * 256 + tid; i < 64 * 16; i += nb * 256) {
    const int pos = i >> 4, fi = i & 15;
    const float inv = powf(10000.f, -(float)fi / 16.f);
    const float ang = (float)pos * inv;
    p.ROPE[2 * i] = cosf(ang); p.ROPE[2 * i + 1] = sinf(ang);
  }
}
__device__ __forceinline__ void phase_mod(const Params& p, int bid, int nb, float* lds) {
  const int tid = tidx();
  for (int u = bid; u < 48; u += nb) {
    const int l = u / 24, cb = u % 24, n = cb * 256 + tid;
    for (int i = tid; i < 9 * 1024; i += 256) { const int r = i >> 10, k = i & 1023; const float v = r < 8 ? p.c[r * 1024 + k] : p.c_ctx[k]; lds[i] = siluf(v); }
    __syncthreads();
    float acc[9];
#pragma unroll
    for (int r = 0; r < 9; ++r) acc[r] = 0.f;
    const float* w = p.w_ada + (size_t)l * 1024 * 6144 + n;
    for (int k = 0; k < 1024; ++k) {
      const float wv = w[(size_t)k * 6144];
#pragma unroll
      for (int r = 0; r < 9; ++r) acc[r] += lds[r * 1024 + k] * wv;
    }
    const float bias = p.b_ada[l * 6144 + n];
    const int chunk = n >> 10, kk = n & 1023;
#pragma unroll
    for (int r = 0; r < 9; ++r) {
      float v = acc[r] + bias;
      if (chunk == 1) v = p.norm1_g[l * 1024 + kk] * (1.f + v);
      if (chunk == 4) v = p.norm2_g[l * 1024 + kk] * (1.f + v);
      p.MOD[(size_t)(l * 9 + r) * 6144 + n] = v;
    }
    __syncthreads();
  }
}

__device__ __forceinline__ void phase_g1(const Params& p, int layer, int bid, int nb, bf16_t* lds) {
  const int nMt = TT / 128, nNt = 49, total = nMt * nNt;
  const int lane = tidx() & 63, wave = tidx() >> 6, wm = wave >> 1, wn = wave & 1, g = lane >> 4, l15 = lane & 15;
  const float* modl = p.MOD + (size_t)layer * 9 * 6144;
  ALoadNorm al{layer == 0 ? p.x : p.out, layer == 0 ? p.ctx : p.XC, p.SS + (size_t)(2 * layer) * TT, modl + 1024, modl};
  for (int t = bid; t < total; t += nb) {
    int mt, nt; tile_coord(t, nMt, nNt, mt, nt);
    const int m0 = mt * 128, n0 = nt * 128;
    BLoadWin bl{p.w_in + (size_t)layer * 1024 * DIN, n0};
    f32x4 acc[4][4]; acc_zero(acc);
    gemm_mainloop(acc, al, bl, m0, 1024, lds);
    if (n0 < 1024) {
      const float* gain = (n0 < 512 ? p.na_q_gain : p.na_k_gain) + layer * 64;
      const float mul = n0 < 512 ? 0.125f : 1.f;
#pragma unroll
      for (int mi = 0; mi < 4; ++mi) {
        float ss = 0.f;
#pragma unroll
        for (int ni = 0; ni < 4; ++ni) ss += acc[mi][ni][0] * acc[mi][ni][0] + acc[mi][ni][1] * acc[mi][ni][1] + acc[mi][ni][2] * acc[mi][ni][2] + acc[mi][ni][3] * acc[mi][ni][3];
        ss += __shfl_xor(ss, 16); ss += __shfl_xor(ss, 32);
        const float rs = rsqrtf(ss * (1.f / 64.f) + EPS) * mul;
        const int row = m0 + 64 * wm + 16 * mi + l15;
#pragma unroll
        for (int ni = 0; ni < 4; ++ni) {
          const int cl = 16 * ni + 4 * g;
          const float4 gv = *(const float4*)(gain + cl);
          uint2 o; o.x = pack2(acc[mi][ni][0] * rs * gv.x, acc[mi][ni][1] * rs * gv.y); o.y = pack2(acc[mi][ni][2] * rs * gv.z, acc[mi][ni][3] * rs * gv.w);
          *(uint2*)(p.U + (size_t)row * UW + n0 + 64 * wn + cl) = o;
        }
      }
    } else if (n0 < 6144) {
#pragma unroll
      for (int mi = 0; mi < 4; ++mi) {
        const int row = m0 + 64 * wm + 16 * mi + l15;
        const int rr = row & 63;
        const bool halo = (rr < 2 || rr >= 62) && ((n0 >= 1536 && n0 < 3072) || n0 >= 4608);
        const int hcol0 = n0 < 3072 ? n0 - 1536 : n0 - 3072;
        bf16_t* hb = p.HB + ((size_t)(row >> 6) * 4 + (rr < 2 ? rr : rr - 60)) * 3072 + hcol0 + 64 * wn + 4 * g;
#pragma unroll
        for (int ni = 0; ni < 4; ++ni) {
          uint2 o; o.x = pack2(acc[mi][ni][0], acc[mi][ni][1]); o.y = pack2(acc[mi][ni][2], acc[mi][ni][3]);
          *(uint2*)(p.U + (size_t)row * UW + n0 + 64 * wn + 16 * ni + 4 * g) = o;
          if (halo) *(uint2*)(hb + 16 * ni) = o;
        }
      }
    } else if (wn == 0) {
#pragma unroll
      for (int mi = 0; mi < 4; ++mi) {
        const int row = m0 + 64 * wm + 16 * mi + l15;
#pragma unroll
        for (int ni = 0; ni < 4; ++ni) *(f32x4*)(p.S + (size_t)row * SWD + 16 * ni + 4 * g) = acc[mi][ni];
      }
    }
  }
}

__device__ __forceinline__ void phase_g2a(const Params& p, int layer, int bid, int nb, bf16_t* lds) {
  const int nMt = (layer == 0 ? TT : TL) / 128, nNt = 24, total = nMt * nNt;
  const int lane = tidx() & 63, wave = tidx() >> 6, wm = wave >> 1, wn = wave & 1, g = lane >> 4, l15 = lane & 15;
  const float* modl = p.MOD + (size_t)layer * 9 * 6144;
  ALoadNorm al{layer == 0 ? p.x : p.out, layer == 0 ? p.ctx : p.XC, p.SS + (size_t)(2 * layer) * TT, modl + 1024, modl};
  for (int t = bid; t < total; t += nb) {
    int mt, nt; tile_coord(t, nMt, nNt, mt, nt);
    const int m0 = mt * 128, n0 = nt * 128;
    BLoadW bl{p.w_in + (size_t)layer * 1024 * DIN, DIN, 6208 + n0};
    f32x4 acc[4][4]; acc_zero(acc);
    gemm_mainloop(acc, al, bl, m0, 1024, lds);
#pragma unroll
    for (int mi = 0; mi < 4; ++mi) {
      const int row = m0 + 64 * wm + 16 * mi + l15;
#pragma unroll
      for (int ni = 0; ni < 4; ++ni) {
        uint2 o; o.x = pack2(sigmoidf_(acc[mi][ni][0]), sigmoidf_(acc[mi][ni][1])); o.y = pack2(sigmoidf_(acc[mi][ni][2]), sigmoidf_(acc[mi][ni][3]));
        *(uint2*)(p.U + (size_t)row * UW + U_GATE + n0 + 64 * wn + 16 * ni + 4 * g) = o;
      }
    }
  }
}
__device__ __forceinline__ void phase_g2b(const Params& p, int layer, int bid, int nb, bf16_t* lds) {
  const int nMt = (layer == 0 ? TT : TL) / 128, nNt = 8, total = nMt * nNt;
  const int lane = tidx() & 63, wave = tidx() >> 6, wm = wave >> 1, wn = wave & 1, g = lane >> 4, l15 = lane & 15;
  for (int t = bid; t < total; t += nb) {
    int mt, nt; tile_coord(t, nMt, nNt, mt, nt);
    const int m0 = mt * 128, n0 = nt * 128;
    f32x4 accm[4][4]; acc_zero(accm);
#pragma unroll 1
    for (int i = 0; i < 3; ++i) {
      const int ycol = i == 0 ? U_YA : (i == 1 ? U_YB : U_YC);
      const int Ki = i == 2 ? 1024 : 512;
      const float* w = i == 0 ? p.w_pa + (size_t)layer * 512 * 1024 : (i == 1 ? p.w_pb + (size_t)layer * 512 * 1024 : p.w_pc + (size_t)layer * 1024 * 1024);
      ALoadBf16 al{p.U + ycol, UW};
      BLoadW bl{w, 1024, n0};
      f32x4 acc[4][4]; acc_zero(acc);
      gemm_mainloop(acc, al, bl, m0, Ki, lds);
#pragma unroll
      for (int mi = 0; mi < 4; ++mi) {
        const int row = m0 + 64 * wm + 16 * mi + l15;
#pragma unroll
        for (int ni = 0; ni < 4; ++ni) {
          const uint2 gt = *(const uint2*)(p.U + (size_t)row * UW + U_GATE + 1024 * i + n0 + 64 * wn + 16 * ni + 4 * g);
          accm[mi][ni][0] += bflo(gt.x) * acc[mi][ni][0]; accm[mi][ni][1] += bfhi(gt.x) * acc[mi][ni][1];
          accm[mi][ni][2] += bflo(gt.y) * acc[mi][ni][2]; accm[mi][ni][3] += bfhi(gt.y) * acc[mi][ni][3];
        }
      }
    }
#pragma unroll
    for (int mi = 0; mi < 4; ++mi) {
      const int row = m0 + 64 * wm + 16 * mi + l15;
#pragma unroll
      for (int ni = 0; ni < 4; ++ni) {
        uint2 o; o.x = pack2(accm[mi][ni][0], accm[mi][ni][1]); o.y = pack2(accm[mi][ni][2], accm[mi][ni][3]);
        *(uint2*)(p.U + (size_t)row * UW + U_M + n0 + 64 * wn + 16 * ni + 4 * g) = o;
      }
    }
  }
}
__device__ __forceinline__ void epi_residual(const Params& p, const f32x4 (&acc)[4][4], int layer_in, int m0, int n0, const float* gate, float* ssacc) {
  const int lane = tidx() & 63, wave = tidx() >> 6, wm = wave >> 1, wn = wave & 1, g = lane >> 4, l15 = lane & 15;
#pragma unroll
  for (int mi = 0; mi < 4; ++mi) {
    const int row = m0 + 64 * wm + 16 * mi + l15;
    const float* xi = xrow_in(p, layer_in, row);
    float* xo = xrow_out(p, row);
    const float* gr = gate + modrow(row) * 6144;
    float ss = 0.f;
#pragma unroll
    for (int ni = 0; ni < 4; ++ni) {
      const int col = n0 + 64 * wn + 16 * ni + 4 * g;
      const float4 xv = *(const float4*)(xi + col);
      const float4 gv = *(const float4*)(gr + col);
      float4 o;
      o.x = xv.x + gv.x * acc[mi][ni][0]; o.y = xv.y + gv.y * acc[mi][ni][1]; o.z = xv.z + gv.z * acc[mi][ni][2]; o.w = xv.w + gv.w * acc[mi][ni][3];
      *(float4*)(xo + col) = o;
      ss += o.x * o.x + o.y * o.y + o.z * o.z + o.w * o.w;
    }
    if (ssacc) {
      ss += __shfl_xor(ss, 16); ss += __shfl_xor(ss, 32);
      if (g == 0) atomicAdd(ssacc + row, ss);
    }
  }
}
__device__ __forceinline__ void phase_g3(const Params& p, int layer, int bid, int nb, bf16_t* lds) {
  const int nMt = (layer == 0 ? TT : TL) / 128, nNt = 8, total = nMt * nNt;
  const float* modl = p.MOD + (size_t)layer * 9 * 6144;
  ALoadBf16 al{p.U + U_M, UW};
  for (int t = bid; t < total; t += nb) {
    int mt, nt; tile_coord(t, nMt, nNt, mt, nt);
    const int m0 = mt * 128, n0 = nt * 128;
    BLoadW bl{p.w_out + (size_t)layer * 1024 * 1024, 1024, n0};
    f32x4 acc[4][4]; acc_zero(acc);
    gemm_mainloop(acc, al, bl, m0, 1024, lds);
    epi_residual(p, acc, layer, m0, n0, modl + 2048, p.SS + (size_t)(2 * layer + 1) * TT);
  }
}
__device__ __forceinline__ void phase_g4(const Params& p, int layer, int bid, int nb, bf16_t* lds) {
  const int nMt = (layer == 0 ? TT : TL) / 128, nNt = 32, total = nMt * nNt;
  const int lane = tidx() & 63, wave = tidx() >> 6, wm = wave >> 1, wn = wave & 1, g = lane >> 4, l15 = lane & 15;
  const float* modl = p.MOD + (size_t)layer * 9 * 6144;
  ALoadNorm al{p.out, p.XC, p.SS + (size_t)(2 * layer + 1) * TT, modl + 4096, modl + 3072};
  for (int t = bid; t < total; t += nb) {
    int mt, nt; tile_coord(t, nMt, nNt, mt, nt);
    const int m0 = mt * 128, n0 = nt * 128;
    BLoadW bl{p.w_ff1 + (size_t)layer * 1024 * DFF, DFF, n0};
    f32x4 acc[4][4]; acc_zero(acc);
    gemm_mainloop(acc, al, bl, m0, 1024, lds);
#pragma unroll
    for (int mi = 0; mi < 4; ++mi) {
      const int row = m0 + 64 * wm + 16 * mi + l15;
#pragma unroll
      for (int ni = 0; ni < 4; ++ni) {
        float v0 = fmaxf(acc[mi][ni][0], 0.f), v1 = fmaxf(acc[mi][ni][1], 0.f), v2 = fmaxf(acc[mi][ni][2], 0.f), v3 = fmaxf(acc[mi][ni][3], 0.f);
        uint2 o; o.x = pack2(v0 * v0, v1 * v1); o.y = pack2(v2 * v2, v3 * v3);
        *(uint2*)(p.U + (size_t)row * DFF + n0 + 64 * wn + 16 * ni + 4 * g) = o;
      }
    }
  }
}
__device__ __forceinline__ void phase_g5(const Params& p, int layer, int bid, int nb, bf16_t* lds) {
  const int nMt = (layer == 0 ? TT : TL) / 128, nNt = 8, total = nMt * nNt;
  const float* modl = p.MOD + (size_t)layer * 9 * 6144;
  ALoadBf16 al{p.U, DFF};
  for (int t = bid; t < total; t += nb) {
    int mt, nt; tile_coord(t, nMt, nNt, mt, nt);
    const int m0 = mt * 128, n0 = nt * 128;
    BLoadW bl{p.w_ff2 + (size_t)layer * DFF * 1024, 1024, n0};
    f32x4 acc[4][4]; acc_zero(acc);
    gemm_mainloop(acc, al, bl, m0, DFF, lds);
    epi_residual(p, acc, 1, m0, n0, modl + 5120, layer == 0 ? p.SS + (size_t)2 * TT : nullptr);
  }
}


__device__ __forceinline__ void phase_prep(const Params& p, int layer, int bid, int nb) {
  const int tid = tidx(), lane = tid & 63, wave = tid >> 6;
  for (int i = bid * 256 + tid; i < TT * 64; i += nb * 256) {
    const int c = i & 63;
    float v = p.S[i];
    if (c < 16) v = sigmoidf_(v);
    else if (c < 32) v = -expf(p.dn_a_log[layer * 16 + c - 16]) * softplusf_(v + p.dn_dt_bias[layer * 16 + c - 16]);
    else v = softplusf_(v + p.ssd_dt_bias[layer * 32 + c - 32]);
    p.S[i] = v;
  }
  for (int t = bid; t < 288 * 48; t += nb) {
    const int chunk = t / 48, slab = t % 48;
    const bool dn = slab < 24;
    const int typ = dn ? slab >> 3 : 3;
    const int ucol = dn ? 1536 + 512 * typ + 64 * (slab & 7) : 4608 + 64 * (slab - 24);
    const int hcol = dn ? ucol - 1536 : ucol - 3072;
    const int cch = dn ? 512 * typ + 64 * (slab & 7) + lane : 64 * (slab - 24) + lane;
    const float* cw = dn ? p.dn_conv_w + (size_t)layer * 5 * 1536 : p.ssd_conv_w + (size_t)layer * 5 * 1536;
    float w5[5];
#pragma unroll
    for (int j = 0; j < 5; ++j) w5[j] = cw[j * 1536 + cch];
    const float bias = dn ? 0.f : p.ssd_conv_b[layer * 1536 + cch];
    const bool lat = chunk < 256;
    const int cs = lat ? (chunk & 31) : ((chunk - 256) & 3);
    const bool first = cs == 0, last = lat ? cs == 31 : cs == 3;
    const int r0 = chunk * 64;
    float raw[20];
#pragma unroll
    for (int i = 0; i < 20; ++i) {
      const int rr = 16 * wave + i - 2;
      float v;
      if (rr < 0) v = first ? 0.f : bf2f(p.HB[((size_t)(chunk - 1) * 4 + 4 + rr) * 3072 + hcol + lane]);
      else if (rr >= 64) v = last ? 0.f : bf2f(p.HB[((size_t)(chunk + 1) * 4 + rr - 64) * 3072 + hcol + lane]);
      else v = bf2f(p.U[(size_t)(r0 + rr) * UW + ucol + lane]);
      raw[i] = v;
    }
    __syncthreads();
#pragma unroll
    for (int i = 0; i < 16; ++i) {
      const int rr = 16 * wave + i;
      float v = bias;
#pragma unroll
      for (int j = 0; j < 5; ++j) v += w5[j] * raw[i + j];
      v = siluf(v);
      if (typ < 2) {
        v *= rsqrtf(wave_sum(v * v) + EPS);
        if (lat) {
          const int pos = lane < 32 ? cs : rr;
          const float csn = p.ROPE[(pos * 16 + (lane & 15)) * 2], sn = p.ROPE[(pos * 16 + (lane & 15)) * 2 + 1];
          const float vp = __shfl_xor(v, 16);
          v = v * csn + ((lane & 16) ? vp : -vp) * sn;
        }
        if (typ == 0) v *= 0.125f;
      }
      p.U[(size_t)(r0 + rr) * UW + ucol + lane] = f2bf(v);
    }
  }
}


constexpr int XS = 72;
constexpr int BS2 = 136;
constexpr int SSD_LDS = (3 * 64 * XS + 3 * 64 * BS2) * 2 + 2 * 64 * 4;
__device__ __forceinline__ s16x4 tr16(const bf16_t* ptr) { return __builtin_amdgcn_ds_read_tr16_b64_v4i16((LDS_AS s16x4*)ptr); }
__device__ __forceinline__ bf16x8 cat8(s16x4 lo, s16x4 hi) { return (bf16x8){lo[0], lo[1], lo[2], lo[3], hi[0], hi[1], hi[2], hi[3]}; }
__device__ __forceinline__ void phase_ssd(const Params& p, int layer, int bid, int nb, char* smem) {
  const int tid = tidx(), lane = tid & 63, wave = tid >> 6, g = lane >> 4, l15 = lane & 15, q4 = l15 >> 2, p4 = lane & 3;
  bf16_t* Xt = (bf16_t*)smem;
  bf16_t* Xs = Xt + 64 * XS;
  bf16_t* Wg = Xs + 64 * XS;
  bf16_t* Bt = Wg + 64 * XS;
  bf16_t* Ct = Bt + 64 * BS2;
  bf16_t* Hb = Ct + 64 * BS2;
  float* dts = (float*)(Hb + 64 * BS2);
  float* lam = dts + 64;
  for (int task = bid; task < 128; task += nb) {
    const int head = task & 15, b = task >> 4, grp = head >> 3;
    f32x4 hst[2][8];
#pragma unroll
    for (int d = 0; d < 2; ++d)
#pragma unroll
      for (int n = 0; n < 8; ++n) hst[d][n] = (f32x4){0.f, 0.f, 0.f, 0.f};
    const float dsk = p.ssd_d[layer * 16 + head];
    const float an0 = -expf(p.ssd_a_log[layer * 32 + head]), an1 = -expf(p.ssd_a_log[layer * 32 + 16 + head]);
    for (int it = 0; it < 36; ++it) {
      const int seg = it >= 4, ci = seg ? it - 4 : it, nch = seg ? 32 : 4;
      const int base = seg ? b * 2048 : TL + b * 256;
      const bool want_o = seg == 1 || layer == 0;
      const bool first = ci < nch / 2;
#pragma unroll
      for (int dir = 0; dir < 2; ++dir) {
        const int c = dir ? nch - 1 - ci : ci;
        const int r0 = base + 64 * c;
        __syncthreads();
        {
          const int i = tid >> 2, sub = tid & 3;
          const int row = r0 + (dir ? 63 - i : i);
          const bf16_t* ur = p.U + (size_t)row * UW;
          const uint4* sx = (const uint4*)(ur + U_SX + 64 * head + 16 * sub);
          *(uint4*)(Xt + i * XS + 16 * sub) = sx[0]; *(uint4*)(Xt + i * XS + 16 * sub + 8) = sx[1];
          const uint4* sb = (const uint4*)(ur + U_SB + 128 * grp + 32 * sub);
#pragma unroll
          for (int k = 0; k < 4; ++k) *(uint4*)(Bt + i * BS2 + 32 * sub + 8 * k) = sb[k];
          if (want_o) {
            const uint4* sc = (const uint4*)(ur + U_SC + 128 * grp + 32 * sub);
#pragma unroll
            for (int k = 0; k < 4; ++k) *(uint4*)(Ct + i * BS2 + 32 * sub + 8 * k) = sc[k];
          }
          if (sub == 0) dts[i] = p.S[(size_t)row * SWD + 32 + dir * 16 + head];
        }
        if (want_o) {
#pragma unroll
          for (int nt = 0; nt < 8; ++nt) {
            uint2 o; o.x = pack2(hst[dir][nt][0], hst[dir][nt][1]); o.y = pack2(hst[dir][nt][2], hst[dir][nt][3]);
            *(uint2*)(Hb + (16 * wave + l15) * BS2 + 16 * nt + 4 * g) = o;
          }
        }
        __syncthreads();
        float lv = dts[lane] * (dir ? an1 : an0);
#pragma unroll
        for (int o = 1; o < 64; o <<= 1) { const float tv = __shfl_up(lv, o); if (lane >= o) lv += tv; }
        const float lam_last = __shfl(lv, 63);
        if (wave == 0) lam[lane] = lv;
        {
          const int j = tid >> 2, sub = tid & 3;
          const float lj = __shfl(lv, j & 63);
          const float sc = dts[j] * expf(lam_last - lj);
          const uint4 a = *(const uint4*)(Xt + j * XS + 16 * sub), bq = *(const uint4*)(Xt + j * XS + 16 * sub + 8);
          uint4 oa, ob;
          oa.x = pack2(bflo(a.x) * sc, bfhi(a.x) * sc); oa.y = pack2(bflo(a.y) * sc, bfhi(a.y) * sc); oa.z = pack2(bflo(a.z) * sc, bfhi(a.z) * sc); oa.w = pack2(bflo(a.w) * sc, bfhi(a.w) * sc);
          ob.x = pack2(bflo(bq.x) * sc, bfhi(bq.x) * sc); ob.y = pack2(bflo(bq.y) * sc, bfhi(bq.y) * sc); ob.z = pack2(bflo(bq.z) * sc, bfhi(bq.z) * sc); ob.w = pack2(bflo(bq.w) * sc, bfhi(bq.w) * sc);
          *(uint4*)(Xs + j * XS + 16 * sub) = oa; *(uint4*)(Xs + j * XS + 16 * sub + 8) = ob;
        }
        __syncthreads();
        if (want_o) {
          const int irow = 16 * wave + l15;
          const float li = lam[irow];
#pragma unroll
          for (int jt = 0; jt < 4; ++jt) {
            f32x4 cacc = (f32x4){0.f, 0.f, 0.f, 0.f};
            if (jt <= wave) {
#pragma unroll
              for (int s2 = 0; s2 < 4; ++s2) {
                const bf16x8 af = *(const bf16x8*)(Ct + irow * BS2 + 32 * s2 + 8 * g);
                const bf16x8 bf = *(const bf16x8*)(Bt + (16 * jt + l15) * BS2 + 32 * s2 + 8 * g);
                cacc = __builtin_amdgcn_mfma_f32_16x16x32_bf16(bf, af, cacc, 0, 0, 0);
              }
            }
            const int j0 = 16 * jt + 4 * g;
            const float4 lj = *(const float4*)(lam + j0), dj = *(const float4*)(dts + j0);
            const float w0 = (j0 + 0 <= irow) ? cacc[0] * expf(li - lj.x) * dj.x : 0.f;
            const float w1 = (j0 + 1 <= irow) ? cacc[1] * expf(li - lj.y) * dj.y : 0.f;
            const float w2 = (j0 + 2 <= irow) ? cacc[2] * expf(li - lj.z) * dj.z : 0.f;
            const float w3 = (j0 + 3 <= irow) ? cacc[3] * expf(li - lj.w) * dj.w : 0.f;
            uint2 o; o.x = pack2(w0, w1); o.y = pack2(w2, w3);
            *(uint2*)(Wg + irow * XS + j0) = o;
          }
        }
        __syncthreads();
        if (want_o) {
          const int irow = 16 * wave + l15;
          f32x4 ai[4], ae[4];
#pragma unroll
          for (int pt = 0; pt < 4; ++pt) { ai[pt] = (f32x4){0.f, 0.f, 0.f, 0.f}; ae[pt] = (f32x4){0.f, 0.f, 0.f, 0.f}; }
#pragma unroll
          for (int s2 = 0; s2 < 2; ++s2) {
            const bf16x8 af = *(const bf16x8*)(Wg + irow * XS + 32 * s2 + 8 * g);
#pragma unroll
            for (int pt = 0; pt < 4; ++pt) {
              const bf16x8 bf = cat8(tr16(Xt + (32 * s2 + 8 * g + q4) * XS + 16 * pt + 4 * p4), tr16(Xt + (32 * s2 + 8 * g + 4 + q4) * XS + 16 * pt + 4 * p4));
              ai[pt] = __builtin_amdgcn_mfma_f32_16x16x32_bf16(bf, af, ai[pt], 0, 0, 0);
            }
          }
#pragma unroll
          for (int s2 = 0; s2 < 4; ++s2) {
            const bf16x8 af = *(const bf16x8*)(Ct + irow * BS2 + 32 * s2 + 8 * g);
#pragma unroll
            for (int pt = 0; pt < 4; ++pt) {
              const bf16x8 bf = *(const bf16x8*)(Hb + (16 * pt + l15) * BS2 + 32 * s2 + 8 * g);
              ae[pt] = __builtin_amdgcn_mfma_f32_16x16x32_bf16(bf, af, ae[pt], 0, 0, 0);
            }
          }
          const float el = expf(lam[irow]);
          const int row = r0 + (dir ? 63 - irow : irow);
#pragma unroll
          for (int pt = 0; pt < 4; ++pt) {
            float y0 = ai[pt][0] + el * ae[pt][0], y1 = ai[pt][1] + el * ae[pt][1], y2 = ai[pt][2] + el * ae[pt][2], y3 = ai[pt][3] + el * ae[pt][3];
            if (dir == 0) {
              const uint2 xv = *(const uint2*)(Xt + irow * XS + 16 * pt + 4 * g);
              y0 += dsk * bflo(xv.x); y1 += dsk * bfhi(xv.x); y2 += dsk * bflo(xv.y); y3 += dsk * bfhi(xv.y);
            }
            unsigned long long* dst = (unsigned long long*)(p.P + (size_t)row * 1024 + 64 * head + 16 * pt + 4 * g);
            if (!first) {
              const unsigned long long old = __hip_atomic_load(dst, __ATOMIC_RELAXED, __HIP_MEMORY_SCOPE_AGENT);
              const unsigned lo = (unsigned)old, hi = (unsigned)(old >> 32);
              y0 += bflo(lo); y1 += bfhi(lo); y2 += bflo(hi); y3 += bfhi(hi);
            }
            *dst = (unsigned long long)pack2(y0, y1) | ((unsigned long long)pack2(y2, y3) << 32);
          }
        }
        {
          const float el = expf(lam_last);
#pragma unroll
          for (int nt = 0; nt < 8; ++nt) hst[dir][nt] *= el;
#pragma unroll
          for (int s2 = 0; s2 < 2; ++s2) {
            const bf16x8 mf = cat8(tr16(Xs + (32 * s2 + 8 * g + q4) * XS + 16 * wave + 4 * p4), tr16(Xs + (32 * s2 + 8 * g + 4 + q4) * XS + 16 * wave + 4 * p4));
#pragma unroll
            for (int nt = 0; nt < 8; ++nt) {
              const bf16x8 nf = cat8(tr16(Bt + (32 * s2 + 8 * g + q4) * BS2 + 16 * nt + 4 * p4), tr16(Bt + (32 * s2 + 8 * g + 4 + q4) * BS2 + 16 * nt + 4 * p4));
              hst[dir][nt] = __builtin_amdgcn_mfma_f32_16x16x32_bf16(nf, mf, hst[dir][nt], 0, 0, 0);
            }
          }
        }
      }
    }
  }
}


constexpr int GT = 64 * XS;
constexpr int GDN_LDS = 11 * GT * 2 + 4 * 256 * 4 + 4 * 16 * 24 * 2 + 2 * 64 * 4;
__device__ __forceinline__ void phase_gdn(const Params& p, int layer, int bid, int nb, char* smem) {
  const int tid = tidx(), lane = tid & 63, wave = tid >> 6, g = lane >> 4, l15 = lane & 15, q4 = l15 >> 2, p4 = lane & 3;
  bf16_t* Qt = (bf16_t*)smem;
  bf16_t* Kt = Qt + GT;
  bf16_t* Vt = Kt + GT;
  bf16_t* Qg = Vt + GT;
  bf16_t* Am = Qg + GT;
  bf16_t* Mq = Am + GT;
  bf16_t* Xw = Mq + GT;
  bf16_t* Xu = Xw + GT;
  bf16_t* Vn = Xu + GT;
  bf16_t* Vs = Vn + GT;
  bf16_t* St = Vs + GT;
  float* Adiag = (float*)(St + GT);
  bf16_t* Db = (bf16_t*)(Adiag + 4 * 256);
  float* bet = (float*)(Db + 4 * 16 * 24);
  float* gam = bet + 64;
  const bf16x8 zero8 = (bf16x8){0, 0, 0, 0, 0, 0, 0, 0};
  for (int task = bid; task < 128; task += nb) {
    const int dir = task & 1, h = (task >> 1) & 7, b = task >> 4;
    bf16_t* Og = layer == 0 ? p.OG0 + (size_t)dir * TT * 512 : p.OG1 + (size_t)dir * TL * 512;
    f32x4 sst[4];
#pragma unroll
    for (int e = 0; e < 4; ++e) sst[e] = (f32x4){0.f, 0.f, 0.f, 0.f};
    __syncthreads();
    for (int i = tid; i < 64 * XS / 2; i += 256) { ((unsigned*)St)[i] = 0u; ((unsigned*)Xw)[i] = 0u; ((unsigned*)Xu)[i] = 0u; }
    for (int it = 0; it < 36; ++it) {
      const int seg = it >= 4, ci = seg ? it - 4 : it, nch = seg ? 32 : 4;
      const int base = seg ? b * 2048 : TL + b * 256;
      const bool want_o = seg == 1 || layer == 0;
      const int c = dir ? nch - 1 - ci : ci;
      const int r0 = base + 64 * c;
      __syncthreads();
      {
        const int i = tid >> 2, sub = tid & 3;
        const int row = r0 + (dir ? 63 - i : i);
        const bf16_t* ur = p.U + (size_t)row * UW + 64 * h + 16 * sub;
        const uint4* sq = (const uint4*)(ur + U_DNQ); const uint4* sk = (const uint4*)(ur + U_DNK); const uint4* sv = (const uint4*)(ur + U_DNV);
        *(uint4*)(Qt + i * XS + 16 * sub) = sq[0]; *(uint4*)(Qt + i * XS + 16 * sub + 8) = sq[1];
        *(uint4*)(Kt + i * XS + 16 * sub) = sk[0]; *(uint4*)(Kt + i * XS + 16 * sub + 8) = sk[1];
        *(uint4*)(Vt + i * XS + 16 * sub) = sv[0]; *(uint4*)(Vt + i * XS + 16 * sub + 8) = sv[1];
        if (sub == 0) { bet[i] = p.S[(size_t)row * SWD + dir * 8 + h]; gam[i] = p.S[(size_t)row * SWD + 16 + dir * 8 + h]; }
      }
      __syncthreads();
      float lv = gam[lane];
#pragma unroll
      for (int o = 1; o < 64; o <<= 1) { const float tv = __shfl_up(lv, o); if (lane >= o) lv += tv; }
      const float gam_last = __shfl(lv, 63);
      __syncthreads();
      if (wave == 0) gam[lane] = lv;
      {
        const int j = tid >> 2, sub = tid & 3;
        const float sc = expf(__shfl(lv, j & 63));
        const uint4 a = *(const uint4*)(Qt + j * XS + 16 * sub), bq = *(const uint4*)(Qt + j * XS + 16 * sub + 8);
        uint4 oa, ob;
        oa.x = pack2(bflo(a.x) * sc, bfhi(a.x) * sc); oa.y = pack2(bflo(a.y) * sc, bfhi(a.y) * sc); oa.z = pack2(bflo(a.z) * sc, bfhi(a.z) * sc); oa.w = pack2(bflo(a.w) * sc, bfhi(a.w) * sc);
        ob.x = pack2(bflo(bq.x) * sc, bfhi(bq.x) * sc); ob.y = pack2(bflo(bq.y) * sc, bfhi(bq.y) * sc); ob.z = pack2(bflo(bq.z) * sc, bfhi(bq.z) * sc); ob.w = pack2(bflo(bq.w) * sc, bfhi(bq.w) * sc);
        *(uint4*)(Qg + j * XS + 16 * sub) = oa; *(uint4*)(Qg + j * XS + 16 * sub + 8) = ob;
      }
      __syncthreads();
      {
        const int irow = 16 * wave + l15;
        const float gi = gam[irow], bi = bet[irow];
#pragma unroll
        for (int jt = 0; jt < 4; ++jt) {
          f32x4 kk = (f32x4){0.f, 0.f, 0.f, 0.f}, qk = (f32x4){0.f, 0.f, 0.f, 0.f};
          if (jt <= wave) {
#pragma unroll
            for (int s2 = 0; s2 < 2; ++s2) {
              const bf16x8 nf = *(const bf16x8*)(Kt + (16 * jt + l15) * XS + 32 * s2 + 8 * g);
              const bf16x8 mk = *(const bf16x8*)(Kt + irow * XS + 32 * s2 + 8 * g);
              const bf16x8 mq = *(const bf16x8*)(Qt + irow * XS + 32 * s2 + 8 * g);
              kk = __builtin_amdgcn_mfma_f32_16x16x32_bf16(nf, mk, kk, 0, 0, 0);
              qk = __builtin_amdgcn_mfma_f32_16x16x32_bf16(nf, mq, qk, 0, 0, 0);
            }
          }
          const int j0 = 16 * jt + 4 * g;
          const float4 gj = *(const float4*)(gam + j0);
          const float gjv[4] = {gj.x, gj.y, gj.z, gj.w};
          float av[4], mv[4];
#pragma unroll
          for (int r = 0; r < 4; ++r) {
            const int j = j0 + r;
            const float dec = j <= irow ? expf(gi - gjv[r]) : 0.f;
            av[r] = j < irow ? bi * kk[r] * dec : 0.f;
            mv[r] = qk[r] * dec;
          }
          uint2 oa; oa.x = pack2(av[0], av[1]); oa.y = pack2(av[2], av[3]);
          uint2 om; om.x = pack2(mv[0], mv[1]); om.y = pack2(mv[2], mv[3]);
          *(uint2*)(Am + irow * XS + j0) = oa;
          *(uint2*)(Mq + irow * XS + j0) = om;
          if (jt == wave) *(f32x4*)(Adiag + wave * 256 + l15 * 16 + 4 * g) = (f32x4){av[0], av[1], av[2], av[3]};
        }
      }
      __syncthreads();
      {
        const int cc = lane & 15;
        const float* Ad = Adiag + wave * 256;
        float dcol[16];
#pragma unroll
        for (int r = 0; r < 16; ++r) {
          float sacc = (r == cc) ? 1.f : 0.f;
#pragma unroll
          for (int j = 0; j < r; ++j) sacc -= Ad[r * 16 + j] * dcol[j];
          dcol[r] = sacc;
        }
        if (lane < 16) {
#pragma unroll
          for (int r = 0; r < 16; ++r) Db[(wave * 16 + r) * 24 + cc] = f2bf(dcol[r]);
        }
      }
      __syncthreads();
      {
        const bool isW = wave < 2;
        bf16_t* Xd = isW ? Xw : Xu;
        const bf16_t* Src = isW ? Kt : Vt;
        const int fbase = (wave & 1) * 32;
#pragma unroll
        for (int ib = 0; ib < 4; ++ib) {
          const int irow = 16 * ib + l15;
          const float sc = isW ? bet[irow] * expf(gam[irow]) : bet[irow];
          f32x4 y[2];
#pragma unroll
          for (int fi = 0; fi < 2; ++fi) {
            const int f0 = fbase + 16 * fi;
            const uint2 rv = *(const uint2*)(Src + irow * XS + f0 + 4 * g);
            f32x4 tmp = (f32x4){0.f, 0.f, 0.f, 0.f};
#pragma unroll
            for (int s2 = 0; s2 < 2; ++s2) {
              if (32 * s2 < 16 * ib) {
                const bool half = (32 * s2 + 32) > 16 * ib;
                bf16x8 mf = *(const bf16x8*)(Am + irow * XS + 32 * s2 + 8 * g);
                if (half && g >= 2) mf = zero8;
                const bf16x8 nf = cat8(tr16(Xd + (32 * s2 + 8 * g + q4) * XS + f0 + 4 * p4), tr16(Xd + (32 * s2 + 8 * g + 4 + q4) * XS + f0 + 4 * p4));
                tmp = __builtin_amdgcn_mfma_f32_16x16x32_bf16(nf, mf, tmp, 0, 0, 0);
              }
            }
            y[fi] = (f32x4){bflo(rv.x) * sc - tmp[0], bfhi(rv.x) * sc - tmp[1], bflo(rv.y) * sc - tmp[2], bfhi(rv.y) * sc - tmp[3]};
          }
          __syncthreads();
#pragma unroll
          for (int fi = 0; fi < 2; ++fi) {
            uint2 o; o.x = pack2(y[fi][0], y[fi][1]); o.y = pack2(y[fi][2], y[fi][3]);
            *(uint2*)(Xd + irow * XS + fbase + 16 * fi + 4 * g) = o;
          }
          __syncthreads();
          bf16x8 dm = zero8;
          if (g < 2) dm = *(const bf16x8*)(Db + (ib * 16 + l15) * 24 + 8 * g);
#pragma unroll
          for (int fi = 0; fi < 2; ++fi) {
            const int f0 = fbase + 16 * fi;
            const bf16x8 nf = cat8(tr16(Xd + (16 * ib + 8 * (g & 1) + q4) * XS + f0 + 4 * p4), tr16(Xd + (16 * ib + 8 * (g & 1) + 4 + q4) * XS + f0 + 4 * p4));
            y[fi] = __builtin_amdgcn_mfma_f32_16x16x32_bf16(nf, dm, (f32x4){0.f, 0.f, 0.f, 0.f}, 0, 0, 0);
          }
          __syncthreads();
#pragma unroll
          for (int fi = 0; fi < 2; ++fi) {
            uint2 o; o.x = pack2(y[fi][0], y[fi][1]); o.y = pack2(y[fi][2], y[fi][3]);
            *(uint2*)(Xd + irow * XS + fbase + 16 * fi + 4 * g) = o;
          }
          __syncthreads();
        }
      }
      {
        const int irow = 16 * wave + l15;
        const float dl = expf(gam_last - gam[irow]);
        f32x4 acc[4];
#pragma unroll
        for (int et = 0; et < 4; ++et) acc[et] = (f32x4){0.f, 0.f, 0.f, 0.f};
#pragma unroll
        for (int s2 = 0; s2 < 2; ++s2) {
          const bf16x8 mf = *(const bf16x8*)(Xw + irow * XS + 32 * s2 + 8 * g);
#pragma unroll
          for (int et = 0; et < 4; ++et) {
            const bf16x8 nf = *(const bf16x8*)(St + (16 * et + l15) * XS + 32 * s2 + 8 * g);
            acc[et] = __builtin_amdgcn_mfma_f32_16x16x32_bf16(nf, mf, acc[et], 0, 0, 0);
          }
        }
#pragma unroll
        for (int et = 0; et < 4; ++et) {
          const uint2 uv = *(const uint2*)(Xu + irow * XS + 16 * et + 4 * g);
          const float v0 = bflo(uv.x) - acc[et][0], v1 = bfhi(uv.x) - acc[et][1], v2 = bflo(uv.y) - acc[et][2], v3 = bfhi(uv.y) - acc[et][3];
          uint2 o; o.x = pack2(v0, v1); o.y = pack2(v2, v3);
          *(uint2*)(Vn + irow * XS + 16 * et + 4 * g) = o;
          o.x = pack2(v0 * dl, v1 * dl); o.y = pack2(v2 * dl, v3 * dl);
          *(uint2*)(Vs + irow * XS + 16 * et + 4 * g) = o;
        }
      }
      __syncthreads();
      if (want_o) {
        const int irow = 16 * wave + l15;
        f32x4 acc[4];
#pragma unroll
        for (int et = 0; et < 4; ++et) acc[et] = (f32x4){0.f, 0.f, 0.f, 0.f};
#pragma unroll
        for (int s2 = 0; s2 < 2; ++s2) {
          const bf16x8 mf = *(const bf16x8*)(Qg + irow * XS + 32 * s2 + 8 * g);
          const bf16x8 mf2 = *(const bf16x8*)(Mq + irow * XS + 32 * s2 + 8 * g);
#pragma unroll
          for (int et = 0; et < 4; ++et) {
            const bf16x8 nf = *(const bf16x8*)(St + (16 * et + l15) * XS + 32 * s2 + 8 * g);
            acc[et] = __builtin_amdgcn_mfma_f32_16x16x32_bf16(nf, mf, acc[et], 0, 0, 0);
            const bf16x8 nf2 = cat8(tr16(Vn + (32 * s2 + 8 * g + q4) * XS + 16 * et + 4 * p4), tr16(Vn + (32 * s2 + 8 * g + 4 + q4) * XS + 16 * et + 4 * p4));
            acc[et] = __builtin_amdgcn_mfma_f32_16x16x32_bf16(nf2, mf2, acc[et], 0, 0, 0);
          }
        }
        const int row = r0 + (dir ? 63 - irow : irow);
#pragma unroll
        for (int et = 0; et < 4; ++et) {
          uint2 o; o.x = pack2(acc[et][0], acc[et][1]); o.y = pack2(acc[et][2], acc[et][3]);
          *(uint2*)(Og + (size_t)row * 512 + 64 * h + 16 * et + 4 * g) = o;
        }
      }
      {
        const float el = expf(gam_last);
#pragma unroll
        for (int et = 0; et < 4; ++et) sst[et] *= el;
#pragma unroll
        for (int s2 = 0; s2 < 2; ++s2) {
          const bf16x8 nf = cat8(tr16(Kt + (32 * s2 + 8 * g + q4) * XS + 16 * wave + 4 * p4), tr16(Kt + (32 * s2 + 8 * g + 4 + q4) * XS + 16 * wave + 4 * p4));
#pragma unroll
          for (int et = 0; et < 4; ++et) {
            const bf16x8 mf = cat8(tr16(Vs + (32 * s2 + 8 * g + q4) * XS + 16 * et + 4 * p4), tr16(Vs + (32 * s2 + 8 * g + 4 + q4) * XS + 16 * et + 4 * p4));
            sst[et] = __builtin_amdgcn_mfma_f32_16x16x32_bf16(nf, mf, sst[et], 0, 0, 0);
          }
        }
      }
      __syncthreads();
#pragma unroll
      for (int et = 0; et < 4; ++et) {
        uint2 o; o.x = pack2(sst[et][0], sst[et][1]); o.y = pack2(sst[et][2], sst[et][3]);
        *(uint2*)(St + (16 * et + l15) * XS + 16 * wave + 4 * g) = o;
      }
    }
  }
}


constexpr int NA_VS = 72;
constexpr int NA_LDS_WAVE = 2 * 32 * NA_VS * 2;
__device__ __forceinline__ void phase_na(const Params& p, int layer, unsigned* ctr, char* smem) {
  const int lane = tidx() & 63, wave = tidx() >> 6, g = lane >> 4, l15 = lane & 15, q4 = l15 >> 2, p4 = lane & 3;
  bf16_t* Vl = (bf16_t*)(smem + wave * NA_LDS_WAVE);
  const int ntask = layer == 0 ? 8192 + 1024 : 8192;
  const float* rpb = p.na_rpb + (size_t)layer * 8 * 15 * 31;
  for (;;) {
    int w0 = 0;
    if (lane == 0) w0 = (int)atomicAdd(ctr, 1u);
    const int task = __builtin_amdgcn_readfirstlane(__shfl(w0, 0));
    if (task >= ntask) break;
    const bool lat = task < 8192;
    int b, h, r = 0, cb = 0, qtok0, R0 = 0, C0 = 0;
    if (lat) { cb = task & 3; r = (task >> 2) & 31; h = (task >> 7) & 7; b = task >> 10; qtok0 = b * 2048 + r * 64 + 16 * cb; R0 = min(max(r - 4, 0), 24); C0 = min(max(16 * cb - 8, 0), 32); }
    else { const int t2 = task - 8192; const int qb = t2 & 15; h = (t2 >> 4) & 7; b = t2 >> 7; qtok0 = TL + b * 256 + 16 * qb; }
    const int tau0 = lat ? 0 : 16;
    const int wtok0 = b * 2048 + R0 * 64 + C0, ctok0 = TL + b * 256;
#define tile_tok(tau) ((tau) < 16 ? wtok0 + ((tau) >> 1) * 64 + 16 * ((tau) & 1) : ctok0 + 16 * ((tau) - 16))
    const bf16_t* qp = p.U + (size_t)(qtok0 + l15) * UW + U_NAQ + 64 * h + 8 * g;
    const bf16x8 qf0 = *(const bf16x8*)qp, qf1 = *(const bf16x8*)(qp + 32);
    f32x4 sc[32];
#pragma unroll
    for (int tau = 0; tau < 32; ++tau) {
      sc[tau] = (f32x4){-INFINITY, -INFINITY, -INFINITY, -INFINITY};
      if (tau >= tau0) {
        const bf16_t* kp = p.U + (size_t)(tile_tok(tau) + l15) * UW + U_NAK + 64 * h + 8 * g;
        const bf16x8 kf0 = *(const bf16x8*)kp, kf1 = *(const bf16x8*)(kp + 32);
        f32x4 a = (f32x4){0.f, 0.f, 0.f, 0.f};
        a = __builtin_amdgcn_mfma_f32_16x16x32_bf16(kf0, qf0, a, 0, 0, 0);
        a = __builtin_amdgcn_mfma_f32_16x16x32_bf16(kf1, qf1, a, 0, 0, 0);
        if (tau < 16) {
          const int qcol = 16 * cb + l15, ws = min(max(qcol - 8, 0), 48);
          const int dr = R0 + (tau >> 1) - r + 7;
#pragma unroll
          for (int rg = 0; rg < 4; ++rg) {
            const int kcol = C0 + 16 * (tau & 1) + 4 * g + rg;
            const bool ok = kcol >= ws && kcol < ws + 16;
            const float bias = ok ? rpb[(h * 15 + dr) * 31 + (kcol - qcol + 15)] : 0.f;
            a[rg] = ok ? a[rg] + bias : -INFINITY;
          }
        }
        sc[tau] = a;
      }
    }
    float mx = -INFINITY;
#pragma unroll
    for (int tau = 0; tau < 32; ++tau) mx = fmaxf(mx, fmaxf(fmaxf(sc[tau][0], sc[tau][1]), fmaxf(sc[tau][2], sc[tau][3])));
    mx = fmaxf(mx, __shfl_xor(mx, 16)); mx = fmaxf(mx, __shfl_xor(mx, 32));
    float sum = 0.f;
#pragma unroll
    for (int tau = 0; tau < 32; ++tau) {
#pragma unroll
      for (int rg = 0; rg < 4; ++rg) { const float e = __expf(sc[tau][rg] - mx); sc[tau][rg] = e; sum += e; }
    }
    sum += __shfl_xor(sum, 16); sum += __shfl_xor(sum, 32);
    f32x4 oacc[4];
#pragma unroll
    for (int dt = 0; dt < 4; ++dt) oacc[dt] = (f32x4){0.f, 0.f, 0.f, 0.f};
    const int kap0 = tau0 >> 1;
    uint4 vr0, vr1, vr2, vr3;
#define NA_VLOAD(KAP) { \
      const int kk0_ = lane >> 3, cc_ = lane & 7; \
      const bf16_t* vb_ = p.U + U_NAV + 64 * h + 8 * cc_; \
      vr0 = *(const uint4*)(vb_ + (size_t)(tile_tok(2 * (KAP)) + kk0_) * UW); \
      vr1 = *(const uint4*)(vb_ + (size_t)(tile_tok(2 * (KAP)) + kk0_ + 8) * UW); \
      vr2 = *(const uint4*)(vb_ + (size_t)(tile_tok(2 * (KAP) + 1) + kk0_) * UW); \
      vr3 = *(const uint4*)(vb_ + (size_t)(tile_tok(2 * (KAP) + 1) + kk0_ + 8) * UW); }
    NA_VLOAD(kap0)
#pragma unroll
    for (int kap = 0; kap < 16; ++kap) {
      if (kap >= kap0) {
        bf16_t* Vb = Vl + (kap & 1) * 32 * NA_VS;
        {
          const int kk0_ = lane >> 3, cc_ = lane & 7;
          *(uint4*)(Vb + kk0_ * NA_VS + 8 * cc_) = vr0; *(uint4*)(Vb + (kk0_ + 8) * NA_VS + 8 * cc_) = vr1;
          *(uint4*)(Vb + (kk0_ + 16) * NA_VS + 8 * cc_) = vr2; *(uint4*)(Vb + (kk0_ + 24) * NA_VS + 8 * cc_) = vr3;
        }
        if (kap + 1 < 16) NA_VLOAD(kap + 1)
        __builtin_amdgcn_fence(__ATOMIC_RELEASE, "workgroup"); __builtin_amdgcn_wave_barrier(); __builtin_amdgcn_fence(__ATOMIC_ACQUIRE, "workgroup");
        bf16x8 pf;
        {
          const unsigned w0_ = pack2(sc[2 * kap][0], sc[2 * kap][1]), w1_ = pack2(sc[2 * kap][2], sc[2 * kap][3]);
          const unsigned w2_ = pack2(sc[2 * kap + 1][0], sc[2 * kap + 1][1]), w3_ = pack2(sc[2 * kap + 1][2], sc[2 * kap + 1][3]);
          pf = (bf16x8){(short)(w0_ & 0xffff), (short)(w0_ >> 16), (short)(w1_ & 0xffff), (short)(w1_ >> 16), (short)(w2_ & 0xffff), (short)(w2_ >> 16), (short)(w3_ & 0xffff), (short)(w3_ >> 16)};
        }
#pragma unroll
        for (int dt = 0; dt < 4; ++dt) {
          const bf16x8 vf = cat8(tr16(Vb + (4 * g + q4) * NA_VS + 16 * dt + 4 * p4), tr16(Vb + (16 + 4 * g + q4) * NA_VS + 16 * dt + 4 * p4));
          oacc[dt] = __builtin_amdgcn_mfma_f32_16x16x32_bf16(vf, pf, oacc[dt], 0, 0, 0);
        }
      }
    }
#undef NA_VLOAD
#undef tile_tok
    const float inv = 1.f / sum;
    bf16_t* op = p.U + (size_t)(qtok0 + l15) * UW + U_YA + 64 * h + 4 * g;
#pragma unroll
    for (int dt = 0; dt < 4; ++dt) {
      uint2 o; o.x = pack2(oacc[dt][0] * inv, oacc[dt][1] * inv); o.y = pack2(oacc[dt][2] * inv, oacc[dt][3] * inv);
      *(uint2*)(op + 16 * dt) = o;
    }
  }
}

__device__ __attribute__((noinline)) void na_naive_fn(bf16_t* Ubase, const float* rpb, int layer, unsigned* ctr) {
  struct { bf16_t* U; } p{Ubase};
  const int lane = tidx() & 63;
  const int ntok = layer == 0 ? TT : TL;
  for (;;) {
    int w0 = 0;
    if (lane == 0) w0 = (int)atomicAdd(ctr, 1u);
    const int w = __shfl(w0, 0);
    if (w >= ntok * 8) break;
    const int tok = w >> 3, h = w & 7;
    const bool lat = tok < TL;
    const int b = lat ? tok >> 11 : (tok - TL) >> 8;
    int r = 0, cq = 0, R0 = 0, ws = 0;
    if (lat) { const int tt = tok & 2047; r = tt >> 6; cq = tt & 63; R0 = min(max(r - 4, 0), 24); ws = min(max(cq - 8, 0), 48); }
    const int npass = lat ? 6 : 4;
    float sc[6];
#pragma unroll
    for (int ps = 0; ps < 6; ++ps) {
      sc[ps] = -INFINITY;
      if (ps < npass) {
        int ktok; float bias = 0.f;
        const int pw = lat ? ps : ps + 2;
        if (pw < 2) { const int idx = pw * 64 + lane, i = idx >> 4, j = idx & 15; const int kr = R0 + i, kc = ws + j; ktok = b * 2048 + kr * 64 + kc; bias = rpb[(h * 15 + (kr - r + 7)) * 31 + (kc - cq + 15)]; }
        else ktok = TL + b * 256 + (pw - 2) * 64 + lane;
        const bf16_t* kp = p.U + (size_t)ktok * UW + U_NAK + 64 * h;
        float dot = 0.f;
        const bf16_t* qp = p.U + (size_t)tok * UW + U_NAQ + 64 * h;
#pragma unroll 1
        for (int c = 0; c < 8; ++c) {
          const uint4 kk = *(const uint4*)(kp + 8 * c);
          const uint4 qq = *(const uint4*)(qp + 8 * c);
          dot += bflo(kk.x) * bflo(qq.x) + bfhi(kk.x) * bfhi(qq.x) + bflo(kk.y) * bflo(qq.y) + bfhi(kk.y) * bfhi(qq.y)
               + bflo(kk.z) * bflo(qq.z) + bfhi(kk.z) * bfhi(qq.z) + bflo(kk.w) * bflo(qq.w) + bfhi(kk.w) * bfhi(qq.w);
        }
        sc[ps] = dot + bias;
      }
    }
    float mx = sc[0];
#pragma unroll
    for (int ps = 1; ps < 6; ++ps) mx = fmaxf(mx, sc[ps]);
    mx = wave_max(mx);
    float sum = 0.f;
#pragma unroll
    for (int ps = 0; ps < 6; ++ps) { sc[ps] = ps < npass ? expf(sc[ps] - mx) : 0.f; sum += sc[ps]; }
    sum = wave_sum(sum);
    const float inv = 1.f / sum;
    float o = 0.f;
#pragma unroll
    for (int ps = 0; ps < 6; ++ps) {
      if (ps < npass) {
        const int pw = lat ? ps : ps + 2;
        for (int src = 0; src < 64; ++src) {
          const float pk = __shfl(sc[ps], src);
          int ktok;
          if (pw < 2) { const int idx = pw * 64 + src, i = idx >> 4, j = idx & 15; ktok = b * 2048 + (R0 + i) * 64 + ws + j; }
          else ktok = TL + b * 256 + (pw - 2) * 64 + src;
          o += pk * bf2f(p.U[(size_t)ktok * UW + U_NAV + 64 * h + lane]);
        }
      }
    }
    p.U[(size_t)tok * UW + U_YA + 64 * h + lane] = f2bf(o * inv);
  }
}

__device__ __forceinline__ void phase_gdn_naive(const Params& p, int layer, int bid, int nb, float* lds) {
  const int lane = tidx() & 63, wave = tidx() >> 6;
  float* kq = lds + wave * 128;
  const bool need_ctx = layer == 0;
  for (int ch = bid * 4 + wave; ch < 128; ch += nb * 4) {
    const int dir = ch & 1, h = (ch >> 1) & 7, b = ch >> 4;
    bf16_t* Og = layer == 0 ? p.OG0 + (size_t)dir * TT * 512 : p.OG1 + (size_t)dir * TL * 512;
    float S[64];
#pragma unroll
    for (int d = 0; d < 64; ++d) S[d] = 0.f;
    for (int seg = 0; seg < 2; ++seg) {
      const int L = seg ? 2048 : 256, base = seg ? b * 2048 : TL + b * 256;
      const int start = dir ? L - 1 : 0, step = dir ? -1 : 1;
      const bool want_o = seg == 1 || need_ctx;
      for (int n = 0; n < L; ++n) {
        const int t = start + step * n, row = base + t;
        const bf16_t* ur = p.U + (size_t)row * UW + 64 * h + lane;
        const float q = bf2f(ur[U_DNQ]), k = bf2f(ur[U_DNK]), v = bf2f(ur[U_DNV]);
        const float beta = p.S[(size_t)row * SWD + dir * 8 + h];
        const float eg = expf(p.S[(size_t)row * SWD + 16 + dir * 8 + h]);
        kq[lane] = k; kq[64 + lane] = q;
        __builtin_amdgcn_fence(__ATOMIC_RELEASE, "workgroup"); __builtin_amdgcn_wave_barrier(); __builtin_amdgcn_fence(__ATOMIC_ACQUIRE, "workgroup");
        float dot = 0.f;
#pragma unroll
        for (int d = 0; d < 64; d += 4) { const float4 kk = *(const float4*)(kq + d); dot += S[d] * kk.x + S[d + 1] * kk.y + S[d + 2] * kk.z + S[d + 3] * kk.w; }
        const float vn = beta * (v - eg * dot);
        float o = 0.f;
#pragma unroll
        for (int d = 0; d < 64; d += 4) {
          const float4 kk = *(const float4*)(kq + d), qq = *(const float4*)(kq + 64 + d);
          S[d] = eg * S[d] + kk.x * vn; o += S[d] * qq.x;
          S[d + 1] = eg * S[d + 1] + kk.y * vn; o += S[d + 1] * qq.y;
          S[d + 2] = eg * S[d + 2] + kk.z * vn; o += S[d + 2] * qq.z;
          S[d + 3] = eg * S[d + 3] + kk.w * vn; o += S[d + 3] * qq.w;
        }
        __builtin_amdgcn_fence(__ATOMIC_RELEASE, "workgroup"); __builtin_amdgcn_wave_barrier(); __builtin_amdgcn_fence(__ATOMIC_ACQUIRE, "workgroup");
        if (want_o) Og[(size_t)(seg ? b * 2048 + t : row) * 512 + 64 * h + lane] = f2bf(o);
      }
    }
  }
}

__device__ __forceinline__ void phase_ssd_naive(const Params& p, int layer, int dir, int bid, int nb, float* lds) {
  const int tid = tidx();
  const bool need_ctx = layer == 0;
  float* xs = lds;
  float* Bs = lds + 32 * 64;
  float* Cs = Bs + 32 * 128;
  float* dts = Cs + 32 * 128;
  for (int ch = bid; ch < 128; ch += nb) {
    const int head = ch & 15, b = ch >> 4, grp = head >> 3;
    const float a = -expf(p.ssd_a_log[layer * 32 + dir * 16 + head]);
    const float dsk = p.ssd_d[layer * 16 + head];
    const int pp = tid >> 2, nq = tid & 3;
    float hst[32];
#pragma unroll
    for (int i = 0; i < 32; ++i) hst[i] = 0.f;
    for (int seg = 0; seg < 2; ++seg) {
      const int L = seg ? 2048 : 256, base = seg ? b * 2048 : TL + b * 256;
      const int start = dir ? L - 1 : 0, step = dir ? -1 : 1;
      const bool want_o = seg == 1 || need_ctx;
      for (int n0 = 0; n0 < L; n0 += 32) {
        __syncthreads();
        for (int e = tid; e < 32 * 320; e += 256) {
          const int i = e / 320, cid = e % 320;
          const int t = start + step * (n0 + i);
          int ucol;
          if (cid < 64) ucol = U_SX + 64 * head + cid;
          else if (cid < 192) ucol = U_SB + 128 * grp + (cid - 64);
          else ucol = U_SC + 128 * grp + (cid - 192);
          const float acc = bf2f(p.U[(size_t)(base + t) * UW + ucol]);
          if (cid < 64) xs[i * 64 + cid] = acc; else if (cid < 192) Bs[i * 128 + cid - 64] = acc; else Cs[i * 128 + cid - 192] = acc;
        }
        if (tid < 32) { const int t = start + step * (n0 + tid); dts[tid] = p.S[(size_t)(base + t) * SWD + 32 + dir * 16 + head]; }
        __syncthreads();
        for (int i = 0; i < 32; ++i) {
          const int t = start + step * (n0 + i), row = base + t;
          const float dt = dts[i], da = expf(dt * a), xv = xs[i * 64 + pp], dx = dt * xv;
          float y = 0.f;
#pragma unroll
          for (int j = 0; j < 32; ++j) { hst[j] = da * hst[j] + dx * Bs[i * 128 + 32 * nq + j]; y += hst[j] * Cs[i * 128 + 32 * nq + j]; }
          y += __shfl_xor(y, 1); y += __shfl_xor(y, 2);
          if (want_o && nq == 0) {
            bf16_t* dst = p.P + (size_t)row * 1024 + 64 * head + pp;
            if (dir == 0) *dst = f2bf(y + dsk * xv); else *dst = f2bf(bf2f(*dst) + y);
          }
        }
      }
    }
  }
}

__device__ __forceinline__ void phase_fin(const Params& p, int layer, int bid, int nb) {
  const int lane = tidx() & 63, wave = tidx() >> 6;
  const int ntok = layer == 0 ? TT : TL;
  for (int tok = bid * 4 + wave; tok < ntok; tok += nb * 4) {
    bf16_t* ur = p.U + (size_t)tok * UW;
    {
      const bf16_t* of = (layer == 0 ? p.OG0 : p.OG1) + (size_t)tok * 512 + 8 * lane;
      const bf16_t* ob = of + (size_t)(layer == 0 ? TT : TL) * 512;
      const uint4 a = *(const uint4*)of, bq = *(const uint4*)ob, z = *(const uint4*)(ur + U_DNZ + 8 * lane);
      float o[8] = {bflo(a.x) + bflo(bq.x), bfhi(a.x) + bfhi(bq.x), bflo(a.y) + bflo(bq.y), bfhi(a.y) + bfhi(bq.y), bflo(a.z) + bflo(bq.z), bfhi(a.z) + bfhi(bq.z), bflo(a.w) + bflo(bq.w), bfhi(a.w) + bfhi(bq.w)};
      const float zz[8] = {bflo(z.x), bfhi(z.x), bflo(z.y), bfhi(z.y), bflo(z.z), bfhi(z.z), bflo(z.w), bfhi(z.w)};
      float ss = 0.f;
#pragma unroll
      for (int i = 0; i < 8; ++i) ss += o[i] * o[i];
      ss += __shfl_xor(ss, 1); ss += __shfl_xor(ss, 2); ss += __shfl_xor(ss, 4);
      const float rs = rsqrtf(ss * (1.f / 64.f) + EPS);
      const float* gn = p.dn_o_gain + layer * 64 + 8 * (lane & 7);
#pragma unroll
      for (int i = 0; i < 8; ++i) o[i] = o[i] * rs * gn[i] * siluf(zz[i]);
      uint4 w; w.x = pack2(o[0], o[1]); w.y = pack2(o[2], o[3]); w.z = pack2(o[4], o[5]); w.w = pack2(o[6], o[7]);
      *(uint4*)(ur + U_YB + 8 * lane) = w;
    }
    {
      float yv[16];
      float ss = 0.f;
#pragma unroll
      for (int hf = 0; hf < 2; ++hf) {
        const uint4 a = *(const uint4*)(p.P + (size_t)tok * 1024 + 16 * lane + 8 * hf), z = *(const uint4*)(ur + U_SZ + 16 * lane + 8 * hf);
        const float av[8] = {bflo(a.x), bfhi(a.x), bflo(a.y), bfhi(a.y), bflo(a.z), bfhi(a.z), bflo(a.w), bfhi(a.w)};
        const float zz[8] = {bflo(z.x), bfhi(z.x), bflo(z.y), bfhi(z.y), bflo(z.z), bfhi(z.z), bflo(z.w), bfhi(z.w)};
#pragma unroll
        for (int i = 0; i < 8; ++i) { const float v = av[i] * siluf(zz[i]); yv[8 * hf + i] = v; ss += v * v; }
      }
      ss += __shfl_xor(ss, 1); ss += __shfl_xor(ss, 2); ss += __shfl_xor(ss, 4); ss += __shfl_xor(ss, 8); ss += __shfl_xor(ss, 16);
      const float rs = rsqrtf(ss * (1.f / 512.f) + EPS);
      const float* gn = p.ssd_o_gain + layer * 1024 + 16 * lane;
#pragma unroll
      for (int hf = 0; hf < 2; ++hf) {
        uint4 w;
        w.x = pack2(yv[8 * hf + 0] * rs * gn[8 * hf + 0], yv[8 * hf + 1] * rs * gn[8 * hf + 1]);
        w.y = pack2(yv[8 * hf + 2] * rs * gn[8 * hf + 2], yv[8 * hf + 3] * rs * gn[8 * hf + 3]);
        w.z = pack2(yv[8 * hf + 4] * rs * gn[8 * hf + 4], yv[8 * hf + 5] * rs * gn[8 * hf + 5]);
        w.w = pack2(yv[8 * hf + 6] * rs * gn[8 * hf + 6], yv[8 * hf + 7] * rs * gn[8 * hf + 7]);
        *(uint4*)(ur + U_YC + 16 * lane + 8 * hf) = w;
      }
    }
  }
}

namespace cg = cooperative_groups;
constexpr int MEGA_LDS = GDN_LDS > SSD_LDS ? GDN_LDS : SSD_LDS;
__global__ void __launch_bounds__(256) k_mega(Params p) {
  cg::grid_group grid = cg::this_grid();
  __shared__ __attribute__((aligned(16))) char smem[MEGA_LDS];
  const int bid = blockIdx.x, nb = gridDim.x;
  phase_pro(p, bid, nb);
  phase_mod(p, bid, nb, (float*)smem);
  grid.sync();
  for (int layer = 0; layer < 2; ++layer) {
    phase_g1(p, layer, bid, nb, (bf16_t*)smem);
    grid.sync();
    phase_prep(p, layer, bid, nb);
    grid.sync();
    if (bid < 128) phase_gdn(p, layer, bid, 128, smem);
    else phase_ssd(p, layer, bid - 128, nb - 128, smem);
    phase_na(p, layer, p.CTR + layer, smem);
    grid.sync();
    phase_fin(p, layer, bid, nb);
    grid.sync();
    phase_g2a(p, layer, bid, nb, (bf16_t*)smem);
    grid.sync();
    phase_g2b(p, layer, bid, nb, (bf16_t*)smem);
    grid.sync();
    phase_g3(p, layer, bid, nb, (bf16_t*)smem);
    grid.sync();
    phase_g4(p, layer, bid, nb, (bf16_t*)smem);
    grid.sync();
    phase_g5(p, layer, bid, nb, (bf16_t*)smem);
    if (layer == 0) grid.sync();
  }
}

extern "C" void kernel_launch(void* const* d_in, const int* in_sizes, int n_in, void* d_out, int out_size, void* d_ws, size_t ws_size,
                              hipStream_t stream) {
  Params p{};
  const float** fp = (const float**)&p;
  for (int i = 0; i < 28; ++i) fp[i] = (const float*)d_in[i];
  p.out = (float*)d_out;
  char* ws = (char*)d_ws;
  size_t off = 0;
  auto take = [&](size_t bytes) { char* r = ws + off; off += (bytes + 255) & ~(size_t)255; return r; };
  p.U = (bf16_t*)take((size_t)TT * UW * 2);
  p.S = (float*)take((size_t)TT * SWD * 4);
  p.MOD = (float*)take((size_t)2 * 9 * 6144 * 4);
  p.SS = (float*)take((size_t)4 * TT * 4);
  p.ROPE = (float*)take(64 * 16 * 2 * 4);
  p.CTR = (unsigned*)take(256);
  p.P = (bf16_t*)take((size_t)TT * 1024 * 2);
  p.XC = (float*)take((size_t)TC * 1024 * 4);
  p.HB = p.P;
  p.OG0 = (bf16_t*)d_out;
  p.OG1 = (bf16_t*)((char*)p.P + (size_t)TL * 1024 * 2);
  const size_t need = (size_t)((char*)p.OG1 - ws) + (size_t)2 * TL * 512 * 2;
  if (need > ws_size) { fprintf(stderr, "workspace too small: need %zu have %zu\n", need, ws_size); return; }
  static int grid_blocks = 0;
  if (!grid_blocks) {
    int dev = 0, cus = 0, per_cu = 0;
    hipGetDevice(&dev);
    hipDeviceGetAttribute(&cus, hipDeviceAttributeMultiprocessorCount, dev);
    hipOccupancyMaxActiveBlocksPerMultiprocessor(&per_cu, k_mega, 256, 0);
    if (per_cu > 2) per_cu = 2;
    grid_blocks = cus * per_cu;
  }
  void* args[] = {&p};
  hipError_t e = hipLaunchCooperativeKernel((void*)k_mega, dim3(grid_blocks), dim3(256), args, 0, stream);
  if (e != hipSuccess) fprintf(stderr, "cooperative launch failed: %s (grid %d)\n", hipGetErrorString(e), grid_blocks);
}
```

```cpp
#include <hip/hip_runtime.h>
#include <hip/hip_cooperative_groups.h>
#include <cstdio>
#include <cstdint>

typedef unsigned short bf16_t;
typedef short bf16x8 __attribute__((ext_vector_type(8)));
typedef short s16x4 __attribute__((ext_vector_type(4)));
typedef float f32x4 __attribute__((ext_vector_type(4)));
#define LDS_AS __attribute__((address_space(3)))

constexpr int TL = 16384;
constexpr int TC = 2048;
constexpr int TT = TL + TC;
constexpr int DM = 1024;
constexpr int UW = 6144;
constexpr int SWD = 64;
constexpr int DIN = 9280;
constexpr int DFF = 4096;
constexpr float EPS = 1e-6f;
constexpr int U_NAQ = 0, U_NAK = 512, U_NAV = 1024;
constexpr int U_DNQ = 1536, U_DNK = 2048, U_DNV = 2560, U_DNZ = 3072;
constexpr int U_SZ = 3584, U_SX = 4608, U_SB = 5632, U_SC = 5888;
constexpr int U_YA = 0, U_YB = 512, U_YC = 1024, U_GATE = 2048, U_M = 5120;

struct Params {
  const float *x, *c, *ctx, *c_ctx, *w_ada, *b_ada, *norm1_g, *norm2_g, *w_in, *na_q_gain, *na_k_gain, *na_rpb,
      *dn_conv_w, *dn_a_log, *dn_dt_bias, *dn_o_gain, *ssd_conv_w, *ssd_conv_b, *ssd_a_log, *ssd_dt_bias, *ssd_d,
      *ssd_o_gain, *w_pa, *w_pb, *w_pc, *w_out, *w_ff1, *w_ff2;
  float* out;
  bf16_t* U;
  float* S;
  bf16_t* P;
  float* XC;
  float* MOD;
  float* SS;
  float* ROPE;
  unsigned* CTR;
  bf16_t* HB;
  bf16_t* OG0;
  bf16_t* OG1;
};

__device__ __forceinline__ int tidx() { int t = threadIdx.x; asm volatile("" : "+v"(t)); return t; }
__device__ __forceinline__ float bf2f(bf16_t v) { return __uint_as_float(((unsigned)v) << 16); }
__device__ __forceinline__ bf16_t f2bf(float f) {
  unsigned u = __float_as_uint(f);
  u += 0x7fffu + ((u >> 16) & 1u);
  return (bf16_t)(u >> 16);
}
__device__ __forceinline__ unsigned pack2(float a, float b) { return (unsigned)f2bf(a) | ((unsigned)f2bf(b) << 16); }
__device__ __forceinline__ float bflo(unsigned w) { return __uint_as_float(w << 16); }
__device__ __forceinline__ float bfhi(unsigned w) { return __uint_as_float(w & 0xffff0000u); }
__device__ __forceinline__ float wave_sum(float v) {
#pragma unroll
  for (int o = 32; o; o >>= 1) v += __shfl_xor(v, o);
  return v;
}
__device__ __forceinline__ float wave_max(float v) {
#pragma unroll
  for (int o = 32; o; o >>= 1) v = fmaxf(v, __shfl_xor(v, o));
  return v;
}
__device__ __forceinline__ float siluf(float v) { return v / (1.f + expf(-v)); }
__device__ __forceinline__ float sigmoidf_(float v) { return 1.f / (1.f + expf(-v)); }
__device__ __forceinline__ float softplusf_(float v) { return v > 20.f ? v : log1pf(expf(v)); }

__device__ __forceinline__ const float* xrow_in(const Params& p, int layer, int row) {
  if (layer == 0) return row < TL ? p.x + (size_t)row * DM : p.ctx + (size_t)(row - TL) * DM;
  return row < TL ? p.out + (size_t)row * DM : p.XC + (size_t)(row - TL) * DM;
}
__device__ __forceinline__ float* xrow_out(const Params& p, int row) {
  return row < TL ? p.out + (size_t)row * DM : p.XC + (size_t)(row - TL) * DM;
}
__device__ __forceinline__ int modrow(int row) { return row < TL ? (row >> 11) : 8; }

constexpr int G_BK = 32;
constexpr int G_ASTR = G_BK + 8;
constexpr int G_ATILE = 256 * G_ASTR;
constexpr int GEMM_LDS_BYTES = 2 * (G_ATILE + G_BK * (128 + 16)) * 2;
__device__ __forceinline__ s16x4 tr16(const bf16_t* ptr) { return __builtin_amdgcn_ds_read_tr16_b64_v4i16((LDS_AS s16x4*)ptr); }
__device__ __forceinline__ bf16x8 cat8(s16x4 lo, s16x4 hi) { return (bf16x8){lo[0], lo[1], lo[2], lo[3], hi[0], hi[1], hi[2], hi[3]}; }
__device__ __forceinline__ uint4 cvt8(float4 a, float4 b) { uint4 o; o.x = pack2(a.x, a.y); o.y = pack2(a.z, a.w); o.z = pack2(b.x, b.y); o.w = pack2(b.z, b.w); return o; }

__device__ __forceinline__ void gemm_main2(f32x4 (&acc)[8][2], const bf16_t* A, int astride, const float* W, int ldw, int col0, bool small, int K, bf16_t* lds) {
  constexpr int NI = 2, BSTR = 80, BTILE = G_BK * BSTR;
  const int tid = tidx(), lane = tid & 63, wave = tid >> 6, wm = wave >> 1, wn = wave & 1, g = lane >> 4, l15 = lane & 15, q4 = l15 >> 2, p4 = lane & 3;
  bf16_t* As = lds;
  bf16_t* Bs = lds + 2 * G_ATILE;
  const int ar = tid >> 2, ak = (tid & 3) * 8;
  const int bk = tid >> 3, bn = (tid & 7) * 8;
  const int rho0 = (bk & 3) + 4 * ((bk >> 3) & 3) + 16 * ((bk >> 2) & 1);
  int bsrc = col0 + bn; bool bzero = false;
  if (small) { if (bn < 32) bsrc = 3584 + bn; else if (bn < 64) bsrc = 6176 + bn - 32; else { bzero = true; bsrc = 0; } }
  const bf16_t* ap = A + (size_t)ar * astride + ak;
  const float* bp = W + (size_t)bk * ldw + bsrc;
  bf16_t* aw = As + ar * G_ASTR + ak;
  bf16_t* bw = Bs + rho0 * BSTR + bn;
  uint4 ra0, ra1, ra2, ra3; float4 rb0, rb1;
#define G_LOADS(K1) { ra0 = *(const uint4*)(ap + (size_t)(64 * 0) * astride + (K1)); ra1 = *(const uint4*)(ap + (size_t)(64 * 1) * astride + (K1)); ra2 = *(const uint4*)(ap + (size_t)(64 * 2) * astride + (K1)); ra3 = *(const uint4*)(ap + (size_t)(64 * 3) * astride + (K1)); { const float* s_ = bp + (size_t)(K1) * ldw; rb0 = *(const float4*)s_; rb1 = *(const float4*)(s_ + 4); } }
#define G_STORES(NX) { *(uint4*)(aw + (NX) * G_ATILE + 64 * 0 * G_ASTR) = ra0; *(uint4*)(aw + (NX) * G_ATILE + 64 * 1 * G_ASTR) = ra1; *(uint4*)(aw + (NX) * G_ATILE + 64 * 2 * G_ASTR) = ra2; *(uint4*)(aw + (NX) * G_ATILE + 64 * 3 * G_ASTR) = ra3; { uint4 o_ = cvt8(rb0, rb1); if (bzero) o_ = make_uint4(0u, 0u, 0u, 0u); *(uint4*)(bw + (NX) * BTILE + 0 * BSTR) = o_; } }
  G_LOADS(0)
  G_STORES(0)
  __syncthreads();
  const int nk = K / G_BK;
  for (int kt = 0; kt < nk; ++kt) {
    const int cur = kt & 1;
    const int k1 = (kt + 1 < nk ? kt + 1 : kt) * G_BK;
    G_LOADS(k1)
    asm volatile("" ::: "memory");
    const bf16_t* Ac = As + cur * G_ATILE + (128 * wm + l15) * G_ASTR + 8 * g;
    const bf16_t* Bc = Bs + cur * BTILE + (4 * g + q4) * BSTR + 16 * NI * wn + 4 * p4;
    {
      bf16x8 af[8], bfr[NI];
#pragma unroll
      for (int mi = 0; mi < 8; ++mi) af[mi] = *(const bf16x8*)(Ac + mi * 16 * G_ASTR);
#pragma unroll
      for (int ni = 0; ni < NI; ++ni) bfr[ni] = cat8(tr16(Bc + 16 * ni), tr16(Bc + 16 * BSTR + 16 * ni));
#pragma unroll
      for (int mi = 0; mi < 8; ++mi)
#pragma unroll
        for (int ni = 0; ni < NI; ++ni) acc[mi][ni] = __builtin_amdgcn_mfma_f32_16x16x32_bf16(bfr[ni], af[mi], acc[mi][ni], 0, 0, 0);
    }
    asm volatile("" ::: "memory");
    __builtin_amdgcn_sched_barrier(0);
    G_STORES(cur ^ 1)
    __syncthreads();
  }
#undef G_LOADS
#undef G_STORES
}
__device__ __forceinline__ void gemm_main4(f32x4 (&acc)[8][4], const bf16_t* A, int astride, const float* W, int ldw, int col0, bool small, int K, bf16_t* lds) {
  constexpr int NI = 4, BSTR = 144, BTILE = G_BK * BSTR;
  const int tid = tidx(), lane = tid & 63, wave = tid >> 6, wm = wave >> 1, wn = wave & 1, g = lane >> 4, l15 = lane & 15, q4 = l15 >> 2, p4 = lane & 3;
  bf16_t* As = lds;
  bf16_t* Bs = lds + 2 * G_ATILE;
  const int ar = tid >> 2, ak = (tid & 3) * 8;
  const int bk = tid >> 4, bn = (tid & 15) * 8;
  const int rho0 = (bk & 3) + 4 * (bk >> 3) + 16 * ((bk >> 2) & 1);
  int bsrc = col0 + bn; bool bzero = false;
  if (small) { if (bn < 32) bsrc = 3584 + bn; else if (bn < 64) bsrc = 6176 + bn - 32; else { bzero = true; bsrc = 0; } }
  const bf16_t* ap = A + (size_t)ar * astride + ak;
  const float* bp = W + (size_t)bk * ldw + bsrc;
  bf16_t* aw = As + ar * G_ASTR + ak;
  bf16_t* bw = Bs + rho0 * BSTR + bn;
  uint4 ra0, ra1, ra2, ra3; float4 rb0, rb1, rb2, rb3;
#define G_LOADS(K1) { ra0 = *(const uint4*)(ap + (size_t)(64 * 0) * astride + (K1)); ra1 = *(const uint4*)(ap + (size_t)(64 * 1) * astride + (K1)); ra2 = *(const uint4*)(ap + (size_t)(64 * 2) * astride + (K1)); ra3 = *(const uint4*)(ap + (size_t)(64 * 3) * astride + (K1)); { const float* s_ = bp + (size_t)((K1) + 16 * 0) * ldw; rb0 = *(const float4*)s_; rb1 = *(const float4*)(s_ + 4); } { const float* s_ = bp + (size_t)((K1) + 16 * 1) * ldw; rb2 = *(const float4*)s_; rb3 = *(const float4*)(s_ + 4); } }
#define G_STORES(NX) { *(uint4*)(aw + (NX) * G_ATILE + 64 * 0 * G_ASTR) = ra0; *(uint4*)(aw + (NX) * G_ATILE + 64 * 1 * G_ASTR) = ra1; *(uint4*)(aw + (NX) * G_ATILE + 64 * 2 * G_ASTR) = ra2; *(uint4*)(aw + (NX) * G_ATILE + 64 * 3 * G_ASTR) = ra3; { uint4 o_ = cvt8(rb0, rb1); if (bzero) o_ = make_uint4(0u, 0u, 0u, 0u); *(uint4*)(bw + (NX) * BTILE + 0 * BSTR) = o_; } { uint4 o_ = cvt8(rb2, rb3); if (bzero) o_ = make_uint4(0u, 0u, 0u, 0u); *(uint4*)(bw + (NX) * BTILE + 8 * BSTR) = o_; } }
  G_LOADS(0)
  G_STORES(0)
  __syncthreads();
  const int nk = K / G_BK;
  for (int kt = 0; kt < nk; ++kt) {
    const int cur = kt & 1;
    const int k1 = (kt + 1 < nk ? kt + 1 : kt) * G_BK;
    G_LOADS(k1)
    asm volatile("" ::: "memory");
    const bf16_t* Ac = As + cur * G_ATILE + (128 * wm + l15) * G_ASTR + 8 * g;
    const bf16_t* Bc = Bs + cur * BTILE + (4 * g + q4) * BSTR + 16 * NI * wn + 4 * p4;
    {
      bf16x8 af[8], bfr[NI];
#pragma unroll
      for (int mi = 0; mi < 8; ++mi) af[mi] = *(const bf16x8*)(Ac + mi * 16 * G_ASTR);
#pragma unroll
      for (int ni = 0; ni < NI; ++ni) bfr[ni] = cat8(tr16(Bc + 16 * ni), tr16(Bc + 16 * BSTR + 16 * ni));
#pragma unroll
      for (int mi = 0; mi < 8; ++mi)
#pragma unroll
        for (int ni = 0; ni < NI; ++ni) acc[mi][ni] = __builtin_amdgcn_mfma_f32_16x16x32_bf16(bfr[ni], af[mi], acc[mi][ni], 0, 0, 0);
    }
    asm volatile("" ::: "memory");
    __builtin_amdgcn_sched_barrier(0);
    G_STORES(cur ^ 1)
    __syncthreads();
  }
#undef G_LOADS
#undef G_STORES
}
template <int NI> __device__ __forceinline__ void acc_zero(f32x4 (&acc)[8][NI]) {
#pragma unroll
  for (int i = 0; i < 8; ++i)
#pragma unroll
    for (int j = 0; j < NI; ++j) acc[i][j] = (f32x4){0.f, 0.f, 0.f, 0.f};
}
__device__ __forceinline__ bool tile_next(int i, int bid, int nb, int nMt, int nNt, bool nsplit, int& mt, int& nt) {
  const int xcd = bid & 7, slot = bid >> 3, nslots = nb >> 3;
  const int j = slot + i * nslots;
  if (nsplit) {
    const int nNx = (nNt - xcd + 7) >> 3;
    if (j >= nMt * nNx) return false;
    mt = j / nNx; nt = xcd + 8 * (j % nNx);
  } else {
    const int nMx = (nMt - xcd + 7) >> 3;
    if (j >= nMx * nNt) return false;
    mt = xcd + 8 * (j / nNt); nt = j % nNt;
  }
  return true;
}
#define EPI_IDS const int lane = tidx() & 63, wave = tidx() >> 6, wm = wave >> 1, wn = wave & 1, g = lane >> 4, l15 = lane & 15

__device__ __forceinline__ void phase_pro(const Params& p, int bid, int nb) {
  const int tid = tidx(), lane = tid & 63, wave = tid >> 6;
  for (int row = bid * 4 + wave; row < TT; row += nb * 4) {
    const float* xr = xrow_in(p, 0, row);
    float s = 0.f;
#pragma unroll
    for (int i = 0; i < 4; ++i) { const float4 v = *(const float4*)(xr + lane * 4 + 256 * i); s += v.x * v.x + v.y * v.y + v.z * v.z + v.w * v.w; }
    s = wave_sum(s);
    if (lane == 0) { p.SS[row] = s; p.SS[TT + row] = 0.f; p.SS[2 * TT + row] = 0.f; p.SS[3 * TT + row] = 0.f; }
  }
  for (int i = bid * 256 + tid; i < 64 + 2 * 2048; i += nb * 256) p.CTR[i] = 0u;
  for (int i = bid * 256 + tid; i < 64 * 16; i += nb * 256) {
    const int pos = i >> 4, fi = i & 15;
    const float inv = powf(10000.f, -(float)fi / 16.f);
    const float ang = (float)pos * inv;
    p.ROPE[2 * i] = cosf(ang); p.ROPE[2 * i + 1] = sinf(ang);
  }
}
__device__ __forceinline__ void phase_modp(const Params& p, int bid, int nb, float* lds) {
  const int tid = tidx();
  float* MODP = (float*)p.U;
  for (int u = bid; u < 768; u += nb) {
    const int ks = u & 15, cb = (u >> 4) % 24, l = u / 384, n = cb * 256 + tid;
    __syncthreads();
    for (int i = tid; i < 9 * 64; i += 256) { const int r = i >> 6, k = 64 * ks + (i & 63); const float v = r < 8 ? p.c[r * 1024 + k] : p.c_ctx[k]; lds[i] = siluf(v); }
    __syncthreads();
    float acc[9];
#pragma unroll
    for (int r = 0; r < 9; ++r) acc[r] = 0.f;
    const float* w = p.w_ada + ((size_t)l * 1024 + 64 * ks) * 6144 + n;
#pragma unroll 16
    for (int k = 0; k < 64; ++k) {
      const float wv = w[(size_t)k * 6144];
#pragma unroll
      for (int r = 0; r < 9; ++r) acc[r] += lds[r * 64 + k] * wv;
    }
#pragma unroll
    for (int r = 0; r < 9; ++r) MODP[((size_t)(ks * 2 + l) * 9 + r) * 6144 + n] = acc[r];
  }
}
__device__ __forceinline__ void phase_modfin(const Params& p, int bid, int nb) {
  const float* MODP = (const float*)p.U;
  for (int i = bid * 256 + tidx(); i < 2 * 9 * 6144; i += nb * 256) {
    const int l = i / (9 * 6144), rem = i % (9 * 6144), r = rem / 6144, n = rem % 6144;
    float v = p.b_ada[l * 6144 + n];
#pragma unroll
    for (int ks = 0; ks < 16; ++ks) v += MODP[((size_t)(ks * 2 + l) * 9 + r) * 6144 + n];
    const int chunk = n >> 10, kk = n & 1023;
    if (chunk == 1) v = p.norm1_g[l * 1024 + kk] * (1.f + v);
    if (chunk == 4) v = p.norm2_g[l * 1024 + kk] * (1.f + v);
    p.MOD[i] = v;
  }
}

__device__ __forceinline__ void norm_rows4(const float* x0, const float* x1, const float* x2, const float* x3, const float* ss, int row0, const float* alpha, const float* shift, bf16_t* h0, int lane) {
  const float* xr[4] = {x0, x1, x2, x3};
  float4 v[4][4];
#pragma unroll
  for (int j = 0; j < 4; ++j)
#pragma unroll
    for (int i = 0; i < 4; ++i) v[j][i] = *(const float4*)(xr[j] + lane * 4 + 256 * i);
  float rs[4];
#pragma unroll
  for (int j = 0; j < 4; ++j) rs[j] = rsqrtf(ss[row0 + j] * (1.f / DM) + EPS);
#pragma unroll
  for (int i = 0; i < 4; ++i) {
    const int k = lane * 4 + 256 * i;
    const float4 a = *(const float4*)(alpha + k), s = *(const float4*)(shift + k);
#pragma unroll
    for (int j = 0; j < 4; ++j) {
      uint2 o; o.x = pack2(v[j][i].x * rs[j] * a.x + s.x, v[j][i].y * rs[j] * a.y + s.y); o.y = pack2(v[j][i].z * rs[j] * a.z + s.z, v[j][i].w * rs[j] * a.w + s.w);
      *(uint2*)(h0 + (size_t)j * 1024 + k) = o;
    }
  }
}
__device__ __forceinline__ void phase_norm(const Params& p, int layer, int which, int bid, int nb) {
  const int lane = tidx() & 63, wave = tidx() >> 6;
  const int nrow = (which == 1 && layer == 1) ? TL : TT;
  const float* modl = p.MOD + (size_t)layer * 9 * 6144;
  const float* ss = p.SS + (size_t)(2 * layer + which) * TT;
  const int lin = which == 0 ? layer : 1;
  for (int row = (bid * 4 + wave) * 4; row < nrow; row += nb * 16) {
    const float* mr = modl + modrow(row) * 6144;
    norm_rows4(xrow_in(p, lin, row), xrow_in(p, lin, row + 1), xrow_in(p, lin, row + 2), xrow_in(p, lin, row + 3), ss, row,
               mr + (which ? 4096 : 1024), mr + (which ? 3072 : 0), p.P + (size_t)row * 1024, lane);
  }
}

__device__ __forceinline__ void phase_g1(const Params& p, int layer, int bid, int nb, bf16_t* lds) {
  constexpr bool NSPLIT = true;
  const int nMt = TT / 256, nNt = 49;
  EPI_IDS;
  for (int ti = 0;; ++ti) {
    int mt, nt; if (!tile_next(ti, bid, nb, nMt, nNt, NSPLIT, mt, nt)) break;
    const int m0 = mt * 256, n0 = nt * 128;
    f32x4 acc[8][4]; acc_zero<4>(acc);
    gemm_main4(acc, p.P + (size_t)m0 * 1024, 1024, p.w_in + (size_t)layer * 1024 * DIN, DIN, n0 < 3584 ? n0 : n0 + 32, nt == 48, 1024, lds);
    if (n0 < 1024) {
      const float* gain = (n0 < 512 ? p.na_q_gain : p.na_k_gain) + layer * 64;
      const float mul = n0 < 512 ? 0.125f : 1.f;
#pragma unroll
      for (int mi = 0; mi < 8; ++mi) {
        float ss = 0.f;
#pragma unroll
        for (int ni = 0; ni < 4; ++ni) ss += acc[mi][ni][0] * acc[mi][ni][0] + acc[mi][ni][1] * acc[mi][ni][1] + acc[mi][ni][2] * acc[mi][ni][2] + acc[mi][ni][3] * acc[mi][ni][3];
        ss += __shfl_xor(ss, 16); ss += __shfl_xor(ss, 32);
        const float rs = rsqrtf(ss * (1.f / 64.f) + EPS) * mul;
        const int row = m0 + 128 * wm + 16 * mi + l15;
#pragma unroll
        for (int ni = 0; ni < 4; ++ni) {
          const int cl = 16 * ni + 4 * g;
          const float4 gv = *(const float4*)(gain + cl);
          uint2 o; o.x = pack2(acc[mi][ni][0] * rs * gv.x, acc[mi][ni][1] * rs * gv.y); o.y = pack2(acc[mi][ni][2] * rs * gv.z, acc[mi][ni][3] * rs * gv.w);
          *(uint2*)(p.U + (size_t)row * UW + n0 + 64 * wn + cl) = o;
        }
      }
    } else if (n0 < 6144) {
      const bool hsec = (n0 >= 1536 && n0 < 3072) || n0 >= 4608;
      const int hcol0 = n0 < 3072 ? n0 - 1536 : n0 - 3072;
#pragma unroll
      for (int mi = 0; mi < 8; ++mi) {
        const int row = m0 + 128 * wm + 16 * mi + l15;
        const int rr = row & 63;
        const bool halo = hsec && (rr < 2 || rr >= 62);
        bf16_t* hb = p.HB + ((size_t)(row >> 6) * 4 + (rr < 2 ? rr : rr - 60)) * 3072 + hcol0 + 64 * wn + 4 * g;
#pragma unroll
        for (int ni = 0; ni < 4; ++ni) {
          uint2 o; o.x = pack2(acc[mi][ni][0], acc[mi][ni][1]); o.y = pack2(acc[mi][ni][2], acc[mi][ni][3]);
          *(uint2*)(p.U + (size_t)row * UW + n0 + 64 * wn + 16 * ni + 4 * g) = o;
          if (halo) *(uint2*)(hb + 16 * ni) = o;
        }
      }
    } else if (wn == 0) {
#pragma unroll
      for (int mi = 0; mi < 8; ++mi) {
        const int row = m0 + 128 * wm + 16 * mi + l15;
#pragma unroll
        for (int ni = 0; ni < 4; ++ni) *(f32x4*)(p.S + (size_t)row * SWD + 16 * ni + 4 * g) = acc[mi][ni];
      }
    }
  }
}

__device__ __forceinline__ void phase_g2a(const Params& p, int layer, int bid, int nb, bf16_t* lds) {
  constexpr bool NSPLIT = true;
  const int nMt = (layer == 0 ? TT : TL) / 256, nNt = 24;
  EPI_IDS;
  for (int ti = 0;; ++ti) {
    int mt, nt; if (!tile_next(ti, bid, nb, nMt, nNt, NSPLIT, mt, nt)) break;
    const int m0 = mt * 256, n0 = nt * 128;
    f32x4 acc[8][4]; acc_zero<4>(acc);
    gemm_main4(acc, p.P + (size_t)m0 * 1024, 1024, p.w_in + (size_t)layer * 1024 * DIN, DIN, 6208 + n0, false, 1024, lds);
#pragma unroll
    for (int mi = 0; mi < 8; ++mi) {
      const int row = m0 + 128 * wm + 16 * mi + l15;
#pragma unroll
      for (int ni = 0; ni < 4; ++ni) {
        uint2 o; o.x = pack2(sigmoidf_(acc[mi][ni][0]), sigmoidf_(acc[mi][ni][1])); o.y = pack2(sigmoidf_(acc[mi][ni][2]), sigmoidf_(acc[mi][ni][3]));
        *(uint2*)(p.U + (size_t)row * UW + U_GATE + n0 + 64 * wn + 16 * ni + 4 * g) = o;
      }
    }
  }
}
__device__ __forceinline__ void phase_g2b(const Params& p, int layer, int bid, int nb, bf16_t* lds) {
  constexpr bool NSPLIT = false;
  const int nMt = (layer == 0 ? TT : TL) / 256, nNt = 16;
  EPI_IDS;
  for (int ti = 0;; ++ti) {
    int mt, nt; if (!tile_next(ti, bid, nb, nMt, nNt, NSPLIT, mt, nt)) break;
    const int m0 = mt * 256, n0 = nt * 64;
    f32x4 accm[8][2]; acc_zero<2>(accm);
#pragma unroll 1
    for (int i = 0; i < 3; ++i) {
      const int ycol = i == 0 ? U_YA : (i == 1 ? U_YB : U_YC);
      const int Ki = i == 2 ? 1024 : 512;
      const float* w = i == 0 ? p.w_pa + (size_t)layer * 512 * 1024 : (i == 1 ? p.w_pb + (size_t)layer * 512 * 1024 : p.w_pc + (size_t)layer * 1024 * 1024);
      f32x4 acc[8][2]; acc_zero<2>(acc);
      gemm_main2(acc, p.U + (size_t)m0 * UW + ycol, UW, w, 1024, n0, false, Ki, lds);
#pragma unroll
      for (int mi = 0; mi < 8; ++mi) {
        const int row = m0 + 128 * wm + 16 * mi + l15;
#pragma unroll
        for (int ni = 0; ni < 2; ++ni) {
          const uint2 gt = *(const uint2*)(p.U + (size_t)row * UW + U_GATE + 1024 * i + n0 + 32 * wn + 16 * ni + 4 * g);
          accm[mi][ni][0] += bflo(gt.x) * acc[mi][ni][0]; accm[mi][ni][1] += bfhi(gt.x) * acc[mi][ni][1];
          accm[mi][ni][2] += bflo(gt.y) * acc[mi][ni][2]; accm[mi][ni][3] += bfhi(gt.y) * acc[mi][ni][3];
        }
      }
    }
#pragma unroll
    for (int mi = 0; mi < 8; ++mi) {
      const int row = m0 + 128 * wm + 16 * mi + l15;
#pragma unroll
      for (int ni = 0; ni < 2; ++ni) {
        uint2 o; o.x = pack2(accm[mi][ni][0], accm[mi][ni][1]); o.y = pack2(accm[mi][ni][2], accm[mi][ni][3]);
        *(uint2*)(p.U + (size_t)row * UW + U_M + n0 + 32 * wn + 16 * ni + 4 * g) = o;
      }
    }
  }
}
__device__ __forceinline__ void epi_residual(const Params& p, const f32x4 (&acc)[8][4], int layer_in, int m0, int n0, const float* gate, float* ssacc) {
  EPI_IDS;
#pragma unroll
  for (int mi = 0; mi < 8; ++mi) {
    const int row = m0 + 128 * wm + 16 * mi + l15;
    const float* xi = xrow_in(p, layer_in, row);
    float* xo = xrow_out(p, row);
    const float* gr = gate + modrow(row) * 6144;
    float ss = 0.f;
#pragma unroll
    for (int ni = 0; ni < 4; ++ni) {
      const int col = n0 + 64 * wn + 16 * ni + 4 * g;
      const float4 xv = *(const float4*)(xi + col);
      const float4 gv = *(const float4*)(gr + col);
      float4 o;
      o.x = xv.x + gv.x * acc[mi][ni][0]; o.y = xv.y + gv.y * acc[mi][ni][1]; o.z = xv.z + gv.z * acc[mi][ni][2]; o.w = xv.w + gv.w * acc[mi][ni][3];
      *(float4*)(xo + col) = o;
      ss += o.x * o.x + o.y * o.y + o.z * o.z + o.w * o.w;
    }
    if (ssacc) {
      ss += __shfl_xor(ss, 16); ss += __shfl_xor(ss, 32);
      if (g == 0) atomicAdd(ssacc + row, ss);
    }
  }
}
__device__ __forceinline__ void phase_g3(const Params& p, int layer, int bid, int nb, bf16_t* lds) {
  constexpr bool NSPLIT = false;
  const int nMt = (layer == 0 ? TT : TL) / 256, nNt = 8;
  const float* modl = p.MOD + (size_t)layer * 9 * 6144;
  for (int ti = 0;; ++ti) {
    int mt, nt; if (!tile_next(ti, bid, nb, nMt, nNt, NSPLIT, mt, nt)) break;
    const int m0 = mt * 256, n0 = nt * 128;
    f32x4 acc[8][4]; acc_zero<4>(acc);
    gemm_main4(acc, p.U + (size_t)m0 * UW + U_M, UW, p.w_out + (size_t)layer * 1024 * 1024, 1024, n0, false, 1024, lds);
    epi_residual(p, acc, layer, m0, n0, modl + 2048, p.SS + (size_t)(2 * layer + 1) * TT);
  }
}
__device__ __forceinline__ void phase_g4(const Params& p, int layer, int bid, int nb, bf16_t* lds) {
  constexpr bool NSPLIT = true;
  const int nMt = (layer == 0 ? TT : TL) / 256, nNt = 32;
  EPI_IDS;
  for (int ti = 0;; ++ti) {
    int mt, nt; if (!tile_next(ti, bid, nb, nMt, nNt, NSPLIT, mt, nt)) break;
    const int m0 = mt * 256, n0 = nt * 128;
    f32x4 acc[8][4]; acc_zero<4>(acc);
    gemm_main4(acc, p.P + (size_t)m0 * 1024, 1024, p.w_ff1 + (size_t)layer * 1024 * DFF, DFF, n0, false, 1024, lds);
#pragma unroll
    for (int mi = 0; mi < 8; ++mi) {
      const int row = m0 + 128 * wm + 16 * mi + l15;
#pragma unroll
      for (int ni = 0; ni < 4; ++ni) {
        const float v0 = fmaxf(acc[mi][ni][0], 0.f), v1 = fmaxf(acc[mi][ni][1], 0.f), v2 = fmaxf(acc[mi][ni][2], 0.f), v3 = fmaxf(acc[mi][ni][3], 0.f);
        uint2 o; o.x = pack2(v0 * v0, v1 * v1); o.y = pack2(v2 * v2, v3 * v3);
        *(uint2*)(p.U + (size_t)row * DFF + n0 + 64 * wn + 16 * ni + 4 * g) = o;
      }
    }
  }
}
__device__ __forceinline__ void phase_g5(const Params& p, int layer, int bid, int nb, bf16_t* lds) {
  constexpr bool NSPLIT = false;
  const int nMt = (layer == 0 ? TT : TL) / 256, nNt = 8;
  const float* modl = p.MOD + (size_t)layer * 9 * 6144;
  for (int ti = 0;; ++ti) {
    int mt, nt; if (!tile_next(ti, bid, nb, nMt, nNt, NSPLIT, mt, nt)) break;
    const int m0 = mt * 256, n0 = nt * 128;
    f32x4 acc[8][4]; acc_zero<4>(acc);
    gemm_main4(acc, p.U + (size_t)m0 * DFF, DFF, p.w_ff2 + (size_t)layer * DFF * 1024, 1024, n0, false, DFF, lds);
    epi_residual(p, acc, 1, m0, n0, modl + 5120, layer == 0 ? p.SS + (size_t)2 * TT : nullptr);
  }
}

__device__ __forceinline__ void phase_prep(const Params& p, int layer, int bid, int nb) {
  const int tid = tidx();
  for (int i = bid * 256 + tid; i < TT * 64; i += nb * 256) {
    const int c = i & 63;
    float v = p.S[i];
    if (c < 16) v = sigmoidf_(v);
    else if (c < 32) v = -expf(p.dn_a_log[layer * 16 + c - 16]) * softplusf_(v + p.dn_dt_bias[layer * 16 + c - 16]);
    else v = softplusf_(v + p.ssd_dt_bias[layer * 32 + c - 32]);
    p.S[i] = v;
  }
  const int cg = tid & 7, rA = tid >> 3;
  for (int t = bid; t < 288 * 48; t += nb) {
    const int chunk = t / 48, slab = t % 48;
    const bool dn = slab < 24;
    const int typ = dn ? slab >> 3 : 3;
    const int ucol = (dn ? 1536 + 512 * typ + 64 * (slab & 7) : 4608 + 64 * (slab - 24)) + 8 * cg;
    const int hcol = dn ? ucol - 1536 : ucol - 3072;
    const int cch = (dn ? 512 * typ + 64 * (slab & 7) : 64 * (slab - 24)) + 8 * cg;
    const float* cw = (dn ? p.dn_conv_w : p.ssd_conv_w) + (size_t)layer * 5 * 1536 + cch;
    float w5[5][8];
#pragma unroll
    for (int j = 0; j < 5; ++j) {
      const float4 a = *(const float4*)(cw + j * 1536), b = *(const float4*)(cw + j * 1536 + 4);
      w5[j][0] = a.x; w5[j][1] = a.y; w5[j][2] = a.z; w5[j][3] = a.w; w5[j][4] = b.x; w5[j][5] = b.y; w5[j][6] = b.z; w5[j][7] = b.w;
    }
    float bias[8];
#pragma unroll
    for (int e = 0; e < 8; ++e) bias[e] = dn ? 0.f : p.ssd_conv_b[layer * 1536 + cch + e];
    const bool lat = chunk < 256;
    const int cs = lat ? (chunk & 31) : ((chunk - 256) & 3);
    const bool first = cs == 0, last = lat ? cs == 31 : cs == 3;
    const int r0 = chunk * 64;
    uint4 raw[2][5];
#pragma unroll
    for (int it = 0; it < 2; ++it)
#pragma unroll
      for (int j = 0; j < 5; ++j) {
        const int rr = rA + 32 * it - 2 + j;
        uint4 v = make_uint4(0u, 0u, 0u, 0u);
        if (rr < 0) { if (!first) v = *(const uint4*)(p.HB + ((size_t)(chunk - 1) * 4 + 4 + rr) * 3072 + hcol); }
        else if (rr >= 64) { if (!last) v = *(const uint4*)(p.HB + ((size_t)(chunk + 1) * 4 + rr - 64) * 3072 + hcol); }
        else v = *(const uint4*)(p.U + (size_t)(r0 + rr) * UW + ucol);
        raw[it][j] = v;
      }
    __syncthreads();
#pragma unroll
    for (int it = 0; it < 2; ++it) {
      const int rr = rA + 32 * it;
      float v[8];
#pragma unroll
      for (int e = 0; e < 8; ++e) v[e] = bias[e];
#pragma unroll
      for (int j = 0; j < 5; ++j) {
        const uint4 x = raw[it][j];
        v[0] += w5[j][0] * bflo(x.x); v[1] += w5[j][1] * bfhi(x.x); v[2] += w5[j][2] * bflo(x.y); v[3] += w5[j][3] * bfhi(x.y);
        v[4] += w5[j][4] * bflo(x.z); v[5] += w5[j][5] * bfhi(x.z); v[6] += w5[j][6] * bflo(x.w); v[7] += w5[j][7] * bfhi(x.w);
      }
#pragma unroll
      for (int e = 0; e < 8; ++e) v[e] = siluf(v[e]);
      if (typ < 2) {
        float ss = 0.f;
#pragma unroll
        for (int e = 0; e < 8; ++e) ss += v[e] * v[e];
        ss += __shfl_xor(ss, 1); ss += __shfl_xor(ss, 2); ss += __shfl_xor(ss, 4);
        const float rs = rsqrtf(ss + EPS) * (typ == 0 ? 0.125f : 1.f);
        if (lat) {
          const int pos = cg < 4 ? cs : rr;
          const float* rp = p.ROPE + (pos * 16 + 8 * (cg & 1)) * 2;
          const float4 c0 = *(const float4*)rp, c1 = *(const float4*)(rp + 4), c2 = *(const float4*)(rp + 8), c3 = *(const float4*)(rp + 12);
          const float cs8[8] = {c0.x, c0.z, c1.x, c1.z, c2.x, c2.z, c3.x, c3.z}, sn8[8] = {c0.y, c0.w, c1.y, c1.w, c2.y, c2.w, c3.y, c3.w};
#pragma unroll
          for (int e = 0; e < 8; ++e) {
            const float vp = __shfl_xor(v[e], 2);
            v[e] = v[e] * cs8[e] + ((cg & 2) ? vp : -vp) * sn8[e];
          }
        }
#pragma unroll
        for (int e = 0; e < 8; ++e) v[e] *= rs;
      }
      uint4 o; o.x = pack2(v[0], v[1]); o.y = pack2(v[2], v[3]); o.z = pack2(v[4], v[5]); o.w = pack2(v[6], v[7]);
      *(uint4*)(p.U + (size_t)(r0 + rr) * UW + ucol) = o;
    }
  }
}

constexpr int XS = 72;
constexpr int BS2 = 136;
constexpr int SSD_LDS = (3 * 64 * XS + 3 * 64 * BS2) * 2 + 2 * 64 * 4;
__device__ __forceinline__ void phase_ssd(const Params& p, int layer, int task, char* smem) {
  const int tid = tidx(), lane = tid & 63, wave = tid >> 6, g = lane >> 4, l15 = lane & 15, q4 = l15 >> 2, p4 = lane & 3;
  bf16_t* Xt = (bf16_t*)smem;
  bf16_t* Xs = Xt + 64 * XS;
  bf16_t* Wg = Xs + 64 * XS;
  bf16_t* Bt = Wg + 64 * XS;
  bf16_t* Ct = Bt + 64 * BS2;
  bf16_t* Hb = Ct + 64 * BS2;
  float* dts = (float*)(Hb + 64 * BS2);
  float* lam = dts + 64;
  {
    const int head = task & 15, b = task >> 4, grp = head >> 3;
    f32x4 hst[2][8];
#pragma unroll
    for (int d = 0; d < 2; ++d)
#pragma unroll
      for (int n = 0; n < 8; ++n) hst[d][n] = (f32x4){0.f, 0.f, 0.f, 0.f};
    const float dsk = p.ssd_d[layer * 16 + head];
    const float an0 = -expf(p.ssd_a_log[layer * 32 + head]), an1 = -expf(p.ssd_a_log[layer * 32 + 16 + head]);
    for (int it = 0; it < 36; ++it) {
      const int seg = it >= 4, ci = seg ? it - 4 : it, nch = seg ? 32 : 4;
      const int base = seg ? b * 2048 : TL + b * 256;
      const bool want_o = seg == 1 || layer == 0;
      const bool first = ci < nch / 2;
#pragma unroll
      for (int dir = 0; dir < 2; ++dir) {
        const int c = dir ? nch - 1 - ci : ci;
        const int r0 = base + 64 * c;
        __syncthreads();
        {
          const int i = tid >> 2, sub = tid & 3;
          const int row = r0 + (dir ? 63 - i : i);
          const bf16_t* ur = p.U + (size_t)row * UW;
          const uint4* sx = (const uint4*)(ur + U_SX + 64 * head + 16 * sub);
          *(uint4*)(Xt + i * XS + 16 * sub) = sx[0]; *(uint4*)(Xt + i * XS + 16 * sub + 8) = sx[1];
          const uint4* sb = (const uint4*)(ur + U_SB + 128 * grp + 32 * sub);
#pragma unroll
          for (int k = 0; k < 4; ++k) *(uint4*)(Bt + i * BS2 + 32 * sub + 8 * k) = sb[k];
          if (want_o) {
            const uint4* sc = (const uint4*)(ur + U_SC + 128 * grp + 32 * sub);
#pragma unroll
            for (int k = 0; k < 4; ++k) *(uint4*)(Ct + i * BS2 + 32 * sub + 8 * k) = sc[k];
          }
          if (sub == 0) dts[i] = p.S[(size_t)row * SWD + 32 + dir * 16 + head];
        }
        if (want_o) {
#pragma unroll
          for (int nt = 0; nt < 8; ++nt) {
            uint2 o; o.x = pack2(hst[dir][nt][0], hst[dir][nt][1]); o.y = pack2(hst[dir][nt][2], hst[dir][nt][3]);
            *(uint2*)(Hb + (16 * wave + l15) * BS2 + 16 * nt + 4 * g) = o;
          }
        }
        __syncthreads();
        float lv = dts[lane] * (dir ? an1 : an0);
#pragma unroll
        for (int o = 1; o < 64; o <<= 1) { const float tv = __shfl_up(lv, o); if (lane >= o) lv += tv; }
        const float lam_last = __shfl(lv, 63);
        if (wave == 0) lam[lane] = lv;
        {
          const int j = tid >> 2, sub = tid & 3;
          const float lj = __shfl(lv, j & 63);
          const float sc = dts[j] * expf(lam_last - lj);
          const uint4 a = *(const uint4*)(Xt + j * XS + 16 * sub), bq = *(const uint4*)(Xt + j * XS + 16 * sub + 8);
          uint4 oa, ob;
          oa.x = pack2(bflo(a.x) * sc, bfhi(a.x) * sc); oa.y = pack2(bflo(a.y) * sc, bfhi(a.y) * sc); oa.z = pack2(bflo(a.z) * sc, bfhi(a.z) * sc); oa.w = pack2(bflo(a.w) * sc, bfhi(a.w) * sc);
          ob.x = pack2(bflo(bq.x) * sc, bfhi(bq.x) * sc); ob.y = pack2(bflo(bq.y) * sc, bfhi(bq.y) * sc); ob.z = pack2(bflo(bq.z) * sc, bfhi(bq.z) * sc); ob.w = pack2(bflo(bq.w) * sc, bfhi(bq.w) * sc);
          *(uint4*)(Xs + j * XS + 16 * sub) = oa; *(uint4*)(Xs + j * XS + 16 * sub + 8) = ob;
        }
        __syncthreads();
        if (want_o) {
          const int irow = 16 * wave + l15;
          const float li = lam[irow];
#pragma unroll
          for (int jt = 0; jt < 4; ++jt) {
            f32x4 cacc = (f32x4){0.f, 0.f, 0.f, 0.f};
            if (jt <= wave) {
#pragma unroll
              for (int s2 = 0; s2 < 4; ++s2) {
                const bf16x8 af = *(const bf16x8*)(Ct + irow * BS2 + 32 * s2 + 8 * g);
                const bf16x8 bf = *(const bf16x8*)(Bt + (16 * jt + l15) * BS2 + 32 * s2 + 8 * g);
                cacc = __builtin_amdgcn_mfma_f32_16x16x32_bf16(bf, af, cacc, 0, 0, 0);
              }
            }
            const int j0 = 16 * jt + 4 * g;
            const float4 lj = *(const float4*)(lam + j0), dj = *(const float4*)(dts + j0);
            const float w0 = (j0 + 0 <= irow) ? cacc[0] * expf(li - lj.x) * dj.x : 0.f;
            const float w1 = (j0 + 1 <= irow) ? cacc[1] * expf(li - lj.y) * dj.y : 0.f;
            const float w2 = (j0 + 2 <= irow) ? cacc[2] * expf(li - lj.z) * dj.z : 0.f;
            const float w3 = (j0 + 3 <= irow) ? cacc[3] * expf(li - lj.w) * dj.w : 0.f;
            uint2 o; o.x = pack2(w0, w1); o.y = pack2(w2, w3);
            *(uint2*)(Wg + irow * XS + j0) = o;
          }
        }
        __syncthreads();
        if (want_o) {
          const int irow = 16 * wave + l15;
          f32x4 ai[4], ae[4];
#pragma unroll
          for (int pt = 0; pt < 4; ++pt) { ai[pt] = (f32x4){0.f, 0.f, 0.f, 0.f}; ae[pt] = (f32x4){0.f, 0.f, 0.f, 0.f}; }
#pragma unroll
          for (int s2 = 0; s2 < 2; ++s2) {
            const bf16x8 af = *(const bf16x8*)(Wg + irow * XS + 32 * s2 + 8 * g);
#pragma unroll
            for (int pt = 0; pt < 4; ++pt) {
              const bf16x8 bf = cat8(tr16(Xt + (32 * s2 + 8 * g + q4) * XS + 16 * pt + 4 * p4), tr16(Xt + (32 * s2 + 8 * g + 4 + q4) * XS + 16 * pt + 4 * p4));
              ai[pt] = __builtin_amdgcn_mfma_f32_16x16x32_bf16(bf, af, ai[pt], 0, 0, 0);
            }
          }
#pragma unroll
          for (int s2 = 0; s2 < 4; ++s2) {
            const bf16x8 af = *(const bf16x8*)(Ct + irow * BS2 + 32 * s2 + 8 * g);
#pragma unroll
            for (int pt = 0; pt < 4; ++pt) {
              const bf16x8 bf = *(const bf16x8*)(Hb + (16 * pt + l15) * BS2 + 32 * s2 + 8 * g);
              ae[pt] = __builtin_amdgcn_mfma_f32_16x16x32_bf16(bf, af, ae[pt], 0, 0, 0);
            }
          }
          const float el = expf(lam[irow]);
          const int row = r0 + (dir ? 63 - irow : irow);
#pragma unroll
          for (int pt = 0; pt < 4; ++pt) {
            float y0 = ai[pt][0] + el * ae[pt][0], y1 = ai[pt][1] + el * ae[pt][1], y2 = ai[pt][2] + el * ae[pt][2], y3 = ai[pt][3] + el * ae[pt][3];
            if (dir == 0) {
              const uint2 xv = *(const uint2*)(Xt + irow * XS + 16 * pt + 4 * g);
              y0 += dsk * bflo(xv.x); y1 += dsk * bfhi(xv.x); y2 += dsk * bflo(xv.y); y3 += dsk * bfhi(xv.y);
            }
            unsigned long long* dst = (unsigned long long*)(p.P + (size_t)row * 1024 + 64 * head + 16 * pt + 4 * g);
            if (!first) {
              const unsigned long long old = __hip_atomic_load(dst, __ATOMIC_RELAXED, __HIP_MEMORY_SCOPE_AGENT);
              const unsigned lo = (unsigned)old, hi = (unsigned)(old >> 32);
              y0 += bflo(lo); y1 += bfhi(lo); y2 += bflo(hi); y3 += bfhi(hi);
            }
            *dst = (unsigned long long)pack2(y0, y1) | ((unsigned long long)pack2(y2, y3) << 32);
          }
        }
        {
          const float el = expf(lam_last);
#pragma unroll
          for (int nt = 0; nt < 8; ++nt) hst[dir][nt] *= el;
#pragma unroll
          for (int s2 = 0; s2 < 2; ++s2) {
            const bf16x8 mf = cat8(tr16(Xs + (32 * s2 + 8 * g + q4) * XS + 16 * wave + 4 * p4), tr16(Xs + (32 * s2 + 8 * g + 4 + q4) * XS + 16 * wave + 4 * p4));
#pragma unroll
            for (int nt = 0; nt < 8; ++nt) {
              const bf16x8 nf = cat8(tr16(Bt + (32 * s2 + 8 * g + q4) * BS2 + 16 * nt + 4 * p4), tr16(Bt + (32 * s2 + 8 * g + 4 + q4) * BS2 + 16 * nt + 4 * p4));
              hst[dir][nt] = __builtin_amdgcn_mfma_f32_16x16x32_bf16(nf, mf, hst[dir][nt], 0, 0, 0);
            }
          }
        }
      }
    }
  }
}


constexpr int GT = 64 * XS;
constexpr int GDN_LDS = 8 * GT * 2 + 4 * 256 * 4 + 4 * 16 * 24 * 2 + 2 * 64 * 4;
__device__ __forceinline__ void phase_gdn(const Params& p, int layer, int task, char* smem) {
  const int tid = tidx(), lane = tid & 63, wave = tid >> 6, g = lane >> 4, l15 = lane & 15, q4 = l15 >> 2, p4 = lane & 3;
  bf16_t* Qt = (bf16_t*)smem;
  bf16_t* Kt = Qt + GT;
  bf16_t* Vt = Kt + GT;
  bf16_t* Am = Vt + GT;
  bf16_t* Mq = Am + GT;
  bf16_t* Xw = Mq + GT;
  bf16_t* Xu = Xw + GT;
  bf16_t* St = Xu + GT;
  bf16_t* Qg = Qt; bf16_t* Vn = Vt; bf16_t* Vs = Am;
  float* Adiag = (float*)(St + GT);
  bf16_t* Db = (bf16_t*)(Adiag + 4 * 256);
  float* bet = (float*)(Db + 4 * 16 * 24);
  float* gam = bet + 64;
  const bf16x8 zero8 = (bf16x8){0, 0, 0, 0, 0, 0, 0, 0};
  {
    const int dir = task & 1, h = (task >> 1) & 7, b = task >> 4;
    bf16_t* Og = layer == 0 ? p.OG0 + (size_t)dir * TT * 512 : p.OG1 + (size_t)dir * TL * 512;
    f32x4 sst[4];
#pragma unroll
    for (int e = 0; e < 4; ++e) sst[e] = (f32x4){0.f, 0.f, 0.f, 0.f};
    __syncthreads();
    for (int i = tid; i < 64 * XS / 2; i += 256) { ((unsigned*)St)[i] = 0u; ((unsigned*)Xw)[i] = 0u; ((unsigned*)Xu)[i] = 0u; }
    for (int it = 0; it < 36; ++it) {
      const int seg = it >= 4, ci = seg ? it - 4 : it, nch = seg ? 32 : 4;
      const int base = seg ? b * 2048 : TL + b * 256;
      const bool want_o = seg == 1 || layer == 0;
      const int c = dir ? nch - 1 - ci : ci;
      const int r0 = base + 64 * c;
      __syncthreads();
      {
        const int i = tid >> 2, sub = tid & 3;
        const int row = r0 + (dir ? 63 - i : i);
        const bf16_t* ur = p.U + (size_t)row * UW + 64 * h + 16 * sub;
        const uint4* sq = (const uint4*)(ur + U_DNQ); const uint4* sk = (const uint4*)(ur + U_DNK); const uint4* sv = (const uint4*)(ur + U_DNV);
        *(uint4*)(Qt + i * XS + 16 * sub) = sq[0]; *(uint4*)(Qt + i * XS + 16 * sub + 8) = sq[1];
        *(uint4*)(Kt + i * XS + 16 * sub) = sk[0]; *(uint4*)(Kt + i * XS + 16 * sub + 8) = sk[1];
        *(uint4*)(Vt + i * XS + 16 * sub) = sv[0]; *(uint4*)(Vt + i * XS + 16 * sub + 8) = sv[1];
        if (sub == 0) { bet[i] = p.S[(size_t)row * SWD + dir * 8 + h]; gam[i] = p.S[(size_t)row * SWD + 16 + dir * 8 + h]; }
      }
      __syncthreads();
      float lv = gam[lane];
#pragma unroll
      for (int o = 1; o < 64; o <<= 1) { const float tv = __shfl_up(lv, o); if (lane >= o) lv += tv; }
      const float gam_last = __shfl(lv, 63);
      __syncthreads();
      if (wave == 0) gam[lane] = lv;
      __syncthreads();
      {
        const int irow = 16 * wave + l15;
        const float gi = gam[irow], bi = bet[irow];
#pragma unroll
        for (int jt = 0; jt < 4; ++jt) {
          f32x4 kk = (f32x4){0.f, 0.f, 0.f, 0.f}, qk = (f32x4){0.f, 0.f, 0.f, 0.f};
          if (jt <= wave) {
#pragma unroll
            for (int s2 = 0; s2 < 2; ++s2) {
              const bf16x8 nf = *(const bf16x8*)(Kt + (16 * jt + l15) * XS + 32 * s2 + 8 * g);
              const bf16x8 mk = *(const bf16x8*)(Kt + irow * XS + 32 * s2 + 8 * g);
              const bf16x8 mq = *(const bf16x8*)(Qt + irow * XS + 32 * s2 + 8 * g);
              kk = __builtin_amdgcn_mfma_f32_16x16x32_bf16(nf, mk, kk, 0, 0, 0);
              qk = __builtin_amdgcn_mfma_f32_16x16x32_bf16(nf, mq, qk, 0, 0, 0);
            }
          }
          const int j0 = 16 * jt + 4 * g;
          const float4 gj = *(const float4*)(gam + j0);
          const float gjv[4] = {gj.x, gj.y, gj.z, gj.w};
          float av[4], mv[4];
#pragma unroll
          for (int r = 0; r < 4; ++r) {
            const int j = j0 + r;
            const float dec = j <= irow ? expf(gi - gjv[r]) : 0.f;
            av[r] = j < irow ? bi * kk[r] * dec : 0.f;
            mv[r] = qk[r] * dec;
          }
          uint2 oa; oa.x = pack2(av[0], av[1]); oa.y = pack2(av[2], av[3]);
          uint2 om; om.x = pack2(mv[0], mv[1]); om.y = pack2(mv[2], mv[3]);
          *(uint2*)(Am + irow * XS + j0) = oa;
          *(uint2*)(Mq + irow * XS + j0) = om;
          if (jt == wave) *(f32x4*)(Adiag + wave * 256 + l15 * 16 + 4 * g) = (f32x4){av[0], av[1], av[2], av[3]};
        }
      }
      __syncthreads();
      {
        const int j = tid >> 2, sub = tid & 3;
        const float sc = expf(gam[j]);
        const uint4 a = *(const uint4*)(Qt + j * XS + 16 * sub), bq = *(const uint4*)(Qt + j * XS + 16 * sub + 8);
        uint4 oa, ob;
        oa.x = pack2(bflo(a.x) * sc, bfhi(a.x) * sc); oa.y = pack2(bflo(a.y) * sc, bfhi(a.y) * sc); oa.z = pack2(bflo(a.z) * sc, bfhi(a.z) * sc); oa.w = pack2(bflo(a.w) * sc, bfhi(a.w) * sc);
        ob.x = pack2(bflo(bq.x) * sc, bfhi(bq.x) * sc); ob.y = pack2(bflo(bq.y) * sc, bfhi(bq.y) * sc); ob.z = pack2(bflo(bq.z) * sc, bfhi(bq.z) * sc); ob.w = pack2(bflo(bq.w) * sc, bfhi(bq.w) * sc);
        *(uint4*)(Qg + j * XS + 16 * sub) = oa; *(uint4*)(Qg + j * XS + 16 * sub + 8) = ob;
      }
      {
        const int cc = lane & 15;
        const float* Ad = Adiag + wave * 256;
        float dcol[16];
#pragma unroll
        for (int r = 0; r < 16; ++r) {
          float sacc = (r == cc) ? 1.f : 0.f;
#pragma unroll
          for (int j = 0; j < r; ++j) sacc -= Ad[r * 16 + j] * dcol[j];
          dcol[r] = sacc;
        }
        if (lane < 16) {
#pragma unroll
          for (int r = 0; r < 16; ++r) Db[(wave * 16 + r) * 24 + cc] = f2bf(dcol[r]);
        }
      }
      __syncthreads();
      {
        const bool isW = wave < 2;
        bf16_t* Xd = isW ? Xw : Xu;
        const bf16_t* Src = isW ? Kt : Vt;
        const int fbase = (wave & 1) * 32;
#pragma unroll
        for (int ib = 0; ib < 4; ++ib) {
          const int irow = 16 * ib + l15;
          const float sc = isW ? bet[irow] * expf(gam[irow]) : bet[irow];
          f32x4 y[2];
#pragma unroll
          for (int fi = 0; fi < 2; ++fi) {
            const int f0 = fbase + 16 * fi;
            const uint2 rv = *(const uint2*)(Src + irow * XS + f0 + 4 * g);
            f32x4 tmp = (f32x4){0.f, 0.f, 0.f, 0.f};
#pragma unroll
            for (int s2 = 0; s2 < 2; ++s2) {
              if (32 * s2 < 16 * ib) {
                const bool half = (32 * s2 + 32) > 16 * ib;
                bf16x8 mf = *(const bf16x8*)(Am + irow * XS + 32 * s2 + 8 * g);
                if (half && g >= 2) mf = zero8;
                const bf16x8 nf = cat8(tr16(Xd + (32 * s2 + 8 * g + q4) * XS + f0 + 4 * p4), tr16(Xd + (32 * s2 + 8 * g + 4 + q4) * XS + f0 + 4 * p4));
                tmp = __builtin_amdgcn_mfma_f32_16x16x32_bf16(nf, mf, tmp, 0, 0, 0);
              }
            }
            y[fi] = (f32x4){bflo(rv.x) * sc - tmp[0], bfhi(rv.x) * sc - tmp[1], bflo(rv.y) * sc - tmp[2], bfhi(rv.y) * sc - tmp[3]};
          }
          __syncthreads();
#pragma unroll
          for (int fi = 0; fi < 2; ++fi) {
            uint2 o; o.x = pack2(y[fi][0], y[fi][1]); o.y = pack2(y[fi][2], y[fi][3]);
            *(uint2*)(Xd + irow * XS + fbase + 16 * fi + 4 * g) = o;
          }
          __syncthreads();
          bf16x8 dm = zero8;
          if (g < 2) dm = *(const bf16x8*)(Db + (ib * 16 + l15) * 24 + 8 * g);
#pragma unroll
          for (int fi = 0; fi < 2; ++fi) {
            const int f0 = fbase + 16 * fi;
            const bf16x8 nf = cat8(tr16(Xd + (16 * ib + 8 * (g & 1) + q4) * XS + f0 + 4 * p4), tr16(Xd + (16 * ib + 8 * (g & 1) + 4 + q4) * XS + f0 + 4 * p4));
            y[fi] = __builtin_amdgcn_mfma_f32_16x16x32_bf16(nf, dm, (f32x4){0.f, 0.f, 0.f, 0.f}, 0, 0, 0);
          }
          __syncthreads();
#pragma unroll
          for (int fi = 0; fi < 2; ++fi) {
            uint2 o; o.x = pack2(y[fi][0], y[fi][1]); o.y = pack2(y[fi][2], y[fi][3]);
            *(uint2*)(Xd + irow * XS + fbase + 16 * fi + 4 * g) = o;
          }
          __syncthreads();
        }
      }
      {
        const int irow = 16 * wave + l15;
        const float dl = expf(gam_last - gam[irow]);
        f32x4 acc[4];
#pragma unroll
        for (int et = 0; et < 4; ++et) acc[et] = (f32x4){0.f, 0.f, 0.f, 0.f};
#pragma unroll
        for (int s2 = 0; s2 < 2; ++s2) {
          const bf16x8 mf = *(const bf16x8*)(Xw + irow * XS + 32 * s2 + 8 * g);
#pragma unroll
          for (int et = 0; et < 4; ++et) {
            const bf16x8 nf = *(const bf16x8*)(St + (16 * et + l15) * XS + 32 * s2 + 8 * g);
            acc[et] = __builtin_amdgcn_mfma_f32_16x16x32_bf16(nf, mf, acc[et], 0, 0, 0);
          }
        }
#pragma unroll
        for (int et = 0; et < 4; ++et) {
          const uint2 uv = *(const uint2*)(Xu + irow * XS + 16 * et + 4 * g);
          const float v0 = bflo(uv.x) - acc[et][0], v1 = bfhi(uv.x) - acc[et][1], v2 = bflo(uv.y) - acc[et][2], v3 = bfhi(uv.y) - acc[et][3];
          uint2 o; o.x = pack2(v0, v1); o.y = pack2(v2, v3);
          *(uint2*)(Vn + irow * XS + 16 * et + 4 * g) = o;
          o.x = pack2(v0 * dl, v1 * dl); o.y = pack2(v2 * dl, v3 * dl);
          *(uint2*)(Vs + irow * XS + 16 * et + 4 * g) = o;
        }
      }
      __syncthreads();
      if (want_o) {
        const int irow = 16 * wave + l15;
        f32x4 acc[4];
#pragma unroll
        for (int et = 0; et < 4; ++et) acc[et] = (f32x4){0.f, 0.f, 0.f, 0.f};
#pragma unroll
        for (int s2 = 0; s2 < 2; ++s2) {
          const bf16x8 mf = *(const bf16x8*)(Qg + irow * XS + 32 * s2 + 8 * g);
          const bf16x8 mf2 = *(const bf16x8*)(Mq + irow * XS + 32 * s2 + 8 * g);
#pragma unroll
          for (int et = 0; et < 4; ++et) {
            const bf16x8 nf = *(const bf16x8*)(St + (16 * et + l15) * XS + 32 * s2 + 8 * g);
            acc[et] = __builtin_amdgcn_mfma_f32_16x16x32_bf16(nf, mf, acc[et], 0, 0, 0);
            const bf16x8 nf2 = cat8(tr16(Vn + (32 * s2 + 8 * g + q4) * XS + 16 * et + 4 * p4), tr16(Vn + (32 * s2 + 8 * g + 4 + q4) * XS + 16 * et + 4 * p4));
            acc[et] = __builtin_amdgcn_mfma_f32_16x16x32_bf16(nf2, mf2, acc[et], 0, 0, 0);
          }
        }
        const int row = r0 + (dir ? 63 - irow : irow);
#pragma unroll
        for (int et = 0; et < 4; ++et) {
          uint2 o; o.x = pack2(acc[et][0], acc[et][1]); o.y = pack2(acc[et][2], acc[et][3]);
          *(uint2*)(Og + (size_t)row * 512 + 64 * h + 16 * et + 4 * g) = o;
        }
      }
      {
        const float el = expf(gam_last);
#pragma unroll
        for (int et = 0; et < 4; ++et) sst[et] *= el;
#pragma unroll
        for (int s2 = 0; s2 < 2; ++s2) {
          const bf16x8 nf = cat8(tr16(Kt + (32 * s2 + 8 * g + q4) * XS + 16 * wave + 4 * p4), tr16(Kt + (32 * s2 + 8 * g + 4 + q4) * XS + 16 * wave + 4 * p4));
#pragma unroll
          for (int et = 0; et < 4; ++et) {
            const bf16x8 mf = cat8(tr16(Vs + (32 * s2 + 8 * g + q4) * XS + 16 * et + 4 * p4), tr16(Vs + (32 * s2 + 8 * g + 4 + q4) * XS + 16 * et + 4 * p4));
            sst[et] = __builtin_amdgcn_mfma_f32_16x16x32_bf16(nf, mf, sst[et], 0, 0, 0);
          }
        }
      }
      __syncthreads();
#pragma unroll
      for (int et = 0; et < 4; ++et) {
        uint2 o; o.x = pack2(sst[et][0], sst[et][1]); o.y = pack2(sst[et][2], sst[et][3]);
        *(uint2*)(St + (16 * et + l15) * XS + 16 * wave + 4 * g) = o;
      }
    }
  }
}


constexpr int NA_VS = 72;
constexpr int NA_LDS_WAVE = 2 * 32 * NA_VS * 2;
__device__ __forceinline__ void phase_na(const Params& p, int layer, unsigned* ctr, char* smem) {
  const int lane = tidx() & 63, wave = tidx() >> 6, g = lane >> 4, l15 = lane & 15, q4 = l15 >> 2, p4 = lane & 3;
  bf16_t* Vl = (bf16_t*)(smem + wave * NA_LDS_WAVE);
  const int ntask = layer == 0 ? 8192 + 1024 : 8192;
  const float* rpb = p.na_rpb + (size_t)layer * 8 * 15 * 31;
  for (;;) {
    int w0 = 0;
    if (lane == 0) w0 = (int)atomicAdd(ctr, 1u);
    const int task = __builtin_amdgcn_readfirstlane(__shfl(w0, 0));
    if (task >= ntask) break;
    const bool lat = task < 8192;
    int b, h, r = 0, cb = 0, qtok0, R0 = 0, C0 = 0;
    if (lat) { cb = task & 3; r = (task >> 2) & 31; h = (task >> 7) & 7; b = task >> 10; qtok0 = b * 2048 + r * 64 + 16 * cb; R0 = min(max(r - 4, 0), 24); C0 = min(max(16 * cb - 8, 0), 32); }
    else { const int t2 = task - 8192; const int qb = t2 & 15; h = (t2 >> 4) & 7; b = t2 >> 7; qtok0 = TL + b * 256 + 16 * qb; }
    const int tau0 = lat ? 0 : 16;
    const int wtok0 = b * 2048 + R0 * 64 + C0, ctok0 = TL + b * 256;
#define tile_tok(tau) ((tau) < 16 ? wtok0 + ((tau) >> 1) * 64 + 16 * ((tau) & 1) : ctok0 + 16 * ((tau) - 16))
    const bf16_t* qp = p.U + (size_t)(qtok0 + l15) * UW + U_NAQ + 64 * h + 8 * g;
    const bf16x8 qf0 = *(const bf16x8*)qp, qf1 = *(const bf16x8*)(qp + 32);
    f32x4 sc[32];
#pragma unroll
    for (int tau = 0; tau < 32; ++tau) {
      sc[tau] = (f32x4){-INFINITY, -INFINITY, -INFINITY, -INFINITY};
      if (tau >= tau0) {
        const bf16_t* kp = p.U + (size_t)(tile_tok(tau) + l15) * UW + U_NAK + 64 * h + 8 * g;
        const bf16x8 kf0 = *(const bf16x8*)kp, kf1 = *(const bf16x8*)(kp + 32);
        f32x4 a = (f32x4){0.f, 0.f, 0.f, 0.f};
        a = __builtin_amdgcn_mfma_f32_16x16x32_bf16(kf0, qf0, a, 0, 0, 0);
        a = __builtin_amdgcn_mfma_f32_16x16x32_bf16(kf1, qf1, a, 0, 0, 0);
        if (tau < 16) {
          const int qcol = 16 * cb + l15, ws = min(max(qcol - 8, 0), 48);
          const int dr = R0 + (tau >> 1) - r + 7;
#pragma unroll
          for (int rg = 0; rg < 4; ++rg) {
            const int kcol = C0 + 16 * (tau & 1) + 4 * g + rg;
            const bool ok = kcol >= ws && kcol < ws + 16;
            const float bias = ok ? rpb[(h * 15 + dr) * 31 + (kcol - qcol + 15)] : 0.f;
            a[rg] = ok ? a[rg] + bias : -INFINITY;
          }
        }
        sc[tau] = a;
      }
    }
    float mx = -INFINITY;
#pragma unroll
    for (int tau = 0; tau < 32; ++tau) mx = fmaxf(mx, fmaxf(fmaxf(sc[tau][0], sc[tau][1]), fmaxf(sc[tau][2], sc[tau][3])));
    mx = fmaxf(mx, __shfl_xor(mx, 16)); mx = fmaxf(mx, __shfl_xor(mx, 32));
    float sum = 0.f;
#pragma unroll
    for (int tau = 0; tau < 32; ++tau) {
#pragma unroll
      for (int rg = 0; rg < 4; ++rg) { const float e = __expf(sc[tau][rg] - mx); sc[tau][rg] = e; sum += e; }
    }
    sum += __shfl_xor(sum, 16); sum += __shfl_xor(sum, 32);
    f32x4 oacc[4];
#pragma unroll
    for (int dt = 0; dt < 4; ++dt) oacc[dt] = (f32x4){0.f, 0.f, 0.f, 0.f};
    const int kap0 = tau0 >> 1;
    uint4 vr0, vr1, vr2, vr3;
#define NA_VLOAD(KAP) { \
      const int kk0_ = lane >> 3, cc_ = lane & 7; \
      const bf16_t* vb_ = p.U + U_NAV + 64 * h + 8 * cc_; \
      vr0 = *(const uint4*)(vb_ + (size_t)(tile_tok(2 * (KAP)) + kk0_) * UW); \
      vr1 = *(const uint4*)(vb_ + (size_t)(tile_tok(2 * (KAP)) + kk0_ + 8) * UW); \
      vr2 = *(const uint4*)(vb_ + (size_t)(tile_tok(2 * (KAP) + 1) + kk0_) * UW); \
      vr3 = *(const uint4*)(vb_ + (size_t)(tile_tok(2 * (KAP) + 1) + kk0_ + 8) * UW); }
    NA_VLOAD(kap0)
#pragma unroll
    for (int kap = 0; kap < 16; ++kap) {
      if (kap >= kap0) {
        bf16_t* Vb = Vl + (kap & 1) * 32 * NA_VS;
        {
          const int kk0_ = lane >> 3, cc_ = lane & 7;
          *(uint4*)(Vb + kk0_ * NA_VS + 8 * cc_) = vr0; *(uint4*)(Vb + (kk0_ + 8) * NA_VS + 8 * cc_) = vr1;
          *(uint4*)(Vb + (kk0_ + 16) * NA_VS + 8 * cc_) = vr2; *(uint4*)(Vb + (kk0_ + 24) * NA_VS + 8 * cc_) = vr3;
        }
        if (kap + 1 < 16) NA_VLOAD(kap + 1)
        __builtin_amdgcn_fence(__ATOMIC_RELEASE, "workgroup"); __builtin_amdgcn_wave_barrier(); __builtin_amdgcn_fence(__ATOMIC_ACQUIRE, "workgroup");
        bf16x8 pf;
        {
          const unsigned w0_ = pack2(sc[2 * kap][0], sc[2 * kap][1]), w1_ = pack2(sc[2 * kap][2], sc[2 * kap][3]);
          const unsigned w2_ = pack2(sc[2 * kap + 1][0], sc[2 * kap + 1][1]), w3_ = pack2(sc[2 * kap + 1][2], sc[2 * kap + 1][3]);
          pf = (bf16x8){(short)(w0_ & 0xffff), (short)(w0_ >> 16), (short)(w1_ & 0xffff), (short)(w1_ >> 16), (short)(w2_ & 0xffff), (short)(w2_ >> 16), (short)(w3_ & 0xffff), (short)(w3_ >> 16)};
        }
#pragma unroll
        for (int dt = 0; dt < 4; ++dt) {
          const bf16x8 vf = cat8(tr16(Vb + (4 * g + q4) * NA_VS + 16 * dt + 4 * p4), tr16(Vb + (16 + 4 * g + q4) * NA_VS + 16 * dt + 4 * p4));
          oacc[dt] = __builtin_amdgcn_mfma_f32_16x16x32_bf16(vf, pf, oacc[dt], 0, 0, 0);
        }
      }
    }
#undef NA_VLOAD
#undef tile_tok
    const float inv = 1.f / sum;
    bf16_t* op = p.U + (size_t)(qtok0 + l15) * UW + U_YA + 64 * h + 4 * g;
#pragma unroll
    for (int dt = 0; dt < 4; ++dt) {
      uint2 o; o.x = pack2(oacc[dt][0] * inv, oacc[dt][1] * inv); o.y = pack2(oacc[dt][2] * inv, oacc[dt][3] * inv);
      *(uint2*)(op + 16 * dt) = o;
    }
  }
}

__device__ __forceinline__ void norm_row(const float* xr, float rs, const float* alpha, const float* shift, bf16_t* hrow, int lane) {
#pragma unroll
  for (int i = 0; i < 4; ++i) {
    const int k = lane * 4 + 256 * i;
    const float4 v = *(const float4*)(xr + k), a = *(const float4*)(alpha + k), s = *(const float4*)(shift + k);
    uint2 o; o.x = pack2(v.x * rs * a.x + s.x, v.y * rs * a.y + s.y); o.y = pack2(v.z * rs * a.z + s.z, v.w * rs * a.w + s.w);
    *(uint2*)(hrow + k) = o;
  }
}
__device__ __forceinline__ void phase_fin(const Params& p, int layer, int bid, int nb) {
  const int lane = tidx() & 63, wave = tidx() >> 6;
  const int ntok = layer == 0 ? TT : TL;
  for (int tok = bid * 4 + wave; tok < ntok; tok += nb * 4) {
    bf16_t* ur = p.U + (size_t)tok * UW;
    {
      const bf16_t* of = (layer == 0 ? p.OG0 : p.OG1) + (size_t)tok * 512 + 8 * lane;
      const bf16_t* ob = of + (size_t)(layer == 0 ? TT : TL) * 512;
      const uint4 a = *(const uint4*)of, bq = *(const uint4*)ob, z = *(const uint4*)(ur + U_DNZ + 8 * lane);
      float o[8] = {bflo(a.x) + bflo(bq.x), bfhi(a.x) + bfhi(bq.x), bflo(a.y) + bflo(bq.y), bfhi(a.y) + bfhi(bq.y), bflo(a.z) + bflo(bq.z), bfhi(a.z) + bfhi(bq.z), bflo(a.w) + bflo(bq.w), bfhi(a.w) + bfhi(bq.w)};
      const float zz[8] = {bflo(z.x), bfhi(z.x), bflo(z.y), bfhi(z.y), bflo(z.z), bfhi(z.z), bflo(z.w), bfhi(z.w)};
      float ss = 0.f;
#pragma unroll
      for (int i = 0; i < 8; ++i) ss += o[i] * o[i];
      ss += __shfl_xor(ss, 1); ss += __shfl_xor(ss, 2); ss += __shfl_xor(ss, 4);
      const float rs = rsqrtf(ss * (1.f / 64.f) + EPS);
      const float* gn = p.dn_o_gain + layer * 64 + 8 * (lane & 7);
#pragma unroll
      for (int i = 0; i < 8; ++i) o[i] = o[i] * rs * gn[i] * siluf(zz[i]);
      uint4 w; w.x = pack2(o[0], o[1]); w.y = pack2(o[2], o[3]); w.z = pack2(o[4], o[5]); w.w = pack2(o[6], o[7]);
      *(uint4*)(ur + U_YB + 8 * lane) = w;
    }
    {
      float yv[16];
      float ss = 0.f;
#pragma unroll
      for (int hf = 0; hf < 2; ++hf) {
        const uint4 a = *(const uint4*)(p.P + (size_t)tok * 1024 + 16 * lane + 8 * hf), z = *(const uint4*)(ur + U_SZ + 16 * lane + 8 * hf);
        const float av[8] = {bflo(a.x), bfhi(a.x), bflo(a.y), bfhi(a.y), bflo(a.z), bfhi(a.z), bflo(a.w), bfhi(a.w)};
        const float zz[8] = {bflo(z.x), bfhi(z.x), bflo(z.y), bfhi(z.y), bflo(z.z), bfhi(z.z), bflo(z.w), bfhi(z.w)};
#pragma unroll
        for (int i = 0; i < 8; ++i) { const float v = av[i] * siluf(zz[i]); yv[8 * hf + i] = v; ss += v * v; }
      }
      ss += __shfl_xor(ss, 1); ss += __shfl_xor(ss, 2); ss += __shfl_xor(ss, 4); ss += __shfl_xor(ss, 8); ss += __shfl_xor(ss, 16);
      const float rs = rsqrtf(ss * (1.f / 512.f) + EPS);
      const float* gn = p.ssd_o_gain + layer * 1024 + 16 * lane;
#pragma unroll
      for (int hf = 0; hf < 2; ++hf) {
        uint4 w;
        w.x = pack2(yv[8 * hf + 0] * rs * gn[8 * hf + 0], yv[8 * hf + 1] * rs * gn[8 * hf + 1]);
        w.y = pack2(yv[8 * hf + 2] * rs * gn[8 * hf + 2], yv[8 * hf + 3] * rs * gn[8 * hf + 3]);
        w.z = pack2(yv[8 * hf + 4] * rs * gn[8 * hf + 4], yv[8 * hf + 5] * rs * gn[8 * hf + 5]);
        w.w = pack2(yv[8 * hf + 6] * rs * gn[8 * hf + 6], yv[8 * hf + 7] * rs * gn[8 * hf + 7]);
        *(uint4*)(ur + U_YC + 16 * lane + 8 * hf) = w;
      }
    }
    {
      asm volatile("s_waitcnt vmcnt(0)" ::: "memory");
      const float* mr = p.MOD + (size_t)layer * 9 * 6144 + modrow(tok) * 6144;
      const float rs = rsqrtf(p.SS[(size_t)(2 * layer) * TT + tok] * (1.f / DM) + EPS);
      norm_row(xrow_in(p, layer, tok), rs, mr + 1024, mr, p.P + (size_t)tok * 1024, lane);
    }
  }
}

namespace cg = cooperative_groups;
constexpr int MEGA_LDS = GDN_LDS > SSD_LDS ? GDN_LDS : SSD_LDS;
static_assert(MEGA_LDS <= 81408 && GEMM_LDS_BYTES <= MEGA_LDS && 4 * NA_LDS_WAVE <= MEGA_LDS, "LDS budget");
__global__ void __launch_bounds__(256, 2) k_mega(Params p) {
  cg::grid_group grid = cg::this_grid();
  __shared__ __attribute__((aligned(16))) char smem[MEGA_LDS];
  const int bid = blockIdx.x, nb = gridDim.x;
  phase_pro(p, bid, nb);
  phase_modp(p, bid, nb, (float*)smem);
  grid.sync();
  phase_modfin(p, bid, nb);
  grid.sync();
  phase_norm(p, 0, 0, bid, nb);
  grid.sync();
  for (int layer = 0; layer < 2; ++layer) {
    phase_g1(p, layer, bid, nb, (bf16_t*)smem);
    grid.sync();
    phase_prep(p, layer, bid, nb);
    grid.sync();
    {
      __shared__ int s_role;
      unsigned* chain_ctr = p.CTR + 8 + layer;
      if (threadIdx.x == 0) {
        const unsigned key = (((unsigned)__builtin_amdgcn_s_getreg((3 << 11) | 20) & 0xFu) << 8) | (((unsigned)__builtin_amdgcn_s_getreg(63492) >> 8) & 0xffu);
        const unsigned slot = nb > 256 ? atomicAdd(p.CTR + 64 + 2048 * layer + key, 1u) : 0u;
        s_role = slot == 0 ? (int)atomicAdd(chain_ctr, 1u) : 1 << 20;
      }
      __syncthreads();
      int c = s_role;
      __syncthreads();
      if (c < 128) phase_gdn(p, layer, c, smem); else if (c < 256) phase_ssd(p, layer, c - 128, smem);
      __syncthreads();
      phase_na(p, layer, p.CTR + layer, smem);
      for (;;) {
        __syncthreads();
        if (threadIdx.x == 0) s_role = (int)atomicAdd(chain_ctr, 1u);
        __syncthreads();
        c = s_role;
        if (c >= 256) break;
        if (c < 128) phase_gdn(p, layer, c, smem); else phase_ssd(p, layer, c - 128, smem);
      }
    }
    grid.sync();
    phase_fin(p, layer, bid, nb);
    grid.sync();
    phase_g2a(p, layer, bid, nb, (bf16_t*)smem);
    grid.sync();
    phase_g2b(p, layer, bid, nb, (bf16_t*)smem);
    grid.sync();
    phase_g3(p, layer, bid, nb, (bf16_t*)smem);
    grid.sync();
    phase_norm(p, layer, 1, bid, nb);
    grid.sync();
    phase_g4(p, layer, bid, nb, (bf16_t*)smem);
    grid.sync();
    phase_g5(p, layer, bid, nb, (bf16_t*)smem);
    if (layer == 0) { grid.sync(); phase_norm(p, 1, 0, bid, nb); grid.sync(); }
  }
}

extern "C" void kernel_launch(void* const* d_in, const int* in_sizes, int n_in, void* d_out, int out_size, void* d_ws, size_t ws_size,
                              hipStream_t stream) {
  Params p{};
  const float** fp = (const float**)&p;
  for (int i = 0; i < 28; ++i) fp[i] = (const float*)d_in[i];
  p.out = (float*)d_out;
  char* ws = (char*)d_ws;
  size_t off = 0;
  auto take = [&](size_t bytes) { char* r = ws + off; off += (bytes + 255) & ~(size_t)255; return r; };
  p.U = (bf16_t*)take((size_t)TT * UW * 2);
  p.S = (float*)take((size_t)TT * SWD * 4);
  p.MOD = (float*)take((size_t)2 * 9 * 6144 * 4);
  p.SS = (float*)take((size_t)4 * TT * 4);
  p.ROPE = (float*)take(64 * 16 * 2 * 4);
  p.CTR = (unsigned*)take((64 + 2 * 2048) * 4);
  p.P = (bf16_t*)take((size_t)TT * 1024 * 2);
  p.XC = (float*)take((size_t)TC * 1024 * 4);
  p.HB = (bf16_t*)p.XC;
  p.OG0 = (bf16_t*)d_out;
  p.OG1 = (bf16_t*)((char*)p.P + (size_t)TL * 1024 * 2);
  const size_t need = (size_t)((char*)p.OG1 - ws) + (size_t)2 * TL * 512 * 2;
  if (need > ws_size) { fprintf(stderr, "workspace too small: need %zu have %zu\n", need, ws_size); return; }
  static int grid_blocks = 0;
  if (!grid_blocks) {
    int dev = 0, cus = 0, per_cu = 0;
    hipGetDevice(&dev);
    hipDeviceGetAttribute(&cus, hipDeviceAttributeMultiprocessorCount, dev);
    hipOccupancyMaxActiveBlocksPerMultiprocessor(&per_cu, k_mega, 256, 0);
    if (per_cu > 2) per_cu = 2;
    grid_blocks = cus * per_cu;
  }
  void* args[] = {&p};
  hipError_t e = hipLaunchCooperativeKernel((void*)k_mega, dim3(grid_blocks), dim3(256), args, 0, stream);
  if (e != hipSuccess) fprintf(stderr, "cooperative launch failed: %s (grid %d)\n", hipGetErrorString(e), grid_blocks);
}
```

```cpp
#include <hip/hip_runtime.h>
#include <hip/hip_cooperative_groups.h>
#include <cstdio>
#include <cstdint>

typedef unsigned short bf16_t;
typedef short bf16x8 __attribute__((ext_vector_type(8)));
typedef short s16x4 __attribute__((ext_vector_type(4)));
typedef float f32x4 __attribute__((ext_vector_type(4)));
#define LDS_AS __attribute__((address_space(3)))

constexpr int TL = 16384;
constexpr int TC = 2048;
constexpr int TT = TL + TC;
constexpr int DM = 1024;
constexpr int UW = 6144;
constexpr int SWD = 64;
constexpr int DIN = 9280;
constexpr int DFF = 4096;
constexpr float EPS = 1e-6f;
constexpr int U_NAQ = 0, U_NAK = 512, U_NAV = 1024;
constexpr int U_DNQ = 1536, U_DNK = 2048, U_DNV = 2560, U_DNZ = 3072;
constexpr int U_SZ = 3584, U_SX = 4608, U_SB = 5632, U_SC = 5888;
constexpr int U_YA = 0, U_YB = 512, U_YC = 1024, U_GATE = 2048, U_M = 5120;

struct Params {
  const float *x, *c, *ctx, *c_ctx, *w_ada, *b_ada, *norm1_g, *norm2_g, *w_in, *na_q_gain, *na_k_gain, *na_rpb,
      *dn_conv_w, *dn_a_log, *dn_dt_bias, *dn_o_gain, *ssd_conv_w, *ssd_conv_b, *ssd_a_log, *ssd_dt_bias, *ssd_d,
      *ssd_o_gain, *w_pa, *w_pb, *w_pc, *w_out, *w_ff1, *w_ff2;
  float* out;
  bf16_t* U;
  float* S;
  bf16_t* P;
  float* XC;
  float* MOD;
  float* SS;
  float* ROPE;
  unsigned* BAR;
  unsigned* CTR;
  bf16_t* HB;
  bf16_t* OG0;
  bf16_t* OG1;
};

__device__ __forceinline__ int tidx() { int t = threadIdx.x; asm volatile("" : "+v"(t)); return t; }
__device__ __forceinline__ float bf2f(bf16_t v) { return __uint_as_float(((unsigned)v) << 16); }
__device__ __forceinline__ bf16_t f2bf(float f) {
  unsigned u = __float_as_uint(f);
  u += 0x7fffu + ((u >> 16) & 1u);
  return (bf16_t)(u >> 16);
}
__device__ __forceinline__ unsigned pack2(float a, float b) { return (unsigned)f2bf(a) | ((unsigned)f2bf(b) << 16); }
__device__ __forceinline__ float bflo(unsigned w) { return __uint_as_float(w << 16); }
__device__ __forceinline__ float bfhi(unsigned w) { return __uint_as_float(w & 0xffff0000u); }
__device__ __forceinline__ float wave_sum(float v) {
#pragma unroll
  for (int o = 32; o; o >>= 1) v += __shfl_xor(v, o);
  return v;
}
__device__ __forceinline__ float wave_max(float v) {
#pragma unroll
  for (int o = 32; o; o >>= 1) v = fmaxf(v, __shfl_xor(v, o));
  return v;
}
__device__ __forceinline__ float siluf(float v) { return v / (1.f + expf(-v)); }
__device__ __forceinline__ float sigmoidf_(float v) { return 1.f / (1.f + expf(-v)); }
__device__ __forceinline__ float softplusf_(float v) { return v > 20.f ? v : log1pf(expf(v)); }

__device__ __forceinline__ const float* xrow_in(const Params& p, int layer, int row) {
  if (layer == 0) return row < TL ? p.x + (size_t)row * DM : p.ctx + (size_t)(row - TL) * DM;
  return row < TL ? p.out + (size_t)row * DM : p.XC + (size_t)(row - TL) * DM;
}
__device__ __forceinline__ float* xrow_out(const Params& p, int row) {
  return row < TL ? p.out + (size_t)row * DM : p.XC + (size_t)(row - TL) * DM;
}
__device__ __forceinline__ int modrow(int row) { return row < TL ? (row >> 11) : 8; }

constexpr int G_BK = 32;
constexpr int G_ASTR = G_BK + 8;
constexpr int G_ATILE = 256 * G_ASTR;
constexpr int GEMM_LDS_BYTES = 2 * (G_ATILE + G_BK * (128 + 16)) * 2;
__device__ __forceinline__ s16x4 tr16(const bf16_t* ptr) { return __builtin_amdgcn_ds_read_tr16_b64_v4i16((LDS_AS s16x4*)ptr); }
__device__ __forceinline__ bf16x8 cat8(s16x4 lo, s16x4 hi) { return (bf16x8){lo[0], lo[1], lo[2], lo[3], hi[0], hi[1], hi[2], hi[3]}; }
__device__ __forceinline__ uint4 cvt8(float4 a, float4 b) { uint4 o; o.x = pack2(a.x, a.y); o.y = pack2(a.z, a.w); o.z = pack2(b.x, b.y); o.w = pack2(b.z, b.w); return o; }

__device__ __forceinline__ void gemm_main2(f32x4 (&acc)[8][2], const bf16_t* A, int astride, const float* W, int ldw, int col0, bool small, int K, bf16_t* lds) {
  constexpr int NI = 2, BSTR = 80, BTILE = G_BK * BSTR;
  const int tid = tidx(), lane = tid & 63, wave = tid >> 6, wm = wave >> 1, wn = wave & 1, g = lane >> 4, l15 = lane & 15, q4 = l15 >> 2, p4 = lane & 3;
  bf16_t* As = lds;
  bf16_t* Bs = lds + 2 * G_ATILE;
  const int ar = tid >> 2, ak = (tid & 3) * 8;
  const int bk = tid >> 3, bn = (tid & 7) * 8;
  const int rho0 = (bk & 3) + 4 * ((bk >> 3) & 3) + 16 * ((bk >> 2) & 1);
  int bsrc = col0 + bn; bool bzero = false;
  if (small) { if (bn < 32) bsrc = 3584 + bn; else if (bn < 64) bsrc = 6176 + bn - 32; else { bzero = true; bsrc = 0; } }
  const bf16_t* ap = A + (size_t)ar * astride + ak;
  const float* bp = W + (size_t)bk * ldw + bsrc;
  bf16_t* aw = As + ar * G_ASTR + ak;
  bf16_t* bw = Bs + rho0 * BSTR + bn;
  uint4 ra0, ra1, ra2, ra3; float4 rb0, rb1;
#define G_LOADS(K1) { ra0 = *(const uint4*)(ap + (size_t)(64 * 0) * astride + (K1)); ra1 = *(const uint4*)(ap + (size_t)(64 * 1) * astride + (K1)); ra2 = *(const uint4*)(ap + (size_t)(64 * 2) * astride + (K1)); ra3 = *(const uint4*)(ap + (size_t)(64 * 3) * astride + (K1)); { const float* s_ = bp + (size_t)(K1) * ldw; rb0 = *(const float4*)s_; rb1 = *(const float4*)(s_ + 4); } }
#define G_STORES(NX) { *(uint4*)(aw + (NX) * G_ATILE + 64 * 0 * G_ASTR) = ra0; *(uint4*)(aw + (NX) * G_ATILE + 64 * 1 * G_ASTR) = ra1; *(uint4*)(aw + (NX) * G_ATILE + 64 * 2 * G_ASTR) = ra2; *(uint4*)(aw + (NX) * G_ATILE + 64 * 3 * G_ASTR) = ra3; { uint4 o_ = cvt8(rb0, rb1); if (bzero) o_ = make_uint4(0u, 0u, 0u, 0u); *(uint4*)(bw + (NX) * BTILE + 0 * BSTR) = o_; } }
  G_LOADS(0)
  G_STORES(0)
  __syncthreads();
  const int nk = K / G_BK;
  for (int kt = 0; kt < nk; ++kt) {
    const int cur = kt & 1;
    const int k1 = (kt + 1 < nk ? kt + 1 : kt) * G_BK;
    G_LOADS(k1)
    asm volatile("" ::: "memory");
    const bf16_t* Ac = As + cur * G_ATILE + (128 * wm + l15) * G_ASTR + 8 * g;
    const bf16_t* Bc = Bs + cur * BTILE + (4 * g + q4) * BSTR + 16 * NI * wn + 4 * p4;
    {
      bf16x8 af[8], bfr[NI];
#pragma unroll
      for (int mi = 0; mi < 8; ++mi) af[mi] = *(const bf16x8*)(Ac + mi * 16 * G_ASTR);
#pragma unroll
      for (int ni = 0; ni < NI; ++ni) bfr[ni] = cat8(tr16(Bc + 16 * ni), tr16(Bc + 16 * BSTR + 16 * ni));
#pragma unroll
      for (int mi = 0; mi < 8; ++mi)
#pragma unroll
        for (int ni = 0; ni < NI; ++ni) acc[mi][ni] = __builtin_amdgcn_mfma_f32_16x16x32_bf16(bfr[ni], af[mi], acc[mi][ni], 0, 0, 0);
    }
    asm volatile("" ::: "memory");
    __builtin_amdgcn_sched_barrier(0);
    G_STORES(cur ^ 1)
    __syncthreads();
  }
#undef G_LOADS
#undef G_STORES
}
__device__ __forceinline__ void gemm_main4(f32x4 (&acc)[8][4], const bf16_t* A, int astride, const float* W, int ldw, int col0, bool small, int K, bf16_t* lds) {
  constexpr int NI = 4, BSTR = 144, BTILE = G_BK * BSTR;
  const int tid = tidx(), lane = tid & 63, wave = tid >> 6, wm = wave >> 1, wn = wave & 1, g = lane >> 4, l15 = lane & 15, q4 = l15 >> 2, p4 = lane & 3;
  bf16_t* As = lds;
  bf16_t* Bs = lds + 2 * G_ATILE;
  const int ar = tid >> 2, ak = (tid & 3) * 8;
  const int bk = tid >> 4, bn = (tid & 15) * 8;
  const int rho0 = (bk & 3) + 4 * (bk >> 3) + 16 * ((bk >> 2) & 1);
  int bsrc = col0 + bn; bool bzero = false;
  if (small) { if (bn < 32) bsrc = 3584 + bn; else if (bn < 64) bsrc = 6176 + bn - 32; else { bzero = true; bsrc = 0; } }
  const bf16_t* ap = A + (size_t)ar * astride + ak;
  const float* bp = W + (size_t)bk * ldw + bsrc;
  bf16_t* aw = As + ar * G_ASTR + ak;
  bf16_t* bw = Bs + rho0 * BSTR + bn;
  uint4 ra0, ra1, ra2, ra3; float4 rb0, rb1, rb2, rb3;
#define G_LOADS(K1) { ra0 = *(const uint4*)(ap + (size_t)(64 * 0) * astride + (K1)); ra1 = *(const uint4*)(ap + (size_t)(64 * 1) * astride + (K1)); ra2 = *(const uint4*)(ap + (size_t)(64 * 2) * astride + (K1)); ra3 = *(const uint4*)(ap + (size_t)(64 * 3) * astride + (K1)); { const float* s_ = bp + (size_t)((K1) + 16 * 0) * ldw; rb0 = *(const float4*)s_; rb1 = *(const float4*)(s_ + 4); } { const float* s_ = bp + (size_t)((K1) + 16 * 1) * ldw; rb2 = *(const float4*)s_; rb3 = *(const float4*)(s_ + 4); } }
#define G_STORES(NX) { *(uint4*)(aw + (NX) * G_ATILE + 64 * 0 * G_ASTR) = ra0; *(uint4*)(aw + (NX) * G_ATILE + 64 * 1 * G_ASTR) = ra1; *(uint4*)(aw + (NX) * G_ATILE + 64 * 2 * G_ASTR) = ra2; *(uint4*)(aw + (NX) * G_ATILE + 64 * 3 * G_ASTR) = ra3; { uint4 o_ = cvt8(rb0, rb1); if (bzero) o_ = make_uint4(0u, 0u, 0u, 0u); *(uint4*)(bw + (NX) * BTILE + 0 * BSTR) = o_; } { uint4 o_ = cvt8(rb2, rb3); if (bzero) o_ = make_uint4(0u, 0u, 0u, 0u); *(uint4*)(bw + (NX) * BTILE + 8 * BSTR) = o_; } }
  G_LOADS(0)
  G_STORES(0)
  __syncthreads();
  const int nk = K / G_BK;
  for (int kt = 0; kt < nk; ++kt) {
    const int cur = kt & 1;
    const int k1 = (kt + 1 < nk ? kt + 1 : kt) * G_BK;
    G_LOADS(k1)
    asm volatile("" ::: "memory");
    const bf16_t* Ac = As + cur * G_ATILE + (128 * wm + l15) * G_ASTR + 8 * g;
    const bf16_t* Bc = Bs + cur * BTILE + (4 * g + q4) * BSTR + 16 * NI * wn + 4 * p4;
    {
      bf16x8 af[8], bfr[NI];
#pragma unroll
      for (int mi = 0; mi < 8; ++mi) af[mi] = *(const bf16x8*)(Ac + mi * 16 * G_ASTR);
#pragma unroll
      for (int ni = 0; ni < NI; ++ni) bfr[ni] = cat8(tr16(Bc + 16 * ni), tr16(Bc + 16 * BSTR + 16 * ni));
#pragma unroll
      for (int mi = 0; mi < 8; ++mi)
#pragma unroll
        for (int ni = 0; ni < NI; ++ni) acc[mi][ni] = __builtin_amdgcn_mfma_f32_16x16x32_bf16(bfr[ni], af[mi], acc[mi][ni], 0, 0, 0);
    }
    asm volatile("" ::: "memory");
    __builtin_amdgcn_sched_barrier(0);
    G_STORES(cur ^ 1)
    __syncthreads();
  }
#undef G_LOADS
#undef G_STORES
}
template <int NI> __device__ __forceinline__ void acc_zero(f32x4 (&acc)[8][NI]) {
#pragma unroll
  for (int i = 0; i < 8; ++i)
#pragma unroll
    for (int j = 0; j < NI; ++j) acc[i][j] = (f32x4){0.f, 0.f, 0.f, 0.f};
}
__device__ __forceinline__ bool tile_next(int i, int bid, int nb, int nMt, int nNt, bool nsplit, int& mt, int& nt) {
  const int xcd = bid & 7, slot = bid >> 3, nslots = nb >> 3;
  const int j = slot + i * nslots;
  if (nsplit) {
    const int nNx = (nNt - xcd + 7) >> 3;
    if (j >= nMt * nNx) return false;
    mt = j / nNx; nt = xcd + 8 * (j % nNx);
  } else {
    const int nMx = (nMt - xcd + 7) >> 3;
    if (j >= nMx * nNt) return false;
    mt = xcd + 8 * (j / nNt); nt = j % nNt;
  }
  return true;
}
#define EPI_IDS const int lane = tidx() & 63, wave = tidx() >> 6, wm = wave >> 1, wn = wave & 1, g = lane >> 4, l15 = lane & 15

__device__ __forceinline__ void phase_pro(const Params& p, int bid, int nb) {
  const int tid = tidx(), lane = tid & 63, wave = tid >> 6;
  for (int row = bid * 4 + wave; row < TT; row += nb * 4) {
    const float* xr = xrow_in(p, 0, row);
    float s = 0.f;
#pragma unroll
    for (int i = 0; i < 4; ++i) { const float4 v = *(const float4*)(xr + lane * 4 + 256 * i); s += v.x * v.x + v.y * v.y + v.z * v.z + v.w * v.w; }
    s = wave_sum(s);
    if (lane == 0) { p.SS[row] = s; p.SS[TT + row] = 0.f; p.SS[2 * TT + row] = 0.f; p.SS[3 * TT + row] = 0.f; }
  }
  for (int i = bid * 256 + tid; i < 64 * 16; i += nb * 256) {
    const int pos = i >> 4, fi = i & 15;
    const float inv = powf(10000.f, -(float)fi / 16.f);
    const float ang = (float)pos * inv;
    p.ROPE[2 * i] = cosf(ang); p.ROPE[2 * i + 1] = sinf(ang);
  }
}
__device__ __forceinline__ void phase_modp(const Params& p, int bid, int nb, float* lds) {
  const int tid = tidx();
  float* MODP = (float*)p.U;
  for (int u = bid; u < 768; u += nb) {
    const int ks = u & 15, cb = (u >> 4) % 24, l = u / 384, n = cb * 256 + tid;
    __syncthreads();
    for (int i = tid; i < 9 * 64; i += 256) { const int r = i >> 6, k = 64 * ks + (i & 63); const float v = r < 8 ? p.c[r * 1024 + k] : p.c_ctx[k]; lds[i] = siluf(v); }
    __syncthreads();
    float acc[9];
#pragma unroll
    for (int r = 0; r < 9; ++r) acc[r] = 0.f;
    const float* w = p.w_ada + ((size_t)l * 1024 + 64 * ks) * 6144 + n;
#pragma unroll 16
    for (int k = 0; k < 64; ++k) {
      const float wv = w[(size_t)k * 6144];
#pragma unroll
      for (int r = 0; r < 9; ++r) acc[r] += lds[r * 64 + k] * wv;
    }
#pragma unroll
    for (int r = 0; r < 9; ++r) MODP[((size_t)(ks * 2 + l) * 9 + r) * 6144 + n] = acc[r];
  }
}
__device__ __forceinline__ void phase_modfin(const Params& p, int bid, int nb) {
  const float* MODP = (const float*)p.U;
  for (int i = bid * 256 + tidx(); i < 2 * 9 * 6144; i += nb * 256) {
    const int l = i / (9 * 6144), rem = i % (9 * 6144), r = rem / 6144, n = rem % 6144;
    float v = p.b_ada[l * 6144 + n];
#pragma unroll
    for (int ks = 0; ks < 16; ++ks) v += MODP[((size_t)(ks * 2 + l) * 9 + r) * 6144 + n];
    const int chunk = n >> 10, kk = n & 1023;
    if (chunk == 1) v = p.norm1_g[l * 1024 + kk] * (1.f + v);
    if (chunk == 4) v = p.norm2_g[l * 1024 + kk] * (1.f + v);
    p.MOD[i] = v;
  }
}

__device__ __forceinline__ void norm_rows4(const float* x0, const float* x1, const float* x2, const float* x3, const float* ss, int row0, const float* alpha, const float* shift, bf16_t* h0, int lane) {
  const float* xr[4] = {x0, x1, x2, x3};
  float4 v[4][4];
#pragma unroll
  for (int j = 0; j < 4; ++j)
#pragma unroll
    for (int i = 0; i < 4; ++i) v[j][i] = *(const float4*)(xr[j] + lane * 4 + 256 * i);
  float rs[4];
#pragma unroll
  for (int j = 0; j < 4; ++j) rs[j] = rsqrtf(ss[row0 + j] * (1.f / DM) + EPS);
#pragma unroll
  for (int i = 0; i < 4; ++i) {
    const int k = lane * 4 + 256 * i;
    const float4 a = *(const float4*)(alpha + k), s = *(const float4*)(shift + k);
#pragma unroll
    for (int j = 0; j < 4; ++j) {
      uint2 o; o.x = pack2(v[j][i].x * rs[j] * a.x + s.x, v[j][i].y * rs[j] * a.y + s.y); o.y = pack2(v[j][i].z * rs[j] * a.z + s.z, v[j][i].w * rs[j] * a.w + s.w);
      *(uint2*)(h0 + (size_t)j * 1024 + k) = o;
    }
  }
}
__device__ __forceinline__ void phase_norm(const Params& p, int layer, int which, int bid, int nb) {
  const int lane = tidx() & 63, wave = tidx() >> 6;
  const int nrow = (which == 1 && layer == 1) ? TL : TT;
  const float* modl = p.MOD + (size_t)layer * 9 * 6144;
  const float* ss = p.SS + (size_t)(2 * layer + which) * TT;
  const int lin = which == 0 ? layer : 1;
  for (int row = (bid * 4 + wave) * 4; row < nrow; row += nb * 16) {
    const float* mr = modl + modrow(row) * 6144;
    norm_rows4(xrow_in(p, lin, row), xrow_in(p, lin, row + 1), xrow_in(p, lin, row + 2), xrow_in(p, lin, row + 3), ss, row,
               mr + (which ? 4096 : 1024), mr + (which ? 3072 : 0), p.P + (size_t)row * 1024, lane);
  }
}

__device__ __forceinline__ void phase_g1(const Params& p, int layer, int bid, int nb, bf16_t* lds) {
  constexpr bool NSPLIT = true;
  const int nMt = TT / 256, nNt = 49;
  EPI_IDS;
  for (int ti = 0;; ++ti) {
    int mt, nt; if (!tile_next(ti, bid, nb, nMt, nNt, NSPLIT, mt, nt)) break;
    const int m0 = mt * 256, n0 = nt * 128;
    f32x4 acc[8][4]; acc_zero<4>(acc);
    gemm_main4(acc, p.P + (size_t)m0 * 1024, 1024, p.w_in + (size_t)layer * 1024 * DIN, DIN, n0 < 3584 ? n0 : n0 + 32, nt == 48, 1024, lds);
    if (n0 < 1024) {
      const float* gain = (n0 < 512 ? p.na_q_gain : p.na_k_gain) + layer * 64;
      const float mul = n0 < 512 ? 0.125f : 1.f;
#pragma unroll
      for (int mi = 0; mi < 8; ++mi) {
        float ss = 0.f;
#pragma unroll
        for (int ni = 0; ni < 4; ++ni) ss += acc[mi][ni][0] * acc[mi][ni][0] + acc[mi][ni][1] * acc[mi][ni][1] + acc[mi][ni][2] * acc[mi][ni][2] + acc[mi][ni][3] * acc[mi][ni][3];
        ss += __shfl_xor(ss, 16); ss += __shfl_xor(ss, 32);
        const float rs = rsqrtf(ss * (1.f / 64.f) + EPS) * mul;
        const int row = m0 + 128 * wm + 16 * mi + l15;
#pragma unroll
        for (int ni = 0; ni < 4; ++ni) {
          const int cl = 16 * ni + 4 * g;
          const float4 gv = *(const float4*)(gain + cl);
          uint2 o; o.x = pack2(acc[mi][ni][0] * rs * gv.x, acc[mi][ni][1] * rs * gv.y); o.y = pack2(acc[mi][ni][2] * rs * gv.z, acc[mi][ni][3] * rs * gv.w);
          *(uint2*)(p.U + (size_t)row * UW + n0 + 64 * wn + cl) = o;
        }
      }
    } else if (n0 < 6144) {
      const bool hsec = (n0 >= 1536 && n0 < 3072) || n0 >= 4608;
      const int hcol0 = n0 < 3072 ? n0 - 1536 : n0 - 3072;
#pragma unroll
      for (int mi = 0; mi < 8; ++mi) {
        const int row = m0 + 128 * wm + 16 * mi + l15;
        const int rr = row & 63;
        const bool halo = hsec && (rr < 2 || rr >= 62);
        bf16_t* hb = p.HB + ((size_t)(row >> 6) * 4 + (rr < 2 ? rr : rr - 60)) * 3072 + hcol0 + 64 * wn + 4 * g;
#pragma unroll
        for (int ni = 0; ni < 4; ++ni) {
          uint2 o; o.x = pack2(acc[mi][ni][0], acc[mi][ni][1]); o.y = pack2(acc[mi][ni][2], acc[mi][ni][3]);
          *(uint2*)(p.U + (size_t)row * UW + n0 + 64 * wn + 16 * ni + 4 * g) = o;
          if (halo) *(uint2*)(hb + 16 * ni) = o;
        }
      }
    } else if (wn == 0) {
#pragma unroll
      for (int mi = 0; mi < 8; ++mi) {
        const int row = m0 + 128 * wm + 16 * mi + l15;
#pragma unroll
        for (int ni = 0; ni < 4; ++ni) *(f32x4*)(p.S + (size_t)row * SWD + 16 * ni + 4 * g) = acc[mi][ni];
      }
    }
  }
}

__device__ __forceinline__ void phase_g2a(const Params& p, int layer, int bid, int nb, bf16_t* lds) {
  constexpr bool NSPLIT = true;
  const int nMt = (layer == 0 ? TT : TL) / 256, nNt = 24;
  EPI_IDS;
  for (int ti = 0;; ++ti) {
    int mt, nt; if (!tile_next(ti, bid, nb, nMt, nNt, NSPLIT, mt, nt)) break;
    const int m0 = mt * 256, n0 = nt * 128;
    f32x4 acc[8][4]; acc_zero<4>(acc);
    gemm_main4(acc, p.P + (size_t)m0 * 1024, 1024, p.w_in + (size_t)layer * 1024 * DIN, DIN, 6208 + n0, false, 1024, lds);
#pragma unroll
    for (int mi = 0; mi < 8; ++mi) {
      const int row = m0 + 128 * wm + 16 * mi + l15;
#pragma unroll
      for (int ni = 0; ni < 4; ++ni) {
        uint2 o; o.x = pack2(sigmoidf_(acc[mi][ni][0]), sigmoidf_(acc[mi][ni][1])); o.y = pack2(sigmoidf_(acc[mi][ni][2]), sigmoidf_(acc[mi][ni][3]));
        *(uint2*)(p.U + (size_t)row * UW + U_GATE + n0 + 64 * wn + 16 * ni + 4 * g) = o;
      }
    }
  }
}
__device__ __forceinline__ void phase_g2b(const Params& p, int layer, int bid, int nb, bf16_t* lds) {
  constexpr bool NSPLIT = false;
  const int nMt = (layer == 0 ? TT : TL) / 256, nNt = 16;
  EPI_IDS;
  for (int ti = 0;; ++ti) {
    int mt, nt; if (!tile_next(ti, bid, nb, nMt, nNt, NSPLIT, mt, nt)) break;
    const int m0 = mt * 256, n0 = nt * 64;
    f32x4 accm[8][2]; acc_zero<2>(accm);
#pragma unroll 1
    for (int i = 0; i < 3; ++i) {
      const int ycol = i == 0 ? U_YA : (i == 1 ? U_YB : U_YC);
      const int Ki = i == 2 ? 1024 : 512;
      const float* w = i == 0 ? p.w_pa + (size_t)layer * 512 * 1024 : (i == 1 ? p.w_pb + (size_t)layer * 512 * 1024 : p.w_pc + (size_t)layer * 1024 * 1024);
      f32x4 acc[8][2]; acc_zero<2>(acc);
      gemm_main2(acc, p.U + (size_t)m0 * UW + ycol, UW, w, 1024, n0, false, Ki, lds);
#pragma unroll
      for (int mi = 0; mi < 8; ++mi) {
        const int row = m0 + 128 * wm + 16 * mi + l15;
#pragma unroll
        for (int ni = 0; ni < 2; ++ni) {
          const uint2 gt = *(const uint2*)(p.U + (size_t)row * UW + U_GATE + 1024 * i + n0 + 32 * wn + 16 * ni + 4 * g);
          accm[mi][ni][0] += bflo(gt.x) * acc[mi][ni][0]; accm[mi][ni][1] += bfhi(gt.x) * acc[mi][ni][1];
          accm[mi][ni][2] += bflo(gt.y) * acc[mi][ni][2]; accm[mi][ni][3] += bfhi(gt.y) * acc[mi][ni][3];
        }
      }
    }
#pragma unroll
    for (int mi = 0; mi < 8; ++mi) {
      const int row = m0 + 128 * wm + 16 * mi + l15;
#pragma unroll
      for (int ni = 0; ni < 2; ++ni) {
        uint2 o; o.x = pack2(accm[mi][ni][0], accm[mi][ni][1]); o.y = pack2(accm[mi][ni][2], accm[mi][ni][3]);
        *(uint2*)(p.U + (size_t)row * UW + U_M + n0 + 32 * wn + 16 * ni + 4 * g) = o;
      }
    }
  }
}
__device__ __forceinline__ void epi_residual(const Params& p, const f32x4 (&acc)[8][4], int layer_in, int m0, int n0, const float* gate, float* ssacc) {
  EPI_IDS;
#pragma unroll
  for (int mi = 0; mi < 8; ++mi) {
    const int row = m0 + 128 * wm + 16 * mi + l15;
    const float* xi = xrow_in(p, layer_in, row);
    float* xo = xrow_out(p, row);
    const float* gr = gate + modrow(row) * 6144;
    float ss = 0.f;
#pragma unroll
    for (int ni = 0; ni < 4; ++ni) {
      const int col = n0 + 64 * wn + 16 * ni + 4 * g;
      const float4 xv = *(const float4*)(xi + col);
      const float4 gv = *(const float4*)(gr + col);
      float4 o;
      o.x = xv.x + gv.x * acc[mi][ni][0]; o.y = xv.y + gv.y * acc[mi][ni][1]; o.z = xv.z + gv.z * acc[mi][ni][2]; o.w = xv.w + gv.w * acc[mi][ni][3];
      *(float4*)(xo + col) = o;
      ss += o.x * o.x + o.y * o.y + o.z * o.z + o.w * o.w;
    }
    if (ssacc) {
      ss += __shfl_xor(ss, 16); ss += __shfl_xor(ss, 32);
      if (g == 0) atomicAdd(ssacc + row, ss);
    }
  }
}
__device__ __forceinline__ void phase_g3(const Params& p, int layer, int bid, int nb, bf16_t* lds) {
  constexpr bool NSPLIT = false;
  const int nMt = (layer == 0 ? TT : TL) / 256, nNt = 8;
  const float* modl = p.MOD + (size_t)layer * 9 * 6144;
  for (int ti = 0;; ++ti) {
    int mt, nt; if (!tile_next(ti, bid, nb, nMt, nNt, NSPLIT, mt, nt)) break;
    const int m0 = mt * 256, n0 = nt * 128;
    f32x4 acc[8][4]; acc_zero<4>(acc);
    gemm_main4(acc, p.U + (size_t)m0 * UW + U_M, UW, p.w_out + (size_t)layer * 1024 * 1024, 1024, n0, false, 1024, lds);
    epi_residual(p, acc, layer, m0, n0, modl + 2048, p.SS + (size_t)(2 * layer + 1) * TT);
  }
}
__device__ __forceinline__ void phase_g4(const Params& p, int layer, int bid, int nb, bf16_t* lds) {
  constexpr bool NSPLIT = true;
  const int nMt = (layer == 0 ? TT : TL) / 256, nNt = 32;
  EPI_IDS;
  for (int ti = 0;; ++ti) {
    int mt, nt; if (!tile_next(ti, bid, nb, nMt, nNt, NSPLIT, mt, nt)) break;
    const int m0 = mt * 256, n0 = nt * 128;
    f32x4 acc[8][4]; acc_zero<4>(acc);
    gemm_main4(acc, p.P + (size_t)m0 * 1024, 1024, p.w_ff1 + (size_t)layer * 1024 * DFF, DFF, n0, false, 1024, lds);
#pragma unroll
    for (int mi = 0; mi < 8; ++mi) {
      const int row = m0 + 128 * wm + 16 * mi + l15;
#pragma unroll
      for (int ni = 0; ni < 4; ++ni) {
        const float v0 = fmaxf(acc[mi][ni][0], 0.f), v1 = fmaxf(acc[mi][ni][1], 0.f), v2 = fmaxf(acc[mi][ni][2], 0.f), v3 = fmaxf(acc[mi][ni][3], 0.f);
        uint2 o; o.x = pack2(v0 * v0, v1 * v1); o.y = pack2(v2 * v2, v3 * v3);
        *(uint2*)(p.U + (size_t)row * DFF + n0 + 64 * wn + 16 * ni + 4 * g) = o;
      }
    }
  }
}
__device__ __forceinline__ void phase_g5(const Params& p, int layer, int bid, int nb, bf16_t* lds) {
  constexpr bool NSPLIT = false;
  const int nMt = (layer == 0 ? TT : TL) / 256, nNt = 8;
  const float* modl = p.MOD + (size_t)layer * 9 * 6144;
  for (int ti = 0;; ++ti) {
    int mt, nt; if (!tile_next(ti, bid, nb, nMt, nNt, NSPLIT, mt, nt)) break;
    const int m0 = mt * 256, n0 = nt * 128;
    f32x4 acc[8][4]; acc_zero<4>(acc);
    gemm_main4(acc, p.U + (size_t)m0 * DFF, DFF, p.w_ff2 + (size_t)layer * DFF * 1024, 1024, n0, false, DFF, lds);
    epi_residual(p, acc, 1, m0, n0, modl + 5120, layer == 0 ? p.SS + (size_t)2 * TT : nullptr);
  }
}

__device__ __forceinline__ void phase_prep(const Params& p, int layer, int bid, int nb) {
  const int tid = tidx();
  for (int i = bid * 256 + tid; i < TT * 64; i += nb * 256) {
    const int c = i & 63;
    float v = p.S[i];
    if (c < 16) v = sigmoidf_(v);
    else if (c < 32) v = -expf(p.dn_a_log[layer * 16 + c - 16]) * softplusf_(v + p.dn_dt_bias[layer * 16 + c - 16]);
    else v = softplusf_(v + p.ssd_dt_bias[layer * 32 + c - 32]);
    p.S[i] = v;
  }
  const int cg = tid & 7, rA = tid >> 3;
  for (int t = bid; t < 288 * 48; t += nb) {
    const int chunk = t / 48, slab = t % 48;
    const bool dn = slab < 24;
    const int typ = dn ? slab >> 3 : 3;
    const int ucol = (dn ? 1536 + 512 * typ + 64 * (slab & 7) : 4608 + 64 * (slab - 24)) + 8 * cg;
    const int hcol = dn ? ucol - 1536 : ucol - 3072;
    const int cch = (dn ? 512 * typ + 64 * (slab & 7) : 64 * (slab - 24)) + 8 * cg;
    const float* cw = (dn ? p.dn_conv_w : p.ssd_conv_w) + (size_t)layer * 5 * 1536 + cch;
    float w5[5][8];
#pragma unroll
    for (int j = 0; j < 5; ++j) {
      const float4 a = *(const float4*)(cw + j * 1536), b = *(const float4*)(cw + j * 1536 + 4);
      w5[j][0] = a.x; w5[j][1] = a.y; w5[j][2] = a.z; w5[j][3] = a.w; w5[j][4] = b.x; w5[j][5] = b.y; w5[j][6] = b.z; w5[j][7] = b.w;
    }
    float bias[8];
#pragma unroll
    for (int e = 0; e < 8; ++e) bias[e] = dn ? 0.f : p.ssd_conv_b[layer * 1536 + cch + e];
    const bool lat = chunk < 256;
    const int cs = lat ? (chunk & 31) : ((chunk - 256) & 3);
    const bool first = cs == 0, last = lat ? cs == 31 : cs == 3;
    const int r0 = chunk * 64;
    uint4 raw[2][5];
#pragma unroll
    for (int it = 0; it < 2; ++it)
#pragma unroll
      for (int j = 0; j < 5; ++j) {
        const int rr = rA + 32 * it - 2 + j;
        uint4 v = make_uint4(0u, 0u, 0u, 0u);
        if (rr < 0) { if (!first) v = *(const uint4*)(p.HB + ((size_t)(chunk - 1) * 4 + 4 + rr) * 3072 + hcol); }
        else if (rr >= 64) { if (!last) v = *(const uint4*)(p.HB + ((size_t)(chunk + 1) * 4 + rr - 64) * 3072 + hcol); }
        else v = *(const uint4*)(p.U + (size_t)(r0 + rr) * UW + ucol);
        raw[it][j] = v;
      }
    __syncthreads();
#pragma unroll
    for (int it = 0; it < 2; ++it) {
      const int rr = rA + 32 * it;
      float v[8];
#pragma unroll
      for (int e = 0; e < 8; ++e) v[e] = bias[e];
#pragma unroll
      for (int j = 0; j < 5; ++j) {
        const uint4 x = raw[it][j];
        v[0] += w5[j][0] * bflo(x.x); v[1] += w5[j][1] * bfhi(x.x); v[2] += w5[j][2] * bflo(x.y); v[3] += w5[j][3] * bfhi(x.y);
        v[4] += w5[j][4] * bflo(x.z); v[5] += w5[j][5] * bfhi(x.z); v[6] += w5[j][6] * bflo(x.w); v[7] += w5[j][7] * bfhi(x.w);
      }
#pragma unroll
      for (int e = 0; e < 8; ++e) v[e] = siluf(v[e]);
      if (typ < 2) {
        float ss = 0.f;
#pragma unroll
        for (int e = 0; e < 8; ++e) ss += v[e] * v[e];
        ss += __shfl_xor(ss, 1); ss += __shfl_xor(ss, 2); ss += __shfl_xor(ss, 4);
        const float rs = rsqrtf(ss + EPS) * (typ == 0 ? 0.125f : 1.f);
        if (lat) {
          const int pos = cg < 4 ? cs : rr;
          const float* rp = p.ROPE + (pos * 16 + 8 * (cg & 1)) * 2;
          const float4 c0 = *(const float4*)rp, c1 = *(const float4*)(rp + 4), c2 = *(const float4*)(rp + 8), c3 = *(const float4*)(rp + 12);
          const float cs8[8] = {c0.x, c0.z, c1.x, c1.z, c2.x, c2.z, c3.x, c3.z}, sn8[8] = {c0.y, c0.w, c1.y, c1.w, c2.y, c2.w, c3.y, c3.w};
#pragma unroll
          for (int e = 0; e < 8; ++e) {
            const float vp = __shfl_xor(v[e], 2);
            v[e] = v[e] * cs8[e] + ((cg & 2) ? vp : -vp) * sn8[e];
          }
        }
#pragma unroll
        for (int e = 0; e < 8; ++e) v[e] *= rs;
      }
      uint4 o; o.x = pack2(v[0], v[1]); o.y = pack2(v[2], v[3]); o.z = pack2(v[4], v[5]); o.w = pack2(v[6], v[7]);
      *(uint4*)(p.U + (size_t)(r0 + rr) * UW + ucol) = o;
    }
  }
}

constexpr int XS = 72;
constexpr int BS2 = 136;
constexpr int SSD_LDS = (3 * 64 * XS + 3 * 64 * BS2) * 2 + 2 * 64 * 4;
__device__ __forceinline__ void phase_ssd(const Params& p, int layer, int task, char* smem) {
  const int tid = tidx(), lane = tid & 63, wave = tid >> 6, g = lane >> 4, l15 = lane & 15, q4 = l15 >> 2, p4 = lane & 3;
  bf16_t* Xt = (bf16_t*)smem;
  bf16_t* Xs = Xt + 64 * XS;
  bf16_t* Wg = Xs + 64 * XS;
  bf16_t* Bt = Wg + 64 * XS;
  bf16_t* Ct = Bt + 64 * BS2;
  bf16_t* Hb = Ct + 64 * BS2;
  float* dts = (float*)(Hb + 64 * BS2);
  float* lam = dts + 64;
  {
    const int head = task & 15, b = task >> 4, grp = head >> 3;
    f32x4 hst[2][8];
#pragma unroll
    for (int d = 0; d < 2; ++d)
#pragma unroll
      for (int n = 0; n < 8; ++n) hst[d][n] = (f32x4){0.f, 0.f, 0.f, 0.f};
    const float dsk = p.ssd_d[layer * 16 + head];
    const float an0 = -expf(p.ssd_a_log[layer * 32 + head]), an1 = -expf(p.ssd_a_log[layer * 32 + 16 + head]);
    for (int it = 0; it < 36; ++it) {
      const int seg = it >= 4, ci = seg ? it - 4 : it, nch = seg ? 32 : 4;
      const int base = seg ? b * 2048 : TL + b * 256;
      const bool want_o = seg == 1 || layer == 0;
      const bool first = ci < nch / 2;
#pragma unroll
      for (int dir = 0; dir < 2; ++dir) {
        const int c = dir ? nch - 1 - ci : ci;
        const int r0 = base + 64 * c;
        __syncthreads();
        {
          const int i = tid >> 2, sub = tid & 3;
          const int row = r0 + (dir ? 63 - i : i);
          const bf16_t* ur = p.U + (size_t)row * UW;
          const uint4* sx = (const uint4*)(ur + U_SX + 64 * head + 16 * sub);
          *(uint4*)(Xt + i * XS + 16 * sub) = sx[0]; *(uint4*)(Xt + i * XS + 16 * sub + 8) = sx[1];
          const uint4* sb = (const uint4*)(ur + U_SB + 128 * grp + 32 * sub);
#pragma unroll
          for (int k = 0; k < 4; ++k) *(uint4*)(Bt + i * BS2 + 32 * sub + 8 * k) = sb[k];
          if (want_o) {
            const uint4* sc = (const uint4*)(ur + U_SC + 128 * grp + 32 * sub);
#pragma unroll
            for (int k = 0; k < 4; ++k) *(uint4*)(Ct + i * BS2 + 32 * sub + 8 * k) = sc[k];
          }
          if (sub == 0) dts[i] = p.S[(size_t)row * SWD + 32 + dir * 16 + head];
        }
        if (want_o) {
#pragma unroll
          for (int nt = 0; nt < 8; ++nt) {
            uint2 o; o.x = pack2(hst[dir][nt][0], hst[dir][nt][1]); o.y = pack2(hst[dir][nt][2], hst[dir][nt][3]);
            *(uint2*)(Hb + (16 * wave + l15) * BS2 + 16 * nt + 4 * g) = o;
          }
        }
        __syncthreads();
        float lv = dts[lane] * (dir ? an1 : an0);
#pragma unroll
        for (int o = 1; o < 64; o <<= 1) { const float tv = __shfl_up(lv, o); if (lane >= o) lv += tv; }
        const float lam_last = __shfl(lv, 63);
        if (wave == 0) lam[lane] = lv;
        {
          const int j = tid >> 2, sub = tid & 3;
          const float lj = __shfl(lv, j & 63);
          const float sc = dts[j] * expf(lam_last - lj);
          const uint4 a = *(const uint4*)(Xt + j * XS + 16 * sub), bq = *(const uint4*)(Xt + j * XS + 16 * sub + 8);
          uint4 oa, ob;
          oa.x = pack2(bflo(a.x) * sc, bfhi(a.x) * sc); oa.y = pack2(bflo(a.y) * sc, bfhi(a.y) * sc); oa.z = pack2(bflo(a.z) * sc, bfhi(a.z) * sc); oa.w = pack2(bflo(a.w) * sc, bfhi(a.w) * sc);
          ob.x = pack2(bflo(bq.x) * sc, bfhi(bq.x) * sc); ob.y = pack2(bflo(bq.y) * sc, bfhi(bq.y) * sc); ob.z = pack2(bflo(bq.z) * sc, bfhi(bq.z) * sc); ob.w = pack2(bflo(bq.w) * sc, bfhi(bq.w) * sc);
          *(uint4*)(Xs + j * XS + 16 * sub) = oa; *(uint4*)(Xs + j * XS + 16 * sub + 8) = ob;
        }
        __syncthreads();
        if (want_o) {
          const int irow = 16 * wave + l15;
          const float li = lam[irow];
#pragma unroll
          for (int jt = 0; jt < 4; ++jt) {
            f32x4 cacc = (f32x4){0.f, 0.f, 0.f, 0.f};
            if (jt <= wave) {
#pragma unroll
              for (int s2 = 0; s2 < 4; ++s2) {
                const bf16x8 af = *(const bf16x8*)(Ct + irow * BS2 + 32 * s2 + 8 * g);
                const bf16x8 bf = *(const bf16x8*)(Bt + (16 * jt + l15) * BS2 + 32 * s2 + 8 * g);
                cacc = __builtin_amdgcn_mfma_f32_16x16x32_bf16(bf, af, cacc, 0, 0, 0);
              }
            }
            const int j0 = 16 * jt + 4 * g;
            const float4 lj = *(const float4*)(lam + j0), dj = *(const float4*)(dts + j0);
            const float w0 = (j0 + 0 <= irow) ? cacc[0] * expf(li - lj.x) * dj.x : 0.f;
            const float w1 = (j0 + 1 <= irow) ? cacc[1] * expf(li - lj.y) * dj.y : 0.f;
            const float w2 = (j0 + 2 <= irow) ? cacc[2] * expf(li - lj.z) * dj.z : 0.f;
            const float w3 = (j0 + 3 <= irow) ? cacc[3] * expf(li - lj.w) * dj.w : 0.f;
            uint2 o; o.x = pack2(w0, w1); o.y = pack2(w2, w3);
            *(uint2*)(Wg + irow * XS + j0) = o;
          }
        }
        __syncthreads();
        if (want_o) {
          const int irow = 16 * wave + l15;
          f32x4 ai[4], ae[4];
#pragma unroll
          for (int pt = 0; pt < 4; ++pt) { ai[pt] = (f32x4){0.f, 0.f, 0.f, 0.f}; ae[pt] = (f32x4){0.f, 0.f, 0.f, 0.f}; }
#pragma unroll
          for (int s2 = 0; s2 < 2; ++s2) {
            const bf16x8 af = *(const bf16x8*)(Wg + irow * XS + 32 * s2 + 8 * g);
#pragma unroll
            for (int pt = 0; pt < 4; ++pt) {
              const bf16x8 bf = cat8(tr16(Xt + (32 * s2 + 8 * g + q4) * XS + 16 * pt + 4 * p4), tr16(Xt + (32 * s2 + 8 * g + 4 + q4) * XS + 16 * pt + 4 * p4));
              ai[pt] = __builtin_amdgcn_mfma_f32_16x16x32_bf16(bf, af, ai[pt], 0, 0, 0);
            }
          }
#pragma unroll
          for (int s2 = 0; s2 < 4; ++s2) {
            const bf16x8 af = *(const bf16x8*)(Ct + irow * BS2 + 32 * s2 + 8 * g);
#pragma unroll
            for (int pt = 0; pt < 4; ++pt) {
              const bf16x8 bf = *(const bf16x8*)(Hb + (16 * pt + l15) * BS2 + 32 * s2 + 8 * g);
              ae[pt] = __builtin_amdgcn_mfma_f32_16x16x32_bf16(bf, af, ae[pt], 0, 0, 0);
            }
          }
          const float el = expf(lam[irow]);
          const int row = r0 + (dir ? 63 - irow : irow);
#pragma unroll
          for (int pt = 0; pt < 4; ++pt) {
            float y0 = ai[pt][0] + el * ae[pt][0], y1 = ai[pt][1] + el * ae[pt][1], y2 = ai[pt][2] + el * ae[pt][2], y3 = ai[pt][3] + el * ae[pt][3];
            if (dir == 0) {
              const uint2 xv = *(const uint2*)(Xt + irow * XS + 16 * pt + 4 * g);
              y0 += dsk * bflo(xv.x); y1 += dsk * bfhi(xv.x); y2 += dsk * bflo(xv.y); y3 += dsk * bfhi(xv.y);
            }
            unsigned long long* dst = (unsigned long long*)(p.P + (size_t)row * 1024 + 64 * head + 16 * pt + 4 * g);
            if (!first) {
              const unsigned long long old = __hip_atomic_load(dst, __ATOMIC_RELAXED, __HIP_MEMORY_SCOPE_AGENT);
              const unsigned lo = (unsigned)old, hi = (unsigned)(old >> 32);
              y0 += bflo(lo); y1 += bfhi(lo); y2 += bflo(hi); y3 += bfhi(hi);
            }
            *dst = (unsigned long long)pack2(y0, y1) | ((unsigned long long)pack2(y2, y3) << 32);
          }
        }
        {
          const float el = expf(lam_last);
#pragma unroll
          for (int nt = 0; nt < 8; ++nt) hst[dir][nt] *= el;
#pragma unroll
          for (int s2 = 0; s2 < 2; ++s2) {
            const bf16x8 mf = cat8(tr16(Xs + (32 * s2 + 8 * g + q4) * XS + 16 * wave + 4 * p4), tr16(Xs + (32 * s2 + 8 * g + 4 + q4) * XS + 16 * wave + 4 * p4));
#pragma unroll
            for (int nt = 0; nt < 8; ++nt) {
              const bf16x8 nf = cat8(tr16(Bt + (32 * s2 + 8 * g + q4) * BS2 + 16 * nt + 4 * p4), tr16(Bt + (32 * s2 + 8 * g + 4 + q4) * BS2 + 16 * nt + 4 * p4));
              hst[dir][nt] = __builtin_amdgcn_mfma_f32_16x16x32_bf16(nf, mf, hst[dir][nt], 0, 0, 0);
            }
          }
        }
      }
    }
  }
}


constexpr int GT = 64 * XS;
constexpr int GDN_LDS = 8 * GT * 2 + 4 * 256 * 4 + 4 * 16 * 24 * 2 + 2 * 64 * 4;
__device__ __forceinline__ void phase_gdn(const Params& p, int layer, int task, char* smem) {
  const int tid = tidx(), lane = tid & 63, wave = tid >> 6, g = lane >> 4, l15 = lane & 15, q4 = l15 >> 2, p4 = lane & 3;
  bf16_t* Qt = (bf16_t*)smem;
  bf16_t* Kt = Qt + GT;
  bf16_t* Vt = Kt + GT;
  bf16_t* Am = Vt + GT;
  bf16_t* Mq = Am + GT;
  bf16_t* Xw = Mq + GT;
  bf16_t* Xu = Xw + GT;
  bf16_t* St = Xu + GT;
  bf16_t* Qg = Qt; bf16_t* Vn = Vt; bf16_t* Vs = Am;
  float* Adiag = (float*)(St + GT);
  bf16_t* Db = (bf16_t*)(Adiag + 4 * 256);
  float* bet = (float*)(Db + 4 * 16 * 24);
  float* gam = bet + 64;
  const bf16x8 zero8 = (bf16x8){0, 0, 0, 0, 0, 0, 0, 0};
  {
    const int dir = task & 1, h = (task >> 1) & 7, b = task >> 4;
    bf16_t* Og = layer == 0 ? p.OG0 + (size_t)dir * TT * 512 : p.OG1 + (size_t)dir * TL * 512;
    f32x4 sst[4];
#pragma unroll
    for (int e = 0; e < 4; ++e) sst[e] = (f32x4){0.f, 0.f, 0.f, 0.f};
    __syncthreads();
    for (int i = tid; i < 64 * XS / 2; i += 256) { ((unsigned*)St)[i] = 0u; ((unsigned*)Xw)[i] = 0u; ((unsigned*)Xu)[i] = 0u; }
    for (int it = 0; it < 36; ++it) {
      const int seg = it >= 4, ci = seg ? it - 4 : it, nch = seg ? 32 : 4;
      const int base = seg ? b * 2048 : TL + b * 256;
      const bool want_o = seg == 1 || layer == 0;
      const int c = dir ? nch - 1 - ci : ci;
      const int r0 = base + 64 * c;
      __syncthreads();
      {
        const int i = tid >> 2, sub = tid & 3;
        const int row = r0 + (dir ? 63 - i : i);
        const bf16_t* ur = p.U + (size_t)row * UW + 64 * h + 16 * sub;
        const uint4* sq = (const uint4*)(ur + U_DNQ); const uint4* sk = (const uint4*)(ur + U_DNK); const uint4* sv = (const uint4*)(ur + U_DNV);
        *(uint4*)(Qt + i * XS + 16 * sub) = sq[0]; *(uint4*)(Qt + i * XS + 16 * sub + 8) = sq[1];
        *(uint4*)(Kt + i * XS + 16 * sub) = sk[0]; *(uint4*)(Kt + i * XS + 16 * sub + 8) = sk[1];
        *(uint4*)(Vt + i * XS + 16 * sub) = sv[0]; *(uint4*)(Vt + i * XS + 16 * sub + 8) = sv[1];
        if (sub == 0) { bet[i] = p.S[(size_t)row * SWD + dir * 8 + h]; gam[i] = p.S[(size_t)row * SWD + 16 + dir * 8 + h]; }
      }
      __syncthreads();
      float lv = gam[lane];
#pragma unroll
      for (int o = 1; o < 64; o <<= 1) { const float tv = __shfl_up(lv, o); if (lane >= o) lv += tv; }
      const float gam_last = __shfl(lv, 63);
      __syncthreads();
      if (wave == 0) gam[lane] = lv;
      __syncthreads();
      {
        const int irow = 16 * wave + l15;
        const float gi = gam[irow], bi = bet[irow];
#pragma unroll
        for (int jt = 0; jt < 4; ++jt) {
          f32x4 kk = (f32x4){0.f, 0.f, 0.f, 0.f}, qk = (f32x4){0.f, 0.f, 0.f, 0.f};
          if (jt <= wave) {
#pragma unroll
            for (int s2 = 0; s2 < 2; ++s2) {
              const bf16x8 nf = *(const bf16x8*)(Kt + (16 * jt + l15) * XS + 32 * s2 + 8 * g);
              const bf16x8 mk = *(const bf16x8*)(Kt + irow * XS + 32 * s2 + 8 * g);
              const bf16x8 mq = *(const bf16x8*)(Qt + irow * XS + 32 * s2 + 8 * g);
              kk = __builtin_amdgcn_mfma_f32_16x16x32_bf16(nf, mk, kk, 0, 0, 0);
              qk = __builtin_amdgcn_mfma_f32_16x16x32_bf16(nf, mq, qk, 0, 0, 0);
            }
          }
          const int j0 = 16 * jt + 4 * g;
          const float4 gj = *(const float4*)(gam + j0);
          const float gjv[4] = {gj.x, gj.y, gj.z, gj.w};
          float av[4], mv[4];
#pragma unroll
          for (int r = 0; r < 4; ++r) {
            const int j = j0 + r;
            const float dec = j <= irow ? expf(gi - gjv[r]) : 0.f;
            av[r] = j < irow ? bi * kk[r] * dec : 0.f;
            mv[r] = qk[r] * dec;
          }
          uint2 oa; oa.x = pack2(av[0], av[1]); oa.y = pack2(av[2], av[3]);
          uint2 om; om.x = pack2(mv[0], mv[1]); om.y = pack2(mv[2], mv[3]);
          *(uint2*)(Am + irow * XS + j0) = oa;
          *(uint2*)(Mq + irow * XS + j0) = om;
          if (jt == wave) *(f32x4*)(Adiag + wave * 256 + l15 * 16 + 4 * g) = (f32x4){av[0], av[1], av[2], av[3]};
        }
      }
      __syncthreads();
      {
        const int j = tid >> 2, sub = tid & 3;
        const float sc = expf(gam[j]);
        const uint4 a = *(const uint4*)(Qt + j * XS + 16 * sub), bq = *(const uint4*)(Qt + j * XS + 16 * sub + 8);
        uint4 oa, ob;
        oa.x = pack2(bflo(a.x) * sc, bfhi(a.x) * sc); oa.y = pack2(bflo(a.y) * sc, bfhi(a.y) * sc); oa.z = pack2(bflo(a.z) * sc, bfhi(a.z) * sc); oa.w = pack2(bflo(a.w) * sc, bfhi(a.w) * sc);
        ob.x = pack2(bflo(bq.x) * sc, bfhi(bq.x) * sc); ob.y = pack2(bflo(bq.y) * sc, bfhi(bq.y) * sc); ob.z = pack2(bflo(bq.z) * sc, bfhi(bq.z) * sc); ob.w = pack2(bflo(bq.w) * sc, bfhi(bq.w) * sc);
        *(uint4*)(Qg + j * XS + 16 * sub) = oa; *(uint4*)(Qg + j * XS + 16 * sub + 8) = ob;
      }
      {
        const int cc = lane & 15;
        const float* Ad = Adiag + wave * 256;
        float dcol[16];
#pragma unroll
        for (int r = 0; r < 16; ++r) {
          float sacc = (r == cc) ? 1.f : 0.f;
#pragma unroll
          for (int j = 0; j < r; ++j) sacc -= Ad[r * 16 + j] * dcol[j];
          dcol[r] = sacc;
        }
        if (lane < 16) {
#pragma unroll
          for (int r = 0; r < 16; ++r) Db[(wave * 16 + r) * 24 + cc] = f2bf(dcol[r]);
        }
      }
      __syncthreads();
      {
        const bool isW = wave < 2;
        bf16_t* Xd = isW ? Xw : Xu;
        const bf16_t* Src = isW ? Kt : Vt;
        const int fbase = (wave & 1) * 32;
#pragma unroll
        for (int ib = 0; ib < 4; ++ib) {
          const int irow = 16 * ib + l15;
          const float sc = isW ? bet[irow] * expf(gam[irow]) : bet[irow];
          f32x4 y[2];
#pragma unroll
          for (int fi = 0; fi < 2; ++fi) {
            const int f0 = fbase + 16 * fi;
            const uint2 rv = *(const uint2*)(Src + irow * XS + f0 + 4 * g);
            f32x4 tmp = (f32x4){0.f, 0.f, 0.f, 0.f};
#pragma unroll
            for (int s2 = 0; s2 < 2; ++s2) {
              if (32 * s2 < 16 * ib) {
                const bool half = (32 * s2 + 32) > 16 * ib;
                bf16x8 mf = *(const bf16x8*)(Am + irow * XS + 32 * s2 + 8 * g);
                if (half && g >= 2) mf = zero8;
                const bf16x8 nf = cat8(tr16(Xd + (32 * s2 + 8 * g + q4) * XS + f0 + 4 * p4), tr16(Xd + (32 * s2 + 8 * g + 4 + q4) * XS + f0 + 4 * p4));
                tmp = __builtin_amdgcn_mfma_f32_16x16x32_bf16(nf, mf, tmp, 0, 0, 0);
              }
            }
            y[fi] = (f32x4){bflo(rv.x) * sc - tmp[0], bfhi(rv.x) * sc - tmp[1], bflo(rv.y) * sc - tmp[2], bfhi(rv.y) * sc - tmp[3]};
          }
          __syncthreads();
#pragma unroll
          for (int fi = 0; fi < 2; ++fi) {
            uint2 o; o.x = pack2(y[fi][0], y[fi][1]); o.y = pack2(y[fi][2], y[fi][3]);
            *(uint2*)(Xd + irow * XS + fbase + 16 * fi + 4 * g) = o;
          }
          __syncthreads();
          bf16x8 dm = zero8;
          if (g < 2) dm = *(const bf16x8*)(Db + (ib * 16 + l15) * 24 + 8 * g);
#pragma unroll
          for (int fi = 0; fi < 2; ++fi) {
            const int f0 = fbase + 16 * fi;
            const bf16x8 nf = cat8(tr16(Xd + (16 * ib + 8 * (g & 1) + q4) * XS + f0 + 4 * p4), tr16(Xd + (16 * ib + 8 * (g & 1) + 4 + q4) * XS + f0 + 4 * p4));
            y[fi] = __builtin_amdgcn_mfma_f32_16x16x32_bf16(nf, dm, (f32x4){0.f, 0.f, 0.f, 0.f}, 0, 0, 0);
          }
          __syncthreads();
#pragma unroll
          for (int fi = 0; fi < 2; ++fi) {
            uint2 o; o.x = pack2(y[fi][0], y[fi][1]); o.y = pack2(y[fi][2], y[fi][3]);
            *(uint2*)(Xd + irow * XS + fbase + 16 * fi + 4 * g) = o;
          }
          __syncthreads();
        }
      }
      {
        const int irow = 16 * wave + l15;
        const float dl = expf(gam_last - gam[irow]);
        f32x4 acc[4];
#pragma unroll
        for (int et = 0; et < 4; ++et) acc[et] = (f32x4){0.f, 0.f, 0.f, 0.f};
#pragma unroll
        for (int s2 = 0; s2 < 2; ++s2) {
          const bf16x8 mf = *(const bf16x8*)(Xw + irow * XS + 32 * s2 + 8 * g);
#pragma unroll
          for (int et = 0; et < 4; ++et) {
            const bf16x8 nf = *(const bf16x8*)(St + (16 * et + l15) * XS + 32 * s2 + 8 * g);
            acc[et] = __builtin_amdgcn_mfma_f32_16x16x32_bf16(nf, mf, acc[et], 0, 0, 0);
          }
        }
#pragma unroll
        for (int et = 0; et < 4; ++et) {
          const uint2 uv = *(const uint2*)(Xu + irow * XS + 16 * et + 4 * g);
          const float v0 = bflo(uv.x) - acc[et][0], v1 = bfhi(uv.x) - acc[et][1], v2 = bflo(uv.y) - acc[et][2], v3 = bfhi(uv.y) - acc[et][3];
          uint2 o; o.x = pack2(v0, v1); o.y = pack2(v2, v3);
          *(uint2*)(Vn + irow * XS + 16 * et + 4 * g) = o;
          o.x = pack2(v0 * dl, v1 * dl); o.y = pack2(v2 * dl, v3 * dl);
          *(uint2*)(Vs + irow * XS + 16 * et + 4 * g) = o;
        }
      }
      __syncthreads();
      if (want_o) {
        const int irow = 16 * wave + l15;
        f32x4 acc[4];
#pragma unroll
        for (int et = 0; et < 4; ++et) acc[et] = (f32x4){0.f, 0.f, 0.f, 0.f};
#pragma unroll
        for (int s2 = 0; s2 < 2; ++s2) {
          const bf16x8 mf = *(const bf16x8*)(Qg + irow * XS + 32 * s2 + 8 * g);
          const bf16x8 mf2 = *(const bf16x8*)(Mq + irow * XS + 32 * s2 + 8 * g);
#pragma unroll
          for (int et = 0; et < 4; ++et) {
            const bf16x8 nf = *(const bf16x8*)(St + (16 * et + l15) * XS + 32 * s2 + 8 * g);
            acc[et] = __builtin_amdgcn_mfma_f32_16x16x32_bf16(nf, mf, acc[et], 0, 0, 0);
            const bf16x8 nf2 = cat8(tr16(Vn + (32 * s2 + 8 * g + q4) * XS + 16 * et + 4 * p4), tr16(Vn + (32 * s2 + 8 * g + 4 + q4) * XS + 16 * et + 4 * p4));
            acc[et] = __builtin_amdgcn_mfma_f32_16x16x32_bf16(nf2, mf2, acc[et], 0, 0, 0);
          }
        }
        const int row = r0 + (dir ? 63 - irow : irow);
#pragma unroll
        for (int et = 0; et < 4; ++et) {
          uint2 o; o.x = pack2(acc[et][0], acc[et][1]); o.y = pack2(acc[et][2], acc[et][3]);
          *(uint2*)(Og + (size_t)row * 512 + 64 * h + 16 * et + 4 * g) = o;
        }
      }
      {
        const float el = expf(gam_last);
#pragma unroll
        for (int et = 0; et < 4; ++et) sst[et] *= el;
#pragma unroll
        for (int s2 = 0; s2 < 2; ++s2) {
          const bf16x8 nf = cat8(tr16(Kt + (32 * s2 + 8 * g + q4) * XS + 16 * wave + 4 * p4), tr16(Kt + (32 * s2 + 8 * g + 4 + q4) * XS + 16 * wave + 4 * p4));
#pragma unroll
          for (int et = 0; et < 4; ++et) {
            const bf16x8 mf = cat8(tr16(Vs + (32 * s2 + 8 * g + q4) * XS + 16 * et + 4 * p4), tr16(Vs + (32 * s2 + 8 * g + 4 + q4) * XS + 16 * et + 4 * p4));
            sst[et] = __builtin_amdgcn_mfma_f32_16x16x32_bf16(nf, mf, sst[et], 0, 0, 0);
          }
        }
      }
      __syncthreads();
#pragma unroll
      for (int et = 0; et < 4; ++et) {
        uint2 o; o.x = pack2(sst[et][0], sst[et][1]); o.y = pack2(sst[et][2], sst[et][3]);
        *(uint2*)(St + (16 * et + l15) * XS + 16 * wave + 4 * g) = o;
      }
    }
  }
}


constexpr int NA_VS = 72;
constexpr int NA_LDS_WAVE = 2 * 32 * NA_VS * 2;
__device__ __forceinline__ void phase_na(const Params& p, int layer, unsigned* ctr, char* smem) {
  const int lane = tidx() & 63, wave = tidx() >> 6, g = lane >> 4, l15 = lane & 15, q4 = l15 >> 2, p4 = lane & 3;
  bf16_t* Vl = (bf16_t*)(smem + wave * NA_LDS_WAVE);
  const int ntask = layer == 0 ? 8192 + 1024 : 8192;
  const float* rpb = p.na_rpb + (size_t)layer * 8 * 15 * 31;
  for (;;) {
    int w0 = 0;
    if (lane == 0) w0 = (int)atomicAdd(ctr, 1u);
    const int task = __builtin_amdgcn_readfirstlane(__shfl(w0, 0));
    if (task >= ntask) break;
    const bool lat = task < 8192;
    int b, h, r = 0, cb = 0, qtok0, R0 = 0, C0 = 0;
    if (lat) { cb = task & 3; r = (task >> 2) & 31; h = (task >> 7) & 7; b = task >> 10; qtok0 = b * 2048 + r * 64 + 16 * cb; R0 = min(max(r - 4, 0), 24); C0 = min(max(16 * cb - 8, 0), 32); }
    else { const int t2 = task - 8192; const int qb = t2 & 15; h = (t2 >> 4) & 7; b = t2 >> 7; qtok0 = TL + b * 256 + 16 * qb; }
    const int tau0 = lat ? 0 : 16;
    const int wtok0 = b * 2048 + R0 * 64 + C0, ctok0 = TL + b * 256;
#define tile_tok(tau) ((tau) < 16 ? wtok0 + ((tau) >> 1) * 64 + 16 * ((tau) & 1) : ctok0 + 16 * ((tau) - 16))
    const bf16_t* qp = p.U + (size_t)(qtok0 + l15) * UW + U_NAQ + 64 * h + 8 * g;
    const bf16x8 qf0 = *(const bf16x8*)qp, qf1 = *(const bf16x8*)(qp + 32);
    f32x4 sc[32];
#pragma unroll
    for (int tau = 0; tau < 32; ++tau) {
      sc[tau] = (f32x4){-INFINITY, -INFINITY, -INFINITY, -INFINITY};
      if (tau >= tau0) {
        const bf16_t* kp = p.U + (size_t)(tile_tok(tau) + l15) * UW + U_NAK + 64 * h + 8 * g;
        const bf16x8 kf0 = *(const bf16x8*)kp, kf1 = *(const bf16x8*)(kp + 32);
        f32x4 a = (f32x4){0.f, 0.f, 0.f, 0.f};
        a = __builtin_amdgcn_mfma_f32_16x16x32_bf16(kf0, qf0, a, 0, 0, 0);
        a = __builtin_amdgcn_mfma_f32_16x16x32_bf16(kf1, qf1, a, 0, 0, 0);
        if (tau < 16) {
          const int qcol = 16 * cb + l15, ws = min(max(qcol - 8, 0), 48);
          const int dr = R0 + (tau >> 1) - r + 7;
#pragma unroll
          for (int rg = 0; rg < 4; ++rg) {
            const int kcol = C0 + 16 * (tau & 1) + 4 * g + rg;
            const bool ok = kcol >= ws && kcol < ws + 16;
            const float bias = ok ? rpb[(h * 15 + dr) * 31 + (kcol - qcol + 15)] : 0.f;
            a[rg] = ok ? a[rg] + bias : -INFINITY;
          }
        }
        sc[tau] = a;
      }
    }
    float mx = -INFINITY;
#pragma unroll
    for (int tau = 0; tau < 32; ++tau) mx = fmaxf(mx, fmaxf(fmaxf(sc[tau][0], sc[tau][1]), fmaxf(sc[tau][2], sc[tau][3])));
    mx = fmaxf(mx, __shfl_xor(mx, 16)); mx = fmaxf(mx, __shfl_xor(mx, 32));
    float sum = 0.f;
#pragma unroll
    for (int tau = 0; tau < 32; ++tau) {
#pragma unroll
      for (int rg = 0; rg < 4; ++rg) { const float e = __expf(sc[tau][rg] - mx); sc[tau][rg] = e; sum += e; }
    }
    sum += __shfl_xor(sum, 16); sum += __shfl_xor(sum, 32);
    f32x4 oacc[4];
#pragma unroll
    for (int dt = 0; dt < 4; ++dt) oacc[dt] = (f32x4){0.f, 0.f, 0.f, 0.f};
    const int kap0 = tau0 >> 1;
    uint4 vr0, vr1, vr2, vr3;
#define NA_VLOAD(KAP) { \
      const int kk0_ = lane >> 3, cc_ = lane & 7; \
      const bf16_t* vb_ = p.U + U_NAV + 64 * h + 8 * cc_; \
      vr0 = *(const uint4*)(vb_ + (size_t)(tile_tok(2 * (KAP)) + kk0_) * UW); \
      vr1 = *(const uint4*)(vb_ + (size_t)(tile_tok(2 * (KAP)) + kk0_ + 8) * UW); \
      vr2 = *(const uint4*)(vb_ + (size_t)(tile_tok(2 * (KAP) + 1) + kk0_) * UW); \
      vr3 = *(const uint4*)(vb_ + (size_t)(tile_tok(2 * (KAP) + 1) + kk0_ + 8) * UW); }
    NA_VLOAD(kap0)
#pragma unroll
    for (int kap = 0; kap < 16; ++kap) {
      if (kap >= kap0) {
        bf16_t* Vb = Vl + (kap & 1) * 32 * NA_VS;
        {
          const int kk0_ = lane >> 3, cc_ = lane & 7;
          *(uint4*)(Vb + kk0_ * NA_VS + 8 * cc_) = vr0; *(uint4*)(Vb + (kk0_ + 8) * NA_VS + 8 * cc_) = vr1;
          *(uint4*)(Vb + (kk0_ + 16) * NA_VS + 8 * cc_) = vr2; *(uint4*)(Vb + (kk0_ + 24) * NA_VS + 8 * cc_) = vr3;
        }
        if (kap + 1 < 16) NA_VLOAD(kap + 1)
        __builtin_amdgcn_fence(__ATOMIC_RELEASE, "workgroup"); __builtin_amdgcn_wave_barrier(); __builtin_amdgcn_fence(__ATOMIC_ACQUIRE, "workgroup");
        bf16x8 pf;
        {
          const unsigned w0_ = pack2(sc[2 * kap][0], sc[2 * kap][1]), w1_ = pack2(sc[2 * kap][2], sc[2 * kap][3]);
          const unsigned w2_ = pack2(sc[2 * kap + 1][0], sc[2 * kap + 1][1]), w3_ = pack2(sc[2 * kap + 1][2], sc[2 * kap + 1][3]);
          pf = (bf16x8){(short)(w0_ & 0xffff), (short)(w0_ >> 16), (short)(w1_ & 0xffff), (short)(w1_ >> 16), (short)(w2_ & 0xffff), (short)(w2_ >> 16), (short)(w3_ & 0xffff), (short)(w3_ >> 16)};
        }
#pragma unroll
        for (int dt = 0; dt < 4; ++dt) {
          const bf16x8 vf = cat8(tr16(Vb + (4 * g + q4) * NA_VS + 16 * dt + 4 * p4), tr16(Vb + (16 + 4 * g + q4) * NA_VS + 16 * dt + 4 * p4));
          oacc[dt] = __builtin_amdgcn_mfma_f32_16x16x32_bf16(vf, pf, oacc[dt], 0, 0, 0);
        }
      }
    }
#undef NA_VLOAD
#undef tile_tok
    const float inv = 1.f / sum;
    bf16_t* op = p.U + (size_t)(qtok0 + l15) * UW + U_YA + 64 * h + 4 * g;
#pragma unroll
    for (int dt = 0; dt < 4; ++dt) {
      uint2 o; o.x = pack2(oacc[dt][0] * inv, oacc[dt][1] * inv); o.y = pack2(oacc[dt][2] * inv, oacc[dt][3] * inv);
      *(uint2*)(op + 16 * dt) = o;
    }
  }
}

__device__ __forceinline__ void norm_row(const float* xr, float rs, const float* alpha, const float* shift, bf16_t* hrow, int lane) {
#pragma unroll
  for (int i = 0; i < 4; ++i) {
    const int k = lane * 4 + 256 * i;
    const float4 v = *(const float4*)(xr + k), a = *(const float4*)(alpha + k), s = *(const float4*)(shift + k);
    uint2 o; o.x = pack2(v.x * rs * a.x + s.x, v.y * rs * a.y + s.y); o.y = pack2(v.z * rs * a.z + s.z, v.w * rs * a.w + s.w);
    *(uint2*)(hrow + k) = o;
  }
}
__device__ __forceinline__ void phase_fin(const Params& p, int layer, int bid, int nb) {
  const int lane = tidx() & 63, wave = tidx() >> 6;
  const int ntok = layer == 0 ? TT : TL;
  for (int tok = bid * 4 + wave; tok < ntok; tok += nb * 4) {
    bf16_t* ur = p.U + (size_t)tok * UW;
    {
      const bf16_t* of = (layer == 0 ? p.OG0 : p.OG1) + (size_t)tok * 512 + 8 * lane;
      const bf16_t* ob = of + (size_t)(layer == 0 ? TT : TL) * 512;
      const uint4 a = *(const uint4*)of, bq = *(const uint4*)ob, z = *(const uint4*)(ur + U_DNZ + 8 * lane);
      float o[8] = {bflo(a.x) + bflo(bq.x), bfhi(a.x) + bfhi(bq.x), bflo(a.y) + bflo(bq.y), bfhi(a.y) + bfhi(bq.y), bflo(a.z) + bflo(bq.z), bfhi(a.z) + bfhi(bq.z), bflo(a.w) + bflo(bq.w), bfhi(a.w) + bfhi(bq.w)};
      const float zz[8] = {bflo(z.x), bfhi(z.x), bflo(z.y), bfhi(z.y), bflo(z.z), bfhi(z.z), bflo(z.w), bfhi(z.w)};
      float ss = 0.f;
#pragma unroll
      for (int i = 0; i < 8; ++i) ss += o[i] * o[i];
      ss += __shfl_xor(ss, 1); ss += __shfl_xor(ss, 2); ss += __shfl_xor(ss, 4);
      const float rs = rsqrtf(ss * (1.f / 64.f) + EPS);
      const float* gn = p.dn_o_gain + layer * 64 + 8 * (lane & 7);
#pragma unroll
      for (int i = 0; i < 8; ++i) o[i] = o[i] * rs * gn[i] * siluf(zz[i]);
      uint4 w; w.x = pack2(o[0], o[1]); w.y = pack2(o[2], o[3]); w.z = pack2(o[4], o[5]); w.w = pack2(o[6], o[7]);
      *(uint4*)(ur + U_YB + 8 * lane) = w;
    }
    {
      float yv[16];
      float ss = 0.f;
#pragma unroll
      for (int hf = 0; hf < 2; ++hf) {
        const uint4 a = *(const uint4*)(p.P + (size_t)tok * 1024 + 16 * lane + 8 * hf), z = *(const uint4*)(ur + U_SZ + 16 * lane + 8 * hf);
        const float av[8] = {bflo(a.x), bfhi(a.x), bflo(a.y), bfhi(a.y), bflo(a.z), bfhi(a.z), bflo(a.w), bfhi(a.w)};
        const float zz[8] = {bflo(z.x), bfhi(z.x), bflo(z.y), bfhi(z.y), bflo(z.z), bfhi(z.z), bflo(z.w), bfhi(z.w)};
#pragma unroll
        for (int i = 0; i < 8; ++i) { const float v = av[i] * siluf(zz[i]); yv[8 * hf + i] = v; ss += v * v; }
      }
      ss += __shfl_xor(ss, 1); ss += __shfl_xor(ss, 2); ss += __shfl_xor(ss, 4); ss += __shfl_xor(ss, 8); ss += __shfl_xor(ss, 16);
      const float rs = rsqrtf(ss * (1.f / 512.f) + EPS);
      const float* gn = p.ssd_o_gain + layer * 1024 + 16 * lane;
#pragma unroll
      for (int hf = 0; hf < 2; ++hf) {
        uint4 w;
        w.x = pack2(yv[8 * hf + 0] * rs * gn[8 * hf + 0], yv[8 * hf + 1] * rs * gn[8 * hf + 1]);
        w.y = pack2(yv[8 * hf + 2] * rs * gn[8 * hf + 2], yv[8 * hf + 3] * rs * gn[8 * hf + 3]);
        w.z = pack2(yv[8 * hf + 4] * rs * gn[8 * hf + 4], yv[8 * hf + 5] * rs * gn[8 * hf + 5]);
        w.w = pack2(yv[8 * hf + 6] * rs * gn[8 * hf + 6], yv[8 * hf + 7] * rs * gn[8 * hf + 7]);
        *(uint4*)(ur + U_YC + 16 * lane + 8 * hf) = w;
      }
    }
    {
      asm volatile("s_waitcnt vmcnt(0)" ::: "memory");
      const float* mr = p.MOD + (size_t)layer * 9 * 6144 + modrow(tok) * 6144;
      const float rs = rsqrtf(p.SS[(size_t)(2 * layer) * TT + tok] * (1.f / DM) + EPS);
      norm_row(xrow_in(p, layer, tok), rs, mr + 1024, mr, p.P + (size_t)tok * 1024, lane);
    }
  }
}


#define XB_TMO      128
#define XB_XCNT(j)  (256  + 64 * (j))
#define XB_XSUB(j)  (1280 + 64 * (j))
#define XB_XGEN(j)  (2304 + 64 * (j))
#define XB_TOP      3328
#define XB_TOPGEN   3392
#define XCD_BAR_WORDS 3456
#define XB_SPIN_CAP (1u << 20)
__device__ __forceinline__ unsigned xb_ld(unsigned* p)              { return __hip_atomic_load(p, __ATOMIC_RELAXED, __HIP_MEMORY_SCOPE_AGENT); }
__device__ __forceinline__ unsigned xb_add(unsigned* p, unsigned v) { return __hip_atomic_fetch_add(p, v, __ATOMIC_RELAXED, __HIP_MEMORY_SCOPE_AGENT); }
__device__ __forceinline__ unsigned xb_xcc_id() { return (unsigned)__builtin_amdgcn_s_getreg((3 << 11) | 20) & 0xFu; }
#define XB_SPIN(cond, bar) do { unsigned _sp = 0; while (cond) { __builtin_amdgcn_s_sleep(1); \
    if ((++_sp & 255u) == 0u) { if (xb_ld(&(bar)[XB_TMO])) break; if (_sp > XB_SPIN_CAP) { atomicAdd(&(bar)[XB_TMO], 1u); break; } } } } while (0)
struct XcdBarrier { unsigned* bar; unsigned x; volatile LDS_AS unsigned* st; };
__device__ __forceinline__ XcdBarrier xcd_barrier_post(unsigned* bar, volatile LDS_AS unsigned* st) {
  XcdBarrier b; b.bar = bar; b.x = xb_xcc_id(); b.st = st;
  if (threadIdx.x == 0) (void)xb_add(&bar[XB_XCNT(b.x)], 1u);
  return b;
}
__device__ __forceinline__ void xcd_barrier_complete(unsigned* bar, unsigned x, unsigned& nloc, unsigned& nx) {
  const unsigned G = gridDim.x * gridDim.y * gridDim.z;
  unsigned sum, cnt, mine, sp = 0u;
  for (;;) {
    sum = 0u; cnt = 0u; mine = 0u;
#pragma unroll
    for (unsigned j = 0; j < 16; ++j) { const unsigned c = xb_ld(&bar[XB_XCNT(j)]); sum += c; cnt += (c > 0u) ? 1u : 0u; mine = (j == x) ? c : mine; }
    if (sum == G) break;
    __builtin_amdgcn_s_sleep(1);
    if ((++sp & 255u) == 0u) { if (xb_ld(&bar[XB_TMO])) break; if (sp > XB_SPIN_CAP) { atomicAdd(&bar[XB_TMO], 1u); break; } }
  }
  nloc = mine > 0u ? mine : 1u; nx = cnt > 0u ? cnt : 1u;
}
__device__ __forceinline__ void xcd_barrier(const XcdBarrier& b) {
  asm volatile("s_waitcnt vmcnt(0)" ::: "memory");
  __syncthreads();
  if (threadIdx.x == 0) {
    unsigned* bar = b.bar;
    __builtin_amdgcn_s_waitcnt(0);
    unsigned nloc = b.st[0], nx = b.st[1];
    if (nloc == 0u) { xcd_barrier_complete(bar, b.x, nloc, nx); b.st[0] = nloc; b.st[1] = nx; }
    const unsigned old = xb_add(&bar[XB_XSUB(b.x)], 1u);
    const unsigned gen = old / nloc;
    if (old + 1u == (gen + 1u) * nloc) {
      __builtin_amdgcn_fence(__ATOMIC_RELEASE, "agent");
      asm volatile("s_waitcnt vmcnt(0)" ::: "memory");
      const unsigned og = xb_add(&bar[XB_TOP], 1u);
      const unsigned tg = og / nx;
      if (og + 1u == (tg + 1u) * nx) xb_add(&bar[XB_TOPGEN], 1u);
      else XB_SPIN(xb_ld(&bar[XB_TOPGEN]) == tg, bar);
      __builtin_amdgcn_fence(__ATOMIC_ACQUIRE, "agent");
      xb_add(&bar[XB_XGEN(b.x)], 1u);
      asm volatile("s_waitcnt vmcnt(0)" ::: "memory");
    } else {
      XB_SPIN(xb_ld(&bar[XB_XGEN(b.x)]) == gen, bar);
      __builtin_amdgcn_fence(__ATOMIC_ACQUIRE, "agent");
      asm volatile("s_waitcnt vmcnt(0)" ::: "memory");
    }
  }
  __syncthreads();
}

namespace cg = cooperative_groups;
constexpr int MEGA_LDS = GDN_LDS > SSD_LDS ? GDN_LDS : SSD_LDS;
static_assert(MEGA_LDS <= 81408 && GEMM_LDS_BYTES <= MEGA_LDS && 4 * NA_LDS_WAVE <= MEGA_LDS, "LDS budget");
__global__ void __launch_bounds__(256, 2) k_mega(Params p) {
  cg::grid_group grid = cg::this_grid();
  __shared__ __attribute__((aligned(16))) char smem[MEGA_LDS];
  const int bid = blockIdx.x, nb = gridDim.x;
  __shared__ uint4 xb_words;
  if (threadIdx.x == 0) xb_words = make_uint4(0u, 0u, 0u, 0u);
  __syncthreads();
  const XcdBarrier xb = xcd_barrier_post(p.BAR, (volatile LDS_AS unsigned*)&xb_words);
  phase_pro(p, bid, nb);
  phase_modp(p, bid, nb, (float*)smem);
  grid.sync();
  phase_modfin(p, bid, nb);
  xcd_barrier(xb);
  phase_norm(p, 0, 0, bid, nb);
  xcd_barrier(xb);
  for (int layer = 0; layer < 2; ++layer) {
    phase_g1(p, layer, bid, nb, (bf16_t*)smem);
    xcd_barrier(xb);
    phase_prep(p, layer, bid, nb);
    xcd_barrier(xb);
    {
      __shared__ int s_role;
      unsigned* chain_ctr = p.CTR + 8 + layer;
      if (threadIdx.x == 0) {
        const unsigned key = (((unsigned)__builtin_amdgcn_s_getreg((3 << 11) | 20) & 0xFu) << 8) | (((unsigned)__builtin_amdgcn_s_getreg(63492) >> 8) & 0xffu);
        const unsigned slot = nb > 256 ? atomicAdd(p.CTR + 64 + 2048 * layer + key, 1u) : 0u;
        s_role = slot == 0 ? (int)atomicAdd(chain_ctr, 1u) : 1 << 20;
      }
      __syncthreads();
      int c = s_role;
      __syncthreads();
      if (c < 128) phase_gdn(p, layer, c, smem); else if (c < 256) phase_ssd(p, layer, c - 128, smem);
      __syncthreads();
      phase_na(p, layer, p.CTR + layer, smem);
      for (;;) {
        __syncthreads();
        if (threadIdx.x == 0) s_role = (int)atomicAdd(chain_ctr, 1u);
        __syncthreads();
        c = s_role;
        if (c >= 256) break;
        if (c < 128) phase_gdn(p, layer, c, smem); else phase_ssd(p, layer, c - 128, smem);
      }
    }
    xcd_barrier(xb);
    phase_fin(p, layer, bid, nb);
    xcd_barrier(xb);
    phase_g2a(p, layer, bid, nb, (bf16_t*)smem);
    xcd_barrier(xb);
    phase_g2b(p, layer, bid, nb, (bf16_t*)smem);
    xcd_barrier(xb);
    phase_g3(p, layer, bid, nb, (bf16_t*)smem);
    xcd_barrier(xb);
    phase_norm(p, layer, 1, bid, nb);
    xcd_barrier(xb);
    phase_g4(p, layer, bid, nb, (bf16_t*)smem);
    xcd_barrier(xb);
    phase_g5(p, layer, bid, nb, (bf16_t*)smem);
    if (layer == 0) { xcd_barrier(xb); phase_norm(p, 1, 0, bid, nb); xcd_barrier(xb); }
  }
}

extern "C" void kernel_launch(void* const* d_in, const int* in_sizes, int n_in, void* d_out, int out_size, void* d_ws, size_t ws_size,
                              hipStream_t stream) {
  Params p{};
  const float** fp = (const float**)&p;
  for (int i = 0; i < 28; ++i) fp[i] = (const float*)d_in[i];
  p.out = (float*)d_out;
  char* ws = (char*)d_ws;
  size_t off = 0;
  auto take = [&](size_t bytes) { char* r = ws + off; off += (bytes + 255) & ~(size_t)255; return r; };
  p.U = (bf16_t*)take((size_t)TT * UW * 2);
  p.S = (float*)take((size_t)TT * SWD * 4);
  p.MOD = (float*)take((size_t)2 * 9 * 6144 * 4);
  p.SS = (float*)take((size_t)4 * TT * 4);
  p.ROPE = (float*)take(64 * 16 * 2 * 4);
  p.BAR = (unsigned*)take((size_t)XCD_BAR_WORDS * 4 + (64 + 2 * 2048) * 4);
  p.CTR = p.BAR + XCD_BAR_WORDS;
  p.P = (bf16_t*)take((size_t)TT * 1024 * 2);
  p.XC = (float*)take((size_t)TC * 1024 * 4);
  p.HB = (bf16_t*)p.XC;
  p.OG0 = (bf16_t*)d_out;
  p.OG1 = (bf16_t*)((char*)p.P + (size_t)TL * 1024 * 2);
  const size_t need = (size_t)((char*)p.OG1 - ws) + (size_t)2 * TL * 512 * 2;
  if (need > ws_size) { fprintf(stderr, "workspace too small: need %zu have %zu\n", need, ws_size); return; }
  static int grid_blocks = 0;
  if (!grid_blocks) {
    int dev = 0, cus = 0, per_cu = 0;
    hipGetDevice(&dev);
    hipDeviceGetAttribute(&cus, hipDeviceAttributeMultiprocessorCount, dev);
    hipOccupancyMaxActiveBlocksPerMultiprocessor(&per_cu, k_mega, 256, 0);
    if (per_cu > 2) per_cu = 2;
    grid_blocks = cus * per_cu;
  }
  hipMemsetAsync(p.BAR, 0, (size_t)XCD_BAR_WORDS * 4 + (64 + 2 * 2048) * 4, stream);
  void* args[] = {&p};
  hipError_t e = hipLaunchCooperativeKernel((void*)k_mega, dim3(grid_blocks), dim3(256), args, 0, stream);
  if (e != hipSuccess) fprintf(stderr, "cooperative launch failed: %s (grid %d)\n", hipGetErrorString(e), grid_blocks);
}
```

```cpp
#include <hip/hip_runtime.h>
#include <hip/hip_cooperative_groups.h>
#include <cstdio>
#include <cstdint>

typedef unsigned short bf16_t;
typedef short bf16x8 __attribute__((ext_vector_type(8)));
typedef short s16x4 __attribute__((ext_vector_type(4)));
typedef float f32x4 __attribute__((ext_vector_type(4)));
#define LDS_AS __attribute__((address_space(3)))

constexpr int TL = 16384;
constexpr int TC = 2048;
constexpr int TT = TL + TC;
constexpr int DM = 1024;
constexpr int UW = 6144;
constexpr int SWD = 64;
constexpr int DIN = 9280;
constexpr int DFF = 4096;
constexpr float EPS = 1e-6f;
constexpr int U_NAQ = 0, U_NAK = 512, U_NAV = 1024;
constexpr int U_DNQ = 1536, U_DNK = 2048, U_DNV = 2560, U_DNZ = 3072;
constexpr int U_SZ = 3584, U_SX = 4608, U_SB = 5632, U_SC = 5888;
constexpr int U_YA = 0, U_YB = 512, U_YC = 1024, U_GATE = 2048, U_M = 5120;

struct Params {
  const float *x, *c, *ctx, *c_ctx, *w_ada, *b_ada, *norm1_g, *norm2_g, *w_in, *na_q_gain, *na_k_gain, *na_rpb,
      *dn_conv_w, *dn_a_log, *dn_dt_bias, *dn_o_gain, *ssd_conv_w, *ssd_conv_b, *ssd_a_log, *ssd_dt_bias, *ssd_d,
      *ssd_o_gain, *w_pa, *w_pb, *w_pc, *w_out, *w_ff1, *w_ff2;
  float* out;
  bf16_t* U;
  float* S;
  bf16_t* P;
  float* XC;
  float* MOD;
  float* SS;
  float* ROPE;
  unsigned* BAR;
  unsigned* CTR;
  bf16_t* HB;
  bf16_t* OG0;
  bf16_t* OG1;
};

__device__ __forceinline__ int tidx() { int t = threadIdx.x; asm volatile("" : "+v"(t)); return t; }
__device__ __forceinline__ float bf2f(bf16_t v) { return __uint_as_float(((unsigned)v) << 16); }
__device__ __forceinline__ bf16_t f2bf(float f) {
  unsigned u = __float_as_uint(f);
  u += 0x7fffu + ((u >> 16) & 1u);
  return (bf16_t)(u >> 16);
}
__device__ __forceinline__ unsigned pack2(float a, float b) { return (unsigned)f2bf(a) | ((unsigned)f2bf(b) << 16); }
__device__ __forceinline__ float bflo(unsigned w) { return __uint_as_float(w << 16); }
__device__ __forceinline__ float bfhi(unsigned w) { return __uint_as_float(w & 0xffff0000u); }
__device__ __forceinline__ float wave_sum(float v) {
#pragma unroll
  for (int o = 32; o; o >>= 1) v += __shfl_xor(v, o);
  return v;
}
__device__ __forceinline__ float wave_max(float v) {
#pragma unroll
  for (int o = 32; o; o >>= 1) v = fmaxf(v, __shfl_xor(v, o));
  return v;
}
__device__ __forceinline__ float siluf(float v) { return v * __builtin_amdgcn_rcpf(1.f + __expf(-v)); }
__device__ __forceinline__ float sigmoidf_(float v) { return __builtin_amdgcn_rcpf(1.f + __expf(-v)); }
__device__ __forceinline__ float softplusf_(float v) { return v > 20.f ? v : log1pf(expf(v)); }

__device__ __forceinline__ const float* xrow_in(const Params& p, int layer, int row) {
  if (layer == 0) return row < TL ? p.x + (size_t)row * DM : p.ctx + (size_t)(row - TL) * DM;
  return row < TL ? p.out + (size_t)row * DM : p.XC + (size_t)(row - TL) * DM;
}
__device__ __forceinline__ float* xrow_out(const Params& p, int row) {
  return row < TL ? p.out + (size_t)row * DM : p.XC + (size_t)(row - TL) * DM;
}
__device__ __forceinline__ int modrow(int row) { return row < TL ? (row >> 11) : 8; }

constexpr int G_BK = 32;
constexpr int G_ASTR = G_BK + 8;
constexpr int G_ATILE = 256 * G_ASTR;
constexpr int GEMM_LDS_BYTES = 2 * (G_ATILE + G_BK * (128 + 16)) * 2;
__device__ __forceinline__ s16x4 tr16(const bf16_t* ptr) { return __builtin_amdgcn_ds_read_tr16_b64_v4i16((LDS_AS s16x4*)ptr); }
__device__ __forceinline__ bf16x8 cat8(s16x4 lo, s16x4 hi) { return (bf16x8){lo[0], lo[1], lo[2], lo[3], hi[0], hi[1], hi[2], hi[3]}; }
__device__ __forceinline__ uint4 cvt8(float4 a, float4 b) { uint4 o; o.x = pack2(a.x, a.y); o.y = pack2(a.z, a.w); o.z = pack2(b.x, b.y); o.w = pack2(b.z, b.w); return o; }

__device__ __forceinline__ void gemm_main2(f32x4 (&acc)[8][2], const bf16_t* A, int astride, const float* W, int ldw, int col0, bool small, int K, bf16_t* lds) {
  constexpr int NI = 2, BSTR = 80, BTILE = G_BK * BSTR;
  const int tid = tidx(), lane = tid & 63, wave = tid >> 6, wm = wave >> 1, wn = wave & 1, g = lane >> 4, l15 = lane & 15, q4 = l15 >> 2, p4 = lane & 3;
  bf16_t* As = lds;
  bf16_t* Bs = lds + 2 * G_ATILE;
  const int ar = tid >> 2, ak = (tid & 3) * 8;
  const int bk = tid >> 3, bn = (tid & 7) * 8;
  const int rho0 = (bk & 3) + 4 * ((bk >> 3) & 3) + 16 * ((bk >> 2) & 1);
  int bsrc = col0 + bn; bool bzero = false;
  if (small) { if (bn < 32) bsrc = 3584 + bn; else if (bn < 64) bsrc = 6176 + bn - 32; else { bzero = true; bsrc = 0; } }
  const bf16_t* ap = A + (size_t)ar * astride + ak;
  const float* bp = W + (size_t)bk * ldw + bsrc;
  bf16_t* aw = As + ar * G_ASTR + ak;
  bf16_t* bw = Bs + rho0 * BSTR + bn;
  uint4 ra0, ra1, ra2, ra3; float4 rb0, rb1;
#define G_LOADS(K1) { ra0 = *(const uint4*)(ap + (size_t)(64 * 0) * astride + (K1)); ra1 = *(const uint4*)(ap + (size_t)(64 * 1) * astride + (K1)); ra2 = *(const uint4*)(ap + (size_t)(64 * 2) * astride + (K1)); ra3 = *(const uint4*)(ap + (size_t)(64 * 3) * astride + (K1)); { const float* s_ = bp + (size_t)(K1) * ldw; rb0 = *(const float4*)s_; rb1 = *(const float4*)(s_ + 4); } }
#define G_STORES(NX) { *(uint4*)(aw + (NX) * G_ATILE + 64 * 0 * G_ASTR) = ra0; *(uint4*)(aw + (NX) * G_ATILE + 64 * 1 * G_ASTR) = ra1; *(uint4*)(aw + (NX) * G_ATILE + 64 * 2 * G_ASTR) = ra2; *(uint4*)(aw + (NX) * G_ATILE + 64 * 3 * G_ASTR) = ra3; { uint4 o_ = cvt8(rb0, rb1); if (bzero) o_ = make_uint4(0u, 0u, 0u, 0u); *(uint4*)(bw + (NX) * BTILE + 0 * BSTR) = o_; } }
  G_LOADS(0)
  G_STORES(0)
  __syncthreads();
  const int nk = K / G_BK;
  for (int kt = 0; kt < nk; ++kt) {
    const int cur = kt & 1;
    const int k1 = (kt + 1 < nk ? kt + 1 : kt) * G_BK;
    G_LOADS(k1)
    asm volatile("" ::: "memory");
    const bf16_t* Ac = As + cur * G_ATILE + (128 * wm + l15) * G_ASTR + 8 * g;
    const bf16_t* Bc = Bs + cur * BTILE + (4 * g + q4) * BSTR + 16 * NI * wn + 4 * p4;
    {
      bf16x8 af[8], bfr[NI];
#pragma unroll
      for (int mi = 0; mi < 8; ++mi) af[mi] = *(const bf16x8*)(Ac + mi * 16 * G_ASTR);
#pragma unroll
      for (int ni = 0; ni < NI; ++ni) bfr[ni] = cat8(tr16(Bc + 16 * ni), tr16(Bc + 16 * BSTR + 16 * ni));
#pragma unroll
      for (int mi = 0; mi < 8; ++mi)
#pragma unroll
        for (int ni = 0; ni < NI; ++ni) acc[mi][ni] = __builtin_amdgcn_mfma_f32_16x16x32_bf16(bfr[ni], af[mi], acc[mi][ni], 0, 0, 0);
    }
    asm volatile("" ::: "memory");
    __builtin_amdgcn_sched_barrier(0);
    G_STORES(cur ^ 1)
    __syncthreads();
  }
#undef G_LOADS
#undef G_STORES
}
__device__ __forceinline__ void gemm_main4(f32x4 (&acc)[8][4], const bf16_t* A, int astride, const float* W, int ldw, int col0, bool small, int K, bf16_t* lds) {
  constexpr int NI = 4, BSTR = 144, BTILE = G_BK * BSTR;
  const int tid = tidx(), lane = tid & 63, wave = tid >> 6, wm = wave >> 1, wn = wave & 1, g = lane >> 4, l15 = lane & 15, q4 = l15 >> 2, p4 = lane & 3;
  bf16_t* As = lds;
  bf16_t* Bs = lds + 2 * G_ATILE;
  const int ar = tid >> 2, ak = (tid & 3) * 8;
  const int bk = tid >> 4, bn = (tid & 15) * 8;
  const int rho0 = (bk & 3) + 4 * (bk >> 3) + 16 * ((bk >> 2) & 1);
  int bsrc = col0 + bn; bool bzero = false;
  if (small) { if (bn < 32) bsrc = 3584 + bn; else if (bn < 64) bsrc = 6176 + bn - 32; else { bzero = true; bsrc = 0; } }
  const bf16_t* ap = A + (size_t)ar * astride + ak;
  const float* bp = W + (size_t)bk * ldw + bsrc;
  bf16_t* aw = As + ar * G_ASTR + ak;
  bf16_t* bw = Bs + rho0 * BSTR + bn;
  uint4 ra0, ra1, ra2, ra3; float4 rb0, rb1, rb2, rb3;
#define G_LOADS(K1) { ra0 = *(const uint4*)(ap + (size_t)(64 * 0) * astride + (K1)); ra1 = *(const uint4*)(ap + (size_t)(64 * 1) * astride + (K1)); ra2 = *(const uint4*)(ap + (size_t)(64 * 2) * astride + (K1)); ra3 = *(const uint4*)(ap + (size_t)(64 * 3) * astride + (K1)); { const float* s_ = bp + (size_t)((K1) + 16 * 0) * ldw; rb0 = *(const float4*)s_; rb1 = *(const float4*)(s_ + 4); } { const float* s_ = bp + (size_t)((K1) + 16 * 1) * ldw; rb2 = *(const float4*)s_; rb3 = *(const float4*)(s_ + 4); } }
#define G_STORES(NX) { *(uint4*)(aw + (NX) * G_ATILE + 64 * 0 * G_ASTR) = ra0; *(uint4*)(aw + (NX) * G_ATILE + 64 * 1 * G_ASTR) = ra1; *(uint4*)(aw + (NX) * G_ATILE + 64 * 2 * G_ASTR) = ra2; *(uint4*)(aw + (NX) * G_ATILE + 64 * 3 * G_ASTR) = ra3; { uint4 o_ = cvt8(rb0, rb1); if (bzero) o_ = make_uint4(0u, 0u, 0u, 0u); *(uint4*)(bw + (NX) * BTILE + 0 * BSTR) = o_; } { uint4 o_ = cvt8(rb2, rb3); if (bzero) o_ = make_uint4(0u, 0u, 0u, 0u); *(uint4*)(bw + (NX) * BTILE + 8 * BSTR) = o_; } }
  G_LOADS(0)
  G_STORES(0)
  __syncthreads();
  const int nk = K / G_BK;
  for (int kt = 0; kt < nk; ++kt) {
    const int cur = kt & 1;
    const int k1 = (kt + 1 < nk ? kt + 1 : kt) * G_BK;
    G_LOADS(k1)
    asm volatile("" ::: "memory");
    const bf16_t* Ac = As + cur * G_ATILE + (128 * wm + l15) * G_ASTR + 8 * g;
    const bf16_t* Bc = Bs + cur * BTILE + (4 * g + q4) * BSTR + 16 * NI * wn + 4 * p4;
    {
      bf16x8 af[8], bfr[NI];
#pragma unroll
      for (int mi = 0; mi < 8; ++mi) af[mi] = *(const bf16x8*)(Ac + mi * 16 * G_ASTR);
#pragma unroll
      for (int ni = 0; ni < NI; ++ni) bfr[ni] = cat8(tr16(Bc + 16 * ni), tr16(Bc + 16 * BSTR + 16 * ni));
#pragma unroll
      for (int mi = 0; mi < 8; ++mi)
#pragma unroll
        for (int ni = 0; ni < NI; ++ni) acc[mi][ni] = __builtin_amdgcn_mfma_f32_16x16x32_bf16(bfr[ni], af[mi], acc[mi][ni], 0, 0, 0);
    }
    asm volatile("" ::: "memory");
    __builtin_amdgcn_sched_barrier(0);
    G_STORES(cur ^ 1)
    __syncthreads();
  }
#undef G_LOADS
#undef G_STORES
}
template <int NI> __device__ __forceinline__ void acc_zero(f32x4 (&acc)[8][NI]) {
#pragma unroll
  for (int i = 0; i < 8; ++i)
#pragma unroll
    for (int j = 0; j < NI; ++j) acc[i][j] = (f32x4){0.f, 0.f, 0.f, 0.f};
}
__device__ __forceinline__ bool tile_next(int i, int bid, int nb, int nMt, int nNt, bool nsplit, int& mt, int& nt) {
  const int xcd = bid & 7, slot = bid >> 3, nslots = nb >> 3;
  const int j = slot + i * nslots;
  if (nsplit) {
    const int nNx = (nNt - xcd + 7) >> 3;
    if (j >= nMt * nNx) return false;
    mt = j / nNx; nt = xcd + 8 * (j % nNx);
  } else {
    const int nMx = (nMt - xcd + 7) >> 3;
    if (j >= nMx * nNt) return false;
    mt = xcd + 8 * (j / nNt); nt = j % nNt;
  }
  return true;
}
#define EPI_IDS const int lane = tidx() & 63, wave = tidx() >> 6, wm = wave >> 1, wn = wave & 1, g = lane >> 4, l15 = lane & 15

__device__ __forceinline__ void phase_pro(const Params& p, int bid, int nb) {
  const int tid = tidx(), lane = tid & 63, wave = tid >> 6;
  for (int row = bid * 4 + wave; row < TT; row += nb * 4) {
    const float* xr = xrow_in(p, 0, row);
    float s = 0.f;
#pragma unroll
    for (int i = 0; i < 4; ++i) { const float4 v = *(const float4*)(xr + lane * 4 + 256 * i); s += v.x * v.x + v.y * v.y + v.z * v.z + v.w * v.w; }
    s = wave_sum(s);
    if (lane == 0) { p.SS[row] = s; p.SS[TT + row] = 0.f; p.SS[2 * TT + row] = 0.f; p.SS[3 * TT + row] = 0.f; }
  }
  for (int i = bid * 256 + tid; i < 64 * 16; i += nb * 256) {
    const int pos = i >> 4, fi = i & 15;
    const float inv = powf(10000.f, -(float)fi / 16.f);
    const float ang = (float)pos * inv;
    p.ROPE[2 * i] = cosf(ang); p.ROPE[2 * i + 1] = sinf(ang);
  }
}
__device__ __forceinline__ void phase_modp(const Params& p, int bid, int nb, float* lds) {
  const int tid = tidx();
  float* MODP = (float*)p.U;
  for (int u = bid; u < 768; u += nb) {
    const int ks = u & 15, cb = (u >> 4) % 24, l = u / 384, n = cb * 256 + tid;
    __syncthreads();
    for (int i = tid; i < 9 * 64; i += 256) { const int r = i >> 6, k = 64 * ks + (i & 63); const float v = r < 8 ? p.c[r * 1024 + k] : p.c_ctx[k]; lds[i] = siluf(v); }
    __syncthreads();
    float acc[9];
#pragma unroll
    for (int r = 0; r < 9; ++r) acc[r] = 0.f;
    const float* w = p.w_ada + ((size_t)l * 1024 + 64 * ks) * 6144 + n;
#pragma unroll 16
    for (int k = 0; k < 64; ++k) {
      const float wv = w[(size_t)k * 6144];
#pragma unroll
      for (int r = 0; r < 9; ++r) acc[r] += lds[r * 64 + k] * wv;
    }
#pragma unroll
    for (int r = 0; r < 9; ++r) MODP[((size_t)(ks * 2 + l) * 9 + r) * 6144 + n] = acc[r];
  }
}
__device__ __forceinline__ void phase_modfin(const Params& p, int bid, int nb) {
  const float* MODP = (const float*)p.U;
  for (int i = bid * 256 + tidx(); i < 2 * 9 * 6144; i += nb * 256) {
    const int l = i / (9 * 6144), rem = i % (9 * 6144), r = rem / 6144, n = rem % 6144;
    float v = p.b_ada[l * 6144 + n];
#pragma unroll
    for (int ks = 0; ks < 16; ++ks) v += MODP[((size_t)(ks * 2 + l) * 9 + r) * 6144 + n];
    const int chunk = n >> 10, kk = n & 1023;
    if (chunk == 1) v = p.norm1_g[l * 1024 + kk] * (1.f + v);
    if (chunk == 4) v = p.norm2_g[l * 1024 + kk] * (1.f + v);
    p.MOD[i] = v;
  }
}

__device__ __forceinline__ void norm_rows4(const float* x0, const float* x1, const float* x2, const float* x3, const float* ss, int row0, const float* alpha, const float* shift, bf16_t* h0, int lane) {
  const float* xr[4] = {x0, x1, x2, x3};
  float4 v[4][4];
#pragma unroll
  for (int j = 0; j < 4; ++j)
#pragma unroll
    for (int i = 0; i < 4; ++i) v[j][i] = *(const float4*)(xr[j] + lane * 4 + 256 * i);
  float rs[4];
#pragma unroll
  for (int j = 0; j < 4; ++j) rs[j] = rsqrtf(ss[row0 + j] * (1.f / DM) + EPS);
#pragma unroll
  for (int i = 0; i < 4; ++i) {
    const int k = lane * 4 + 256 * i;
    const float4 a = *(const float4*)(alpha + k), s = *(const float4*)(shift + k);
#pragma unroll
    for (int j = 0; j < 4; ++j) {
      uint2 o; o.x = pack2(v[j][i].x * rs[j] * a.x + s.x, v[j][i].y * rs[j] * a.y + s.y); o.y = pack2(v[j][i].z * rs[j] * a.z + s.z, v[j][i].w * rs[j] * a.w + s.w);
      *(uint2*)(h0 + (size_t)j * 1024 + k) = o;
    }
  }
}
__device__ __forceinline__ void phase_norm(const Params& p, int layer, int which, int bid, int nb) {
  const int lane = tidx() & 63, wave = tidx() >> 6;
  const int nrow = (which == 1 && layer == 1) ? TL : TT;
  const float* modl = p.MOD + (size_t)layer * 9 * 6144;
  const float* ss = p.SS + (size_t)(2 * layer + which) * TT;
  const int lin = which == 0 ? layer : 1;
  for (int row = (bid * 4 + wave) * 4; row < nrow; row += nb * 16) {
    const float* mr = modl + modrow(row) * 6144;
    norm_rows4(xrow_in(p, lin, row), xrow_in(p, lin, row + 1), xrow_in(p, lin, row + 2), xrow_in(p, lin, row + 3), ss, row,
               mr + (which ? 4096 : 1024), mr + (which ? 3072 : 0), p.P + (size_t)row * 1024, lane);
  }
}

__device__ __forceinline__ void phase_g1(const Params& p, int layer, int bid, int nb, bf16_t* lds) {
  constexpr bool NSPLIT = true;
  const int nMt = TT / 256, nNt = 49;
  EPI_IDS;
  for (int ti = 0;; ++ti) {
    int mt, nt; if (!tile_next(ti, bid, nb, nMt, nNt, NSPLIT, mt, nt)) break;
    const int m0 = mt * 256, n0 = nt * 128;
    f32x4 acc[8][4]; acc_zero<4>(acc);
    gemm_main4(acc, p.P + (size_t)m0 * 1024, 1024, p.w_in + (size_t)layer * 1024 * DIN, DIN, n0 < 3584 ? n0 : n0 + 32, nt == 48, 1024, lds);
    if (n0 < 1024) {
      const float* gain = (n0 < 512 ? p.na_q_gain : p.na_k_gain) + layer * 64;
      const float mul = n0 < 512 ? 0.125f : 1.f;
#pragma unroll
      for (int mi = 0; mi < 8; ++mi) {
        float ss = 0.f;
#pragma unroll
        for (int ni = 0; ni < 4; ++ni) ss += acc[mi][ni][0] * acc[mi][ni][0] + acc[mi][ni][1] * acc[mi][ni][1] + acc[mi][ni][2] * acc[mi][ni][2] + acc[mi][ni][3] * acc[mi][ni][3];
        ss += __shfl_xor(ss, 16); ss += __shfl_xor(ss, 32);
        const float rs = rsqrtf(ss * (1.f / 64.f) + EPS) * mul;
        const int row = m0 + 128 * wm + 16 * mi + l15;
#pragma unroll
        for (int ni = 0; ni < 4; ++ni) {
          const int cl = 16 * ni + 4 * g;
          const float4 gv = *(const float4*)(gain + cl);
          uint2 o; o.x = pack2(acc[mi][ni][0] * rs * gv.x, acc[mi][ni][1] * rs * gv.y); o.y = pack2(acc[mi][ni][2] * rs * gv.z, acc[mi][ni][3] * rs * gv.w);
          *(uint2*)(p.U + (size_t)row * UW + n0 + 64 * wn + cl) = o;
        }
      }
    } else if (n0 < 6144) {
      const bool hsec = (n0 >= 1536 && n0 < 3072) || n0 >= 4608;
      const int hcol0 = n0 < 3072 ? n0 - 1536 : n0 - 3072;
#pragma unroll
      for (int mi = 0; mi < 8; ++mi) {
        const int row = m0 + 128 * wm + 16 * mi + l15;
        const int rr = row & 63;
        const bool halo = hsec && (rr < 2 || rr >= 62);
        bf16_t* hb = p.HB + ((size_t)(row >> 6) * 4 + (rr < 2 ? rr : rr - 60)) * 3072 + hcol0 + 64 * wn + 4 * g;
#pragma unroll
        for (int ni = 0; ni < 4; ++ni) {
          uint2 o; o.x = pack2(acc[mi][ni][0], acc[mi][ni][1]); o.y = pack2(acc[mi][ni][2], acc[mi][ni][3]);
          *(uint2*)(p.U + (size_t)row * UW + n0 + 64 * wn + 16 * ni + 4 * g) = o;
          if (halo) *(uint2*)(hb + 16 * ni) = o;
        }
      }
    } else if (wn == 0) {
#pragma unroll
      for (int mi = 0; mi < 8; ++mi) {
        const int row = m0 + 128 * wm + 16 * mi + l15;
#pragma unroll
        for (int ni = 0; ni < 4; ++ni) *(f32x4*)(p.S + (size_t)row * SWD + 16 * ni + 4 * g) = acc[mi][ni];
      }
    }
  }
}

__device__ __forceinline__ void phase_g2a(const Params& p, int layer, int bid, int nb, bf16_t* lds) {
  constexpr bool NSPLIT = true;
  const int nMt = (layer == 0 ? TT : TL) / 256, nNt = 24;
  EPI_IDS;
  for (int ti = 0;; ++ti) {
    int mt, nt; if (!tile_next(ti, bid, nb, nMt, nNt, NSPLIT, mt, nt)) break;
    const int m0 = mt * 256, n0 = nt * 128;
    f32x4 acc[8][4]; acc_zero<4>(acc);
    gemm_main4(acc, p.P + (size_t)m0 * 1024, 1024, p.w_in + (size_t)layer * 1024 * DIN, DIN, 6208 + n0, false, 1024, lds);
#pragma unroll
    for (int mi = 0; mi < 8; ++mi) {
      const int row = m0 + 128 * wm + 16 * mi + l15;
#pragma unroll
      for (int ni = 0; ni < 4; ++ni) {
        uint2 o; o.x = pack2(sigmoidf_(acc[mi][ni][0]), sigmoidf_(acc[mi][ni][1])); o.y = pack2(sigmoidf_(acc[mi][ni][2]), sigmoidf_(acc[mi][ni][3]));
        *(uint2*)(p.U + (size_t)row * UW + U_GATE + n0 + 64 * wn + 16 * ni + 4 * g) = o;
      }
    }
  }
}
__device__ __forceinline__ void phase_g2b(const Params& p, int layer, int bid, int nb, bf16_t* lds) {
  constexpr bool NSPLIT = false;
  const int nMt = (layer == 0 ? TT : TL) / 256, nNt = 16;
  EPI_IDS;
  for (int ti = 0;; ++ti) {
    int mt, nt; if (!tile_next(ti, bid, nb, nMt, nNt, NSPLIT, mt, nt)) break;
    const int m0 = mt * 256, n0 = nt * 64;
    f32x4 accm[8][2]; acc_zero<2>(accm);
#pragma unroll 1
    for (int i = 0; i < 3; ++i) {
      const int ycol = i == 0 ? U_YA : (i == 1 ? U_YB : U_YC);
      const int Ki = i == 2 ? 1024 : 512;
      const float* w = i == 0 ? p.w_pa + (size_t)layer * 512 * 1024 : (i == 1 ? p.w_pb + (size_t)layer * 512 * 1024 : p.w_pc + (size_t)layer * 1024 * 1024);
      f32x4 acc[8][2]; acc_zero<2>(acc);
      gemm_main2(acc, p.U + (size_t)m0 * UW + ycol, UW, w, 1024, n0, false, Ki, lds);
#pragma unroll
      for (int mi = 0; mi < 8; ++mi) {
        const int row = m0 + 128 * wm + 16 * mi + l15;
#pragma unroll
        for (int ni = 0; ni < 2; ++ni) {
          const uint2 gt = *(const uint2*)(p.U + (size_t)row * UW + U_GATE + 1024 * i + n0 + 32 * wn + 16 * ni + 4 * g);
          accm[mi][ni][0] += bflo(gt.x) * acc[mi][ni][0]; accm[mi][ni][1] += bfhi(gt.x) * acc[mi][ni][1];
          accm[mi][ni][2] += bflo(gt.y) * acc[mi][ni][2]; accm[mi][ni][3] += bfhi(gt.y) * acc[mi][ni][3];
        }
      }
    }
#pragma unroll
    for (int mi = 0; mi < 8; ++mi) {
      const int row = m0 + 128 * wm + 16 * mi + l15;
#pragma unroll
      for (int ni = 0; ni < 2; ++ni) {
        uint2 o; o.x = pack2(accm[mi][ni][0], accm[mi][ni][1]); o.y = pack2(accm[mi][ni][2], accm[mi][ni][3]);
        *(uint2*)(p.U + (size_t)row * UW + U_M + n0 + 32 * wn + 16 * ni + 4 * g) = o;
      }
    }
  }
}
__device__ __forceinline__ void epi_residual(const Params& p, const f32x4 (&acc)[8][4], int layer_in, int m0, int n0, const float* gate, float* ssacc) {
  EPI_IDS;
#pragma unroll
  for (int mi = 0; mi < 8; ++mi) {
    const int row = m0 + 128 * wm + 16 * mi + l15;
    const float* xi = xrow_in(p, layer_in, row);
    float* xo = xrow_out(p, row);
    const float* gr = gate + modrow(row) * 6144;
    float ss = 0.f;
#pragma unroll
    for (int ni = 0; ni < 4; ++ni) {
      const int col = n0 + 64 * wn + 16 * ni + 4 * g;
      const float4 xv = *(const float4*)(xi + col);
      const float4 gv = *(const float4*)(gr + col);
      float4 o;
      o.x = xv.x + gv.x * acc[mi][ni][0]; o.y = xv.y + gv.y * acc[mi][ni][1]; o.z = xv.z + gv.z * acc[mi][ni][2]; o.w = xv.w + gv.w * acc[mi][ni][3];
      *(float4*)(xo + col) = o;
      ss += o.x * o.x + o.y * o.y + o.z * o.z + o.w * o.w;
    }
    if (ssacc) {
      ss += __shfl_xor(ss, 16); ss += __shfl_xor(ss, 32);
      if (g == 0) atomicAdd(ssacc + row, ss);
    }
  }
}
__device__ __forceinline__ void phase_g3(const Params& p, int layer, int bid, int nb, bf16_t* lds) {
  constexpr bool NSPLIT = false;
  const int nMt = (layer == 0 ? TT : TL) / 256, nNt = 8;
  const float* modl = p.MOD + (size_t)layer * 9 * 6144;
  for (int ti = 0;; ++ti) {
    int mt, nt; if (!tile_next(ti, bid, nb, nMt, nNt, NSPLIT, mt, nt)) break;
    const int m0 = mt * 256, n0 = nt * 128;
    f32x4 acc[8][4]; acc_zero<4>(acc);
    gemm_main4(acc, p.U + (size_t)m0 * UW + U_M, UW, p.w_out + (size_t)layer * 1024 * 1024, 1024, n0, false, 1024, lds);
    epi_residual(p, acc, layer, m0, n0, modl + 2048, p.SS + (size_t)(2 * layer + 1) * TT);
  }
}
__device__ __forceinline__ void phase_g4(const Params& p, int layer, int bid, int nb, bf16_t* lds) {
  constexpr bool NSPLIT = true;
  const int nMt = (layer == 0 ? TT : TL) / 256, nNt = 32;
  EPI_IDS;
  for (int ti = 0;; ++ti) {
    int mt, nt; if (!tile_next(ti, bid, nb, nMt, nNt, NSPLIT, mt, nt)) break;
    const int m0 = mt * 256, n0 = nt * 128;
    f32x4 acc[8][4]; acc_zero<4>(acc);
    gemm_main4(acc, p.P + (size_t)m0 * 1024, 1024, p.w_ff1 + (size_t)layer * 1024 * DFF, DFF, n0, false, 1024, lds);
#pragma unroll
    for (int mi = 0; mi < 8; ++mi) {
      const int row = m0 + 128 * wm + 16 * mi + l15;
#pragma unroll
      for (int ni = 0; ni < 4; ++ni) {
        const float v0 = fmaxf(acc[mi][ni][0], 0.f), v1 = fmaxf(acc[mi][ni][1], 0.f), v2 = fmaxf(acc[mi][ni][2], 0.f), v3 = fmaxf(acc[mi][ni][3], 0.f);
        uint2 o; o.x = pack2(v0 * v0, v1 * v1); o.y = pack2(v2 * v2, v3 * v3);
        *(uint2*)(p.U + (size_t)row * DFF + n0 + 64 * wn + 16 * ni + 4 * g) = o;
      }
    }
  }
}
__device__ __forceinline__ void phase_g5(const Params& p, int layer, int bid, int nb, bf16_t* lds) {
  constexpr bool NSPLIT = false;
  const int nMt = (layer == 0 ? TT : TL) / 256, nNt = 8;
  const float* modl = p.MOD + (size_t)layer * 9 * 6144;
  for (int ti = 0;; ++ti) {
    int mt, nt; if (!tile_next(ti, bid, nb, nMt, nNt, NSPLIT, mt, nt)) break;
    const int m0 = mt * 256, n0 = nt * 128;
    f32x4 acc[8][4]; acc_zero<4>(acc);
    gemm_main4(acc, p.U + (size_t)m0 * DFF, DFF, p.w_ff2 + (size_t)layer * DFF * 1024, 1024, n0, false, DFF, lds);
    epi_residual(p, acc, 1, m0, n0, modl + 5120, layer == 0 ? p.SS + (size_t)2 * TT : nullptr);
  }
}

__device__ __forceinline__ void phase_prep(const Params& p, int layer, int bid, int nb) {
  const int tid = tidx();
  for (int i = bid * 256 + tid; i < TT * 64; i += nb * 256) {
    const int c = i & 63;
    float v = p.S[i];
    if (c < 16) v = sigmoidf_(v);
    else if (c < 32) v = -expf(p.dn_a_log[layer * 16 + c - 16]) * softplusf_(v + p.dn_dt_bias[layer * 16 + c - 16]);
    else v = softplusf_(v + p.ssd_dt_bias[layer * 32 + c - 32]);
    p.S[i] = v;
  }
  const int cg = tid & 7, rA = tid >> 3;
  {
    const int slab = bid % 48, c0 = bid / 48, cstep = (nb + 47 - slab) / 48;
    const bool dn = slab < 24;
    const int typ = dn ? slab >> 3 : 3;
    const int ucol = (dn ? 1536 + 512 * typ + 64 * (slab & 7) : 4608 + 64 * (slab - 24)) + 8 * cg;
    const int hcol = dn ? ucol - 1536 : ucol - 3072;
    const int cch = (dn ? 512 * typ + 64 * (slab & 7) : 64 * (slab - 24)) + 8 * cg;
    const float* cw = (dn ? p.dn_conv_w : p.ssd_conv_w) + (size_t)layer * 5 * 1536 + cch;
    float w5[5][8];
#pragma unroll
    for (int j = 0; j < 5; ++j) {
      const float4 a = *(const float4*)(cw + j * 1536), b = *(const float4*)(cw + j * 1536 + 4);
      w5[j][0] = a.x; w5[j][1] = a.y; w5[j][2] = a.z; w5[j][3] = a.w; w5[j][4] = b.x; w5[j][5] = b.y; w5[j][6] = b.z; w5[j][7] = b.w;
    }
    float bias[8];
#pragma unroll
    for (int e = 0; e < 8; ++e) bias[e] = dn ? 0.f : p.ssd_conv_b[layer * 1536 + cch + e];
    uint4 raw[2][5];
#define PREP_LOAD(CHUNK) { \
      const bool lat_ = (CHUNK) < 256; const int cs_ = lat_ ? ((CHUNK) & 31) : (((CHUNK) - 256) & 3); \
      const bool first_ = cs_ == 0, last_ = lat_ ? cs_ == 31 : cs_ == 3; \
      _Pragma("unroll") for (int it = 0; it < 2; ++it) _Pragma("unroll") for (int j = 0; j < 5; ++j) { \
        const int rr = rA + 32 * it - 2 + j; \
        uint4 v = make_uint4(0u, 0u, 0u, 0u); \
        if (rr < 0) { if (!first_) v = *(const uint4*)(p.HB + ((size_t)((CHUNK) - 1) * 4 + 4 + rr) * 3072 + hcol); } \
        else if (rr >= 64) { if (!last_) v = *(const uint4*)(p.HB + ((size_t)((CHUNK) + 1) * 4 + rr - 64) * 3072 + hcol); } \
        else v = *(const uint4*)(p.U + (size_t)((CHUNK) * 64 + rr) * UW + ucol); \
        raw[it][j] = v; } }
    if (c0 < 288) PREP_LOAD(c0)
    for (int chunk = c0; chunk < 288; chunk += cstep) {
      const bool lat = chunk < 256;
      const int cs = lat ? (chunk & 31) : ((chunk - 256) & 3);
      const int r0 = chunk * 64;
      uint4 cur[2][5];
#pragma unroll
      for (int it = 0; it < 2; ++it)
#pragma unroll
        for (int j = 0; j < 5; ++j) cur[it][j] = raw[it][j];
      asm volatile("s_waitcnt vmcnt(0)" ::: "memory");
      __syncthreads();
      if (chunk + cstep < 288) PREP_LOAD(chunk + cstep)
#pragma unroll
      for (int it = 0; it < 2; ++it) {
        const int rr = rA + 32 * it;
        float v[8];
#pragma unroll
        for (int e = 0; e < 8; ++e) v[e] = bias[e];
#pragma unroll
        for (int j = 0; j < 5; ++j) {
          const uint4 x = cur[it][j];
          v[0] += w5[j][0] * bflo(x.x); v[1] += w5[j][1] * bfhi(x.x); v[2] += w5[j][2] * bflo(x.y); v[3] += w5[j][3] * bfhi(x.y);
          v[4] += w5[j][4] * bflo(x.z); v[5] += w5[j][5] * bfhi(x.z); v[6] += w5[j][6] * bflo(x.w); v[7] += w5[j][7] * bfhi(x.w);
        }
#pragma unroll
        for (int e = 0; e < 8; ++e) v[e] = siluf(v[e]);
        if (typ < 2) {
          float ss = 0.f;
#pragma unroll
          for (int e = 0; e < 8; ++e) ss += v[e] * v[e];
          ss += __shfl_xor(ss, 1); ss += __shfl_xor(ss, 2); ss += __shfl_xor(ss, 4);
          const float rs = rsqrtf(ss + EPS) * (typ == 0 ? 0.125f : 1.f);
          if (lat) {
            const int pos = cg < 4 ? cs : rr;
            const float* rp = p.ROPE + (pos * 16 + 8 * (cg & 1)) * 2;
            const float4 q0 = *(const float4*)rp, q1 = *(const float4*)(rp + 4), q2 = *(const float4*)(rp + 8), q3 = *(const float4*)(rp + 12);
            const float cs8[8] = {q0.x, q0.z, q1.x, q1.z, q2.x, q2.z, q3.x, q3.z}, sn8[8] = {q0.y, q0.w, q1.y, q1.w, q2.y, q2.w, q3.y, q3.w};
#pragma unroll
            for (int e = 0; e < 8; ++e) {
              const float vp = __shfl_xor(v[e], 2);
              v[e] = v[e] * cs8[e] + ((cg & 2) ? vp : -vp) * sn8[e];
            }
          }
#pragma unroll
          for (int e = 0; e < 8; ++e) v[e] *= rs;
        }
        uint4 o; o.x = pack2(v[0], v[1]); o.y = pack2(v[2], v[3]); o.z = pack2(v[4], v[5]); o.w = pack2(v[6], v[7]);
        *(uint4*)(p.U + (size_t)(r0 + rr) * UW + ucol) = o;
      }
    }
#undef PREP_LOAD
  }
}

constexpr int XS = 72;
constexpr int BS2 = 136;
constexpr int SSD_LDS = (3 * 64 * XS + 3 * 64 * BS2) * 2 + 2 * 64 * 4;
__device__ __forceinline__ void phase_ssd(const Params& p, int layer, int task, char* smem) {
  const int tid = tidx(), lane = tid & 63, wave = tid >> 6, g = lane >> 4, l15 = lane & 15, q4 = l15 >> 2, p4 = lane & 3;
  bf16_t* Xt = (bf16_t*)smem;
  bf16_t* Xs = Xt + 64 * XS;
  bf16_t* Wg = Xs + 64 * XS;
  bf16_t* Bt = Wg + 64 * XS;
  bf16_t* Ct = Bt + 64 * BS2;
  bf16_t* Hb = Ct + 64 * BS2;
  float* dts = (float*)(Hb + 64 * BS2);
  float* lam = dts + 64;
  {
    const int head = task & 15, b = task >> 4, grp = head >> 3;
    f32x4 hst[2][8];
#pragma unroll
    for (int d = 0; d < 2; ++d)
#pragma unroll
      for (int n = 0; n < 8; ++n) hst[d][n] = (f32x4){0.f, 0.f, 0.f, 0.f};
    const float dsk = p.ssd_d[layer * 16 + head];
    const float an0 = -__expf(p.ssd_a_log[layer * 32 + head]), an1 = -__expf(p.ssd_a_log[layer * 32 + 16 + head]);
    uint4 px0, px1, pb0, pb1, pb2, pb3, pc0, pc1, pc2, pc3; float pdt = 0.f;
#define SSD_PREFETCH(IT, DIR) { \
      const int seg_ = (IT) >= 4, ci_ = seg_ ? (IT) - 4 : (IT), nch_ = seg_ ? 32 : 4; \
      const int base_ = seg_ ? b * 2048 : TL + b * 256; \
      const int c_ = (DIR) ? nch_ - 1 - ci_ : ci_; \
      const int i_ = tid >> 2, sub_ = tid & 3; \
      const int row_ = base_ + 64 * c_ + ((DIR) ? 63 - i_ : i_); \
      const bf16_t* ur_ = p.U + (size_t)row_ * UW; \
      const uint4* sx_ = (const uint4*)(ur_ + U_SX + 64 * head + 16 * sub_); px0 = sx_[0]; px1 = sx_[1]; \
      const uint4* sb_ = (const uint4*)(ur_ + U_SB + 128 * grp + 32 * sub_); pb0 = sb_[0]; pb1 = sb_[1]; pb2 = sb_[2]; pb3 = sb_[3]; \
      if (seg_ == 1 || layer == 0) { const uint4* sc_ = (const uint4*)(ur_ + U_SC + 128 * grp + 32 * sub_); pc0 = sc_[0]; pc1 = sc_[1]; pc2 = sc_[2]; pc3 = sc_[3]; } \
      if (sub_ == 0) pdt = p.S[(size_t)row_ * SWD + 32 + (DIR) * 16 + head]; }
    SSD_PREFETCH(0, 0)
    for (int it = 0; it < 36; ++it) {
      const int seg = it >= 4, ci = seg ? it - 4 : it, nch = seg ? 32 : 4;
      const int base = seg ? b * 2048 : TL + b * 256;
      const bool want_o = seg == 1 || layer == 0;
      const bool first = ci < nch / 2;
#pragma unroll
      for (int dir = 0; dir < 2; ++dir) {
        const int c = dir ? nch - 1 - ci : ci;
        const int r0 = base + 64 * c;
        __syncthreads();
        {
          const int i = tid >> 2, sub = tid & 3;
          *(uint4*)(Xt + i * XS + 16 * sub) = px0; *(uint4*)(Xt + i * XS + 16 * sub + 8) = px1;
          *(uint4*)(Bt + i * BS2 + 32 * sub) = pb0; *(uint4*)(Bt + i * BS2 + 32 * sub + 8) = pb1; *(uint4*)(Bt + i * BS2 + 32 * sub + 16) = pb2; *(uint4*)(Bt + i * BS2 + 32 * sub + 24) = pb3;
          if (want_o) { *(uint4*)(Ct + i * BS2 + 32 * sub) = pc0; *(uint4*)(Ct + i * BS2 + 32 * sub + 8) = pc1; *(uint4*)(Ct + i * BS2 + 32 * sub + 16) = pc2; *(uint4*)(Ct + i * BS2 + 32 * sub + 24) = pc3; }
          if (sub == 0) dts[i] = pdt;
        }
        if (dir == 0) SSD_PREFETCH(it, 1) else if (it + 1 < 36) SSD_PREFETCH(it + 1, 0)
        unsigned long long oldp[4] = {0ull, 0ull, 0ull, 0ull};
        if (want_o && !first) {
          const int irow_ = 16 * wave + l15;
          const int prow_ = r0 + (dir ? 63 - irow_ : irow_);
#pragma unroll
          for (int pt = 0; pt < 4; ++pt) oldp[pt] = __hip_atomic_load((unsigned long long*)(p.P + (size_t)prow_ * 1024 + 64 * head + 16 * pt + 4 * g), __ATOMIC_RELAXED, __HIP_MEMORY_SCOPE_AGENT);
        }
        if (want_o) {
#pragma unroll
          for (int nt = 0; nt < 8; ++nt) {
            uint2 o; o.x = pack2(hst[dir][nt][0], hst[dir][nt][1]); o.y = pack2(hst[dir][nt][2], hst[dir][nt][3]);
            *(uint2*)(Hb + (16 * wave + l15) * BS2 + 16 * nt + 4 * g) = o;
          }
        }
        __syncthreads();
        float lv = dts[lane] * (dir ? an1 : an0);
#pragma unroll
        for (int o = 1; o < 64; o <<= 1) { const float tv = __shfl_up(lv, o); if (lane >= o) lv += tv; }
        const float lam_last = __shfl(lv, 63);
        if (wave == 0) lam[lane] = lv;
        {
          const int j = tid >> 2, sub = tid & 3;
          const float lj = __shfl(lv, j & 63);
          const float sc = dts[j] * __expf(lam_last - lj);
          const uint4 a = *(const uint4*)(Xt + j * XS + 16 * sub), bq = *(const uint4*)(Xt + j * XS + 16 * sub + 8);
          uint4 oa, ob;
          oa.x = pack2(bflo(a.x) * sc, bfhi(a.x) * sc); oa.y = pack2(bflo(a.y) * sc, bfhi(a.y) * sc); oa.z = pack2(bflo(a.z) * sc, bfhi(a.z) * sc); oa.w = pack2(bflo(a.w) * sc, bfhi(a.w) * sc);
          ob.x = pack2(bflo(bq.x) * sc, bfhi(bq.x) * sc); ob.y = pack2(bflo(bq.y) * sc, bfhi(bq.y) * sc); ob.z = pack2(bflo(bq.z) * sc, bfhi(bq.z) * sc); ob.w = pack2(bflo(bq.w) * sc, bfhi(bq.w) * sc);
          *(uint4*)(Xs + j * XS + 16 * sub) = oa; *(uint4*)(Xs + j * XS + 16 * sub + 8) = ob;
        }
        __syncthreads();
        if (want_o) {
          const int irow = 16 * wave + l15;
          const float li = lam[irow];
#pragma unroll
          for (int jt = 0; jt < 4; ++jt) {
            f32x4 cacc = (f32x4){0.f, 0.f, 0.f, 0.f};
            if (jt <= wave) {
#pragma unroll
              for (int s2 = 0; s2 < 4; ++s2) {
                const bf16x8 af = *(const bf16x8*)(Ct + irow * BS2 + 32 * s2 + 8 * g);
                const bf16x8 bf = *(const bf16x8*)(Bt + (16 * jt + l15) * BS2 + 32 * s2 + 8 * g);
                cacc = __builtin_amdgcn_mfma_f32_16x16x32_bf16(bf, af, cacc, 0, 0, 0);
              }
            }
            const int j0 = 16 * jt + 4 * g;
            const float4 lj = *(const float4*)(lam + j0), dj = *(const float4*)(dts + j0);
            const float w0 = (j0 + 0 <= irow) ? cacc[0] * __expf(li - lj.x) * dj.x : 0.f;
            const float w1 = (j0 + 1 <= irow) ? cacc[1] * __expf(li - lj.y) * dj.y : 0.f;
            const float w2 = (j0 + 2 <= irow) ? cacc[2] * __expf(li - lj.z) * dj.z : 0.f;
            const float w3 = (j0 + 3 <= irow) ? cacc[3] * __expf(li - lj.w) * dj.w : 0.f;
            uint2 o; o.x = pack2(w0, w1); o.y = pack2(w2, w3);
            *(uint2*)(Wg + irow * XS + j0) = o;
          }
        }
        __syncthreads();
        if (want_o) {
          const int irow = 16 * wave + l15;
          f32x4 ai[4], ae[4];
#pragma unroll
          for (int pt = 0; pt < 4; ++pt) { ai[pt] = (f32x4){0.f, 0.f, 0.f, 0.f}; ae[pt] = (f32x4){0.f, 0.f, 0.f, 0.f}; }
#pragma unroll
          for (int s2 = 0; s2 < 2; ++s2) {
            const bf16x8 af = *(const bf16x8*)(Wg + irow * XS + 32 * s2 + 8 * g);
#pragma unroll
            for (int pt = 0; pt < 4; ++pt) {
              const bf16x8 bf = cat8(tr16(Xt + (32 * s2 + 8 * g + q4) * XS + 16 * pt + 4 * p4), tr16(Xt + (32 * s2 + 8 * g + 4 + q4) * XS + 16 * pt + 4 * p4));
              ai[pt] = __builtin_amdgcn_mfma_f32_16x16x32_bf16(bf, af, ai[pt], 0, 0, 0);
            }
          }
#pragma unroll
          for (int s2 = 0; s2 < 4; ++s2) {
            const bf16x8 af = *(const bf16x8*)(Ct + irow * BS2 + 32 * s2 + 8 * g);
#pragma unroll
            for (int pt = 0; pt < 4; ++pt) {
              const bf16x8 bf = *(const bf16x8*)(Hb + (16 * pt + l15) * BS2 + 32 * s2 + 8 * g);
              ae[pt] = __builtin_amdgcn_mfma_f32_16x16x32_bf16(bf, af, ae[pt], 0, 0, 0);
            }
          }
          const float el = __expf(lam[irow]);
          const int row = r0 + (dir ? 63 - irow : irow);
#pragma unroll
          for (int pt = 0; pt < 4; ++pt) {
            float y0 = ai[pt][0] + el * ae[pt][0], y1 = ai[pt][1] + el * ae[pt][1], y2 = ai[pt][2] + el * ae[pt][2], y3 = ai[pt][3] + el * ae[pt][3];
            if (dir == 0) {
              const uint2 xv = *(const uint2*)(Xt + irow * XS + 16 * pt + 4 * g);
              y0 += dsk * bflo(xv.x); y1 += dsk * bfhi(xv.x); y2 += dsk * bflo(xv.y); y3 += dsk * bfhi(xv.y);
            }
            unsigned long long* dst = (unsigned long long*)(p.P + (size_t)row * 1024 + 64 * head + 16 * pt + 4 * g);
            if (!first) {
              const unsigned long long old = oldp[pt];
              const unsigned lo = (unsigned)old, hi = (unsigned)(old >> 32);
              y0 += bflo(lo); y1 += bfhi(lo); y2 += bflo(hi); y3 += bfhi(hi);
            }
            *dst = (unsigned long long)pack2(y0, y1) | ((unsigned long long)pack2(y2, y3) << 32);
          }
        }
        {
          const float el = __expf(lam_last);
#pragma unroll
          for (int nt = 0; nt < 8; ++nt) hst[dir][nt] *= el;
#pragma unroll
          for (int s2 = 0; s2 < 2; ++s2) {
            const bf16x8 mf = cat8(tr16(Xs + (32 * s2 + 8 * g + q4) * XS + 16 * wave + 4 * p4), tr16(Xs + (32 * s2 + 8 * g + 4 + q4) * XS + 16 * wave + 4 * p4));
#pragma unroll
            for (int nt = 0; nt < 8; ++nt) {
              const bf16x8 nf = cat8(tr16(Bt + (32 * s2 + 8 * g + q4) * BS2 + 16 * nt + 4 * p4), tr16(Bt + (32 * s2 + 8 * g + 4 + q4) * BS2 + 16 * nt + 4 * p4));
              hst[dir][nt] = __builtin_amdgcn_mfma_f32_16x16x32_bf16(nf, mf, hst[dir][nt], 0, 0, 0);
            }
          }
        }
      }
    }
  }
}


#undef SSD_PREFETCH
constexpr int GT = 64 * XS;
constexpr int GDN_LDS = 8 * GT * 2 + 4 * 256 * 4 + 4 * 16 * 24 * 2 + 2 * 64 * 4;
__device__ __forceinline__ void phase_gdn(const Params& p, int layer, int task, char* smem) {
  const int tid = tidx(), lane = tid & 63, wave = tid >> 6, g = lane >> 4, l15 = lane & 15, q4 = l15 >> 2, p4 = lane & 3;
  bf16_t* Qt = (bf16_t*)smem;
  bf16_t* Kt = Qt + GT;
  bf16_t* Vt = Kt + GT;
  bf16_t* Am = Vt + GT;
  bf16_t* Mq = Am + GT;
  bf16_t* Xw = Mq + GT;
  bf16_t* Xu = Xw + GT;
  bf16_t* St = Xu + GT;
  bf16_t* Qg = Qt; bf16_t* Vn = Vt; bf16_t* Vs = Am;
  float* Adiag = (float*)(St + GT);
  bf16_t* Db = (bf16_t*)(Adiag + 4 * 256);
  float* bet = (float*)(Db + 4 * 16 * 24);
  float* gam = bet + 64;
  const bf16x8 zero8 = (bf16x8){0, 0, 0, 0, 0, 0, 0, 0};
  {
    const int dir = task & 1, h = (task >> 1) & 7, b = task >> 4;
    bf16_t* Og = layer == 0 ? p.OG0 + (size_t)dir * TT * 512 : p.OG1 + (size_t)dir * TL * 512;
    f32x4 sst[4];
#pragma unroll
    for (int e = 0; e < 4; ++e) sst[e] = (f32x4){0.f, 0.f, 0.f, 0.f};
    __syncthreads();
    for (int i = tid; i < 64 * XS / 2; i += 256) { ((unsigned*)St)[i] = 0u; ((unsigned*)Xw)[i] = 0u; ((unsigned*)Xu)[i] = 0u; }
    uint4 pq0, pq1, pk0, pk1, pv0, pv1; float pbeta = 0.f, pgam = 0.f;
#define GDN_PREFETCH(IT) { \
      const int seg_ = (IT) >= 4, ci_ = seg_ ? (IT) - 4 : (IT), nch_ = seg_ ? 32 : 4; \
      const int base_ = seg_ ? b * 2048 : TL + b * 256; \
      const int c_ = dir ? nch_ - 1 - ci_ : ci_; \
      const int i_ = tid >> 2, sub_ = tid & 3; \
      const int row_ = base_ + 64 * c_ + (dir ? 63 - i_ : i_); \
      const bf16_t* ur_ = p.U + (size_t)row_ * UW + 64 * h + 16 * sub_; \
      pq0 = *(const uint4*)(ur_ + U_DNQ); pq1 = *(const uint4*)(ur_ + U_DNQ + 8); \
      pk0 = *(const uint4*)(ur_ + U_DNK); pk1 = *(const uint4*)(ur_ + U_DNK + 8); \
      pv0 = *(const uint4*)(ur_ + U_DNV); pv1 = *(const uint4*)(ur_ + U_DNV + 8); \
      if (sub_ == 0) { pbeta = p.S[(size_t)row_ * SWD + dir * 8 + h]; pgam = p.S[(size_t)row_ * SWD + 16 + dir * 8 + h]; } }
    GDN_PREFETCH(0)
    for (int it = 0; it < 36; ++it) {
      const int seg = it >= 4, ci = seg ? it - 4 : it, nch = seg ? 32 : 4;
      const int base = seg ? b * 2048 : TL + b * 256;
      const bool want_o = seg == 1 || layer == 0;
      const int c = dir ? nch - 1 - ci : ci;
      const int r0 = base + 64 * c;
      __syncthreads();
      {
        const int i = tid >> 2, sub = tid & 3;
        *(uint4*)(Qt + i * XS + 16 * sub) = pq0; *(uint4*)(Qt + i * XS + 16 * sub + 8) = pq1;
        *(uint4*)(Kt + i * XS + 16 * sub) = pk0; *(uint4*)(Kt + i * XS + 16 * sub + 8) = pk1;
        *(uint4*)(Vt + i * XS + 16 * sub) = pv0; *(uint4*)(Vt + i * XS + 16 * sub + 8) = pv1;
        if (sub == 0) { bet[i] = pbeta; gam[i] = pgam; }
      }
      if (it + 1 < 36) GDN_PREFETCH(it + 1)
      __syncthreads();
      float lv = gam[lane];
#pragma unroll
      for (int o = 1; o < 64; o <<= 1) { const float tv = __shfl_up(lv, o); if (lane >= o) lv += tv; }
      const float gam_last = __shfl(lv, 63);
      __syncthreads();
      if (wave == 0) gam[lane] = lv;
      __syncthreads();
      {
        const int irow = 16 * wave + l15;
        const float gi = gam[irow], bi = bet[irow];
#pragma unroll
        for (int jt = 0; jt < 4; ++jt) {
          f32x4 kk = (f32x4){0.f, 0.f, 0.f, 0.f}, qk = (f32x4){0.f, 0.f, 0.f, 0.f};
          if (jt <= wave) {
#pragma unroll
            for (int s2 = 0; s2 < 2; ++s2) {
              const bf16x8 nf = *(const bf16x8*)(Kt + (16 * jt + l15) * XS + 32 * s2 + 8 * g);
              const bf16x8 mk = *(const bf16x8*)(Kt + irow * XS + 32 * s2 + 8 * g);
              const bf16x8 mq = *(const bf16x8*)(Qt + irow * XS + 32 * s2 + 8 * g);
              kk = __builtin_amdgcn_mfma_f32_16x16x32_bf16(nf, mk, kk, 0, 0, 0);
              qk = __builtin_amdgcn_mfma_f32_16x16x32_bf16(nf, mq, qk, 0, 0, 0);
            }
          }
          const int j0 = 16 * jt + 4 * g;
          const float4 gj = *(const float4*)(gam + j0);
          const float gjv[4] = {gj.x, gj.y, gj.z, gj.w};
          float av[4], mv[4];
#pragma unroll
          for (int r = 0; r < 4; ++r) {
            const int j = j0 + r;
            const float dec = j <= irow ? __expf(gi - gjv[r]) : 0.f;
            av[r] = j < irow ? bi * kk[r] * dec : 0.f;
            mv[r] = qk[r] * dec;
          }
          uint2 oa; oa.x = pack2(av[0], av[1]); oa.y = pack2(av[2], av[3]);
          uint2 om; om.x = pack2(mv[0], mv[1]); om.y = pack2(mv[2], mv[3]);
          *(uint2*)(Am + irow * XS + j0) = oa;
          *(uint2*)(Mq + irow * XS + j0) = om;
          if (jt == wave) *(f32x4*)(Adiag + wave * 256 + l15 * 16 + 4 * g) = (f32x4){av[0], av[1], av[2], av[3]};
        }
      }
      __syncthreads();
      {
        const int j = tid >> 2, sub = tid & 3;
        const float sc = __expf(gam[j]);
        const uint4 a = *(const uint4*)(Qt + j * XS + 16 * sub), bq = *(const uint4*)(Qt + j * XS + 16 * sub + 8);
        uint4 oa, ob;
        oa.x = pack2(bflo(a.x) * sc, bfhi(a.x) * sc); oa.y = pack2(bflo(a.y) * sc, bfhi(a.y) * sc); oa.z = pack2(bflo(a.z) * sc, bfhi(a.z) * sc); oa.w = pack2(bflo(a.w) * sc, bfhi(a.w) * sc);
        ob.x = pack2(bflo(bq.x) * sc, bfhi(bq.x) * sc); ob.y = pack2(bflo(bq.y) * sc, bfhi(bq.y) * sc); ob.z = pack2(bflo(bq.z) * sc, bfhi(bq.z) * sc); ob.w = pack2(bflo(bq.w) * sc, bfhi(bq.w) * sc);
        *(uint4*)(Qg + j * XS + 16 * sub) = oa; *(uint4*)(Qg + j * XS + 16 * sub + 8) = ob;
      }
      {
        const int cc = lane & 15;
        const float* Ad = Adiag + wave * 256;
        float dcol[16];
#pragma unroll
        for (int r = 0; r < 16; ++r) {
          float sacc = (r == cc) ? 1.f : 0.f;
#pragma unroll
          for (int j = 0; j < r; ++j) sacc -= Ad[r * 16 + j] * dcol[j];
          dcol[r] = sacc;
        }
        if (lane < 16) {
#pragma unroll
          for (int r = 0; r < 16; ++r) Db[(wave * 16 + r) * 24 + cc] = f2bf(dcol[r]);
        }
      }
      __syncthreads();
      {
        const bool isW = wave < 2;
        bf16_t* Xd = isW ? Xw : Xu;
        const bf16_t* Src = isW ? Kt : Vt;
        const int fbase = (wave & 1) * 32;
#pragma unroll
        for (int ib = 0; ib < 4; ++ib) {
          const int irow = 16 * ib + l15;
          const float sc = isW ? bet[irow] * __expf(gam[irow]) : bet[irow];
          f32x4 y[2];
#pragma unroll
          for (int fi = 0; fi < 2; ++fi) {
            const int f0 = fbase + 16 * fi;
            const uint2 rv = *(const uint2*)(Src + irow * XS + f0 + 4 * g);
            f32x4 tmp = (f32x4){0.f, 0.f, 0.f, 0.f};
#pragma unroll
            for (int s2 = 0; s2 < 2; ++s2) {
              if (32 * s2 < 16 * ib) {
                const bool half = (32 * s2 + 32) > 16 * ib;
                bf16x8 mf = *(const bf16x8*)(Am + irow * XS + 32 * s2 + 8 * g);
                if (half && g >= 2) mf = zero8;
                const bf16x8 nf = cat8(tr16(Xd + (32 * s2 + 8 * g + q4) * XS + f0 + 4 * p4), tr16(Xd + (32 * s2 + 8 * g + 4 + q4) * XS + f0 + 4 * p4));
                tmp = __builtin_amdgcn_mfma_f32_16x16x32_bf16(nf, mf, tmp, 0, 0, 0);
              }
            }
            y[fi] = (f32x4){bflo(rv.x) * sc - tmp[0], bfhi(rv.x) * sc - tmp[1], bflo(rv.y) * sc - tmp[2], bfhi(rv.y) * sc - tmp[3]};
          }
          __syncthreads();
#pragma unroll
          for (int fi = 0; fi < 2; ++fi) {
            uint2 o; o.x = pack2(y[fi][0], y[fi][1]); o.y = pack2(y[fi][2], y[fi][3]);
            *(uint2*)(Xd + irow * XS + fbase + 16 * fi + 4 * g) = o;
          }
          __syncthreads();
          bf16x8 dm = zero8;
          if (g < 2) dm = *(const bf16x8*)(Db + (ib * 16 + l15) * 24 + 8 * g);
#pragma unroll
          for (int fi = 0; fi < 2; ++fi) {
            const int f0 = fbase + 16 * fi;
            const bf16x8 nf = cat8(tr16(Xd + (16 * ib + 8 * (g & 1) + q4) * XS + f0 + 4 * p4), tr16(Xd + (16 * ib + 8 * (g & 1) + 4 + q4) * XS + f0 + 4 * p4));
            y[fi] = __builtin_amdgcn_mfma_f32_16x16x32_bf16(nf, dm, (f32x4){0.f, 0.f, 0.f, 0.f}, 0, 0, 0);
          }
          __syncthreads();
#pragma unroll
          for (int fi = 0; fi < 2; ++fi) {
            uint2 o; o.x = pack2(y[fi][0], y[fi][1]); o.y = pack2(y[fi][2], y[fi][3]);
            *(uint2*)(Xd + irow * XS + fbase + 16 * fi + 4 * g) = o;
          }
          __syncthreads();
        }
      }
      {
        const int irow = 16 * wave + l15;
        const float dl = __expf(gam_last - gam[irow]);
        f32x4 acc[4];
#pragma unroll
        for (int et = 0; et < 4; ++et) acc[et] = (f32x4){0.f, 0.f, 0.f, 0.f};
#pragma unroll
        for (int s2 = 0; s2 < 2; ++s2) {
          const bf16x8 mf = *(const bf16x8*)(Xw + irow * XS + 32 * s2 + 8 * g);
#pragma unroll
          for (int et = 0; et < 4; ++et) {
            const bf16x8 nf = *(const bf16x8*)(St + (16 * et + l15) * XS + 32 * s2 + 8 * g);
            acc[et] = __builtin_amdgcn_mfma_f32_16x16x32_bf16(nf, mf, acc[et], 0, 0, 0);
          }
        }
#pragma unroll
        for (int et = 0; et < 4; ++et) {
          const uint2 uv = *(const uint2*)(Xu + irow * XS + 16 * et + 4 * g);
          const float v0 = bflo(uv.x) - acc[et][0], v1 = bfhi(uv.x) - acc[et][1], v2 = bflo(uv.y) - acc[et][2], v3 = bfhi(uv.y) - acc[et][3];
          uint2 o; o.x = pack2(v0, v1); o.y = pack2(v2, v3);
          *(uint2*)(Vn + irow * XS + 16 * et + 4 * g) = o;
          o.x = pack2(v0 * dl, v1 * dl); o.y = pack2(v2 * dl, v3 * dl);
          *(uint2*)(Vs + irow * XS + 16 * et + 4 * g) = o;
        }
      }
      __syncthreads();
      if (want_o) {
        const int irow = 16 * wave + l15;
        f32x4 acc[4];
#pragma unroll
        for (int et = 0; et < 4; ++et) acc[et] = (f32x4){0.f, 0.f, 0.f, 0.f};
#pragma unroll
        for (int s2 = 0; s2 < 2; ++s2) {
          const bf16x8 mf = *(const bf16x8*)(Qg + irow * XS + 32 * s2 + 8 * g);
          const bf16x8 mf2 = *(const bf16x8*)(Mq + irow * XS + 32 * s2 + 8 * g);
#pragma unroll
          for (int et = 0; et < 4; ++et) {
            const bf16x8 nf = *(const bf16x8*)(St + (16 * et + l15) * XS + 32 * s2 + 8 * g);
            acc[et] = __builtin_amdgcn_mfma_f32_16x16x32_bf16(nf, mf, acc[et], 0, 0, 0);
            const bf16x8 nf2 = cat8(tr16(Vn + (32 * s2 + 8 * g + q4) * XS + 16 * et + 4 * p4), tr16(Vn + (32 * s2 + 8 * g + 4 + q4) * XS + 16 * et + 4 * p4));
            acc[et] = __builtin_amdgcn_mfma_f32_16x16x32_bf16(nf2, mf2, acc[et], 0, 0, 0);
          }
        }
        const int row = r0 + (dir ? 63 - irow : irow);
#pragma unroll
        for (int et = 0; et < 4; ++et) {
          uint2 o; o.x = pack2(acc[et][0], acc[et][1]); o.y = pack2(acc[et][2], acc[et][3]);
          *(uint2*)(Og + (size_t)row * 512 + 64 * h + 16 * et + 4 * g) = o;
        }
      }
      {
        const float el = __expf(gam_last);
#pragma unroll
        for (int et = 0; et < 4; ++et) sst[et] *= el;
#pragma unroll
        for (int s2 = 0; s2 < 2; ++s2) {
          const bf16x8 nf = cat8(tr16(Kt + (32 * s2 + 8 * g + q4) * XS + 16 * wave + 4 * p4), tr16(Kt + (32 * s2 + 8 * g + 4 + q4) * XS + 16 * wave + 4 * p4));
#pragma unroll
          for (int et = 0; et < 4; ++et) {
            const bf16x8 mf = cat8(tr16(Vs + (32 * s2 + 8 * g + q4) * XS + 16 * et + 4 * p4), tr16(Vs + (32 * s2 + 8 * g + 4 + q4) * XS + 16 * et + 4 * p4));
            sst[et] = __builtin_amdgcn_mfma_f32_16x16x32_bf16(nf, mf, sst[et], 0, 0, 0);
          }
        }
      }
      __syncthreads();
#pragma unroll
      for (int et = 0; et < 4; ++et) {
        uint2 o; o.x = pack2(sst[et][0], sst[et][1]); o.y = pack2(sst[et][2], sst[et][3]);
        *(uint2*)(St + (16 * et + l15) * XS + 16 * wave + 4 * g) = o;
      }
    }
  }
}


#undef GDN_PREFETCH
constexpr int NA_VS = 72;
constexpr int NA_LDS_WAVE = 2 * 32 * NA_VS * 2;
__device__ __forceinline__ void phase_na(const Params& p, int layer, unsigned* ctr, char* smem) {
  const int lane = tidx() & 63, wave = tidx() >> 6, g = lane >> 4, l15 = lane & 15, q4 = l15 >> 2, p4 = lane & 3;
  bf16_t* Vl = (bf16_t*)(smem + wave * NA_LDS_WAVE);
  const int ntask = layer == 0 ? 8192 + 1024 : 8192;
  const float* rpb = p.na_rpb + (size_t)layer * 8 * 15 * 31;
  for (;;) {
    int w0 = 0;
    if (lane == 0) w0 = (int)atomicAdd(ctr, 1u);
    const int task = __builtin_amdgcn_readfirstlane(__shfl(w0, 0));
    if (task >= ntask) break;
    const bool lat = task < 8192;
    int b, h, r = 0, cb = 0, qtok0, R0 = 0, C0 = 0;
    if (lat) { cb = task & 3; r = (task >> 2) & 31; h = (task >> 7) & 7; b = task >> 10; qtok0 = b * 2048 + r * 64 + 16 * cb; R0 = min(max(r - 4, 0), 24); C0 = min(max(16 * cb - 8, 0), 32); }
    else { const int t2 = task - 8192; const int qb = t2 & 15; h = (t2 >> 4) & 7; b = t2 >> 7; qtok0 = TL + b * 256 + 16 * qb; }
    const int tau0 = lat ? 0 : 16;
    const int wtok0 = b * 2048 + R0 * 64 + C0, ctok0 = TL + b * 256;
#define tile_tok(tau) ((tau) < 16 ? wtok0 + ((tau) >> 1) * 64 + 16 * ((tau) & 1) : ctok0 + 16 * ((tau) - 16))
    const bf16_t* qp = p.U + (size_t)(qtok0 + l15) * UW + U_NAQ + 64 * h + 8 * g;
    const bf16x8 qf0 = *(const bf16x8*)qp, qf1 = *(const bf16x8*)(qp + 32);
    f32x4 sc[32];
#pragma unroll
    for (int tau = 0; tau < 32; ++tau) {
      sc[tau] = (f32x4){-INFINITY, -INFINITY, -INFINITY, -INFINITY};
      if (tau >= tau0) {
        const bf16_t* kp = p.U + (size_t)(tile_tok(tau) + l15) * UW + U_NAK + 64 * h + 8 * g;
        const bf16x8 kf0 = *(const bf16x8*)kp, kf1 = *(const bf16x8*)(kp + 32);
        f32x4 a = (f32x4){0.f, 0.f, 0.f, 0.f};
        a = __builtin_amdgcn_mfma_f32_16x16x32_bf16(kf0, qf0, a, 0, 0, 0);
        a = __builtin_amdgcn_mfma_f32_16x16x32_bf16(kf1, qf1, a, 0, 0, 0);
        if (tau < 16) {
          const int qcol = 16 * cb + l15, ws = min(max(qcol - 8, 0), 48);
          const int dr = R0 + (tau >> 1) - r + 7;
#pragma unroll
          for (int rg = 0; rg < 4; ++rg) {
            const int kcol = C0 + 16 * (tau & 1) + 4 * g + rg;
            const bool ok = kcol >= ws && kcol < ws + 16;
            const float bias = ok ? rpb[(h * 15 + dr) * 31 + (kcol - qcol + 15)] : 0.f;
            a[rg] = ok ? a[rg] + bias : -INFINITY;
          }
        }
        sc[tau] = a;
      }
    }
    float mx = -INFINITY;
#pragma unroll
    for (int tau = 0; tau < 32; ++tau) mx = fmaxf(mx, fmaxf(fmaxf(sc[tau][0], sc[tau][1]), fmaxf(sc[tau][2], sc[tau][3])));
    mx = fmaxf(mx, __shfl_xor(mx, 16)); mx = fmaxf(mx, __shfl_xor(mx, 32));
    float sum = 0.f;
#pragma unroll
    for (int tau = 0; tau < 32; ++tau) {
#pragma unroll
      for (int rg = 0; rg < 4; ++rg) { const float e = __expf(sc[tau][rg] - mx); sc[tau][rg] = e; sum += e; }
    }
    sum += __shfl_xor(sum, 16); sum += __shfl_xor(sum, 32);
    f32x4 oacc[4];
#pragma unroll
    for (int dt = 0; dt < 4; ++dt) oacc[dt] = (f32x4){0.f, 0.f, 0.f, 0.f};
    const int kap0 = tau0 >> 1;
    uint4 vr0, vr1, vr2, vr3;
#define NA_VLOAD(KAP) { \
      const int kk0_ = lane >> 3, cc_ = lane & 7; \
      const bf16_t* vb_ = p.U + U_NAV + 64 * h + 8 * cc_; \
      vr0 = *(const uint4*)(vb_ + (size_t)(tile_tok(2 * (KAP)) + kk0_) * UW); \
      vr1 = *(const uint4*)(vb_ + (size_t)(tile_tok(2 * (KAP)) + kk0_ + 8) * UW); \
      vr2 = *(const uint4*)(vb_ + (size_t)(tile_tok(2 * (KAP) + 1) + kk0_) * UW); \
      vr3 = *(const uint4*)(vb_ + (size_t)(tile_tok(2 * (KAP) + 1) + kk0_ + 8) * UW); }
    NA_VLOAD(kap0)
#pragma unroll
    for (int kap = 0; kap < 16; ++kap) {
      if (kap >= kap0) {
        bf16_t* Vb = Vl + (kap & 1) * 32 * NA_VS;
        {
          const int kk0_ = lane >> 3, cc_ = lane & 7;
          *(uint4*)(Vb + kk0_ * NA_VS + 8 * cc_) = vr0; *(uint4*)(Vb + (kk0_ + 8) * NA_VS + 8 * cc_) = vr1;
          *(uint4*)(Vb + (kk0_ + 16) * NA_VS + 8 * cc_) = vr2; *(uint4*)(Vb + (kk0_ + 24) * NA_VS + 8 * cc_) = vr3;
        }
        if (kap + 1 < 16) NA_VLOAD(kap + 1)
        __builtin_amdgcn_fence(__ATOMIC_RELEASE, "workgroup"); __builtin_amdgcn_wave_barrier(); __builtin_amdgcn_fence(__ATOMIC_ACQUIRE, "workgroup");
        bf16x8 pf;
        {
          const unsigned w0_ = pack2(sc[2 * kap][0], sc[2 * kap][1]), w1_ = pack2(sc[2 * kap][2], sc[2 * kap][3]);
          const unsigned w2_ = pack2(sc[2 * kap + 1][0], sc[2 * kap + 1][1]), w3_ = pack2(sc[2 * kap + 1][2], sc[2 * kap + 1][3]);
          pf = (bf16x8){(short)(w0_ & 0xffff), (short)(w0_ >> 16), (short)(w1_ & 0xffff), (short)(w1_ >> 16), (short)(w2_ & 0xffff), (short)(w2_ >> 16), (short)(w3_ & 0xffff), (short)(w3_ >> 16)};
        }
#pragma unroll
        for (int dt = 0; dt < 4; ++dt) {
          const bf16x8 vf = cat8(tr16(Vb + (4 * g + q4) * NA_VS + 16 * dt + 4 * p4), tr16(Vb + (16 + 4 * g + q4) * NA_VS + 16 * dt + 4 * p4));
          oacc[dt] = __builtin_amdgcn_mfma_f32_16x16x32_bf16(vf, pf, oacc[dt], 0, 0, 0);
        }
      }
    }
#undef NA_VLOAD
#undef tile_tok
    const float inv = 1.f / sum;
    bf16_t* op = p.U + (size_t)(qtok0 + l15) * UW + U_YA + 64 * h + 4 * g;
#pragma unroll
    for (int dt = 0; dt < 4; ++dt) {
      uint2 o; o.x = pack2(oacc[dt][0] * inv, oacc[dt][1] * inv); o.y = pack2(oacc[dt][2] * inv, oacc[dt][3] * inv);
      *(uint2*)(op + 16 * dt) = o;
    }
  }
}

__device__ __forceinline__ void norm_row(const float* xr, float rs, const float* alpha, const float* shift, bf16_t* hrow, int lane) {
#pragma unroll
  for (int i = 0; i < 4; ++i) {
    const int k = lane * 4 + 256 * i;
    const float4 v = *(const float4*)(xr + k), a = *(const float4*)(alpha + k), s = *(const float4*)(shift + k);
    uint2 o; o.x = pack2(v.x * rs * a.x + s.x, v.y * rs * a.y + s.y); o.y = pack2(v.z * rs * a.z + s.z, v.w * rs * a.w + s.w);
    *(uint2*)(hrow + k) = o;
  }
}
constexpr int TKW = 2;
__device__ __forceinline__ void phase_fin(const Params& p, int layer, int bid, int nb) {
  const int lane = tidx() & 63, wave = tidx() >> 6;
  const int ntok = layer == 0 ? TT : TL;
  const bf16_t* ogf = layer == 0 ? p.OG0 : p.OG1;
  const bf16_t* ogb = ogf + (size_t)(layer == 0 ? TT : TL) * 512;
  const float* gnd = p.dn_o_gain + layer * 64 + 8 * (lane & 7);
  const float* gns = p.ssd_o_gain + layer * 1024 + 16 * lane;
  const float* xlat = layer == 0 ? p.x : p.out;
  const float* xctx = layer == 0 ? p.ctx : p.XC;
  for (int tok0 = (bid * 4 + wave) * TKW; tok0 < ntok; tok0 += nb * 4 * TKW) {
    uint4 a[TKW], bq[TKW], zd[TKW], pa[TKW][2], zs[TKW][2];
#pragma unroll
    for (int j = 0; j < TKW; ++j) {
      const int tok = tok0 + j;
      const bf16_t* ur = p.U + (size_t)tok * UW;
      a[j] = *(const uint4*)(ogf + (size_t)tok * 512 + 8 * lane); bq[j] = *(const uint4*)(ogb + (size_t)tok * 512 + 8 * lane); zd[j] = *(const uint4*)(ur + U_DNZ + 8 * lane);
      pa[j][0] = *(const uint4*)(p.P + (size_t)tok * 1024 + 16 * lane); pa[j][1] = *(const uint4*)(p.P + (size_t)tok * 1024 + 16 * lane + 8);
      zs[j][0] = *(const uint4*)(ur + U_SZ + 16 * lane); zs[j][1] = *(const uint4*)(ur + U_SZ + 16 * lane + 8);
    }
#pragma unroll
    for (int j = 0; j < TKW; ++j) {
      bf16_t* ur = p.U + (size_t)(tok0 + j) * UW;
      {
        float o[8] = {bflo(a[j].x) + bflo(bq[j].x), bfhi(a[j].x) + bfhi(bq[j].x), bflo(a[j].y) + bflo(bq[j].y), bfhi(a[j].y) + bfhi(bq[j].y),
                      bflo(a[j].z) + bflo(bq[j].z), bfhi(a[j].z) + bfhi(bq[j].z), bflo(a[j].w) + bflo(bq[j].w), bfhi(a[j].w) + bfhi(bq[j].w)};
        const float zz[8] = {bflo(zd[j].x), bfhi(zd[j].x), bflo(zd[j].y), bfhi(zd[j].y), bflo(zd[j].z), bfhi(zd[j].z), bflo(zd[j].w), bfhi(zd[j].w)};
        float ss = 0.f;
#pragma unroll
        for (int i = 0; i < 8; ++i) ss += o[i] * o[i];
        ss += __shfl_xor(ss, 1); ss += __shfl_xor(ss, 2); ss += __shfl_xor(ss, 4);
        const float rs = rsqrtf(ss * (1.f / 64.f) + EPS);
#pragma unroll
        for (int i = 0; i < 8; ++i) o[i] = o[i] * rs * gnd[i] * siluf(zz[i]);
        uint4 w; w.x = pack2(o[0], o[1]); w.y = pack2(o[2], o[3]); w.z = pack2(o[4], o[5]); w.w = pack2(o[6], o[7]);
        *(uint4*)(ur + U_YB + 8 * lane) = w;
      }
      {
        float yv[16];
        float ss = 0.f;
#pragma unroll
        for (int hf = 0; hf < 2; ++hf) {
          const uint4 av4 = pa[j][hf], z = zs[j][hf];
          const float av[8] = {bflo(av4.x), bfhi(av4.x), bflo(av4.y), bfhi(av4.y), bflo(av4.z), bfhi(av4.z), bflo(av4.w), bfhi(av4.w)};
          const float zz[8] = {bflo(z.x), bfhi(z.x), bflo(z.y), bfhi(z.y), bflo(z.z), bfhi(z.z), bflo(z.w), bfhi(z.w)};
#pragma unroll
          for (int i = 0; i < 8; ++i) { const float v = av[i] * siluf(zz[i]); yv[8 * hf + i] = v; ss += v * v; }
        }
        ss += __shfl_xor(ss, 1); ss += __shfl_xor(ss, 2); ss += __shfl_xor(ss, 4); ss += __shfl_xor(ss, 8); ss += __shfl_xor(ss, 16);
        const float rs = rsqrtf(ss * (1.f / 512.f) + EPS);
#pragma unroll
        for (int hf = 0; hf < 2; ++hf) {
          uint4 w;
          w.x = pack2(yv[8 * hf + 0] * rs * gns[8 * hf + 0], yv[8 * hf + 1] * rs * gns[8 * hf + 1]);
          w.y = pack2(yv[8 * hf + 2] * rs * gns[8 * hf + 2], yv[8 * hf + 3] * rs * gns[8 * hf + 3]);
          w.z = pack2(yv[8 * hf + 4] * rs * gns[8 * hf + 4], yv[8 * hf + 5] * rs * gns[8 * hf + 5]);
          w.w = pack2(yv[8 * hf + 6] * rs * gns[8 * hf + 6], yv[8 * hf + 7] * rs * gns[8 * hf + 7]);
          *(uint4*)(ur + U_YC + 16 * lane + 8 * hf) = w;
        }
      }
    }
    {
      __builtin_amdgcn_s_waitcnt(0x0F70);
      const float* mr = p.MOD + (size_t)layer * 9 * 6144 + modrow(tok0) * 6144;
      float4 xv[TKW][4];
#pragma unroll
      for (int j = 0; j < TKW; ++j)
#pragma unroll
        for (int i = 0; i < 4; ++i) xv[j][i] = *(const float4*)((tok0 < TL ? xlat + (size_t)(tok0 + j) * DM : xctx + (size_t)(tok0 + j - TL) * DM) + lane * 4 + 256 * i);
      float rs[TKW];
#pragma unroll
      for (int j = 0; j < TKW; ++j) rs[j] = rsqrtf(p.SS[(size_t)(2 * layer) * TT + tok0 + j] * (1.f / DM) + EPS);
#pragma unroll
      for (int i = 0; i < 4; ++i) {
        const int k = lane * 4 + 256 * i;
        const float4 al = *(const float4*)(mr + 1024 + k), sh = *(const float4*)(mr + k);
#pragma unroll
        for (int j = 0; j < TKW; ++j) {
          uint2 o; o.x = pack2(xv[j][i].x * rs[j] * al.x + sh.x, xv[j][i].y * rs[j] * al.y + sh.y); o.y = pack2(xv[j][i].z * rs[j] * al.z + sh.z, xv[j][i].w * rs[j] * al.w + sh.w);
          *(uint2*)(p.P + (size_t)(tok0 + j) * 1024 + k) = o;
        }
      }
    }
  }
}

#define XB_TMO      128
#define XB_XCNT(j)  (256  + 64 * (j))
#define XB_XSUB(j)  (1280 + 64 * (j))
#define XB_XGEN(j)  (2304 + 64 * (j))
#define XB_TOP      3328
#define XB_TOPGEN   3392
#define XCD_BAR_WORDS 3456
#define XB_SPIN_CAP (1u << 20)
__device__ __forceinline__ unsigned xb_ld(unsigned* p)              { return __hip_atomic_load(p, __ATOMIC_RELAXED, __HIP_MEMORY_SCOPE_AGENT); }
__device__ __forceinline__ unsigned xb_add(unsigned* p, unsigned v) { return __hip_atomic_fetch_add(p, v, __ATOMIC_RELAXED, __HIP_MEMORY_SCOPE_AGENT); }
__device__ __forceinline__ unsigned xb_xcc_id() { return (unsigned)__builtin_amdgcn_s_getreg((3 << 11) | 20) & 0xFu; }
#define XB_SPIN(cond, bar) do { unsigned _sp = 0; while (cond) { __builtin_amdgcn_s_sleep(1); \
    if ((++_sp & 255u) == 0u) { if (xb_ld(&(bar)[XB_TMO])) break; if (_sp > XB_SPIN_CAP) { atomicAdd(&(bar)[XB_TMO], 1u); break; } } } } while (0)
struct XcdBarrier { unsigned* bar; unsigned x; volatile LDS_AS unsigned* st; };
__device__ __forceinline__ XcdBarrier xcd_barrier_post(unsigned* bar, volatile LDS_AS unsigned* st) {
  XcdBarrier b; b.bar = bar; b.x = xb_xcc_id(); b.st = st;
  if (threadIdx.x == 0) (void)xb_add(&bar[XB_XCNT(b.x)], 1u);
  return b;
}
__device__ __forceinline__ void xcd_barrier_complete(unsigned* bar, unsigned x, unsigned& nloc, unsigned& nx) {
  const unsigned G = gridDim.x * gridDim.y * gridDim.z;
  unsigned sum, cnt, mine, sp = 0u;
  for (;;) {
    sum = 0u; cnt = 0u; mine = 0u;
#pragma unroll
    for (unsigned j = 0; j < 16; ++j) { const unsigned c = xb_ld(&bar[XB_XCNT(j)]); sum += c; cnt += (c > 0u) ? 1u : 0u; mine = (j == x) ? c : mine; }
    if (sum == G) break;
    __builtin_amdgcn_s_sleep(1);
    if ((++sp & 255u) == 0u) { if (xb_ld(&bar[XB_TMO])) break; if (sp > XB_SPIN_CAP) { atomicAdd(&bar[XB_TMO], 1u); break; } }
  }
  nloc = mine > 0u ? mine : 1u; nx = cnt > 0u ? cnt : 1u;
}
__device__ __forceinline__ void xcd_barrier(const XcdBarrier& b) {
  asm volatile("s_waitcnt vmcnt(0)" ::: "memory");
  __syncthreads();
  if (threadIdx.x == 0) {
    unsigned* bar = b.bar;
    __builtin_amdgcn_s_waitcnt(0);
    unsigned nloc = b.st[0], nx = b.st[1];
    if (nloc == 0u) { xcd_barrier_complete(bar, b.x, nloc, nx); b.st[0] = nloc; b.st[1] = nx; }
    const unsigned old = xb_add(&bar[XB_XSUB(b.x)], 1u);
    const unsigned gen = old / nloc;
    if (old + 1u == (gen + 1u) * nloc) {
      __builtin_amdgcn_fence(__ATOMIC_RELEASE, "agent");
      asm volatile("s_waitcnt vmcnt(0)" ::: "memory");
      const unsigned og = xb_add(&bar[XB_TOP], 1u);
      const unsigned tg = og / nx;
      if (og + 1u == (tg + 1u) * nx) xb_add(&bar[XB_TOPGEN], 1u);
      else XB_SPIN(xb_ld(&bar[XB_TOPGEN]) == tg, bar);
      __builtin_amdgcn_fence(__ATOMIC_ACQUIRE, "agent");
      xb_add(&bar[XB_XGEN(b.x)], 1u);
      asm volatile("s_waitcnt vmcnt(0)" ::: "memory");
    } else {
      XB_SPIN(xb_ld(&bar[XB_XGEN(b.x)]) == gen, bar);
      __builtin_amdgcn_fence(__ATOMIC_ACQUIRE, "agent");
      asm volatile("s_waitcnt vmcnt(0)" ::: "memory");
    }
  }
  __syncthreads();
}

namespace cg = cooperative_groups;
constexpr int MEGA_LDS = GDN_LDS > SSD_LDS ? GDN_LDS : SSD_LDS;
static_assert(MEGA_LDS <= 81408 && GEMM_LDS_BYTES <= MEGA_LDS && 4 * NA_LDS_WAVE <= MEGA_LDS, "LDS budget");
__global__ void __launch_bounds__(256, 2) k_mega(Params p) {
  cg::grid_group grid = cg::this_grid();
  __shared__ __attribute__((aligned(16))) char smem[MEGA_LDS];
  const int bid = blockIdx.x, nb = gridDim.x;
  __shared__ uint4 xb_words;
  if (threadIdx.x == 0) xb_words = make_uint4(0u, 0u, 0u, 0u);
  __syncthreads();
  const XcdBarrier xb = xcd_barrier_post(p.BAR, (volatile LDS_AS unsigned*)&xb_words);
  phase_pro(p, bid, nb);
  phase_modp(p, bid, nb, (float*)smem);
  grid.sync();
  phase_modfin(p, bid, nb);
  xcd_barrier(xb);
  phase_norm(p, 0, 0, bid, nb);
  xcd_barrier(xb);
#pragma unroll 1
  for (int layer = 0; layer < 2; ++layer) {
    phase_g1(p, layer, bid, nb, (bf16_t*)smem);
    xcd_barrier(xb);
    phase_prep(p, layer, bid, nb);
    xcd_barrier(xb);
    {
      __shared__ int s_role;
      unsigned* chain_ctr = p.CTR + 8 + layer;
      if (threadIdx.x == 0) {
        const unsigned key = (((unsigned)__builtin_amdgcn_s_getreg((3 << 11) | 20) & 0xFu) << 8) | (((unsigned)__builtin_amdgcn_s_getreg(63492) >> 8) & 0xffu);
        const unsigned slot = nb > 256 ? atomicAdd(p.CTR + 64 + 2048 * layer + key, 1u) : 0u;
        s_role = slot == 0 ? (int)atomicAdd(chain_ctr, 1u) : 1 << 20;
      }
      __syncthreads();
      int c = s_role;
      __syncthreads();
      if (c < 128) phase_gdn(p, layer, c, smem); else if (c < 256) phase_ssd(p, layer, c - 128, smem);
      __syncthreads();
      phase_na(p, layer, p.CTR + layer, smem);
      for (;;) {
        __syncthreads();
        if (threadIdx.x == 0) s_role = (int)atomicAdd(chain_ctr, 1u);
        __syncthreads();
        c = s_role;
        if (c >= 256) break;
        if (c < 128) phase_gdn(p, layer, c, smem); else phase_ssd(p, layer, c - 128, smem);
      }
    }
    xcd_barrier(xb);
    phase_fin(p, layer, bid, nb);
    xcd_barrier(xb);
    phase_g2a(p, layer, bid, nb, (bf16_t*)smem);
    xcd_barrier(xb);
    phase_g2b(p, layer, bid, nb, (bf16_t*)smem);
    xcd_barrier(xb);
    phase_g3(p, layer, bid, nb, (bf16_t*)smem);
    xcd_barrier(xb);
    phase_norm(p, layer, 1, bid, nb);
    xcd_barrier(xb);
    phase_g4(p, layer, bid, nb, (bf16_t*)smem);
    xcd_barrier(xb);
    phase_g5(p, layer, bid, nb, (bf16_t*)smem);
    if (layer == 0) { xcd_barrier(xb); phase_norm(p, 1, 0, bid, nb); xcd_barrier(xb); }
  }
}

extern "C" void kernel_launch(void* const* d_in, const int* in_sizes, int n_in, void* d_out, int out_size, void* d_ws, size_t ws_size,
                              hipStream_t stream) {
  Params p{};
  const float** fp = (const float**)&p;
  for (int i = 0; i < 28; ++i) fp[i] = (const float*)d_in[i];
  p.out = (float*)d_out;
  char* ws = (char*)d_ws;
  size_t off = 0;
  auto take = [&](size_t bytes) { char* r = ws + off; off += (bytes + 255) & ~(size_t)255; return r; };
  p.U = (bf16_t*)take((size_t)TT * UW * 2);
  p.S = (float*)take((size_t)TT * SWD * 4);
  p.MOD = (float*)take((size_t)2 * 9 * 6144 * 4);
  p.SS = (float*)take((size_t)4 * TT * 4);
  p.ROPE = (float*)take(64 * 16 * 2 * 4);
  p.BAR = (unsigned*)take((size_t)XCD_BAR_WORDS * 4 + (64 + 2 * 2048) * 4);
  p.CTR = p.BAR + XCD_BAR_WORDS;
  p.P = (bf16_t*)take((size_t)TT * 1024 * 2);
  p.XC = (float*)take((size_t)TC * 1024 * 4);
  p.HB = (bf16_t*)p.XC;
  p.OG0 = (bf16_t*)d_out;
  p.OG1 = (bf16_t*)((char*)p.P + (size_t)TL * 1024 * 2);
  const size_t need = (size_t)((char*)p.OG1 - ws) + (size_t)2 * TL * 512 * 2;
  if (need > ws_size) { fprintf(stderr, "workspace too small: need %zu have %zu\n", need, ws_size); return; }
  static int grid_blocks = 0;
  if (!grid_blocks) {
    int dev = 0, cus = 0, per_cu = 0;
    hipGetDevice(&dev);
    hipDeviceGetAttribute(&cus, hipDeviceAttributeMultiprocessorCount, dev);
    hipOccupancyMaxActiveBlocksPerMultiprocessor(&per_cu, k_mega, 256, 0);
    if (per_cu > 2) per_cu = 2;
    grid_blocks = cus * per_cu;
  }
  hipMemsetAsync(p.BAR, 0, (size_t)XCD_BAR_WORDS * 4 + (64 + 2 * 2048) * 4, stream);
  void* args[] = {&p};
  hipError_t e = hipLaunchCooperativeKernel((void*)k_mega, dim3(grid_blocks), dim3(256), args, 0, stream);
  if (e != hipSuccess) fprintf(stderr, "cooperative launch failed: %s (grid %d)\n", hipGetErrorString(e), grid_blocks);
}
```

```cpp
#include <hip/hip_runtime.h>
#include <hip/hip_cooperative_groups.h>
#include <cstdio>
#include <cstdint>

typedef unsigned short bf16_t;
typedef short bf16x8 __attribute__((ext_vector_type(8)));
typedef short s16x4 __attribute__((ext_vector_type(4)));
typedef float f32x4 __attribute__((ext_vector_type(4)));
#define LDS_AS __attribute__((address_space(3)))

constexpr int TL = 16384;
constexpr int TC = 2048;
constexpr int TT = TL + TC;
constexpr int DM = 1024;
constexpr int UW = 6144;
constexpr int SWD = 64;
constexpr int DIN = 9280;
constexpr int DFF = 4096;
constexpr float EPS = 1e-6f;
constexpr int U_NAQ = 0, U_NAK = 512, U_NAV = 1024;
constexpr int U_DNQ = 1536, U_DNK = 2048, U_DNV = 2560, U_DNZ = 3072;
constexpr int U_SZ = 3584, U_SX = 4608, U_SB = 5632, U_SC = 5888;
constexpr int U_YA = 0, U_YB = 512, U_YC = 1024, U_GATE = 2048, U_M = 5120;

struct Params {
  const float *x, *c, *ctx, *c_ctx, *w_ada, *b_ada, *norm1_g, *norm2_g, *w_in, *na_q_gain, *na_k_gain, *na_rpb,
      *dn_conv_w, *dn_a_log, *dn_dt_bias, *dn_o_gain, *ssd_conv_w, *ssd_conv_b, *ssd_a_log, *ssd_dt_bias, *ssd_d,
      *ssd_o_gain, *w_pa, *w_pb, *w_pc, *w_out, *w_ff1, *w_ff2;
  float* out;
  bf16_t* U;
  float* S;
  bf16_t* P;
  float* XC;
  float* MOD;
  float* SS;
  float* ROPE;
  unsigned* BAR;
  unsigned* CTR;
  bf16_t* HB;
  bf16_t* OG0;
  bf16_t* OG1;
};

#define AS4 __attribute__((address_space(4)))
typedef const AS4 Params& PRef;
__device__ __forceinline__ const AS4 Params* p_launder(const AS4 Params* q) { asm volatile("" : "+s"(q)); return q; }

__device__ __forceinline__ int tidx() { int t = threadIdx.x; asm volatile("" : "+v"(t)); return t; }
__device__ __forceinline__ float bf2f(bf16_t v) { return __uint_as_float(((unsigned)v) << 16); }
__device__ __forceinline__ bf16_t f2bf(float f) {
  unsigned u = __float_as_uint(f);
  u += 0x7fffu + ((u >> 16) & 1u);
  return (bf16_t)(u >> 16);
}
__device__ __forceinline__ unsigned pack2(float a, float b) { return (unsigned)f2bf(a) | ((unsigned)f2bf(b) << 16); }
__device__ __forceinline__ float bflo(unsigned w) { return __uint_as_float(w << 16); }
__device__ __forceinline__ float bfhi(unsigned w) { return __uint_as_float(w & 0xffff0000u); }
__device__ __forceinline__ float wave_sum(float v) {
#pragma unroll
  for (int o = 32; o; o >>= 1) v += __shfl_xor(v, o);
  return v;
}
__device__ __forceinline__ float wave_max(float v) {
#pragma unroll
  for (int o = 32; o; o >>= 1) v = fmaxf(v, __shfl_xor(v, o));
  return v;
}
__device__ __forceinline__ float siluf(float v) { return v * __builtin_amdgcn_rcpf(1.f + __expf(-v)); }
__device__ __forceinline__ float sigmoidf_(float v) { return __builtin_amdgcn_rcpf(1.f + __expf(-v)); }
__device__ __forceinline__ float softplusf_(float v) {
  const float u = __expf(fminf(v, 20.f));
  const float sp = u < 0.01f ? u * (1.f - u * (0.5f - u * (1.f / 3.f))) : __logf(1.f + u);
  return v > 20.f ? v : sp;
}

__device__ __forceinline__ const float* xrow_in(PRef p, int layer, int row) {
  if (layer == 0) return row < TL ? p.x + (size_t)row * DM : p.ctx + (size_t)(row - TL) * DM;
  return row < TL ? p.out + (size_t)row * DM : p.XC + (size_t)(row - TL) * DM;
}
__device__ __forceinline__ float* xrow_out(PRef p, int row) {
  return row < TL ? p.out + (size_t)row * DM : p.XC + (size_t)(row - TL) * DM;
}
__device__ __forceinline__ int modrow(int row) { return row < TL ? (row >> 11) : 8; }

constexpr int G_BK = 32;
constexpr int G_ASTR = G_BK + 8;
constexpr int G_ATILE = 256 * G_ASTR;
constexpr int GEMM_LDS_BYTES = 2 * (G_ATILE + G_BK * (128 + 16)) * 2;
__device__ __forceinline__ s16x4 tr16(const bf16_t* ptr) { return __builtin_amdgcn_ds_read_tr16_b64_v4i16((LDS_AS s16x4*)ptr); }
__device__ __forceinline__ bf16x8 cat8(s16x4 lo, s16x4 hi) { return (bf16x8){lo[0], lo[1], lo[2], lo[3], hi[0], hi[1], hi[2], hi[3]}; }
__device__ __forceinline__ uint4 cvt8(float4 a, float4 b) { uint4 o; o.x = pack2(a.x, a.y); o.y = pack2(a.z, a.w); o.z = pack2(b.x, b.y); o.w = pack2(b.z, b.w); return o; }

__device__ __forceinline__ void gemm_main2(f32x4 (&acc)[8][2], const bf16_t* A, int astride, const float* W, int ldw, int col0, bool small, int K, bf16_t* lds) {
  constexpr int NI = 2, BSTR = 80, BTILE = G_BK * BSTR;
  const int tid = tidx(), lane = tid & 63, wave = tid >> 6, wm = wave >> 1, wn = wave & 1, g = lane >> 4, l15 = lane & 15, q4 = l15 >> 2, p4 = lane & 3;
  bf16_t* As = lds;
  bf16_t* Bs = lds + 2 * G_ATILE;
  const int ar = tid >> 2, ak = (tid & 3) * 8;
  const int bk = tid >> 3, bn = (tid & 7) * 8;
  const int rho0 = (bk & 3) + 4 * ((bk >> 3) & 3) + 16 * ((bk >> 2) & 1);
  int bsrc = col0 + bn; bool bzero = false;
  if (small) { if (bn < 32) bsrc = 3584 + bn; else if (bn < 64) bsrc = 6176 + bn - 32; else { bzero = true; bsrc = 0; } }
  const bf16_t* ap = A + (size_t)ar * astride + ak;
  const float* bp = W + (size_t)bk * ldw + bsrc;
  bf16_t* aw = As + ar * G_ASTR + ak;
  bf16_t* bw = Bs + rho0 * BSTR + bn;
  uint4 ra0, ra1, ra2, ra3; float4 rb0, rb1;
#define G_LOADS(K1) { ra0 = *(const uint4*)(ap + (size_t)(64 * 0) * astride + (K1)); ra1 = *(const uint4*)(ap + (size_t)(64 * 1) * astride + (K1)); ra2 = *(const uint4*)(ap + (size_t)(64 * 2) * astride + (K1)); ra3 = *(const uint4*)(ap + (size_t)(64 * 3) * astride + (K1)); { const float* s_ = bp + (size_t)(K1) * ldw; rb0 = *(const float4*)s_; rb1 = *(const float4*)(s_ + 4); } }
#define G_STORES(NX) { *(uint4*)(aw + (NX) * G_ATILE + 64 * 0 * G_ASTR) = ra0; *(uint4*)(aw + (NX) * G_ATILE + 64 * 1 * G_ASTR) = ra1; *(uint4*)(aw + (NX) * G_ATILE + 64 * 2 * G_ASTR) = ra2; *(uint4*)(aw + (NX) * G_ATILE + 64 * 3 * G_ASTR) = ra3; { uint4 o_ = cvt8(rb0, rb1); if (bzero) o_ = make_uint4(0u, 0u, 0u, 0u); *(uint4*)(bw + (NX) * BTILE + 0 * BSTR) = o_; } }
  G_LOADS(0)
  G_STORES(0)
  __syncthreads();
  const int nk = K / G_BK;
  for (int kt = 0; kt < nk; ++kt) {
    const int cur = kt & 1;
    const int k1 = (kt + 1 < nk ? kt + 1 : kt) * G_BK;
    G_LOADS(k1)
    asm volatile("" ::: "memory");
    const bf16_t* Ac = As + cur * G_ATILE + (128 * wm + l15) * G_ASTR + 8 * g;
    const bf16_t* Bc = Bs + cur * BTILE + (4 * g + q4) * BSTR + 16 * NI * wn + 4 * p4;
    {
      bf16x8 af[8], bfr[NI];
#pragma unroll
      for (int mi = 0; mi < 8; ++mi) af[mi] = *(const bf16x8*)(Ac + mi * 16 * G_ASTR);
#pragma unroll
      for (int ni = 0; ni < NI; ++ni) bfr[ni] = cat8(tr16(Bc + 16 * ni), tr16(Bc + 16 * BSTR + 16 * ni));
#pragma unroll
      for (int mi = 0; mi < 8; ++mi)
#pragma unroll
        for (int ni = 0; ni < NI; ++ni) acc[mi][ni] = __builtin_amdgcn_mfma_f32_16x16x32_bf16(bfr[ni], af[mi], acc[mi][ni], 0, 0, 0);
    }
    asm volatile("" ::: "memory");
    __builtin_amdgcn_sched_barrier(0);
    G_STORES(cur ^ 1)
    __syncthreads();
  }
#undef G_LOADS
#undef G_STORES
}
__device__ __forceinline__ void gemm_main4(f32x4 (&acc)[8][4], const bf16_t* A, int astride, const float* W, int ldw, int col0, bool small, int K, bf16_t* lds) {
  constexpr int NI = 4, BSTR = 144, BTILE = G_BK * BSTR;
  const int tid = tidx(), lane = tid & 63, wave = tid >> 6, wm = wave >> 1, wn = wave & 1, g = lane >> 4, l15 = lane & 15, q4 = l15 >> 2, p4 = lane & 3;
  bf16_t* As = lds;
  bf16_t* Bs = lds + 2 * G_ATILE;
  const int ar = tid >> 2, ak = (tid & 3) * 8;
  const int bk = tid >> 4, bn = (tid & 15) * 8;
  const int rho0 = (bk & 3) + 4 * (bk >> 3) + 16 * ((bk >> 2) & 1);
  int bsrc = col0 + bn; bool bzero = false;
  if (small) { if (bn < 32) bsrc = 3584 + bn; else if (bn < 64) bsrc = 6176 + bn - 32; else { bzero = true; bsrc = 0; } }
  const bf16_t* ap = A + (size_t)ar * astride + ak;
  const float* bp = W + (size_t)bk * ldw + bsrc;
  bf16_t* aw = As + ar * G_ASTR + ak;
  bf16_t* bw = Bs + rho0 * BSTR + bn;
  uint4 ra0, ra1, ra2, ra3; float4 rb0, rb1, rb2, rb3;
#define G_LOADS(K1) { ra0 = *(const uint4*)(ap + (size_t)(64 * 0) * astride + (K1)); ra1 = *(const uint4*)(ap + (size_t)(64 * 1) * astride + (K1)); ra2 = *(const uint4*)(ap + (size_t)(64 * 2) * astride + (K1)); ra3 = *(const uint4*)(ap + (size_t)(64 * 3) * astride + (K1)); { const float* s_ = bp + (size_t)((K1) + 16 * 0) * ldw; rb0 = *(const float4*)s_; rb1 = *(const float4*)(s_ + 4); } { const float* s_ = bp + (size_t)((K1) + 16 * 1) * ldw; rb2 = *(const float4*)s_; rb3 = *(const float4*)(s_ + 4); } }
#define G_STORES(NX) { *(uint4*)(aw + (NX) * G_ATILE + 64 * 0 * G_ASTR) = ra0; *(uint4*)(aw + (NX) * G_ATILE + 64 * 1 * G_ASTR) = ra1; *(uint4*)(aw + (NX) * G_ATILE + 64 * 2 * G_ASTR) = ra2; *(uint4*)(aw + (NX) * G_ATILE + 64 * 3 * G_ASTR) = ra3; { uint4 o_ = cvt8(rb0, rb1); if (bzero) o_ = make_uint4(0u, 0u, 0u, 0u); *(uint4*)(bw + (NX) * BTILE + 0 * BSTR) = o_; } { uint4 o_ = cvt8(rb2, rb3); if (bzero) o_ = make_uint4(0u, 0u, 0u, 0u); *(uint4*)(bw + (NX) * BTILE + 8 * BSTR) = o_; } }
  G_LOADS(0)
  G_STORES(0)
  __syncthreads();
  const int nk = K / G_BK;
  for (int kt = 0; kt < nk; ++kt) {
    const int cur = kt & 1;
    const int k1 = (kt + 1 < nk ? kt + 1 : kt) * G_BK;
    G_LOADS(k1)
    asm volatile("" ::: "memory");
    const bf16_t* Ac = As + cur * G_ATILE + (128 * wm + l15) * G_ASTR + 8 * g;
    const bf16_t* Bc = Bs + cur * BTILE + (4 * g + q4) * BSTR + 16 * NI * wn + 4 * p4;
    {
      bf16x8 af[8], bfr[NI];
#pragma unroll
      for (int mi = 0; mi < 8; ++mi) af[mi] = *(const bf16x8*)(Ac + mi * 16 * G_ASTR);
#pragma unroll
      for (int ni = 0; ni < NI; ++ni) bfr[ni] = cat8(tr16(Bc + 16 * ni), tr16(Bc + 16 * BSTR + 16 * ni));
#pragma unroll
      for (int mi = 0; mi < 8; ++mi)
#pragma unroll
        for (int ni = 0; ni < NI; ++ni) acc[mi][ni] = __builtin_amdgcn_mfma_f32_16x16x32_bf16(bfr[ni], af[mi], acc[mi][ni], 0, 0, 0);
    }
    asm volatile("" ::: "memory");
    __builtin_amdgcn_sched_barrier(0);
    G_STORES(cur ^ 1)
    __syncthreads();
  }
#undef G_LOADS
#undef G_STORES
}
template <int NI> __device__ __forceinline__ void acc_zero(f32x4 (&acc)[8][NI]) {
#pragma unroll
  for (int i = 0; i < 8; ++i)
#pragma unroll
    for (int j = 0; j < NI; ++j) acc[i][j] = (f32x4){0.f, 0.f, 0.f, 0.f};
}
__device__ __forceinline__ bool tile_next(int i, int bid, int nb, int nMt, int nNt, bool nsplit, int& mt, int& nt) {
  const int xcd = bid & 7, slot = bid >> 3, nslots = nb >> 3;
  const int j = slot + i * nslots;
  if (nsplit) {
    const int nNx = (nNt - xcd + 7) >> 3;
    if (j >= nMt * nNx) return false;
    mt = j / nNx; nt = xcd + 8 * (j % nNx);
  } else {
    const int nMx = (nMt - xcd + 7) >> 3;
    if (j >= nMx * nNt) return false;
    mt = xcd + 8 * (j / nNt); nt = j % nNt;
  }
  return true;
}
#define EPI_IDS const int lane = tidx() & 63, wave = tidx() >> 6, wm = wave >> 1, wn = wave & 1, g = lane >> 4, l15 = lane & 15

__device__ __forceinline__ void phase_pro(PRef p, int bid, int nb) {
  const int tid = tidx(), lane = tid & 63, wave = tid >> 6;
  for (int row = bid * 4 + wave; row < TT; row += nb * 4) {
    const float* xr = xrow_in(p, 0, row);
    float s = 0.f;
#pragma unroll
    for (int i = 0; i < 4; ++i) { const float4 v = *(const float4*)(xr + lane * 4 + 256 * i); s += v.x * v.x + v.y * v.y + v.z * v.z + v.w * v.w; }
    s = wave_sum(s);
    if (lane == 0) { p.SS[row] = s; p.SS[TT + row] = 0.f; p.SS[2 * TT + row] = 0.f; p.SS[3 * TT + row] = 0.f; }
  }
  for (int i = bid * 256 + tid; i < 64 * 16; i += nb * 256) {
    const int pos = i >> 4, fi = i & 15;
    const float inv = __builtin_amdgcn_exp2f(-(float)fi * 0.83048202372184f);
    float ang = (float)pos * inv;
    const float kk = rintf(ang * 0.15915494309189535f);
    ang = fmaf(-kk, 6.2831854820251465f, ang); ang = fmaf(-kk, -1.7484555314695172e-07f, ang);
    p.ROPE[2 * i] = __cosf(ang); p.ROPE[2 * i + 1] = __sinf(ang);
  }
}
__device__ __forceinline__ void phase_modp(PRef p, int bid, int nb, float* lds) {
  const int tid = tidx();
  float* MODP = (float*)p.U;
  for (int u = bid; u < 768; u += nb) {
    const int ks = u & 15, cb = (u >> 4) % 24, l = u / 384, n = cb * 256 + tid;
    __syncthreads();
    for (int i = tid; i < 9 * 64; i += 256) { const int r = i >> 6, k = 64 * ks + (i & 63); const float v = r < 8 ? p.c[r * 1024 + k] : p.c_ctx[k]; lds[i] = siluf(v); }
    __syncthreads();
    float acc[9];
#pragma unroll
    for (int r = 0; r < 9; ++r) acc[r] = 0.f;
    const float* w = p.w_ada + ((size_t)l * 1024 + 64 * ks) * 6144 + n;
#pragma unroll 16
    for (int k = 0; k < 64; ++k) {
      const float wv = w[(size_t)k * 6144];
#pragma unroll
      for (int r = 0; r < 9; ++r) acc[r] += lds[r * 64 + k] * wv;
    }
#pragma unroll
    for (int r = 0; r < 9; ++r) MODP[((size_t)(ks * 2 + l) * 9 + r) * 6144 + n] = acc[r];
  }
}
__device__ __forceinline__ void phase_modfin(PRef p, int bid, int nb) {
  const float* MODP = (const float*)p.U;
  for (int i = bid * 256 + tidx(); i < 2 * 9 * 6144; i += nb * 256) {
    const int l = i / (9 * 6144), rem = i % (9 * 6144), r = rem / 6144, n = rem % 6144;
    float v = p.b_ada[l * 6144 + n];
#pragma unroll
    for (int ks = 0; ks < 16; ++ks) v += MODP[((size_t)(ks * 2 + l) * 9 + r) * 6144 + n];
    const int chunk = n >> 10, kk = n & 1023;
    if (chunk == 1) v = p.norm1_g[l * 1024 + kk] * (1.f + v);
    if (chunk == 4) v = p.norm2_g[l * 1024 + kk] * (1.f + v);
    p.MOD[i] = v;
  }
}

__device__ __forceinline__ void norm_rows4(const float* x0, const float* x1, const float* x2, const float* x3, const float* ss, int row0, const float* alpha, const float* shift, bf16_t* h0, int lane) {
  const float* xr[4] = {x0, x1, x2, x3};
  float4 v[4][4];
#pragma unroll
  for (int j = 0; j < 4; ++j)
#pragma unroll
    for (int i = 0; i < 4; ++i) v[j][i] = *(const float4*)(xr[j] + lane * 4 + 256 * i);
  float rs[4];
#pragma unroll
  for (int j = 0; j < 4; ++j) rs[j] = rsqrtf(ss[row0 + j] * (1.f / DM) + EPS);
#pragma unroll
  for (int i = 0; i < 4; ++i) {
    const int k = lane * 4 + 256 * i;
    const float4 a = *(const float4*)(alpha + k), s = *(const float4*)(shift + k);
#pragma unroll
    for (int j = 0; j < 4; ++j) {
      uint2 o; o.x = pack2(v[j][i].x * rs[j] * a.x + s.x, v[j][i].y * rs[j] * a.y + s.y); o.y = pack2(v[j][i].z * rs[j] * a.z + s.z, v[j][i].w * rs[j] * a.w + s.w);
      *(uint2*)(h0 + (size_t)j * 1024 + k) = o;
    }
  }
}
__device__ __forceinline__ void phase_norm(PRef p, int layer, int which, int bid, int nb) {
  const int lane = tidx() & 63, wave = tidx() >> 6;
  const int nrow = (which == 1 && layer == 1) ? TL : TT;
  const float* modl = p.MOD + (size_t)layer * 9 * 6144;
  const float* ss = p.SS + (size_t)(2 * layer + which) * TT;
  const int lin = which == 0 ? layer : 1;
  for (int row = (bid * 4 + wave) * 4; row < nrow; row += nb * 16) {
    const float* mr = modl + modrow(row) * 6144;
    norm_rows4(xrow_in(p, lin, row), xrow_in(p, lin, row + 1), xrow_in(p, lin, row + 2), xrow_in(p, lin, row + 3), ss, row,
               mr + (which ? 4096 : 1024), mr + (which ? 3072 : 0), p.P + (size_t)row * 1024, lane);
  }
}

__device__ __forceinline__ void phase_g1(PRef p, int layer, int bid, int nb, bf16_t* lds) {
  constexpr bool NSPLIT = true;
  const int nMt = TT / 256, nNt = 49;
  EPI_IDS;
  for (int ti = 0;; ++ti) {
    int mt, nt; if (!tile_next(ti, bid, nb, nMt, nNt, NSPLIT, mt, nt)) break;
    const int m0 = mt * 256, n0 = nt * 128;
    f32x4 acc[8][4]; acc_zero<4>(acc);
    gemm_main4(acc, p.P + (size_t)m0 * 1024, 1024, p.w_in + (size_t)layer * 1024 * DIN, DIN, n0 < 3584 ? n0 : n0 + 32, nt == 48, 1024, lds);
    if (n0 < 1024) {
      const float* gain = (n0 < 512 ? p.na_q_gain : p.na_k_gain) + layer * 64;
      const float mul = n0 < 512 ? 0.125f : 1.f;
#pragma unroll
      for (int mi = 0; mi < 8; ++mi) {
        float ss = 0.f;
#pragma unroll
        for (int ni = 0; ni < 4; ++ni) ss += acc[mi][ni][0] * acc[mi][ni][0] + acc[mi][ni][1] * acc[mi][ni][1] + acc[mi][ni][2] * acc[mi][ni][2] + acc[mi][ni][3] * acc[mi][ni][3];
        ss += __shfl_xor(ss, 16); ss += __shfl_xor(ss, 32);
        const float rs = rsqrtf(ss * (1.f / 64.f) + EPS) * mul;
        const int row = m0 + 128 * wm + 16 * mi + l15;
#pragma unroll
        for (int ni = 0; ni < 4; ++ni) {
          const int cl = 16 * ni + 4 * g;
          const float4 gv = *(const float4*)(gain + cl);
          uint2 o; o.x = pack2(acc[mi][ni][0] * rs * gv.x, acc[mi][ni][1] * rs * gv.y); o.y = pack2(acc[mi][ni][2] * rs * gv.z, acc[mi][ni][3] * rs * gv.w);
          *(uint2*)(p.U + (size_t)row * UW + n0 + 64 * wn + cl) = o;
        }
      }
    } else if (n0 < 6144) {
      const bool hsec = (n0 >= 1536 && n0 < 3072) || n0 >= 4608;
      const int hcol0 = n0 < 3072 ? n0 - 1536 : n0 - 3072;
#pragma unroll
      for (int mi = 0; mi < 8; ++mi) {
        const int row = m0 + 128 * wm + 16 * mi + l15;
        const int rr = row & 63;
        const bool halo = hsec && (rr < 2 || rr >= 62);
        bf16_t* hb = p.HB + ((size_t)(row >> 6) * 4 + (rr < 2 ? rr : rr - 60)) * 3072 + hcol0 + 64 * wn + 4 * g;
#pragma unroll
        for (int ni = 0; ni < 4; ++ni) {
          uint2 o; o.x = pack2(acc[mi][ni][0], acc[mi][ni][1]); o.y = pack2(acc[mi][ni][2], acc[mi][ni][3]);
          *(uint2*)(p.U + (size_t)row * UW + n0 + 64 * wn + 16 * ni + 4 * g) = o;
          if (halo) *(uint2*)(hb + 16 * ni) = o;
        }
      }
    } else if (wn == 0) {
#pragma unroll
      for (int mi = 0; mi < 8; ++mi) {
        const int row = m0 + 128 * wm + 16 * mi + l15;
#pragma unroll
        for (int ni = 0; ni < 4; ++ni) *(f32x4*)(p.S + (size_t)row * SWD + 16 * ni + 4 * g) = acc[mi][ni];
      }
    }
  }
}

__device__ __forceinline__ void phase_g2a(PRef p, int layer, int bid, int nb, bf16_t* lds) {
  constexpr bool NSPLIT = true;
  const int nMt = (layer == 0 ? TT : TL) / 256, nNt = 24;
  EPI_IDS;
  for (int ti = 0;; ++ti) {
    int mt, nt; if (!tile_next(ti, bid, nb, nMt, nNt, NSPLIT, mt, nt)) break;
    const int m0 = mt * 256, n0 = nt * 128;
    f32x4 acc[8][4]; acc_zero<4>(acc);
    gemm_main4(acc, p.P + (size_t)m0 * 1024, 1024, p.w_in + (size_t)layer * 1024 * DIN, DIN, 6208 + n0, false, 1024, lds);
#pragma unroll
    for (int mi = 0; mi < 8; ++mi) {
      const int row = m0 + 128 * wm + 16 * mi + l15;
#pragma unroll
      for (int ni = 0; ni < 4; ++ni) {
        uint2 o; o.x = pack2(sigmoidf_(acc[mi][ni][0]), sigmoidf_(acc[mi][ni][1])); o.y = pack2(sigmoidf_(acc[mi][ni][2]), sigmoidf_(acc[mi][ni][3]));
        *(uint2*)(p.U + (size_t)row * UW + U_GATE + n0 + 64 * wn + 16 * ni + 4 * g) = o;
      }
    }
  }
}
__device__ __forceinline__ void phase_g2b(PRef p, int layer, int bid, int nb, bf16_t* lds) {
  constexpr bool NSPLIT = false;
  const int nMt = (layer == 0 ? TT : TL) / 256, nNt = 16;
  EPI_IDS;
  for (int ti = 0;; ++ti) {
    int mt, nt; if (!tile_next(ti, bid, nb, nMt, nNt, NSPLIT, mt, nt)) break;
    const int m0 = mt * 256, n0 = nt * 64;
    f32x4 accm[8][2]; acc_zero<2>(accm);
#pragma unroll 1
    for (int i = 0; i < 3; ++i) {
      const int ycol = i == 0 ? U_YA : (i == 1 ? U_YB : U_YC);
      const int Ki = i == 2 ? 1024 : 512;
      const float* w = i == 0 ? p.w_pa + (size_t)layer * 512 * 1024 : (i == 1 ? p.w_pb + (size_t)layer * 512 * 1024 : p.w_pc + (size_t)layer * 1024 * 1024);
      f32x4 acc[8][2]; acc_zero<2>(acc);
      gemm_main2(acc, p.U + (size_t)m0 * UW + ycol, UW, w, 1024, n0, false, Ki, lds);
#pragma unroll
      for (int mi = 0; mi < 8; ++mi) {
        const int row = m0 + 128 * wm + 16 * mi + l15;
#pragma unroll
        for (int ni = 0; ni < 2; ++ni) {
          const uint2 gt = *(const uint2*)(p.U + (size_t)row * UW + U_GATE + 1024 * i + n0 + 32 * wn + 16 * ni + 4 * g);
          accm[mi][ni][0] += bflo(gt.x) * acc[mi][ni][0]; accm[mi][ni][1] += bfhi(gt.x) * acc[mi][ni][1];
          accm[mi][ni][2] += bflo(gt.y) * acc[mi][ni][2]; accm[mi][ni][3] += bfhi(gt.y) * acc[mi][ni][3];
        }
      }
    }
#pragma unroll
    for (int mi = 0; mi < 8; ++mi) {
      const int row = m0 + 128 * wm + 16 * mi + l15;
#pragma unroll
      for (int ni = 0; ni < 2; ++ni) {
        uint2 o; o.x = pack2(accm[mi][ni][0], accm[mi][ni][1]); o.y = pack2(accm[mi][ni][2], accm[mi][ni][3]);
        *(uint2*)(p.U + (size_t)row * UW + U_M + n0 + 32 * wn + 16 * ni + 4 * g) = o;
      }
    }
  }
}
__device__ __forceinline__ void epi_residual(PRef p, const f32x4 (&acc)[8][4], int layer_in, int m0, int n0, const float* gate, float* ssacc) {
  EPI_IDS;
#pragma unroll
  for (int mi = 0; mi < 8; ++mi) {
    const int row = m0 + 128 * wm + 16 * mi + l15;
    const float* xi = xrow_in(p, layer_in, row);
    float* xo = xrow_out(p, row);
    const float* gr = gate + modrow(row) * 6144;
    float ss = 0.f;
#pragma unroll
    for (int ni = 0; ni < 4; ++ni) {
      const int col = n0 + 64 * wn + 16 * ni + 4 * g;
      const float4 xv = *(const float4*)(xi + col);
      const float4 gv = *(const float4*)(gr + col);
      float4 o;
      o.x = xv.x + gv.x * acc[mi][ni][0]; o.y = xv.y + gv.y * acc[mi][ni][1]; o.z = xv.z + gv.z * acc[mi][ni][2]; o.w = xv.w + gv.w * acc[mi][ni][3];
      *(float4*)(xo + col) = o;
      ss += o.x * o.x + o.y * o.y + o.z * o.z + o.w * o.w;
    }
    if (ssacc) {
      ss += __shfl_xor(ss, 16); ss += __shfl_xor(ss, 32);
      if (g == 0) atomicAdd(ssacc + row, ss);
    }
  }
}
__device__ __forceinline__ void phase_g3(PRef p, int layer, int bid, int nb, bf16_t* lds) {
  constexpr bool NSPLIT = false;
  const int nMt = (layer == 0 ? TT : TL) / 256, nNt = 8;
  const float* modl = p.MOD + (size_t)layer * 9 * 6144;
  for (int ti = 0;; ++ti) {
    int mt, nt; if (!tile_next(ti, bid, nb, nMt, nNt, NSPLIT, mt, nt)) break;
    const int m0 = mt * 256, n0 = nt * 128;
    f32x4 acc[8][4]; acc_zero<4>(acc);
    gemm_main4(acc, p.U + (size_t)m0 * UW + U_M, UW, p.w_out + (size_t)layer * 1024 * 1024, 1024, n0, false, 1024, lds);
    epi_residual(p, acc, layer, m0, n0, modl + 2048, p.SS + (size_t)(2 * layer + 1) * TT);
  }
}
__device__ __forceinline__ void phase_g4(PRef p, int layer, int bid, int nb, bf16_t* lds) {
  constexpr bool NSPLIT = true;
  const int nMt = (layer == 0 ? TT : TL) / 256, nNt = 32;
  EPI_IDS;
  for (int ti = 0;; ++ti) {
    int mt, nt; if (!tile_next(ti, bid, nb, nMt, nNt, NSPLIT, mt, nt)) break;
    const int m0 = mt * 256, n0 = nt * 128;
    f32x4 acc[8][4]; acc_zero<4>(acc);
    gemm_main4(acc, p.P + (size_t)m0 * 1024, 1024, p.w_ff1 + (size_t)layer * 1024 * DFF, DFF, n0, false, 1024, lds);
#pragma unroll
    for (int mi = 0; mi < 8; ++mi) {
      const int row = m0 + 128 * wm + 16 * mi + l15;
#pragma unroll
      for (int ni = 0; ni < 4; ++ni) {
        const float v0 = fmaxf(acc[mi][ni][0], 0.f), v1 = fmaxf(acc[mi][ni][1], 0.f), v2 = fmaxf(acc[mi][ni][2], 0.f), v3 = fmaxf(acc[mi][ni][3], 0.f);
        uint2 o; o.x = pack2(v0 * v0, v1 * v1); o.y = pack2(v2 * v2, v3 * v3);
        *(uint2*)(p.U + (size_t)row * DFF + n0 + 64 * wn + 16 * ni + 4 * g) = o;
      }
    }
  }
}
__device__ __forceinline__ void phase_g5(PRef p, int layer, int bid, int nb, bf16_t* lds) {
  constexpr bool NSPLIT = false;
  const int nMt = (layer == 0 ? TT : TL) / 256, nNt = 8;
  const float* modl = p.MOD + (size_t)layer * 9 * 6144;
  for (int ti = 0;; ++ti) {
    int mt, nt; if (!tile_next(ti, bid, nb, nMt, nNt, NSPLIT, mt, nt)) break;
    const int m0 = mt * 256, n0 = nt * 128;
    f32x4 acc[8][4]; acc_zero<4>(acc);
    gemm_main4(acc, p.U + (size_t)m0 * DFF, DFF, p.w_ff2 + (size_t)layer * DFF * 1024, 1024, n0, false, DFF, lds);
    epi_residual(p, acc, 1, m0, n0, modl + 5120, layer == 0 ? p.SS + (size_t)2 * TT : nullptr);
  }
}

__device__ __forceinline__ void phase_prep(PRef p, int layer, int bid, int nb, bf16_t* lds) {
  const int tid = tidx();
  for (int i = bid * 256 + tid; i < TT * 64; i += nb * 256) {
    const int c = i & 63;
    float v = p.S[i];
    if (c < 16) v = sigmoidf_(v);
    else if (c < 32) v = -expf(p.dn_a_log[layer * 16 + c - 16]) * softplusf_(v + p.dn_dt_bias[layer * 16 + c - 16]);
    else v = softplusf_(v + p.ssd_dt_bias[layer * 32 + c - 32]);
    p.S[i] = v;
  }
  const int cg = tid & 7, rA = tid >> 3;
  {
    int slab_ = bid % 48; asm volatile("" : "+s"(slab_));
    const int slab = slab_, c0 = bid / 48, cstep = (nb + 47 - slab) / 48;
    const bool dn = slab < 24;
    const int typ = dn ? slab >> 3 : 3;
    const int ucol = (dn ? 1536 + 512 * typ + 64 * (slab & 7) : 4608 + 64 * (slab - 24)) + 8 * cg;
    const int hcol = dn ? ucol - 1536 : ucol - 3072;
    const int cch = (dn ? 512 * typ + 64 * (slab & 7) : 64 * (slab - 24)) + 8 * cg;
    const float* cw = (dn ? p.dn_conv_w : p.ssd_conv_w) + (size_t)layer * 5 * 1536 + cch;
    float w5[5][8];
#pragma unroll
    for (int j = 0; j < 5; ++j) {
      const float4 a = *(const float4*)(cw + j * 1536), b = *(const float4*)(cw + j * 1536 + 4);
      w5[j][0] = a.x; w5[j][1] = a.y; w5[j][2] = a.z; w5[j][3] = a.w; w5[j][4] = b.x; w5[j][5] = b.y; w5[j][6] = b.z; w5[j][7] = b.w;
    }
    float bias[8];
#pragma unroll
    for (int e = 0; e < 8; ++e) bias[e] = dn ? 0.f : p.ssd_conv_b[layer * 1536 + cch + e];
    bf16_t* T = lds;
    constexpr int TS_ = 72;
    uint4 pr0, pr1, pr2;
#define PREP_ROW(CHUNK, TR, DST) { \
      const int rr_ = (TR) - 2; \
      const bool lat_ = (CHUNK) < 256; const int cs_ = lat_ ? ((CHUNK) & 31) : (((CHUNK) - 256) & 3); \
      const bool first_ = cs_ == 0, last_ = lat_ ? cs_ == 31 : cs_ == 3; \
      uint4 v_ = make_uint4(0u, 0u, 0u, 0u); \
      if (rr_ < 0) { if (!first_) v_ = *(const uint4*)(p.HB + ((size_t)((CHUNK) - 1) * 4 + 4 + rr_) * 3072 + hcol); } \
      else if (rr_ >= 64) { if (!last_) v_ = *(const uint4*)(p.HB + ((size_t)((CHUNK) + 1) * 4 + rr_ - 64) * 3072 + hcol); } \
      else v_ = *(const uint4*)(p.U + (size_t)((CHUNK) * 64 + rr_) * UW + ucol); \
      DST = v_; }
#define PREP_LOAD(CHUNK) { PREP_ROW(CHUNK, rA, pr0) PREP_ROW(CHUNK, rA + 32, pr1) if (rA < 4) PREP_ROW(CHUNK, rA + 64, pr2) }
    if (c0 < 288) PREP_LOAD(c0)
    for (int chunk = c0; chunk < 288; chunk += cstep) {
      const bool lat = chunk < 256;
      const int cs = lat ? (chunk & 31) : ((chunk - 256) & 3);
      const int r0 = chunk * 64;
      __syncthreads();
      *(uint4*)(T + rA * TS_ + 8 * cg) = pr0; *(uint4*)(T + (rA + 32) * TS_ + 8 * cg) = pr1;
      if (rA < 4) *(uint4*)(T + (rA + 64) * TS_ + 8 * cg) = pr2;
      __syncthreads();
      if (chunk + cstep < 288) PREP_LOAD(chunk + cstep)
#pragma unroll
      for (int it = 0; it < 2; ++it) {
        const int rr = rA + 32 * it;
        float v[8];
#pragma unroll
        for (int e = 0; e < 8; ++e) v[e] = bias[e];
#pragma unroll
        for (int j = 0; j < 5; ++j) {
          const uint4 x = *(const uint4*)(T + (rr + j) * TS_ + 8 * cg);
          v[0] += w5[j][0] * bflo(x.x); v[1] += w5[j][1] * bfhi(x.x); v[2] += w5[j][2] * bflo(x.y); v[3] += w5[j][3] * bfhi(x.y);
          v[4] += w5[j][4] * bflo(x.z); v[5] += w5[j][5] * bfhi(x.z); v[6] += w5[j][6] * bflo(x.w); v[7] += w5[j][7] * bfhi(x.w);
        }
#pragma unroll
        for (int e = 0; e < 8; ++e) v[e] = siluf(v[e]);
        if (typ < 2) {
          float ss = 0.f;
#pragma unroll
          for (int e = 0; e < 8; ++e) ss += v[e] * v[e];
          ss += __shfl_xor(ss, 1); ss += __shfl_xor(ss, 2); ss += __shfl_xor(ss, 4);
          const float rs = rsqrtf(ss + EPS) * (typ == 0 ? 0.125f : 1.f);
          if (lat) {
            const int pos = cg < 4 ? cs : rr;
            const float* rp = p.ROPE + (pos * 16 + 8 * (cg & 1)) * 2;
            const float4 q0 = *(const float4*)rp, q1 = *(const float4*)(rp + 4), q2 = *(const float4*)(rp + 8), q3 = *(const float4*)(rp + 12);
            const float cs8[8] = {q0.x, q0.z, q1.x, q1.z, q2.x, q2.z, q3.x, q3.z}, sn8[8] = {q0.y, q0.w, q1.y, q1.w, q2.y, q2.w, q3.y, q3.w};
#pragma unroll
            for (int e = 0; e < 8; ++e) {
              const float vp = __shfl_xor(v[e], 2);
              v[e] = v[e] * cs8[e] + ((cg & 2) ? vp : -vp) * sn8[e];
            }
          }
#pragma unroll
          for (int e = 0; e < 8; ++e) v[e] *= rs;
        }
        uint4 o; o.x = pack2(v[0], v[1]); o.y = pack2(v[2], v[3]); o.z = pack2(v[4], v[5]); o.w = pack2(v[6], v[7]);
        *(uint4*)(p.U + (size_t)(r0 + rr) * UW + ucol) = o;
      }
    }
#undef PREP_LOAD
#undef PREP_ROW
  }
}

constexpr int XS = 72;
constexpr int BS2 = 136;
constexpr int SSD_LDS = (3 * 64 * XS + 3 * 64 * BS2) * 2 + 2 * 64 * 4;
__device__ __forceinline__ void phase_ssd(PRef p, int layer, int task, char* smem) {
  const int tid = tidx(), lane = tid & 63, wave = tid >> 6, g = lane >> 4, l15 = lane & 15, q4 = l15 >> 2, p4 = lane & 3;
  bf16_t* Xt = (bf16_t*)smem;
  bf16_t* Xs = Xt + 64 * XS;
  bf16_t* Wg = Xs + 64 * XS;
  bf16_t* Bt = Wg + 64 * XS;
  bf16_t* Ct = Bt + 64 * BS2;
  bf16_t* Hb = Ct + 64 * BS2;
  float* dts = (float*)(Hb + 64 * BS2);
  float* lam = dts + 64;
  {
    const int head = task & 15, b = task >> 4, grp = head >> 3;
    f32x4 hst[2][8];
#pragma unroll
    for (int d = 0; d < 2; ++d)
#pragma unroll
      for (int n = 0; n < 8; ++n) hst[d][n] = (f32x4){0.f, 0.f, 0.f, 0.f};
    const float dsk = p.ssd_d[layer * 16 + head];
    const float an0 = -__expf(p.ssd_a_log[layer * 32 + head]), an1 = -__expf(p.ssd_a_log[layer * 32 + 16 + head]);
    uint4 px0, px1, pb0, pb1, pb2, pb3, pc0, pc1, pc2, pc3; float pdt = 0.f;
#define SSD_PREFETCH(IT, DIR) { \
      const int seg_ = (IT) >= 4, ci_ = seg_ ? (IT) - 4 : (IT), nch_ = seg_ ? 32 : 4; \
      const int base_ = seg_ ? b * 2048 : TL + b * 256; \
      const int c_ = (DIR) ? nch_ - 1 - ci_ : ci_; \
      const int i_ = tid >> 2, sub_ = tid & 3; \
      const int row_ = base_ + 64 * c_ + ((DIR) ? 63 - i_ : i_); \
      const bf16_t* ur_ = p.U + (size_t)row_ * UW; \
      const uint4* sx_ = (const uint4*)(ur_ + U_SX + 64 * head + 16 * sub_); px0 = sx_[0]; px1 = sx_[1]; \
      const uint4* sb_ = (const uint4*)(ur_ + U_SB + 128 * grp + 32 * sub_); pb0 = sb_[0]; pb1 = sb_[1]; pb2 = sb_[2]; pb3 = sb_[3]; \
      if (seg_ == 1 || layer == 0) { const uint4* sc_ = (const uint4*)(ur_ + U_SC + 128 * grp + 32 * sub_); pc0 = sc_[0]; pc1 = sc_[1]; pc2 = sc_[2]; pc3 = sc_[3]; } \
      if (sub_ == 0) pdt = p.S[(size_t)row_ * SWD + 32 + (DIR) * 16 + head]; }
    SSD_PREFETCH(0, 0)
    for (int it = 0; it < 36; ++it) {
      const int seg = it >= 4, ci = seg ? it - 4 : it, nch = seg ? 32 : 4;
      const int base = seg ? b * 2048 : TL + b * 256;
      const bool want_o = seg == 1 || layer == 0;
      const bool first = ci < nch / 2;
#pragma unroll
      for (int dir = 0; dir < 2; ++dir) {
        const int c = dir ? nch - 1 - ci : ci;
        const int r0 = base + 64 * c;
        __syncthreads();
        {
          const int i = tid >> 2, sub = tid & 3;
          *(uint4*)(Xt + i * XS + 16 * sub) = px0; *(uint4*)(Xt + i * XS + 16 * sub + 8) = px1;
          *(uint4*)(Bt + i * BS2 + 32 * sub) = pb0; *(uint4*)(Bt + i * BS2 + 32 * sub + 8) = pb1; *(uint4*)(Bt + i * BS2 + 32 * sub + 16) = pb2; *(uint4*)(Bt + i * BS2 + 32 * sub + 24) = pb3;
          if (want_o) { *(uint4*)(Ct + i * BS2 + 32 * sub) = pc0; *(uint4*)(Ct + i * BS2 + 32 * sub + 8) = pc1; *(uint4*)(Ct + i * BS2 + 32 * sub + 16) = pc2; *(uint4*)(Ct + i * BS2 + 32 * sub + 24) = pc3; }
          if (sub == 0) dts[i] = pdt;
        }
        if (dir == 0) SSD_PREFETCH(it, 1) else if (it + 1 < 36) SSD_PREFETCH(it + 1, 0)
        unsigned long long oldp[4] = {0ull, 0ull, 0ull, 0ull};
        if (want_o && !first) {
          const int irow_ = 16 * wave + l15;
          const int prow_ = r0 + (dir ? 63 - irow_ : irow_);
#pragma unroll
          for (int pt = 0; pt < 4; ++pt) oldp[pt] = __hip_atomic_load((unsigned long long*)(p.P + (size_t)prow_ * 1024 + 64 * head + 16 * pt + 4 * g), __ATOMIC_RELAXED, __HIP_MEMORY_SCOPE_AGENT);
        }
        if (want_o) {
#pragma unroll
          for (int nt = 0; nt < 8; ++nt) {
            uint2 o; o.x = pack2(hst[dir][nt][0], hst[dir][nt][1]); o.y = pack2(hst[dir][nt][2], hst[dir][nt][3]);
            *(uint2*)(Hb + (16 * wave + l15) * BS2 + 16 * nt + 4 * g) = o;
          }
        }
        __syncthreads();
        float lv = dts[lane] * (dir ? an1 : an0);
#pragma unroll
        for (int o = 1; o < 64; o <<= 1) { const float tv = __shfl_up(lv, o); if (lane >= o) lv += tv; }
        const float lam_last = __shfl(lv, 63);
        if (wave == 0) lam[lane] = lv;
        {
          const int j = tid >> 2, sub = tid & 3;
          const float lj = __shfl(lv, j & 63);
          const float sc = dts[j] * __expf(lam_last - lj);
          const uint4 a = *(const uint4*)(Xt + j * XS + 16 * sub), bq = *(const uint4*)(Xt + j * XS + 16 * sub + 8);
          uint4 oa, ob;
          oa.x = pack2(bflo(a.x) * sc, bfhi(a.x) * sc); oa.y = pack2(bflo(a.y) * sc, bfhi(a.y) * sc); oa.z = pack2(bflo(a.z) * sc, bfhi(a.z) * sc); oa.w = pack2(bflo(a.w) * sc, bfhi(a.w) * sc);
          ob.x = pack2(bflo(bq.x) * sc, bfhi(bq.x) * sc); ob.y = pack2(bflo(bq.y) * sc, bfhi(bq.y) * sc); ob.z = pack2(bflo(bq.z) * sc, bfhi(bq.z) * sc); ob.w = pack2(bflo(bq.w) * sc, bfhi(bq.w) * sc);
          *(uint4*)(Xs + j * XS + 16 * sub) = oa; *(uint4*)(Xs + j * XS + 16 * sub + 8) = ob;
        }
        __syncthreads();
        if (want_o) {
          const int irow = 16 * wave + l15;
          const float li = lam[irow];
#pragma unroll
          for (int jt = 0; jt < 4; ++jt) {
            f32x4 cacc = (f32x4){0.f, 0.f, 0.f, 0.f};
            if (jt <= wave) {
#pragma unroll
              for (int s2 = 0; s2 < 4; ++s2) {
                const bf16x8 af = *(const bf16x8*)(Ct + irow * BS2 + 32 * s2 + 8 * g);
                const bf16x8 bf = *(const bf16x8*)(Bt + (16 * jt + l15) * BS2 + 32 * s2 + 8 * g);
                cacc = __builtin_amdgcn_mfma_f32_16x16x32_bf16(bf, af, cacc, 0, 0, 0);
              }
            }
            const int j0 = 16 * jt + 4 * g;
            const float4 lj = *(const float4*)(lam + j0), dj = *(const float4*)(dts + j0);
            const float w0 = (j0 + 0 <= irow) ? cacc[0] * __expf(li - lj.x) * dj.x : 0.f;
            const float w1 = (j0 + 1 <= irow) ? cacc[1] * __expf(li - lj.y) * dj.y : 0.f;
            const float w2 = (j0 + 2 <= irow) ? cacc[2] * __expf(li - lj.z) * dj.z : 0.f;
            const float w3 = (j0 + 3 <= irow) ? cacc[3] * __expf(li - lj.w) * dj.w : 0.f;
            uint2 o; o.x = pack2(w0, w1); o.y = pack2(w2, w3);
            *(uint2*)(Wg + irow * XS + j0) = o;
          }
        }
        __syncthreads();
        if (want_o) {
          const int irow = 16 * wave + l15;
          f32x4 ai[4], ae[4];
#pragma unroll
          for (int pt = 0; pt < 4; ++pt) { ai[pt] = (f32x4){0.f, 0.f, 0.f, 0.f}; ae[pt] = (f32x4){0.f, 0.f, 0.f, 0.f}; }
#pragma unroll
          for (int s2 = 0; s2 < 2; ++s2) {
            const bf16x8 af = *(const bf16x8*)(Wg + irow * XS + 32 * s2 + 8 * g);
#pragma unroll
            for (int pt = 0; pt < 4; ++pt) {
              const bf16x8 bf = cat8(tr16(Xt + (32 * s2 + 8 * g + q4) * XS + 16 * pt + 4 * p4), tr16(Xt + (32 * s2 + 8 * g + 4 + q4) * XS + 16 * pt + 4 * p4));
              ai[pt] = __builtin_amdgcn_mfma_f32_16x16x32_bf16(bf, af, ai[pt], 0, 0, 0);
            }
          }
#pragma unroll
          for (int s2 = 0; s2 < 4; ++s2) {
            const bf16x8 af = *(const bf16x8*)(Ct + irow * BS2 + 32 * s2 + 8 * g);
#pragma unroll
            for (int pt = 0; pt < 4; ++pt) {
              const bf16x8 bf = *(const bf16x8*)(Hb + (16 * pt + l15) * BS2 + 32 * s2 + 8 * g);
              ae[pt] = __builtin_amdgcn_mfma_f32_16x16x32_bf16(bf, af, ae[pt], 0, 0, 0);
            }
          }
          const float el = __expf(lam[irow]);
          const int row = r0 + (dir ? 63 - irow : irow);
#pragma unroll
          for (int pt = 0; pt < 4; ++pt) {
            float y0 = ai[pt][0] + el * ae[pt][0], y1 = ai[pt][1] + el * ae[pt][1], y2 = ai[pt][2] + el * ae[pt][2], y3 = ai[pt][3] + el * ae[pt][3];
            if (dir == 0) {
              const uint2 xv = *(const uint2*)(Xt + irow * XS + 16 * pt + 4 * g);
              y0 += dsk * bflo(xv.x); y1 += dsk * bfhi(xv.x); y2 += dsk * bflo(xv.y); y3 += dsk * bfhi(xv.y);
            }
            unsigned long long* dst = (unsigned long long*)(p.P + (size_t)row * 1024 + 64 * head + 16 * pt + 4 * g);
            if (!first) {
              const unsigned long long old = oldp[pt];
              const unsigned lo = (unsigned)old, hi = (unsigned)(old >> 32);
              y0 += bflo(lo); y1 += bfhi(lo); y2 += bflo(hi); y3 += bfhi(hi);
            }
            *dst = (unsigned long long)pack2(y0, y1) | ((unsigned long long)pack2(y2, y3) << 32);
          }
        }
        {
          const float el = __expf(lam_last);
#pragma unroll
          for (int nt = 0; nt < 8; ++nt) hst[dir][nt] *= el;
#pragma unroll
          for (int s2 = 0; s2 < 2; ++s2) {
            const bf16x8 mf = cat8(tr16(Xs + (32 * s2 + 8 * g + q4) * XS + 16 * wave + 4 * p4), tr16(Xs + (32 * s2 + 8 * g + 4 + q4) * XS + 16 * wave + 4 * p4));
#pragma unroll
            for (int nt = 0; nt < 8; ++nt) {
              const bf16x8 nf = cat8(tr16(Bt + (32 * s2 + 8 * g + q4) * BS2 + 16 * nt + 4 * p4), tr16(Bt + (32 * s2 + 8 * g + 4 + q4) * BS2 + 16 * nt + 4 * p4));
              hst[dir][nt] = __builtin_amdgcn_mfma_f32_16x16x32_bf16(nf, mf, hst[dir][nt], 0, 0, 0);
            }
          }
        }
      }
    }
  }
}


#undef SSD_PREFETCH
constexpr int GT = 64 * XS;
constexpr int GDN_LDS = 8 * GT * 2 + 4 * 256 * 4 + 4 * 16 * 24 * 2 + 2 * 64 * 4;
__device__ __forceinline__ void phase_gdn(PRef p, int layer, int task, char* smem) {
  const int tid = tidx(), lane = tid & 63, wave = tid >> 6, g = lane >> 4, l15 = lane & 15, q4 = l15 >> 2, p4 = lane & 3;
  bf16_t* Qt = (bf16_t*)smem;
  bf16_t* Kt = Qt + GT;
  bf16_t* Vt = Kt + GT;
  bf16_t* Am = Vt + GT;
  bf16_t* Mq = Am + GT;
  bf16_t* Xw = Mq + GT;
  bf16_t* Xu = Xw + GT;
  bf16_t* St = Xu + GT;
  bf16_t* Qg = Qt; bf16_t* Vn = Vt; bf16_t* Vs = Am;
  float* Adiag = (float*)(St + GT);
  bf16_t* Db = (bf16_t*)(Adiag + 4 * 256);
  float* bet = (float*)(Db + 4 * 16 * 24);
  float* gam = bet + 64;
  const bf16x8 zero8 = (bf16x8){0, 0, 0, 0, 0, 0, 0, 0};
  {
    const int dir = task & 1, h = (task >> 1) & 7, b = task >> 4;
    bf16_t* Og = layer == 0 ? p.OG0 + (size_t)dir * TT * 512 : p.OG1 + (size_t)dir * TL * 512;
    f32x4 sst[4];
#pragma unroll
    for (int e = 0; e < 4; ++e) sst[e] = (f32x4){0.f, 0.f, 0.f, 0.f};
    __syncthreads();
    for (int i = tid; i < 64 * XS / 2; i += 256) { ((unsigned*)St)[i] = 0u; ((unsigned*)Xw)[i] = 0u; ((unsigned*)Xu)[i] = 0u; }
    uint4 pq0, pq1, pk0, pk1, pv0, pv1; float pbeta = 0.f, pgam = 0.f;
#define GDN_PREFETCH(IT) { \
      const int seg_ = (IT) >= 4, ci_ = seg_ ? (IT) - 4 : (IT), nch_ = seg_ ? 32 : 4; \
      const int base_ = seg_ ? b * 2048 : TL + b * 256; \
      const int c_ = dir ? nch_ - 1 - ci_ : ci_; \
      const int i_ = tid >> 2, sub_ = tid & 3; \
      const int row_ = base_ + 64 * c_ + (dir ? 63 - i_ : i_); \
      const bf16_t* ur_ = p.U + (size_t)row_ * UW + 64 * h + 16 * sub_; \
      pq0 = *(const uint4*)(ur_ + U_DNQ); pq1 = *(const uint4*)(ur_ + U_DNQ + 8); \
      pk0 = *(const uint4*)(ur_ + U_DNK); pk1 = *(const uint4*)(ur_ + U_DNK + 8); \
      pv0 = *(const uint4*)(ur_ + U_DNV); pv1 = *(const uint4*)(ur_ + U_DNV + 8); \
      if (sub_ == 0) { pbeta = p.S[(size_t)row_ * SWD + dir * 8 + h]; pgam = p.S[(size_t)row_ * SWD + 16 + dir * 8 + h]; } }
    GDN_PREFETCH(0)
    for (int it = 0; it < 36; ++it) {
      const int seg = it >= 4, ci = seg ? it - 4 : it, nch = seg ? 32 : 4;
      const int base = seg ? b * 2048 : TL + b * 256;
      const bool want_o = seg == 1 || layer == 0;
      const int c = dir ? nch - 1 - ci : ci;
      const int r0 = base + 64 * c;
      __syncthreads();
      {
        const int i = tid >> 2, sub = tid & 3;
        *(uint4*)(Qt + i * XS + 16 * sub) = pq0; *(uint4*)(Qt + i * XS + 16 * sub + 8) = pq1;
        *(uint4*)(Kt + i * XS + 16 * sub) = pk0; *(uint4*)(Kt + i * XS + 16 * sub + 8) = pk1;
        *(uint4*)(Vt + i * XS + 16 * sub) = pv0; *(uint4*)(Vt + i * XS + 16 * sub + 8) = pv1;
        if (sub == 0) { bet[i] = pbeta; gam[i] = pgam; }
      }
      if (it + 1 < 36) GDN_PREFETCH(it + 1)
      __syncthreads();
      float lv = gam[lane];
#pragma unroll
      for (int o = 1; o < 64; o <<= 1) { const float tv = __shfl_up(lv, o); if (lane >= o) lv += tv; }
      const float gam_last = __shfl(lv, 63);
      __syncthreads();
      if (wave == 0) gam[lane] = lv;
      __syncthreads();
      {
        const int irow = 16 * wave + l15;
        const float gi = gam[irow], bi = bet[irow];
#pragma unroll
        for (int jt = 0; jt < 4; ++jt) {
          f32x4 kk = (f32x4){0.f, 0.f, 0.f, 0.f}, qk = (f32x4){0.f, 0.f, 0.f, 0.f};
          if (jt <= wave) {
#pragma unroll
            for (int s2 = 0; s2 < 2; ++s2) {
              const bf16x8 nf = *(const bf16x8*)(Kt + (16 * jt + l15) * XS + 32 * s2 + 8 * g);
              const bf16x8 mk = *(const bf16x8*)(Kt + irow * XS + 32 * s2 + 8 * g);
              const bf16x8 mq = *(const bf16x8*)(Qt + irow * XS + 32 * s2 + 8 * g);
              kk = __builtin_amdgcn_mfma_f32_16x16x32_bf16(nf, mk, kk, 0, 0, 0);
              qk = __builtin_amdgcn_mfma_f32_16x16x32_bf16(nf, mq, qk, 0, 0, 0);
            }
          }
          const int j0 = 16 * jt + 4 * g;
          const float4 gj = *(const float4*)(gam + j0);
          const float gjv[4] = {gj.x, gj.y, gj.z, gj.w};
          float av[4], mv[4];
#pragma unroll
          for (int r = 0; r < 4; ++r) {
            const int j = j0 + r;
            const float dec = j <= irow ? __expf(gi - gjv[r]) : 0.f;
            av[r] = j < irow ? bi * kk[r] * dec : 0.f;
            mv[r] = qk[r] * dec;
          }
          uint2 oa; oa.x = pack2(av[0], av[1]); oa.y = pack2(av[2], av[3]);
          uint2 om; om.x = pack2(mv[0], mv[1]); om.y = pack2(mv[2], mv[3]);
          *(uint2*)(Am + irow * XS + j0) = oa;
          *(uint2*)(Mq + irow * XS + j0) = om;
          if (jt == wave) *(f32x4*)(Adiag + wave * 256 + l15 * 16 + 4 * g) = (f32x4){av[0], av[1], av[2], av[3]};
        }
      }
      __syncthreads();
      {
        const int j = tid >> 2, sub = tid & 3;
        const float sc = __expf(gam[j]);
        const uint4 a = *(const uint4*)(Qt + j * XS + 16 * sub), bq = *(const uint4*)(Qt + j * XS + 16 * sub + 8);
        uint4 oa, ob;
        oa.x = pack2(bflo(a.x) * sc, bfhi(a.x) * sc); oa.y = pack2(bflo(a.y) * sc, bfhi(a.y) * sc); oa.z = pack2(bflo(a.z) * sc, bfhi(a.z) * sc); oa.w = pack2(bflo(a.w) * sc, bfhi(a.w) * sc);
        ob.x = pack2(bflo(bq.x) * sc, bfhi(bq.x) * sc); ob.y = pack2(bflo(bq.y) * sc, bfhi(bq.y) * sc); ob.z = pack2(bflo(bq.z) * sc, bfhi(bq.z) * sc); ob.w = pack2(bflo(bq.w) * sc, bfhi(bq.w) * sc);
        *(uint4*)(Qg + j * XS + 16 * sub) = oa; *(uint4*)(Qg + j * XS + 16 * sub + 8) = ob;
      }
      {
        const int cc = lane & 15;
        const float* Ad = Adiag + wave * 256;
        float dcol[16];
#pragma unroll
        for (int r = 0; r < 16; ++r) {
          float sacc = (r == cc) ? 1.f : 0.f;
#pragma unroll
          for (int j = 0; j < r; ++j) sacc -= Ad[r * 16 + j] * dcol[j];
          dcol[r] = sacc;
        }
        if (lane < 16) {
#pragma unroll
          for (int r = 0; r < 16; ++r) Db[(wave * 16 + r) * 24 + cc] = f2bf(dcol[r]);
        }
      }
      __syncthreads();
      {
        const bool isW = wave < 2;
        bf16_t* Xd = isW ? Xw : Xu;
        const bf16_t* Src = isW ? Kt : Vt;
        const int fbase = (wave & 1) * 32;
#pragma unroll
        for (int ib = 0; ib < 4; ++ib) {
          const int irow = 16 * ib + l15;
          const float sc = isW ? bet[irow] * __expf(gam[irow]) : bet[irow];
          f32x4 y[2];
#pragma unroll
          for (int fi = 0; fi < 2; ++fi) {
            const int f0 = fbase + 16 * fi;
            const uint2 rv = *(const uint2*)(Src + irow * XS + f0 + 4 * g);
            f32x4 tmp = (f32x4){0.f, 0.f, 0.f, 0.f};
#pragma unroll
            for (int s2 = 0; s2 < 2; ++s2) {
              if (32 * s2 < 16 * ib) {
                const bool half = (32 * s2 + 32) > 16 * ib;
                bf16x8 mf = *(const bf16x8*)(Am + irow * XS + 32 * s2 + 8 * g);
                if (half && g >= 2) mf = zero8;
                const bf16x8 nf = cat8(tr16(Xd + (32 * s2 + 8 * g + q4) * XS + f0 + 4 * p4), tr16(Xd + (32 * s2 + 8 * g + 4 + q4) * XS + f0 + 4 * p4));
                tmp = __builtin_amdgcn_mfma_f32_16x16x32_bf16(nf, mf, tmp, 0, 0, 0);
              }
            }
            y[fi] = (f32x4){bflo(rv.x) * sc - tmp[0], bfhi(rv.x) * sc - tmp[1], bflo(rv.y) * sc - tmp[2], bfhi(rv.y) * sc - tmp[3]};
          }
          __syncthreads();
#pragma unroll
          for (int fi = 0; fi < 2; ++fi) {
            uint2 o; o.x = pack2(y[fi][0], y[fi][1]); o.y = pack2(y[fi][2], y[fi][3]);
            *(uint2*)(Xd + irow * XS + fbase + 16 * fi + 4 * g) = o;
          }
          __syncthreads();
          bf16x8 dm = zero8;
          if (g < 2) dm = *(const bf16x8*)(Db + (ib * 16 + l15) * 24 + 8 * g);
#pragma unroll
          for (int fi = 0; fi < 2; ++fi) {
            const int f0 = fbase + 16 * fi;
            const bf16x8 nf = cat8(tr16(Xd + (16 * ib + 8 * (g & 1) + q4) * XS + f0 + 4 * p4), tr16(Xd + (16 * ib + 8 * (g & 1) + 4 + q4) * XS + f0 + 4 * p4));
            y[fi] = __builtin_amdgcn_mfma_f32_16x16x32_bf16(nf, dm, (f32x4){0.f, 0.f, 0.f, 0.f}, 0, 0, 0);
          }
          __syncthreads();
#pragma unroll
          for (int fi = 0; fi < 2; ++fi) {
            uint2 o; o.x = pack2(y[fi][0], y[fi][1]); o.y = pack2(y[fi][2], y[fi][3]);
            *(uint2*)(Xd + irow * XS + fbase + 16 * fi + 4 * g) = o;
          }
          __syncthreads();
        }
      }
      {
        const int irow = 16 * wave + l15;
        const float dl = __expf(gam_last - gam[irow]);
        f32x4 acc[4];
#pragma unroll
        for (int et = 0; et < 4; ++et) acc[et] = (f32x4){0.f, 0.f, 0.f, 0.f};
#pragma unroll
        for (int s2 = 0; s2 < 2; ++s2) {
          const bf16x8 mf = *(const bf16x8*)(Xw + irow * XS + 32 * s2 + 8 * g);
#pragma unroll
          for (int et = 0; et < 4; ++et) {
            const bf16x8 nf = *(const bf16x8*)(St + (16 * et + l15) * XS + 32 * s2 + 8 * g);
            acc[et] = __builtin_amdgcn_mfma_f32_16x16x32_bf16(nf, mf, acc[et], 0, 0, 0);
          }
        }
#pragma unroll
        for (int et = 0; et < 4; ++et) {
          const uint2 uv = *(const uint2*)(Xu + irow * XS + 16 * et + 4 * g);
          const float v0 = bflo(uv.x) - acc[et][0], v1 = bfhi(uv.x) - acc[et][1], v2 = bflo(uv.y) - acc[et][2], v3 = bfhi(uv.y) - acc[et][3];
          uint2 o; o.x = pack2(v0, v1); o.y = pack2(v2, v3);
          *(uint2*)(Vn + irow * XS + 16 * et + 4 * g) = o;
          o.x = pack2(v0 * dl, v1 * dl); o.y = pack2(v2 * dl, v3 * dl);
          *(uint2*)(Vs + irow * XS + 16 * et + 4 * g) = o;
        }
      }
      __syncthreads();
      if (want_o) {
        const int irow = 16 * wave + l15;
        f32x4 acc[4];
#pragma unroll
        for (int et = 0; et < 4; ++et) acc[et] = (f32x4){0.f, 0.f, 0.f, 0.f};
#pragma unroll
        for (int s2 = 0; s2 < 2; ++s2) {
          const bf16x8 mf = *(const bf16x8*)(Qg + irow * XS + 32 * s2 + 8 * g);
          const bf16x8 mf2 = *(const bf16x8*)(Mq + irow * XS + 32 * s2 + 8 * g);
#pragma unroll
          for (int et = 0; et < 4; ++et) {
            const bf16x8 nf = *(const bf16x8*)(St + (16 * et + l15) * XS + 32 * s2 + 8 * g);
            acc[et] = __builtin_amdgcn_mfma_f32_16x16x32_bf16(nf, mf, acc[et], 0, 0, 0);
            const bf16x8 nf2 = cat8(tr16(Vn + (32 * s2 + 8 * g + q4) * XS + 16 * et + 4 * p4), tr16(Vn + (32 * s2 + 8 * g + 4 + q4) * XS + 16 * et + 4 * p4));
            acc[et] = __builtin_amdgcn_mfma_f32_16x16x32_bf16(nf2, mf2, acc[et], 0, 0, 0);
          }
        }
        const int row = r0 + (dir ? 63 - irow : irow);
#pragma unroll
        for (int et = 0; et < 4; ++et) {
          uint2 o; o.x = pack2(acc[et][0], acc[et][1]); o.y = pack2(acc[et][2], acc[et][3]);
          *(uint2*)(Og + (size_t)row * 512 + 64 * h + 16 * et + 4 * g) = o;
        }
      }
      {
        const float el = __expf(gam_last);
#pragma unroll
        for (int et = 0; et < 4; ++et) sst[et] *= el;
#pragma unroll
        for (int s2 = 0; s2 < 2; ++s2) {
          const bf16x8 nf = cat8(tr16(Kt + (32 * s2 + 8 * g + q4) * XS + 16 * wave + 4 * p4), tr16(Kt + (32 * s2 + 8 * g + 4 + q4) * XS + 16 * wave + 4 * p4));
#pragma unroll
          for (int et = 0; et < 4; ++et) {
            const bf16x8 mf = cat8(tr16(Vs + (32 * s2 + 8 * g + q4) * XS + 16 * et + 4 * p4), tr16(Vs + (32 * s2 + 8 * g + 4 + q4) * XS + 16 * et + 4 * p4));
            sst[et] = __builtin_amdgcn_mfma_f32_16x16x32_bf16(nf, mf, sst[et], 0, 0, 0);
          }
        }
      }
      __syncthreads();
#pragma unroll
      for (int et = 0; et < 4; ++et) {
        uint2 o; o.x = pack2(sst[et][0], sst[et][1]); o.y = pack2(sst[et][2], sst[et][3]);
        *(uint2*)(St + (16 * et + l15) * XS + 16 * wave + 4 * g) = o;
      }
    }
  }
}


#undef GDN_PREFETCH
constexpr int NA_VS = 72;
constexpr int NA_LDS_WAVE = 2 * 32 * NA_VS * 2;
__device__ __forceinline__ void phase_na(PRef p, int layer, unsigned* ctr, char* smem) {
  const int lane = tidx() & 63, wave = tidx() >> 6, g = lane >> 4, l15 = lane & 15, q4 = l15 >> 2, p4 = lane & 3;
  bf16_t* Vl = (bf16_t*)(smem + wave * NA_LDS_WAVE);
  const int ntask = layer == 0 ? 8192 + 1024 : 8192;
  const float* rpb = p.na_rpb + (size_t)layer * 8 * 15 * 31;
  for (;;) {
    int w0 = 0;
    if (lane == 0) w0 = (int)atomicAdd(ctr, 1u);
    const int task = __builtin_amdgcn_readfirstlane(__shfl(w0, 0));
    if (task >= ntask) break;
    const bool lat = task < 8192;
    int b, h, r = 0, cb = 0, qtok0, R0 = 0, C0 = 0;
    if (lat) { cb = task & 3; r = (task >> 2) & 31; h = (task >> 7) & 7; b = task >> 10; qtok0 = b * 2048 + r * 64 + 16 * cb; R0 = min(max(r - 4, 0), 24); C0 = min(max(16 * cb - 8, 0), 32); }
    else { const int t2 = task - 8192; const int qb = t2 & 15; h = (t2 >> 4) & 7; b = t2 >> 7; qtok0 = TL + b * 256 + 16 * qb; }
    const int tau0 = lat ? 0 : 16;
    const int wtok0 = b * 2048 + R0 * 64 + C0, ctok0 = TL + b * 256;
#define tile_tok(tau) ((tau) < 16 ? wtok0 + ((tau) >> 1) * 64 + 16 * ((tau) & 1) : ctok0 + 16 * ((tau) - 16))
    const bf16_t* qp = p.U + (size_t)(qtok0 + l15) * UW + U_NAQ + 64 * h + 8 * g;
    const bf16x8 qf0 = *(const bf16x8*)qp, qf1 = *(const bf16x8*)(qp + 32);
    f32x4 sc[32];
#pragma unroll
    for (int tau = 0; tau < 32; ++tau) {
      sc[tau] = (f32x4){-INFINITY, -INFINITY, -INFINITY, -INFINITY};
      if (tau >= tau0) {
        const bf16_t* kp = p.U + (size_t)(tile_tok(tau) + l15) * UW + U_NAK + 64 * h + 8 * g;
        const bf16x8 kf0 = *(const bf16x8*)kp, kf1 = *(const bf16x8*)(kp + 32);
        f32x4 a = (f32x4){0.f, 0.f, 0.f, 0.f};
        a = __builtin_amdgcn_mfma_f32_16x16x32_bf16(kf0, qf0, a, 0, 0, 0);
        a = __builtin_amdgcn_mfma_f32_16x16x32_bf16(kf1, qf1, a, 0, 0, 0);
        if (tau < 16) {
          const int qcol = 16 * cb + l15, ws = min(max(qcol - 8, 0), 48);
          const int dr = R0 + (tau >> 1) - r + 7;
#pragma unroll
          for (int rg = 0; rg < 4; ++rg) {
            const int kcol = C0 + 16 * (tau & 1) + 4 * g + rg;
            const bool ok = kcol >= ws && kcol < ws + 16;
            const float bias = ok ? rpb[(h * 15 + dr) * 31 + (kcol - qcol + 15)] : 0.f;
            a[rg] = ok ? a[rg] + bias : -INFINITY;
          }
        }
        sc[tau] = a;
      }
    }
    float mx = -INFINITY;
#pragma unroll
    for (int tau = 0; tau < 32; ++tau) mx = fmaxf(mx, fmaxf(fmaxf(sc[tau][0], sc[tau][1]), fmaxf(sc[tau][2], sc[tau][3])));
    mx = fmaxf(mx, __shfl_xor(mx, 16)); mx = fmaxf(mx, __shfl_xor(mx, 32));
    float sum = 0.f;
#pragma unroll
    for (int tau = 0; tau < 32; ++tau) {
#pragma unroll
      for (int rg = 0; rg < 4; ++rg) { const float e = __expf(sc[tau][rg] - mx); sc[tau][rg] = e; sum += e; }
    }
    sum += __shfl_xor(sum, 16); sum += __shfl_xor(sum, 32);
    f32x4 oacc[4];
#pragma unroll
    for (int dt = 0; dt < 4; ++dt) oacc[dt] = (f32x4){0.f, 0.f, 0.f, 0.f};
    const int kap0 = tau0 >> 1;
    uint4 vr0, vr1, vr2, vr3;
#define NA_VLOAD(KAP) { \
      const int kk0_ = lane >> 3, cc_ = lane & 7; \
      const bf16_t* vb_ = p.U + U_NAV + 64 * h + 8 * cc_; \
      vr0 = *(const uint4*)(vb_ + (size_t)(tile_tok(2 * (KAP)) + kk0_) * UW); \
      vr1 = *(const uint4*)(vb_ + (size_t)(tile_tok(2 * (KAP)) + kk0_ + 8) * UW); \
      vr2 = *(const uint4*)(vb_ + (size_t)(tile_tok(2 * (KAP) + 1) + kk0_) * UW); \
      vr3 = *(const uint4*)(vb_ + (size_t)(tile_tok(2 * (KAP) + 1) + kk0_ + 8) * UW); }
    NA_VLOAD(kap0)
#pragma unroll
    for (int kap = 0; kap < 16; ++kap) {
      if (kap >= kap0) {
        bf16_t* Vb = Vl + (kap & 1) * 32 * NA_VS;
        {
          const int kk0_ = lane >> 3, cc_ = lane & 7;
          *(uint4*)(Vb + kk0_ * NA_VS + 8 * cc_) = vr0; *(uint4*)(Vb + (kk0_ + 8) * NA_VS + 8 * cc_) = vr1;
          *(uint4*)(Vb + (kk0_ + 16) * NA_VS + 8 * cc_) = vr2; *(uint4*)(Vb + (kk0_ + 24) * NA_VS + 8 * cc_) = vr3;
        }
        if (kap + 1 < 16) NA_VLOAD(kap + 1)
        __builtin_amdgcn_fence(__ATOMIC_RELEASE, "workgroup"); __builtin_amdgcn_wave_barrier(); __builtin_amdgcn_fence(__ATOMIC_ACQUIRE, "workgroup");
        bf16x8 pf;
        {
          const unsigned w0_ = pack2(sc[2 * kap][0], sc[2 * kap][1]), w1_ = pack2(sc[2 * kap][2], sc[2 * kap][3]);
          const unsigned w2_ = pack2(sc[2 * kap + 1][0], sc[2 * kap + 1][1]), w3_ = pack2(sc[2 * kap + 1][2], sc[2 * kap + 1][3]);
          pf = (bf16x8){(short)(w0_ & 0xffff), (short)(w0_ >> 16), (short)(w1_ & 0xffff), (short)(w1_ >> 16), (short)(w2_ & 0xffff), (short)(w2_ >> 16), (short)(w3_ & 0xffff), (short)(w3_ >> 16)};
        }
#pragma unroll
        for (int dt = 0; dt < 4; ++dt) {
          const bf16x8 vf = cat8(tr16(Vb + (4 * g + q4) * NA_VS + 16 * dt + 4 * p4), tr16(Vb + (16 + 4 * g + q4) * NA_VS + 16 * dt + 4 * p4));
          oacc[dt] = __builtin_amdgcn_mfma_f32_16x16x32_bf16(vf, pf, oacc[dt], 0, 0, 0);
        }
      }
    }
#undef NA_VLOAD
#undef tile_tok
    const float inv = 1.f / sum;
    bf16_t* op = p.U + (size_t)(qtok0 + l15) * UW + U_YA + 64 * h + 4 * g;
#pragma unroll
    for (int dt = 0; dt < 4; ++dt) {
      uint2 o; o.x = pack2(oacc[dt][0] * inv, oacc[dt][1] * inv); o.y = pack2(oacc[dt][2] * inv, oacc[dt][3] * inv);
      *(uint2*)(op + 16 * dt) = o;
    }
  }
}

__device__ __forceinline__ void norm_row(const float* xr, float rs, const float* alpha, const float* shift, bf16_t* hrow, int lane) {
#pragma unroll
  for (int i = 0; i < 4; ++i) {
    const int k = lane * 4 + 256 * i;
    const float4 v = *(const float4*)(xr + k), a = *(const float4*)(alpha + k), s = *(const float4*)(shift + k);
    uint2 o; o.x = pack2(v.x * rs * a.x + s.x, v.y * rs * a.y + s.y); o.y = pack2(v.z * rs * a.z + s.z, v.w * rs * a.w + s.w);
    *(uint2*)(hrow + k) = o;
  }
}
constexpr int TKW = 2;
__device__ __forceinline__ void phase_fin(PRef p, int layer, int bid, int nb) {
  const int lane = tidx() & 63, wave = tidx() >> 6;
  const int ntok = layer == 0 ? TT : TL;
  const bf16_t* ogf = layer == 0 ? p.OG0 : p.OG1;
  const bf16_t* ogb = ogf + (size_t)(layer == 0 ? TT : TL) * 512;
  const float* gnd = p.dn_o_gain + layer * 64 + 8 * (lane & 7);
  const float* gns = p.ssd_o_gain + layer * 1024 + 16 * lane;
  const float* xlat = layer == 0 ? p.x : p.out;
  const float* xctx = layer == 0 ? p.ctx : p.XC;
  for (int tok0 = (bid * 4 + wave) * TKW; tok0 < ntok; tok0 += nb * 4 * TKW) {
    uint4 a[TKW], bq[TKW], zd[TKW], pa[TKW][2], zs[TKW][2];
    float4 xv[TKW][4];
#pragma unroll
    for (int j = 0; j < TKW; ++j)
#pragma unroll
      for (int i = 0; i < 4; ++i) xv[j][i] = *(const float4*)((tok0 < TL ? xlat + (size_t)(tok0 + j) * DM : xctx + (size_t)(tok0 + j - TL) * DM) + lane * 4 + 256 * i);
#pragma unroll
    for (int j = 0; j < TKW; ++j) {
      const int tok = tok0 + j;
      const bf16_t* ur = p.U + (size_t)tok * UW;
      a[j] = *(const uint4*)(ogf + (size_t)tok * 512 + 8 * lane); bq[j] = *(const uint4*)(ogb + (size_t)tok * 512 + 8 * lane); zd[j] = *(const uint4*)(ur + U_DNZ + 8 * lane);
      pa[j][0] = *(const uint4*)(p.P + (size_t)tok * 1024 + 16 * lane); pa[j][1] = *(const uint4*)(p.P + (size_t)tok * 1024 + 16 * lane + 8);
      zs[j][0] = *(const uint4*)(ur + U_SZ + 16 * lane); zs[j][1] = *(const uint4*)(ur + U_SZ + 16 * lane + 8);
    }
#pragma unroll
    for (int j = 0; j < TKW; ++j) {
      bf16_t* ur = p.U + (size_t)(tok0 + j) * UW;
      {
        float o[8] = {bflo(a[j].x) + bflo(bq[j].x), bfhi(a[j].x) + bfhi(bq[j].x), bflo(a[j].y) + bflo(bq[j].y), bfhi(a[j].y) + bfhi(bq[j].y),
                      bflo(a[j].z) + bflo(bq[j].z), bfhi(a[j].z) + bfhi(bq[j].z), bflo(a[j].w) + bflo(bq[j].w), bfhi(a[j].w) + bfhi(bq[j].w)};
        const float zz[8] = {bflo(zd[j].x), bfhi(zd[j].x), bflo(zd[j].y), bfhi(zd[j].y), bflo(zd[j].z), bfhi(zd[j].z), bflo(zd[j].w), bfhi(zd[j].w)};
        float ss = 0.f;
#pragma unroll
        for (int i = 0; i < 8; ++i) ss += o[i] * o[i];
        ss += __shfl_xor(ss, 1); ss += __shfl_xor(ss, 2); ss += __shfl_xor(ss, 4);
        const float rs = rsqrtf(ss * (1.f / 64.f) + EPS);
#pragma unroll
        for (int i = 0; i < 8; ++i) o[i] = o[i] * rs * gnd[i] * siluf(zz[i]);
        uint4 w; w.x = pack2(o[0], o[1]); w.y = pack2(o[2], o[3]); w.z = pack2(o[4], o[5]); w.w = pack2(o[6], o[7]);
        *(uint4*)(ur + U_YB + 8 * lane) = w;
      }
      {
        float yv[16];
        float ss = 0.f;
#pragma unroll
        for (int hf = 0; hf < 2; ++hf) {
          const uint4 av4 = pa[j][hf], z = zs[j][hf];
          const float av[8] = {bflo(av4.x), bfhi(av4.x), bflo(av4.y), bfhi(av4.y), bflo(av4.z), bfhi(av4.z), bflo(av4.w), bfhi(av4.w)};
          const float zz[8] = {bflo(z.x), bfhi(z.x), bflo(z.y), bfhi(z.y), bflo(z.z), bfhi(z.z), bflo(z.w), bfhi(z.w)};
#pragma unroll
          for (int i = 0; i < 8; ++i) { const float v = av[i] * siluf(zz[i]); yv[8 * hf + i] = v; ss += v * v; }
        }
        ss += __shfl_xor(ss, 1); ss += __shfl_xor(ss, 2); ss += __shfl_xor(ss, 4); ss += __shfl_xor(ss, 8); ss += __shfl_xor(ss, 16);
        const float rs = rsqrtf(ss * (1.f / 512.f) + EPS);
#pragma unroll
        for (int hf = 0; hf < 2; ++hf) {
          uint4 w;
          w.x = pack2(yv[8 * hf + 0] * rs * gns[8 * hf + 0], yv[8 * hf + 1] * rs * gns[8 * hf + 1]);
          w.y = pack2(yv[8 * hf + 2] * rs * gns[8 * hf + 2], yv[8 * hf + 3] * rs * gns[8 * hf + 3]);
          w.z = pack2(yv[8 * hf + 4] * rs * gns[8 * hf + 4], yv[8 * hf + 5] * rs * gns[8 * hf + 5]);
          w.w = pack2(yv[8 * hf + 6] * rs * gns[8 * hf + 6], yv[8 * hf + 7] * rs * gns[8 * hf + 7]);
          *(uint4*)(ur + U_YC + 16 * lane + 8 * hf) = w;
        }
      }
    }
    {
      __builtin_amdgcn_s_waitcnt(0x0F70);
      const float* mr = p.MOD + (size_t)layer * 9 * 6144 + modrow(tok0) * 6144;
      float rs[TKW];
#pragma unroll
      for (int j = 0; j < TKW; ++j) rs[j] = rsqrtf(p.SS[(size_t)(2 * layer) * TT + tok0 + j] * (1.f / DM) + EPS);
#pragma unroll
      for (int i = 0; i < 4; ++i) {
        const int k = lane * 4 + 256 * i;
        const float4 al = *(const float4*)(mr + 1024 + k), sh = *(const float4*)(mr + k);
#pragma unroll
        for (int j = 0; j < TKW; ++j) {
          uint2 o; o.x = pack2(xv[j][i].x * rs[j] * al.x + sh.x, xv[j][i].y * rs[j] * al.y + sh.y); o.y = pack2(xv[j][i].z * rs[j] * al.z + sh.z, xv[j][i].w * rs[j] * al.w + sh.w);
          *(uint2*)(p.P + (size_t)(tok0 + j) * 1024 + k) = o;
        }
      }
    }
  }
}

#define XB_TMO      128
#define XB_XCNT(j)  (256  + 64 * (j))
#define XB_XSUB(j)  (1280 + 64 * (j))
#define XB_XGEN(j)  (2304 + 64 * (j))
#define XB_TOP      3328
#define XB_TOPGEN   3392
#define XCD_BAR_WORDS 3456
#define XB_SPIN_CAP (1u << 20)
__device__ __forceinline__ unsigned xb_ld(unsigned* p)              { return __hip_atomic_load(p, __ATOMIC_RELAXED, __HIP_MEMORY_SCOPE_AGENT); }
__device__ __forceinline__ unsigned xb_add(unsigned* p, unsigned v) { return __hip_atomic_fetch_add(p, v, __ATOMIC_RELAXED, __HIP_MEMORY_SCOPE_AGENT); }
__device__ __forceinline__ unsigned xb_xcc_id() { return (unsigned)__builtin_amdgcn_s_getreg((3 << 11) | 20) & 0xFu; }
#define XB_SPIN(cond, bar) do { unsigned _sp = 0; while (cond) { __builtin_amdgcn_s_sleep(1); \
    if ((++_sp & 255u) == 0u) { if (xb_ld(&(bar)[XB_TMO])) break; if (_sp > XB_SPIN_CAP) { atomicAdd(&(bar)[XB_TMO], 1u); break; } } } } while (0)
struct XcdBarrier { unsigned* bar; unsigned x; volatile LDS_AS unsigned* st; };
__device__ __forceinline__ XcdBarrier xcd_barrier_post(unsigned* bar, volatile LDS_AS unsigned* st) {
  XcdBarrier b; b.bar = bar; b.x = xb_xcc_id(); b.st = st;
  if (threadIdx.x == 0) (void)xb_add(&bar[XB_XCNT(b.x)], 1u);
  return b;
}
__device__ __forceinline__ void xcd_barrier_complete(unsigned* bar, unsigned x, unsigned& nloc, unsigned& nx) {
  const unsigned G = gridDim.x * gridDim.y * gridDim.z;
  unsigned sum, cnt, mine, sp = 0u;
  for (;;) {
    sum = 0u; cnt = 0u; mine = 0u;
#pragma unroll
    for (unsigned j = 0; j < 16; ++j) { const unsigned c = xb_ld(&bar[XB_XCNT(j)]); sum += c; cnt += (c > 0u) ? 1u : 0u; mine = (j == x) ? c : mine; }
    if (sum == G) break;
    __builtin_amdgcn_s_sleep(1);
    if ((++sp & 255u) == 0u) { if (xb_ld(&bar[XB_TMO])) break; if (sp > XB_SPIN_CAP) { atomicAdd(&bar[XB_TMO], 1u); break; } }
  }
  nloc = mine > 0u ? mine : 1u; nx = cnt > 0u ? cnt : 1u;
}
__device__ __forceinline__ void xcd_barrier(const XcdBarrier& b0) {
  asm volatile("s_waitcnt vmcnt(0)" ::: "memory");
  __syncthreads();
  if (threadIdx.x == 0) {
    XcdBarrier b = b0; b.x = xb_xcc_id();
    unsigned* bar = b.bar;
    __builtin_amdgcn_s_waitcnt(0);
    unsigned nloc = b.st[0], nx = b.st[1];
    if (nloc == 0u) { xcd_barrier_complete(bar, b.x, nloc, nx); b.st[0] = nloc; b.st[1] = nx; }
    const unsigned old = xb_add(&bar[XB_XSUB(b.x)], 1u);
    const unsigned gen = old / nloc;
    if (old + 1u == (gen + 1u) * nloc) {
      __builtin_amdgcn_fence(__ATOMIC_RELEASE, "agent");
      asm volatile("s_waitcnt vmcnt(0)" ::: "memory");
      const unsigned og = xb_add(&bar[XB_TOP], 1u);
      const unsigned tg = og / nx;
      if (og + 1u == (tg + 1u) * nx) xb_add(&bar[XB_TOPGEN], 1u);
      else XB_SPIN(xb_ld(&bar[XB_TOPGEN]) == tg, bar);
      __builtin_amdgcn_fence(__ATOMIC_ACQUIRE, "agent");
      xb_add(&bar[XB_XGEN(b.x)], 1u);
      asm volatile("s_waitcnt vmcnt(0)" ::: "memory");
    } else {
      XB_SPIN(xb_ld(&bar[XB_XGEN(b.x)]) == gen, bar);
      __builtin_amdgcn_fence(__ATOMIC_ACQUIRE, "agent");
      asm volatile("s_waitcnt vmcnt(0)" ::: "memory");
    }
  }
  __syncthreads();
}

namespace cg = cooperative_groups;
constexpr int MEGA_LDS = GDN_LDS > SSD_LDS ? GDN_LDS : SSD_LDS;
static_assert(MEGA_LDS <= 81408 && GEMM_LDS_BYTES <= MEGA_LDS && 4 * NA_LDS_WAVE <= MEGA_LDS, "LDS budget");
__global__ void __launch_bounds__(256, 2) k_mega(Params p_unused) {
  const AS4 Params* kp = (const AS4 Params*)__builtin_amdgcn_kernarg_segment_ptr();
#define PP (*p_launder(kp))
  cg::grid_group grid = cg::this_grid();
  __shared__ __attribute__((aligned(16))) char smem[MEGA_LDS];
  const int bid = blockIdx.x, nb = gridDim.x;
  __shared__ uint4 xb_words;
  if (threadIdx.x == 0) xb_words = make_uint4(0u, 0u, 0u, 0u);
  __syncthreads();
  const XcdBarrier xb = xcd_barrier_post(PP.BAR, (volatile LDS_AS unsigned*)&xb_words);
  phase_pro(PP, bid, nb);
  phase_modp(PP, bid, nb, (float*)smem);
  grid.sync();
  phase_modfin(PP, bid, nb);
  xcd_barrier(xb);
  phase_norm(PP, 0, 0, bid, nb);
  xcd_barrier(xb);
#pragma unroll 1
  for (int layer = 0; layer < 2; ++layer) {
    phase_g1(PP, layer, bid, nb, (bf16_t*)smem);
    xcd_barrier(xb);
    phase_prep(PP, layer, bid, nb, (bf16_t*)smem);
    xcd_barrier(xb);
    {
      __shared__ int s_role;
      unsigned* chain_ctr = PP.CTR + 8 + layer;
      if (threadIdx.x == 0) {
        const unsigned key = (((unsigned)__builtin_amdgcn_s_getreg((3 << 11) | 20) & 0xFu) << 8) | (((unsigned)__builtin_amdgcn_s_getreg(63492) >> 8) & 0xffu);
        const unsigned slot = nb > 256 ? atomicAdd(PP.CTR + 64 + 2048 * layer + key, 1u) : 0u;
        s_role = slot == 0 ? (int)atomicAdd(chain_ctr, 1u) : 1 << 20;
      }
      __syncthreads();
      int c = s_role;
      __syncthreads();
      if (c < 128) phase_gdn(PP, layer, c, smem); else if (c < 256) phase_ssd(PP, layer, c - 128, smem);
      __syncthreads();
      phase_na(PP, layer, PP.CTR + layer, smem);
      for (;;) {
        __syncthreads();
        if (threadIdx.x == 0) s_role = (int)atomicAdd(chain_ctr, 1u);
        __syncthreads();
        c = s_role;
        if (c >= 256) break;
        if (c < 128) phase_gdn(PP, layer, c, smem); else phase_ssd(PP, layer, c - 128, smem);
      }
    }
    xcd_barrier(xb);
    phase_fin(PP, layer, bid, nb);
    xcd_barrier(xb);
    phase_g2a(PP, layer, bid, nb, (bf16_t*)smem);
    xcd_barrier(xb);
    phase_g2b(PP, layer, bid, nb, (bf16_t*)smem);
    xcd_barrier(xb);
    phase_g3(PP, layer, bid, nb, (bf16_t*)smem);
    xcd_barrier(xb);
    phase_norm(PP, layer, 1, bid, nb);
    xcd_barrier(xb);
    phase_g4(PP, layer, bid, nb, (bf16_t*)smem);
    xcd_barrier(xb);
    phase_g5(PP, layer, bid, nb, (bf16_t*)smem);
    if (layer == 0) { xcd_barrier(xb); phase_norm(PP, 1, 0, bid, nb); xcd_barrier(xb); }
  }
#undef PP
}

extern "C" void kernel_launch(void* const* d_in, const int* in_sizes, int n_in, void* d_out, int out_size, void* d_ws, size_t ws_size,
                              hipStream_t stream) {
  Params p{};
  const float** fp = (const float**)&p;
  for (int i = 0; i < 28; ++i) fp[i] = (const float*)d_in[i];
  p.out = (float*)d_out;
  char* ws = (char*)d_ws;
  size_t off = 0;
  auto take = [&](size_t bytes) { char* r = ws + off; off += (bytes + 255) & ~(size_t)255; return r; };
  p.U = (bf16_t*)take((size_t)TT * UW * 2);
  p.S = (float*)take((size_t)TT * SWD * 4);
  p.MOD = (float*)take((size_t)2 * 9 * 6144 * 4);
  p.SS = (float*)take((size_t)4 * TT * 4);
  p.ROPE = (float*)take(64 * 16 * 2 * 4);
  p.BAR = (unsigned*)take((size_t)XCD_BAR_WORDS * 4 + (64 + 2 * 2048) * 4);
  p.CTR = p.BAR + XCD_BAR_WORDS;
  p.P = (bf16_t*)take((size_t)TT * 1024 * 2);
  p.XC = (float*)take((size_t)TC * 1024 * 4);
  p.HB = (bf16_t*)p.XC;
  p.OG0 = (bf16_t*)d_out;
  p.OG1 = (bf16_t*)((char*)p.P + (size_t)TL * 1024 * 2);
  const size_t need = (size_t)((char*)p.OG1 - ws) + (size_t)2 * TL * 512 * 2;
  if (need > ws_size) { fprintf(stderr, "workspace too small: need %zu have %zu\n", need, ws_size); return; }
  static int grid_blocks = 0;
  if (!grid_blocks) {
    int dev = 0, cus = 0, per_cu = 0;
    hipGetDevice(&dev);
    hipDeviceGetAttribute(&cus, hipDeviceAttributeMultiprocessorCount, dev);
    hipOccupancyMaxActiveBlocksPerMultiprocessor(&per_cu, k_mega, 256, 0);
    if (per_cu > 2) per_cu = 2;
    grid_blocks = cus * per_cu;
  }
  hipMemsetAsync(p.BAR, 0, (size_t)XCD_BAR_WORDS * 4 + (64 + 2 * 2048) * 4, stream);
  void* args[] = {&p};
  hipError_t e = hipLaunchCooperativeKernel((void*)k_mega, dim3(grid_blocks), dim3(256), args, 0, stream);
  if (e != hipSuccess) fprintf(stderr, "cooperative launch failed: %s (grid %d)\n", hipGetErrorString(e), grid_blocks);
}
```

```cpp
#include <hip/hip_runtime.h>
#include <hip/hip_cooperative_groups.h>
#include <cstdio>
#include <cstdint>

typedef unsigned short bf16_t;
typedef short bf16x8 __attribute__((ext_vector_type(8)));
typedef short s16x4 __attribute__((ext_vector_type(4)));
typedef float f32x4 __attribute__((ext_vector_type(4)));
#define LDS_AS __attribute__((address_space(3)))

constexpr int TL = 16384;
constexpr int TC = 2048;
constexpr int TT = TL + TC;
constexpr int DM = 1024;
constexpr int UW = 6144;
constexpr int SWD = 64;
constexpr int DIN = 9280;
constexpr int DFF = 4096;
constexpr float EPS = 1e-6f;
constexpr int U_NAQ = 0, U_NAK = 512, U_NAV = 1024;
constexpr int U_DNQ = 1536, U_DNK = 2048, U_DNV = 2560, U_DNZ = 3072;
constexpr int U_SZ = 3584, U_SX = 4608, U_SB = 5632, U_SC = 5888;
constexpr int U_YA = 0, U_YB = 512, U_YC = 1024, U_GATE = 2048, U_M = 5120;

struct Params {
  const float *x, *c, *ctx, *c_ctx, *w_ada, *b_ada, *norm1_g, *norm2_g, *w_in, *na_q_gain, *na_k_gain, *na_rpb,
      *dn_conv_w, *dn_a_log, *dn_dt_bias, *dn_o_gain, *ssd_conv_w, *ssd_conv_b, *ssd_a_log, *ssd_dt_bias, *ssd_d,
      *ssd_o_gain, *w_pa, *w_pb, *w_pc, *w_out, *w_ff1, *w_ff2;
  float* out;
  bf16_t* U;
  float* S;
  bf16_t* P;
  float* XC;
  bf16_t* WT;
  float* MOD;
  float* SS;
  float* ROPE;
  unsigned* BAR;
  unsigned* CTR;
  bf16_t* HB;
  bf16_t* OG0;
  bf16_t* OG1;
};

#define AS4 __attribute__((address_space(4)))
typedef const AS4 Params& PRef;
__device__ __forceinline__ const AS4 Params* p_launder(const AS4 Params* q) { asm volatile("" : "+s"(q)); return q; }

__device__ __forceinline__ int tidx() { int t = threadIdx.x; asm volatile("" : "+v"(t)); return t; }
__device__ __forceinline__ float bf2f(bf16_t v) { return __uint_as_float(((unsigned)v) << 16); }
__device__ __forceinline__ bf16_t f2bf(float f) {
  unsigned u = __float_as_uint(f);
  u += 0x7fffu + ((u >> 16) & 1u);
  return (bf16_t)(u >> 16);
}
__device__ __forceinline__ unsigned pack2(float a, float b) { return (unsigned)f2bf(a) | ((unsigned)f2bf(b) << 16); }
__device__ __forceinline__ float bflo(unsigned w) { return __uint_as_float(w << 16); }
__device__ __forceinline__ float bfhi(unsigned w) { return __uint_as_float(w & 0xffff0000u); }
__device__ __forceinline__ float wave_sum(float v) {
#pragma unroll
  for (int o = 32; o; o >>= 1) v += __shfl_xor(v, o);
  return v;
}
__device__ __forceinline__ float wave_max(float v) {
#pragma unroll
  for (int o = 32; o; o >>= 1) v = fmaxf(v, __shfl_xor(v, o));
  return v;
}
__device__ __forceinline__ float siluf(float v) { return v * __builtin_amdgcn_rcpf(1.f + __expf(-v)); }
__device__ __forceinline__ float sigmoidf_(float v) { return __builtin_amdgcn_rcpf(1.f + __expf(-v)); }
__device__ __forceinline__ float softplusf_(float v) {
  const float u = __expf(fminf(v, 20.f));
  const float sp = u < 0.01f ? u * (1.f - u * (0.5f - u * (1.f / 3.f))) : __logf(1.f + u);
  return v > 20.f ? v : sp;
}

__device__ __forceinline__ const float* xrow_in(PRef p, int layer, int row) {
  if (layer == 0) return row < TL ? p.x + (size_t)row * DM : p.ctx + (size_t)(row - TL) * DM;
  return row < TL ? p.out + (size_t)row * DM : p.XC + (size_t)(row - TL) * DM;
}
__device__ __forceinline__ float* xrow_out(PRef p, int row) {
  return row < TL ? p.out + (size_t)row * DM : p.XC + (size_t)(row - TL) * DM;
}
__device__ __forceinline__ int modrow(int row) { return row < TL ? (row >> 11) : 8; }

constexpr int G_BK = 32;
constexpr int G_ASTR = G_BK + 8;
constexpr int G_ATILE = 256 * G_ASTR;
constexpr int GEMM_LDS_BYTES = 2 * (G_ATILE + G_BK * (128 + 16)) * 2;
__device__ __forceinline__ s16x4 tr16(const bf16_t* ptr) { return __builtin_amdgcn_ds_read_tr16_b64_v4i16((LDS_AS s16x4*)ptr); }
__device__ __forceinline__ bf16x8 cat8(s16x4 lo, s16x4 hi) { return (bf16x8){lo[0], lo[1], lo[2], lo[3], hi[0], hi[1], hi[2], hi[3]}; }
__device__ __forceinline__ uint4 cvt8(float4 a, float4 b) { uint4 o; o.x = pack2(a.x, a.y); o.y = pack2(a.z, a.w); o.z = pack2(b.x, b.y); o.w = pack2(b.z, b.w); return o; }

__device__ __forceinline__ void gemm_main2(f32x4 (&acc)[8][2], const bf16_t* A, int astride, const bf16_t* W, int ldw, int col0, int K, bf16_t* lds) {
  constexpr int NI = 2, BSTR = 80, BTILE = G_BK * BSTR;
  const int tid = tidx(), lane = tid & 63, wave = tid >> 6, wm = wave >> 1, wn = wave & 1, g = lane >> 4, l15 = lane & 15, q4 = l15 >> 2, p4 = lane & 3;
  bf16_t* As = lds;
  bf16_t* Bs = lds + 2 * G_ATILE;
  const int ar = tid >> 2, ak = (tid & 3) * 8;
  const int bk = tid >> 3, bn = (tid & 7) * 8;
  const int rho0 = (bk & 3) + 4 * ((bk >> 3) & 3) + 16 * ((bk >> 2) & 1);
  const bf16_t* ap = A + (size_t)ar * astride + ak;
  const bf16_t* bp = W + (size_t)bk * ldw + col0 + bn;
  bf16_t* aw = As + ar * G_ASTR + ak;
  bf16_t* bw = Bs + rho0 * BSTR + bn;
  uint4 ra0, ra1, ra2, ra3, rb0;
#define G_LOADS(K1) { ra0 = *(const uint4*)(ap + (size_t)(64 * 0) * astride + (K1)); ra1 = *(const uint4*)(ap + (size_t)(64 * 1) * astride + (K1)); ra2 = *(const uint4*)(ap + (size_t)(64 * 2) * astride + (K1)); ra3 = *(const uint4*)(ap + (size_t)(64 * 3) * astride + (K1)); rb0 = *(const uint4*)(bp + (size_t)(K1) * ldw); }
#define G_STORES(NX) { *(uint4*)(aw + (NX) * G_ATILE + 64 * 0 * G_ASTR) = ra0; *(uint4*)(aw + (NX) * G_ATILE + 64 * 1 * G_ASTR) = ra1; *(uint4*)(aw + (NX) * G_ATILE + 64 * 2 * G_ASTR) = ra2; *(uint4*)(aw + (NX) * G_ATILE + 64 * 3 * G_ASTR) = ra3; *(uint4*)(bw + (NX) * BTILE + 0 * BSTR) = rb0; }
  G_LOADS(0)
  G_STORES(0)
  __syncthreads();
  const int nk = K / G_BK;
  for (int kt = 0; kt < nk; ++kt) {
    const int cur = kt & 1;
    const int k1 = (kt + 1 < nk ? kt + 1 : kt) * G_BK;
    G_LOADS(k1)
    asm volatile("" ::: "memory");
    const bf16_t* Ac = As + cur * G_ATILE + (128 * wm + l15) * G_ASTR + 8 * g;
    const bf16_t* Bc = Bs + cur * BTILE + (4 * g + q4) * BSTR + 16 * NI * wn + 4 * p4;
    {
      bf16x8 af[8], bfr[NI];
#pragma unroll
      for (int mi = 0; mi < 8; ++mi) af[mi] = *(const bf16x8*)(Ac + mi * 16 * G_ASTR);
#pragma unroll
      for (int ni = 0; ni < NI; ++ni) bfr[ni] = cat8(tr16(Bc + 16 * ni), tr16(Bc + 16 * BSTR + 16 * ni));
#pragma unroll
      for (int mi = 0; mi < 8; ++mi)
#pragma unroll
        for (int ni = 0; ni < NI; ++ni) acc[mi][ni] = __builtin_amdgcn_mfma_f32_16x16x32_bf16(bfr[ni], af[mi], acc[mi][ni], 0, 0, 0);
    }
    asm volatile("" ::: "memory");
    __builtin_amdgcn_sched_barrier(0);
    G_STORES(cur ^ 1)
    __syncthreads();
  }
#undef G_LOADS
#undef G_STORES
}
__device__ __forceinline__ void gemm_main4(f32x4 (&acc)[8][4], const bf16_t* A, int astride, const bf16_t* W, int ldw, int col0, int K, bf16_t* lds) {
  constexpr int NI = 4, BSTR = 144, BTILE = G_BK * BSTR;
  const int tid = tidx(), lane = tid & 63, wave = tid >> 6, wm = wave >> 1, wn = wave & 1, g = lane >> 4, l15 = lane & 15, q4 = l15 >> 2, p4 = lane & 3;
  bf16_t* As = lds;
  bf16_t* Bs = lds + 2 * G_ATILE;
  const int ar = tid >> 2, ak = (tid & 3) * 8;
  const int bk = tid >> 4, bn = (tid & 15) * 8;
  const int rho0 = (bk & 3) + 4 * (bk >> 3) + 16 * ((bk >> 2) & 1);
  const bf16_t* ap = A + (size_t)ar * astride + ak;
  const bf16_t* bp = W + (size_t)bk * ldw + col0 + bn;
  bf16_t* aw = As + ar * G_ASTR + ak;
  bf16_t* bw = Bs + rho0 * BSTR + bn;
  uint4 ra0, ra1, ra2, ra3, rb0, rb1;
#define G_LOADS(K1) { ra0 = *(const uint4*)(ap + (size_t)(64 * 0) * astride + (K1)); ra1 = *(const uint4*)(ap + (size_t)(64 * 1) * astride + (K1)); ra2 = *(const uint4*)(ap + (size_t)(64 * 2) * astride + (K1)); ra3 = *(const uint4*)(ap + (size_t)(64 * 3) * astride + (K1)); rb0 = *(const uint4*)(bp + (size_t)((K1) + 16 * 0) * ldw); rb1 = *(const uint4*)(bp + (size_t)((K1) + 16 * 1) * ldw); }
#define G_STORES(NX) { *(uint4*)(aw + (NX) * G_ATILE + 64 * 0 * G_ASTR) = ra0; *(uint4*)(aw + (NX) * G_ATILE + 64 * 1 * G_ASTR) = ra1; *(uint4*)(aw + (NX) * G_ATILE + 64 * 2 * G_ASTR) = ra2; *(uint4*)(aw + (NX) * G_ATILE + 64 * 3 * G_ASTR) = ra3; *(uint4*)(bw + (NX) * BTILE + 0 * BSTR) = rb0; *(uint4*)(bw + (NX) * BTILE + 8 * BSTR) = rb1; }
  G_LOADS(0)
  G_STORES(0)
  __syncthreads();
  const int nk = K / G_BK;
  for (int kt = 0; kt < nk; ++kt) {
    const int cur = kt & 1;
    const int k1 = (kt + 1 < nk ? kt + 1 : kt) * G_BK;
    G_LOADS(k1)
    asm volatile("" ::: "memory");
    const bf16_t* Ac = As + cur * G_ATILE + (128 * wm + l15) * G_ASTR + 8 * g;
    const bf16_t* Bc = Bs + cur * BTILE + (4 * g + q4) * BSTR + 16 * NI * wn + 4 * p4;
    {
      bf16x8 af[8], bfr[NI];
#pragma unroll
      for (int mi = 0; mi < 8; ++mi) af[mi] = *(const bf16x8*)(Ac + mi * 16 * G_ASTR);
#pragma unroll
      for (int ni = 0; ni < NI; ++ni) bfr[ni] = cat8(tr16(Bc + 16 * ni), tr16(Bc + 16 * BSTR + 16 * ni));
#pragma unroll
      for (int mi = 0; mi < 8; ++mi)
#pragma unroll
        for (int ni = 0; ni < NI; ++ni) acc[mi][ni] = __builtin_amdgcn_mfma_f32_16x16x32_bf16(bfr[ni], af[mi], acc[mi][ni], 0, 0, 0);
    }
    asm volatile("" ::: "memory");
    __builtin_amdgcn_sched_barrier(0);
    G_STORES(cur ^ 1)
    __syncthreads();
  }
#undef G_LOADS
#undef G_STORES
}
template <int NI> __device__ __forceinline__ void acc_zero(f32x4 (&acc)[8][NI]) {
#pragma unroll
  for (int i = 0; i < 8; ++i)
#pragma unroll
    for (int j = 0; j < NI; ++j) acc[i][j] = (f32x4){0.f, 0.f, 0.f, 0.f};
}
__device__ __forceinline__ void wconv(const float* src, int sld, int soff, bool win_order, bf16_t* dst, int dld, int rows, int cols, int bid, int nb) {
  const int cpr = cols >> 3, total = rows * cpr;
  for (int i = bid * 256 + tidx(); i < total; i += nb * 256) {
    const int r = i / cpr, c = (i - r * cpr) << 3;
    int sc = c + soff;
    if (win_order) { if (c < 3584) sc = c; else if (c < 6144) sc = c + 32; else { const int o = c - 6144; sc = o < 32 ? 3584 + o : (o < 64 ? 6176 + o - 32 : -1); } }
    uint4 o = make_uint4(0u, 0u, 0u, 0u);
    if (sc >= 0) { const float* sp = src + (size_t)r * sld + sc; o = cvt8(*(const float4*)sp, *(const float4*)(sp + 4)); }
    *(uint4*)(dst + (size_t)r * dld + c) = o;
  }
}
constexpr int WIN_LD = 6272;
constexpr int U_W = 5120;
constexpr int UWR_G = 0, UWR_PA = 3072, UWR_PB = 3584, UWR_PC = 4096, UWR_OUT = 5120;
__device__ __forceinline__ bool tile_next(int i, int bid, int nb, int nMt, int nNt, bool nsplit, int& mt, int& nt) {
  const int xcd = bid & 7, slot = bid >> 3, nslots = nb >> 3;
  const int j = slot + i * nslots;
  if (nsplit) {
    const int nNx = (nNt - xcd + 7) >> 3;
    if (j >= nMt * nNx) return false;
    mt = j / nNx; nt = xcd + 8 * (j % nNx);
  } else {
    const int nMx = (nMt - xcd + 7) >> 3;
    if (j >= nMx * nNt) return false;
    mt = xcd + 8 * (j / nNt); nt = j % nNt;
  }
  return true;
}
#define EPI_IDS const int lane = tidx() & 63, wave = tidx() >> 6, wm = wave >> 1, wn = wave & 1, g = lane >> 4, l15 = lane & 15

__device__ __forceinline__ void phase_pro(PRef p, int bid, int nb) {
  const int tid = tidx(), lane = tid & 63, wave = tid >> 6;
  for (int row = bid * 4 + wave; row < TT; row += nb * 4) {
    const float* xr = xrow_in(p, 0, row);
    float s = 0.f;
#pragma unroll
    for (int i = 0; i < 4; ++i) { const float4 v = *(const float4*)(xr + lane * 4 + 256 * i); s += v.x * v.x + v.y * v.y + v.z * v.z + v.w * v.w; }
    s = wave_sum(s);
    if (lane == 0) { p.SS[row] = s; p.SS[TT + row] = 0.f; p.SS[2 * TT + row] = 0.f; p.SS[3 * TT + row] = 0.f; }
  }
  for (int i = bid * 256 + tid; i < 64 * 16; i += nb * 256) {
    const int pos = i >> 4, fi = i & 15;
    const float inv = __builtin_amdgcn_exp2f(-(float)fi * 0.83048202372184f);
    float ang = (float)pos * inv;
    const float kk = rintf(ang * 0.15915494309189535f);
    ang = fmaf(-kk, 6.2831854820251465f, ang); ang = fmaf(-kk, -1.7484555314695172e-07f, ang);
    p.ROPE[2 * i] = __cosf(ang); p.ROPE[2 * i + 1] = __sinf(ang);
  }
}
__device__ __forceinline__ void phase_modp(PRef p, int bid, int nb, float* lds) {
  const int tid = tidx();
  float* MODP = (float*)p.U;
  for (int u = bid; u < 768; u += nb) {
    const int ks = u & 15, cb = (u >> 4) % 24, l = u / 384, n = cb * 256 + tid;
    __syncthreads();
    for (int i = tid; i < 9 * 64; i += 256) { const int r = i >> 6, k = 64 * ks + (i & 63); const float v = r < 8 ? p.c[r * 1024 + k] : p.c_ctx[k]; lds[i] = siluf(v); }
    __syncthreads();
    float acc[9];
#pragma unroll
    for (int r = 0; r < 9; ++r) acc[r] = 0.f;
    const float* w = p.w_ada + ((size_t)l * 1024 + 64 * ks) * 6144 + n;
#pragma unroll 16
    for (int k = 0; k < 64; ++k) {
      const float wv = w[(size_t)k * 6144];
#pragma unroll
      for (int r = 0; r < 9; ++r) acc[r] += lds[r * 64 + k] * wv;
    }
#pragma unroll
    for (int r = 0; r < 9; ++r) MODP[((size_t)(ks * 2 + l) * 9 + r) * 6144 + n] = acc[r];
  }
}
__device__ __forceinline__ void phase_modfin(PRef p, int bid, int nb) {
  const float* MODP = (const float*)p.U;
  for (int i = bid * 256 + tidx(); i < 2 * 9 * 6144; i += nb * 256) {
    const int l = i / (9 * 6144), rem = i % (9 * 6144), r = rem / 6144, n = rem % 6144;
    float v = p.b_ada[l * 6144 + n];
#pragma unroll
    for (int ks = 0; ks < 16; ++ks) v += MODP[((size_t)(ks * 2 + l) * 9 + r) * 6144 + n];
    const int chunk = n >> 10, kk = n & 1023;
    if (chunk == 1) v = p.norm1_g[l * 1024 + kk] * (1.f + v);
    if (chunk == 4) v = p.norm2_g[l * 1024 + kk] * (1.f + v);
    p.MOD[i] = v;
  }
}

__device__ __forceinline__ void norm_rows4(const float* x0, const float* x1, const float* x2, const float* x3, const float* ss, int row0, const float* alpha, const float* shift, bf16_t* h0, int lane) {
  const float* xr[4] = {x0, x1, x2, x3};
  float4 v[4][4];
#pragma unroll
  for (int j = 0; j < 4; ++j)
#pragma unroll
    for (int i = 0; i < 4; ++i) v[j][i] = *(const float4*)(xr[j] + lane * 4 + 256 * i);
  float rs[4];
#pragma unroll
  for (int j = 0; j < 4; ++j) rs[j] = rsqrtf(ss[row0 + j] * (1.f / DM) + EPS);
#pragma unroll
  for (int i = 0; i < 4; ++i) {
    const int k = lane * 4 + 256 * i;
    const float4 a = *(const float4*)(alpha + k), s = *(const float4*)(shift + k);
#pragma unroll
    for (int j = 0; j < 4; ++j) {
      uint2 o; o.x = pack2(v[j][i].x * rs[j] * a.x + s.x, v[j][i].y * rs[j] * a.y + s.y); o.y = pack2(v[j][i].z * rs[j] * a.z + s.z, v[j][i].w * rs[j] * a.w + s.w);
      *(uint2*)(h0 + (size_t)j * 1024 + k) = o;
    }
  }
}
__device__ __forceinline__ void phase_norm(PRef p, int layer, int which, int bid, int nb) {
  if (which == 0) wconv(p.w_in + (size_t)layer * 1024 * DIN, DIN, 0, true, p.WT, WIN_LD, 1024, WIN_LD, bid, nb);
  else {
    wconv(p.w_ff1 + (size_t)layer * 1024 * DFF, DFF, 0, false, p.WT, DFF, 1024, DFF, bid, nb);
    wconv(p.w_ff2 + (size_t)layer * DFF * 1024, 1024, 0, false, p.WT + (size_t)1024 * DFF, 1024, DFF, 1024, bid, nb);
  }
  const int lane = tidx() & 63, wave = tidx() >> 6;
  const int nrow = (which == 1 && layer == 1) ? TL : TT;
  const float* modl = p.MOD + (size_t)layer * 9 * 6144;
  const float* ss = p.SS + (size_t)(2 * layer + which) * TT;
  const int lin = which == 0 ? layer : 1;
  for (int row = (bid * 4 + wave) * 4; row < nrow; row += nb * 16) {
    const float* mr = modl + modrow(row) * 6144;
    norm_rows4(xrow_in(p, lin, row), xrow_in(p, lin, row + 1), xrow_in(p, lin, row + 2), xrow_in(p, lin, row + 3), ss, row,
               mr + (which ? 4096 : 1024), mr + (which ? 3072 : 0), p.P + (size_t)row * 1024, lane);
  }
}

__device__ __forceinline__ void phase_g1(PRef p, int layer, int bid, int nb, bf16_t* lds) {
  constexpr bool NSPLIT = true;
  const int nMt = TT / 256, nNt = 49;
  EPI_IDS;
  for (int ti = 0;; ++ti) {
    int mt, nt; if (!tile_next(ti, bid, nb, nMt, nNt, NSPLIT, mt, nt)) break;
    const int m0 = mt * 256, n0 = nt * 128;
    f32x4 acc[8][4]; acc_zero<4>(acc);
    gemm_main4(acc, p.P + (size_t)m0 * 1024, 1024, p.WT, WIN_LD, n0, 1024, lds);
    if (n0 < 1024) {
      const float* gain = (n0 < 512 ? p.na_q_gain : p.na_k_gain) + layer * 64;
      const float mul = n0 < 512 ? 0.125f : 1.f;
#pragma unroll
      for (int mi = 0; mi < 8; ++mi) {
        float ss = 0.f;
#pragma unroll
        for (int ni = 0; ni < 4; ++ni) ss += acc[mi][ni][0] * acc[mi][ni][0] + acc[mi][ni][1] * acc[mi][ni][1] + acc[mi][ni][2] * acc[mi][ni][2] + acc[mi][ni][3] * acc[mi][ni][3];
        ss += __shfl_xor(ss, 16); ss += __shfl_xor(ss, 32);
        const float rs = rsqrtf(ss * (1.f / 64.f) + EPS) * mul;
        const int row = m0 + 128 * wm + 16 * mi + l15;
#pragma unroll
        for (int ni = 0; ni < 4; ++ni) {
          const int cl = 16 * ni + 4 * g;
          const float4 gv = *(const float4*)(gain + cl);
          uint2 o; o.x = pack2(acc[mi][ni][0] * rs * gv.x, acc[mi][ni][1] * rs * gv.y); o.y = pack2(acc[mi][ni][2] * rs * gv.z, acc[mi][ni][3] * rs * gv.w);
          *(uint2*)(p.U + (size_t)row * UW + n0 + 64 * wn + cl) = o;
        }
      }
    } else if (n0 < 6144) {
      const bool hsec = (n0 >= 1536 && n0 < 3072) || n0 >= 4608;
      const int hcol0 = n0 < 3072 ? n0 - 1536 : n0 - 3072;
#pragma unroll
      for (int mi = 0; mi < 8; ++mi) {
        const int row = m0 + 128 * wm + 16 * mi + l15;
        const int rr = row & 63;
        const bool halo = hsec && (rr < 2 || rr >= 62);
        bf16_t* hb = p.HB + ((size_t)(row >> 6) * 4 + (rr < 2 ? rr : rr - 60)) * 3072 + hcol0 + 64 * wn + 4 * g;
#pragma unroll
        for (int ni = 0; ni < 4; ++ni) {
          uint2 o; o.x = pack2(acc[mi][ni][0], acc[mi][ni][1]); o.y = pack2(acc[mi][ni][2], acc[mi][ni][3]);
          *(uint2*)(p.U + (size_t)row * UW + n0 + 64 * wn + 16 * ni + 4 * g) = o;
          if (halo) *(uint2*)(hb + 16 * ni) = o;
        }
      }
    } else if (wn == 0) {
#pragma unroll
      for (int mi = 0; mi < 8; ++mi) {
        const int row = m0 + 128 * wm + 16 * mi + l15;
#pragma unroll
        for (int ni = 0; ni < 4; ++ni) *(f32x4*)(p.S + (size_t)row * SWD + 16 * ni + 4 * g) = acc[mi][ni];
      }
    }
  }
}

__device__ __forceinline__ void phase_g2a(PRef p, int layer, int bid, int nb, bf16_t* lds) {
  constexpr bool NSPLIT = true;
  const int nMt = (layer == 0 ? TT : TL) / 256, nNt = 24;
  EPI_IDS;
  for (int ti = 0;; ++ti) {
    int mt, nt; if (!tile_next(ti, bid, nb, nMt, nNt, NSPLIT, mt, nt)) break;
    const int m0 = mt * 256, n0 = nt * 128;
    f32x4 acc[8][4]; acc_zero<4>(acc);
    gemm_main4(acc, p.P + (size_t)m0 * 1024, 1024, p.U + U_W + (size_t)(UWR_G + 1024 * (n0 >> 10)) * UW, UW, n0 & 1023, 1024, lds);
#pragma unroll
    for (int mi = 0; mi < 8; ++mi) {
      const int row = m0 + 128 * wm + 16 * mi + l15;
#pragma unroll
      for (int ni = 0; ni < 4; ++ni) {
        uint2 o; o.x = pack2(sigmoidf_(acc[mi][ni][0]), sigmoidf_(acc[mi][ni][1])); o.y = pack2(sigmoidf_(acc[mi][ni][2]), sigmoidf_(acc[mi][ni][3]));
        *(uint2*)(p.U + (size_t)row * UW + U_GATE + n0 + 64 * wn + 16 * ni + 4 * g) = o;
      }
    }
  }
}
__device__ __forceinline__ void phase_g2b(PRef p, int layer, int bid, int nb, bf16_t* lds) {
  constexpr bool NSPLIT = false;
  const int nMt = (layer == 0 ? TT : TL) / 256, nNt = 16;
  EPI_IDS;
  for (int ti = 0;; ++ti) {
    int mt, nt; if (!tile_next(ti, bid, nb, nMt, nNt, NSPLIT, mt, nt)) break;
    const int m0 = mt * 256, n0 = nt * 64;
    f32x4 accm[8][2]; acc_zero<2>(accm);
#pragma unroll 1
    for (int i = 0; i < 3; ++i) {
      const int ycol = i == 0 ? U_YA : (i == 1 ? U_YB : U_YC);
      const int Ki = i == 2 ? 1024 : 512;
      const bf16_t* w = p.U + U_W + (size_t)(i == 0 ? UWR_PA : (i == 1 ? UWR_PB : UWR_PC)) * UW;
      f32x4 acc[8][2]; acc_zero<2>(acc);
      gemm_main2(acc, p.U + (size_t)m0 * UW + ycol, UW, w, UW, n0, Ki, lds);
#pragma unroll
      for (int mi = 0; mi < 8; ++mi) {
        const int row = m0 + 128 * wm + 16 * mi + l15;
#pragma unroll
        for (int ni = 0; ni < 2; ++ni) {
          const uint2 gt = *(const uint2*)(p.U + (size_t)row * UW + U_GATE + 1024 * i + n0 + 32 * wn + 16 * ni + 4 * g);
          accm[mi][ni][0] += bflo(gt.x) * acc[mi][ni][0]; accm[mi][ni][1] += bfhi(gt.x) * acc[mi][ni][1];
          accm[mi][ni][2] += bflo(gt.y) * acc[mi][ni][2]; accm[mi][ni][3] += bfhi(gt.y) * acc[mi][ni][3];
        }
      }
    }
#pragma unroll
    for (int mi = 0; mi < 8; ++mi) {
      const int row = m0 + 128 * wm + 16 * mi + l15;
#pragma unroll
      for (int ni = 0; ni < 2; ++ni) {
        uint2 o; o.x = pack2(accm[mi][ni][0], accm[mi][ni][1]); o.y = pack2(accm[mi][ni][2], accm[mi][ni][3]);
        *(uint2*)(p.P + (size_t)row * 1024 + n0 + 32 * wn + 16 * ni + 4 * g) = o;
      }
    }
  }
}
__device__ __forceinline__ void epi_residual(PRef p, const f32x4 (&acc)[8][4], int layer_in, int m0, int n0, const float* gate, float* ssacc) {
  EPI_IDS;
#pragma unroll
  for (int mi = 0; mi < 8; ++mi) {
    const int row = m0 + 128 * wm + 16 * mi + l15;
    const float* xi = xrow_in(p, layer_in, row);
    float* xo = xrow_out(p, row);
    const float* gr = gate + modrow(row) * 6144;
    float ss = 0.f;
#pragma unroll
    for (int ni = 0; ni < 4; ++ni) {
      const int col = n0 + 64 * wn + 16 * ni + 4 * g;
      const float4 xv = *(const float4*)(xi + col);
      const float4 gv = *(const float4*)(gr + col);
      float4 o;
      o.x = xv.x + gv.x * acc[mi][ni][0]; o.y = xv.y + gv.y * acc[mi][ni][1]; o.z = xv.z + gv.z * acc[mi][ni][2]; o.w = xv.w + gv.w * acc[mi][ni][3];
      *(float4*)(xo + col) = o;
      ss += o.x * o.x + o.y * o.y + o.z * o.z + o.w * o.w;
    }
    if (ssacc) {
      ss += __shfl_xor(ss, 16); ss += __shfl_xor(ss, 32);
      if (g == 0) atomicAdd(ssacc + row, ss);
    }
  }
}
__device__ __forceinline__ void phase_g3(PRef p, int layer, int bid, int nb, bf16_t* lds) {
  constexpr bool NSPLIT = false;
  const int nMt = (layer == 0 ? TT : TL) / 256, nNt = 8;
  const float* modl = p.MOD + (size_t)layer * 9 * 6144;
  for (int ti = 0;; ++ti) {
    int mt, nt; if (!tile_next(ti, bid, nb, nMt, nNt, NSPLIT, mt, nt)) break;
    const int m0 = mt * 256, n0 = nt * 128;
    f32x4 acc[8][4]; acc_zero<4>(acc);
    gemm_main4(acc, p.P + (size_t)m0 * 1024, 1024, p.U + U_W + (size_t)UWR_OUT * UW, UW, n0, 1024, lds);
    epi_residual(p, acc, layer, m0, n0, modl + 2048, p.SS + (size_t)(2 * layer + 1) * TT);
  }
}
__device__ __forceinline__ void phase_g4(PRef p, int layer, int bid, int nb, bf16_t* lds) {
  constexpr bool NSPLIT = true;
  const int nMt = (layer == 0 ? TT : TL) / 256, nNt = 32;
  EPI_IDS;
  for (int ti = 0;; ++ti) {
    int mt, nt; if (!tile_next(ti, bid, nb, nMt, nNt, NSPLIT, mt, nt)) break;
    const int m0 = mt * 256, n0 = nt * 128;
    f32x4 acc[8][4]; acc_zero<4>(acc);
    gemm_main4(acc, p.P + (size_t)m0 * 1024, 1024, p.WT, DFF, n0, 1024, lds);
#pragma unroll
    for (int mi = 0; mi < 8; ++mi) {
      const int row = m0 + 128 * wm + 16 * mi + l15;
#pragma unroll
      for (int ni = 0; ni < 4; ++ni) {
        const float v0 = fmaxf(acc[mi][ni][0], 0.f), v1 = fmaxf(acc[mi][ni][1], 0.f), v2 = fmaxf(acc[mi][ni][2], 0.f), v3 = fmaxf(acc[mi][ni][3], 0.f);
        uint2 o; o.x = pack2(v0 * v0, v1 * v1); o.y = pack2(v2 * v2, v3 * v3);
        *(uint2*)(p.U + (size_t)row * DFF + n0 + 64 * wn + 16 * ni + 4 * g) = o;
      }
    }
  }
}
__device__ __forceinline__ void phase_g5(PRef p, int layer, int bid, int nb, bf16_t* lds) {
  constexpr bool NSPLIT = false;
  const int nMt = (layer == 0 ? TT : TL) / 256, nNt = 8;
  const float* modl = p.MOD + (size_t)layer * 9 * 6144;
  for (int ti = 0;; ++ti) {
    int mt, nt; if (!tile_next(ti, bid, nb, nMt, nNt, NSPLIT, mt, nt)) break;
    const int m0 = mt * 256, n0 = nt * 128;
    f32x4 acc[8][4]; acc_zero<4>(acc);
    gemm_main4(acc, p.U + (size_t)m0 * DFF, DFF, p.WT + (size_t)1024 * DFF, 1024, n0, DFF, lds);
    epi_residual(p, acc, 1, m0, n0, modl + 5120, layer == 0 ? p.SS + (size_t)2 * TT : nullptr);
  }
}

__device__ __forceinline__ void phase_prep(PRef p, int layer, int bid, int nb, bf16_t* lds) {
  const int tid = tidx();
  for (int i = bid * 256 + tid; i < TT * 64; i += nb * 256) {
    const int c = i & 63;
    float v = p.S[i];
    if (c < 16) v = sigmoidf_(v);
    else if (c < 32) v = -expf(p.dn_a_log[layer * 16 + c - 16]) * softplusf_(v + p.dn_dt_bias[layer * 16 + c - 16]);
    else v = softplusf_(v + p.ssd_dt_bias[layer * 32 + c - 32]);
    p.S[i] = v;
  }
  const int cg = tid & 7, rA = tid >> 3;
  {
    int slab_ = bid % 48; asm volatile("" : "+s"(slab_));
    const int slab = slab_, c0 = bid / 48, cstep = (nb + 47 - slab) / 48;
    const bool dn = slab < 24;
    const int typ = dn ? slab >> 3 : 3;
    const int ucol = (dn ? 1536 + 512 * typ + 64 * (slab & 7) : 4608 + 64 * (slab - 24)) + 8 * cg;
    const int hcol = dn ? ucol - 1536 : ucol - 3072;
    const int cch = (dn ? 512 * typ + 64 * (slab & 7) : 64 * (slab - 24)) + 8 * cg;
    const float* cw = (dn ? p.dn_conv_w : p.ssd_conv_w) + (size_t)layer * 5 * 1536 + cch;
    float w5[5][8];
#pragma unroll
    for (int j = 0; j < 5; ++j) {
      const float4 a = *(const float4*)(cw + j * 1536), b = *(const float4*)(cw + j * 1536 + 4);
      w5[j][0] = a.x; w5[j][1] = a.y; w5[j][2] = a.z; w5[j][3] = a.w; w5[j][4] = b.x; w5[j][5] = b.y; w5[j][6] = b.z; w5[j][7] = b.w;
    }
    float bias[8];
#pragma unroll
    for (int e = 0; e < 8; ++e) bias[e] = dn ? 0.f : p.ssd_conv_b[layer * 1536 + cch + e];
    bf16_t* T = lds;
    constexpr int TS_ = 72;
    uint4 pr0, pr1, pr2;
#define PREP_ROW(CHUNK, TR, DST) { \
      const int rr_ = (TR) - 2; \
      const bool lat_ = (CHUNK) < 256; const int cs_ = lat_ ? ((CHUNK) & 31) : (((CHUNK) - 256) & 3); \
      const bool first_ = cs_ == 0, last_ = lat_ ? cs_ == 31 : cs_ == 3; \
      uint4 v_ = make_uint4(0u, 0u, 0u, 0u); \
      if (rr_ < 0) { if (!first_) v_ = *(const uint4*)(p.HB + ((size_t)((CHUNK) - 1) * 4 + 4 + rr_) * 3072 + hcol); } \
      else if (rr_ >= 64) { if (!last_) v_ = *(const uint4*)(p.HB + ((size_t)((CHUNK) + 1) * 4 + rr_ - 64) * 3072 + hcol); } \
      else v_ = *(const uint4*)(p.U + (size_t)((CHUNK) * 64 + rr_) * UW + ucol); \
      DST = v_; }
#define PREP_LOAD(CHUNK) { PREP_ROW(CHUNK, rA, pr0) PREP_ROW(CHUNK, rA + 32, pr1) if (rA < 4) PREP_ROW(CHUNK, rA + 64, pr2) }
    if (c0 < 288) PREP_LOAD(c0)
    for (int chunk = c0; chunk < 288; chunk += cstep) {
      const bool lat = chunk < 256;
      const int cs = lat ? (chunk & 31) : ((chunk - 256) & 3);
      const int r0 = chunk * 64;
      __syncthreads();
      *(uint4*)(T + rA * TS_ + 8 * cg) = pr0; *(uint4*)(T + (rA + 32) * TS_ + 8 * cg) = pr1;
      if (rA < 4) *(uint4*)(T + (rA + 64) * TS_ + 8 * cg) = pr2;
      __syncthreads();
      if (chunk + cstep < 288) PREP_LOAD(chunk + cstep)
#pragma unroll
      for (int it = 0; it < 2; ++it) {
        const int rr = rA + 32 * it;
        float v[8];
#pragma unroll
        for (int e = 0; e < 8; ++e) v[e] = bias[e];
#pragma unroll
        for (int j = 0; j < 5; ++j) {
          const uint4 x = *(const uint4*)(T + (rr + j) * TS_ + 8 * cg);
          v[0] += w5[j][0] * bflo(x.x); v[1] += w5[j][1] * bfhi(x.x); v[2] += w5[j][2] * bflo(x.y); v[3] += w5[j][3] * bfhi(x.y);
          v[4] += w5[j][4] * bflo(x.z); v[5] += w5[j][5] * bfhi(x.z); v[6] += w5[j][6] * bflo(x.w); v[7] += w5[j][7] * bfhi(x.w);
        }
#pragma unroll
        for (int e = 0; e < 8; ++e) v[e] = siluf(v[e]);
        if (typ < 2) {
          float ss = 0.f;
#pragma unroll
          for (int e = 0; e < 8; ++e) ss += v[e] * v[e];
          ss += __shfl_xor(ss, 1); ss += __shfl_xor(ss, 2); ss += __shfl_xor(ss, 4);
          const float rs = rsqrtf(ss + EPS) * (typ == 0 ? 0.125f : 1.f);
          if (lat) {
            const int pos = cg < 4 ? cs : rr;
            const float* rp = p.ROPE + (pos * 16 + 8 * (cg & 1)) * 2;
            const float4 q0 = *(const float4*)rp, q1 = *(const float4*)(rp + 4), q2 = *(const float4*)(rp + 8), q3 = *(const float4*)(rp + 12);
            const float cs8[8] = {q0.x, q0.z, q1.x, q1.z, q2.x, q2.z, q3.x, q3.z}, sn8[8] = {q0.y, q0.w, q1.y, q1.w, q2.y, q2.w, q3.y, q3.w};
#pragma unroll
            for (int e = 0; e < 8; ++e) {
              const float vp = __shfl_xor(v[e], 2);
              v[e] = v[e] * cs8[e] + ((cg & 2) ? vp : -vp) * sn8[e];
            }
          }
#pragma unroll
          for (int e = 0; e < 8; ++e) v[e] *= rs;
        }
        uint4 o; o.x = pack2(v[0], v[1]); o.y = pack2(v[2], v[3]); o.z = pack2(v[4], v[5]); o.w = pack2(v[6], v[7]);
        *(uint4*)(p.U + (size_t)(r0 + rr) * UW + ucol) = o;
      }
    }
#undef PREP_LOAD
#undef PREP_ROW
  }
}

constexpr int XS = 72;
constexpr int BS2 = 136;
constexpr int SSD_LDS = (3 * 64 * XS + 3 * 64 * BS2) * 2 + 2 * 64 * 4;
__device__ __forceinline__ void phase_ssd(PRef p, int layer, int task, char* smem) {
  const int tid = tidx(), lane = tid & 63, wave = tid >> 6, g = lane >> 4, l15 = lane & 15, q4 = l15 >> 2, p4 = lane & 3;
  bf16_t* Xt = (bf16_t*)smem;
  bf16_t* Xs = Xt + 64 * XS;
  bf16_t* Wg = Xs + 64 * XS;
  bf16_t* Bt = Wg + 64 * XS;
  bf16_t* Ct = Bt + 64 * BS2;
  bf16_t* Hb = Ct + 64 * BS2;
  float* dts = (float*)(Hb + 64 * BS2);
  float* lam = dts + 64;
  {
    const int head = task & 15, b = task >> 4, grp = head >> 3;
    f32x4 hst[2][8];
#pragma unroll
    for (int d = 0; d < 2; ++d)
#pragma unroll
      for (int n = 0; n < 8; ++n) hst[d][n] = (f32x4){0.f, 0.f, 0.f, 0.f};
    const float dsk = p.ssd_d[layer * 16 + head];
    const float an0 = -__expf(p.ssd_a_log[layer * 32 + head]), an1 = -__expf(p.ssd_a_log[layer * 32 + 16 + head]);
    uint4 px0, px1, pb0, pb1, pb2, pb3, pc0, pc1, pc2, pc3; float pdt = 0.f;
#define SSD_PREFETCH(IT, DIR) { \
      const int seg_ = (IT) >= 4, ci_ = seg_ ? (IT) - 4 : (IT), nch_ = seg_ ? 32 : 4; \
      const int base_ = seg_ ? b * 2048 : TL + b * 256; \
      const int c_ = (DIR) ? nch_ - 1 - ci_ : ci_; \
      const int i_ = tid >> 2, sub_ = tid & 3; \
      const int row_ = base_ + 64 * c_ + ((DIR) ? 63 - i_ : i_); \
      const bf16_t* ur_ = p.U + (size_t)row_ * UW; \
      const uint4* sx_ = (const uint4*)(ur_ + U_SX + 64 * head + 16 * sub_); px0 = sx_[0]; px1 = sx_[1]; \
      const uint4* sb_ = (const uint4*)(ur_ + U_SB + 128 * grp + 32 * sub_); pb0 = sb_[0]; pb1 = sb_[1]; pb2 = sb_[2]; pb3 = sb_[3]; \
      if (seg_ == 1 || layer == 0) { const uint4* sc_ = (const uint4*)(ur_ + U_SC + 128 * grp + 32 * sub_); pc0 = sc_[0]; pc1 = sc_[1]; pc2 = sc_[2]; pc3 = sc_[3]; } \
      if (sub_ == 0) pdt = p.S[(size_t)row_ * SWD + 32 + (DIR) * 16 + head]; }
    SSD_PREFETCH(0, 0)
    for (int it = 0; it < 36; ++it) {
      const int seg = it >= 4, ci = seg ? it - 4 : it, nch = seg ? 32 : 4;
      const int base = seg ? b * 2048 : TL + b * 256;
      const bool want_o = seg == 1 || layer == 0;
      const bool first = ci < nch / 2;
#pragma unroll
      for (int dir = 0; dir < 2; ++dir) {
        const int c = dir ? nch - 1 - ci : ci;
        const int r0 = base + 64 * c;
        __syncthreads();
        {
          const int i = tid >> 2, sub = tid & 3;
          *(uint4*)(Xt + i * XS + 16 * sub) = px0; *(uint4*)(Xt + i * XS + 16 * sub + 8) = px1;
          *(uint4*)(Bt + i * BS2 + 32 * sub) = pb0; *(uint4*)(Bt + i * BS2 + 32 * sub + 8) = pb1; *(uint4*)(Bt + i * BS2 + 32 * sub + 16) = pb2; *(uint4*)(Bt + i * BS2 + 32 * sub + 24) = pb3;
          if (want_o) { *(uint4*)(Ct + i * BS2 + 32 * sub) = pc0; *(uint4*)(Ct + i * BS2 + 32 * sub + 8) = pc1; *(uint4*)(Ct + i * BS2 + 32 * sub + 16) = pc2; *(uint4*)(Ct + i * BS2 + 32 * sub + 24) = pc3; }
          if (sub == 0) dts[i] = pdt;
        }
        if (dir == 0) SSD_PREFETCH(it, 1) else if (it + 1 < 36) SSD_PREFETCH(it + 1, 0)
        unsigned long long oldp[4] = {0ull, 0ull, 0ull, 0ull};
        if (want_o && !first) {
          const int irow_ = 16 * wave + l15;
          const int prow_ = r0 + (dir ? 63 - irow_ : irow_);
#pragma unroll
          for (int pt = 0; pt < 4; ++pt) oldp[pt] = __hip_atomic_load((unsigned long long*)(p.P + (size_t)prow_ * 1024 + 64 * head + 16 * pt + 4 * g), __ATOMIC_RELAXED, __HIP_MEMORY_SCOPE_AGENT);
        }
        if (want_o) {
#pragma unroll
          for (int nt = 0; nt < 8; ++nt) {
            uint2 o; o.x = pack2(hst[dir][nt][0], hst[dir][nt][1]); o.y = pack2(hst[dir][nt][2], hst[dir][nt][3]);
            *(uint2*)(Hb + (16 * wave + l15) * BS2 + 16 * nt + 4 * g) = o;
          }
        }
        __syncthreads();
        float lv = dts[lane] * (dir ? an1 : an0);
#pragma unroll
        for (int o = 1; o < 64; o <<= 1) { const float tv = __shfl_up(lv, o); if (lane >= o) lv += tv; }
        const float lam_last = __shfl(lv, 63);
        if (wave == 0) lam[lane] = lv;
        {
          const int j = tid >> 2, sub = tid & 3;
          const float lj = __shfl(lv, j & 63);
          const float sc = dts[j] * __expf(lam_last - lj);
          const uint4 a = *(const uint4*)(Xt + j * XS + 16 * sub), bq = *(const uint4*)(Xt + j * XS + 16 * sub + 8);
          uint4 oa, ob;
          oa.x = pack2(bflo(a.x) * sc, bfhi(a.x) * sc); oa.y = pack2(bflo(a.y) * sc, bfhi(a.y) * sc); oa.z = pack2(bflo(a.z) * sc, bfhi(a.z) * sc); oa.w = pack2(bflo(a.w) * sc, bfhi(a.w) * sc);
          ob.x = pack2(bflo(bq.x) * sc, bfhi(bq.x) * sc); ob.y = pack2(bflo(bq.y) * sc, bfhi(bq.y) * sc); ob.z = pack2(bflo(bq.z) * sc, bfhi(bq.z) * sc); ob.w = pack2(bflo(bq.w) * sc, bfhi(bq.w) * sc);
          *(uint4*)(Xs + j * XS + 16 * sub) = oa; *(uint4*)(Xs + j * XS + 16 * sub + 8) = ob;
        }
        __syncthreads();
        if (want_o) {
          const int irow = 16 * wave + l15;
          const float li = lam[irow];
#pragma unroll
          for (int jt = 0; jt < 4; ++jt) {
            f32x4 cacc = (f32x4){0.f, 0.f, 0.f, 0.f};
            if (jt <= wave) {
#pragma unroll
              for (int s2 = 0; s2 < 4; ++s2) {
                const bf16x8 af = *(const bf16x8*)(Ct + irow * BS2 + 32 * s2 + 8 * g);
                const bf16x8 bf = *(const bf16x8*)(Bt + (16 * jt + l15) * BS2 + 32 * s2 + 8 * g);
                cacc = __builtin_amdgcn_mfma_f32_16x16x32_bf16(bf, af, cacc, 0, 0, 0);
              }
            }
            const int j0 = 16 * jt + 4 * g;
            const float4 lj = *(const float4*)(lam + j0), dj = *(const float4*)(dts + j0);
            const float w0 = (j0 + 0 <= irow) ? cacc[0] * __expf(li - lj.x) * dj.x : 0.f;
            const float w1 = (j0 + 1 <= irow) ? cacc[1] * __expf(li - lj.y) * dj.y : 0.f;
            const float w2 = (j0 + 2 <= irow) ? cacc[2] * __expf(li - lj.z) * dj.z : 0.f;
            const float w3 = (j0 + 3 <= irow) ? cacc[3] * __expf(li - lj.w) * dj.w : 0.f;
            uint2 o; o.x = pack2(w0, w1); o.y = pack2(w2, w3);
            *(uint2*)(Wg + irow * XS + j0) = o;
          }
        }
        __syncthreads();
        if (want_o) {
          const int irow = 16 * wave + l15;
          f32x4 ai[4], ae[4];
#pragma unroll
          for (int pt = 0; pt < 4; ++pt) { ai[pt] = (f32x4){0.f, 0.f, 0.f, 0.f}; ae[pt] = (f32x4){0.f, 0.f, 0.f, 0.f}; }
#pragma unroll
          for (int s2 = 0; s2 < 2; ++s2) {
            const bf16x8 af = *(const bf16x8*)(Wg + irow * XS + 32 * s2 + 8 * g);
#pragma unroll
            for (int pt = 0; pt < 4; ++pt) {
              const bf16x8 bf = cat8(tr16(Xt + (32 * s2 + 8 * g + q4) * XS + 16 * pt + 4 * p4), tr16(Xt + (32 * s2 + 8 * g + 4 + q4) * XS + 16 * pt + 4 * p4));
              ai[pt] = __builtin_amdgcn_mfma_f32_16x16x32_bf16(bf, af, ai[pt], 0, 0, 0);
            }
          }
#pragma unroll
          for (int s2 = 0; s2 < 4; ++s2) {
            const bf16x8 af = *(const bf16x8*)(Ct + irow * BS2 + 32 * s2 + 8 * g);
#pragma unroll
            for (int pt = 0; pt < 4; ++pt) {
              const bf16x8 bf = *(const bf16x8*)(Hb + (16 * pt + l15) * BS2 + 32 * s2 + 8 * g);
              ae[pt] = __builtin_amdgcn_mfma_f32_16x16x32_bf16(bf, af, ae[pt], 0, 0, 0);
            }
          }
          const float el = __expf(lam[irow]);
          const int row = r0 + (dir ? 63 - irow : irow);
#pragma unroll
          for (int pt = 0; pt < 4; ++pt) {
            float y0 = ai[pt][0] + el * ae[pt][0], y1 = ai[pt][1] + el * ae[pt][1], y2 = ai[pt][2] + el * ae[pt][2], y3 = ai[pt][3] + el * ae[pt][3];
            if (dir == 0) {
              const uint2 xv = *(const uint2*)(Xt + irow * XS + 16 * pt + 4 * g);
              y0 += dsk * bflo(xv.x); y1 += dsk * bfhi(xv.x); y2 += dsk * bflo(xv.y); y3 += dsk * bfhi(xv.y);
            }
            unsigned long long* dst = (unsigned long long*)(p.P + (size_t)row * 1024 + 64 * head + 16 * pt + 4 * g);
            if (!first) {
              const unsigned long long old = oldp[pt];
              const unsigned lo = (unsigned)old, hi = (unsigned)(old >> 32);
              y0 += bflo(lo); y1 += bfhi(lo); y2 += bflo(hi); y3 += bfhi(hi);
            }
            *dst = (unsigned long long)pack2(y0, y1) | ((unsigned long long)pack2(y2, y3) << 32);
          }
        }
        {
          const float el = __expf(lam_last);
#pragma unroll
          for (int nt = 0; nt < 8; ++nt) hst[dir][nt] *= el;
#pragma unroll
          for (int s2 = 0; s2 < 2; ++s2) {
            const bf16x8 mf = cat8(tr16(Xs + (32 * s2 + 8 * g + q4) * XS + 16 * wave + 4 * p4), tr16(Xs + (32 * s2 + 8 * g + 4 + q4) * XS + 16 * wave + 4 * p4));
#pragma unroll
            for (int nt = 0; nt < 8; ++nt) {
              const bf16x8 nf = cat8(tr16(Bt + (32 * s2 + 8 * g + q4) * BS2 + 16 * nt + 4 * p4), tr16(Bt + (32 * s2 + 8 * g + 4 + q4) * BS2 + 16 * nt + 4 * p4));
              hst[dir][nt] = __builtin_amdgcn_mfma_f32_16x16x32_bf16(nf, mf, hst[dir][nt], 0, 0, 0);
            }
          }
        }
      }
    }
  }
}


#undef SSD_PREFETCH
constexpr int GT = 64 * XS;
constexpr int GDN_LDS = 8 * GT * 2 + 4 * 256 * 4 + 4 * 16 * 24 * 2 + 2 * 64 * 4;
__device__ __forceinline__ void phase_gdn(PRef p, int layer, int task, char* smem) {
  const int tid = tidx(), lane = tid & 63, wave = tid >> 6, g = lane >> 4, l15 = lane & 15, q4 = l15 >> 2, p4 = lane & 3;
  bf16_t* Qt = (bf16_t*)smem;
  bf16_t* Kt = Qt + GT;
  bf16_t* Vt = Kt + GT;
  bf16_t* Am = Vt + GT;
  bf16_t* Mq = Am + GT;
  bf16_t* Xw = Mq + GT;
  bf16_t* Xu = Xw + GT;
  bf16_t* St = Xu + GT;
  bf16_t* Qg = Qt; bf16_t* Vn = Vt; bf16_t* Vs = Am;
  float* Adiag = (float*)(St + GT);
  bf16_t* Db = (bf16_t*)(Adiag + 4 * 256);
  float* bet = (float*)(Db + 4 * 16 * 24);
  float* gam = bet + 64;
  const bf16x8 zero8 = (bf16x8){0, 0, 0, 0, 0, 0, 0, 0};
  {
    const int dir = task & 1, h = (task >> 1) & 7, b = task >> 4;
    bf16_t* Og = layer == 0 ? p.OG0 + (size_t)dir * TT * 512 : p.OG1 + (size_t)dir * TL * 512;
    f32x4 sst[4];
#pragma unroll
    for (int e = 0; e < 4; ++e) sst[e] = (f32x4){0.f, 0.f, 0.f, 0.f};
    __syncthreads();
    for (int i = tid; i < 64 * XS / 2; i += 256) { ((unsigned*)St)[i] = 0u; ((unsigned*)Xw)[i] = 0u; ((unsigned*)Xu)[i] = 0u; }
    uint4 pq0, pq1, pk0, pk1, pv0, pv1; float pbeta = 0.f, pgam = 0.f;
#define GDN_PREFETCH(IT) { \
      const int seg_ = (IT) >= 4, ci_ = seg_ ? (IT) - 4 : (IT), nch_ = seg_ ? 32 : 4; \
      const int base_ = seg_ ? b * 2048 : TL + b * 256; \
      const int c_ = dir ? nch_ - 1 - ci_ : ci_; \
      const int i_ = tid >> 2, sub_ = tid & 3; \
      const int row_ = base_ + 64 * c_ + (dir ? 63 - i_ : i_); \
      const bf16_t* ur_ = p.U + (size_t)row_ * UW + 64 * h + 16 * sub_; \
      pq0 = *(const uint4*)(ur_ + U_DNQ); pq1 = *(const uint4*)(ur_ + U_DNQ + 8); \
      pk0 = *(const uint4*)(ur_ + U_DNK); pk1 = *(const uint4*)(ur_ + U_DNK + 8); \
      pv0 = *(const uint4*)(ur_ + U_DNV); pv1 = *(const uint4*)(ur_ + U_DNV + 8); \
      if (sub_ == 0) { pbeta = p.S[(size_t)row_ * SWD + dir * 8 + h]; pgam = p.S[(size_t)row_ * SWD + 16 + dir * 8 + h]; } }
    GDN_PREFETCH(0)
    for (int it = 0; it < 36; ++it) {
      const int seg = it >= 4, ci = seg ? it - 4 : it, nch = seg ? 32 : 4;
      const int base = seg ? b * 2048 : TL + b * 256;
      const bool want_o = seg == 1 || layer == 0;
      const int c = dir ? nch - 1 - ci : ci;
      const int r0 = base + 64 * c;
      __syncthreads();
      {
        const int i = tid >> 2, sub = tid & 3;
        *(uint4*)(Qt + i * XS + 16 * sub) = pq0; *(uint4*)(Qt + i * XS + 16 * sub + 8) = pq1;
        *(uint4*)(Kt + i * XS + 16 * sub) = pk0; *(uint4*)(Kt + i * XS + 16 * sub + 8) = pk1;
        *(uint4*)(Vt + i * XS + 16 * sub) = pv0; *(uint4*)(Vt + i * XS + 16 * sub + 8) = pv1;
        if (sub == 0) { bet[i] = pbeta; gam[i] = pgam; }
      }
      if (it + 1 < 36) GDN_PREFETCH(it + 1)
      __syncthreads();
      float lv = gam[lane];
#pragma unroll
      for (int o = 1; o < 64; o <<= 1) { const float tv = __shfl_up(lv, o); if (lane >= o) lv += tv; }
      const float gam_last = __shfl(lv, 63);
      __syncthreads();
      if (wave == 0) gam[lane] = lv;
      __syncthreads();
      {
        const int irow = 16 * wave + l15;
        const float gi = gam[irow], bi = bet[irow];
#pragma unroll
        for (int jt = 0; jt < 4; ++jt) {
          f32x4 kk = (f32x4){0.f, 0.f, 0.f, 0.f}, qk = (f32x4){0.f, 0.f, 0.f, 0.f};
          if (jt <= wave) {
#pragma unroll
            for (int s2 = 0; s2 < 2; ++s2) {
              const bf16x8 nf = *(const bf16x8*)(Kt + (16 * jt + l15) * XS + 32 * s2 + 8 * g);
              const bf16x8 mk = *(const bf16x8*)(Kt + irow * XS + 32 * s2 + 8 * g);
              const bf16x8 mq = *(const bf16x8*)(Qt + irow * XS + 32 * s2 + 8 * g);
              kk = __builtin_amdgcn_mfma_f32_16x16x32_bf16(nf, mk, kk, 0, 0, 0);
              qk = __builtin_amdgcn_mfma_f32_16x16x32_bf16(nf, mq, qk, 0, 0, 0);
            }
          }
          const int j0 = 16 * jt + 4 * g;
          const float4 gj = *(const float4*)(gam + j0);
          const float gjv[4] = {gj.x, gj.y, gj.z, gj.w};
          float av[4], mv[4];
#pragma unroll
          for (int r = 0; r < 4; ++r) {
            const int j = j0 + r;
            const float dec = j <= irow ? __expf(gi - gjv[r]) : 0.f;
            av[r] = j < irow ? bi * kk[r] * dec : 0.f;
            mv[r] = qk[r] * dec;
          }
          uint2 oa; oa.x = pack2(av[0], av[1]); oa.y = pack2(av[2], av[3]);
          uint2 om; om.x = pack2(mv[0], mv[1]); om.y = pack2(mv[2], mv[3]);
          *(uint2*)(Am + irow * XS + j0) = oa;
          *(uint2*)(Mq + irow * XS + j0) = om;
          if (jt == wave) *(f32x4*)(Adiag + wave * 256 + l15 * 16 + 4 * g) = (f32x4){av[0], av[1], av[2], av[3]};
        }
      }
      __syncthreads();
      {
        const int j = tid >> 2, sub = tid & 3;
        const float sc = __expf(gam[j]);
        const uint4 a = *(const uint4*)(Qt + j * XS + 16 * sub), bq = *(const uint4*)(Qt + j * XS + 16 * sub + 8);
        uint4 oa, ob;
        oa.x = pack2(bflo(a.x) * sc, bfhi(a.x) * sc); oa.y = pack2(bflo(a.y) * sc, bfhi(a.y) * sc); oa.z = pack2(bflo(a.z) * sc, bfhi(a.z) * sc); oa.w = pack2(bflo(a.w) * sc, bfhi(a.w) * sc);
        ob.x = pack2(bflo(bq.x) * sc, bfhi(bq.x) * sc); ob.y = pack2(bflo(bq.y) * sc, bfhi(bq.y) * sc); ob.z = pack2(bflo(bq.z) * sc, bfhi(bq.z) * sc); ob.w = pack2(bflo(bq.w) * sc, bfhi(bq.w) * sc);
        *(uint4*)(Qg + j * XS + 16 * sub) = oa; *(uint4*)(Qg + j * XS + 16 * sub + 8) = ob;
      }
      {
        const int cc = lane & 15;
        const float* Ad = Adiag + wave * 256;
        float dcol[16];
#pragma unroll
        for (int r = 0; r < 16; ++r) {
          float sacc = (r == cc) ? 1.f : 0.f;
#pragma unroll
          for (int j = 0; j < r; ++j) sacc -= Ad[r * 16 + j] * dcol[j];
          dcol[r] = sacc;
        }
        if (lane < 16) {
#pragma unroll
          for (int r = 0; r < 16; ++r) Db[(wave * 16 + r) * 24 + cc] = f2bf(dcol[r]);
        }
      }
      __syncthreads();
      {
        const bool isW = wave < 2;
        bf16_t* Xd = isW ? Xw : Xu;
        const bf16_t* Src = isW ? Kt : Vt;
        const int fbase = (wave & 1) * 32;
#pragma unroll
        for (int ib = 0; ib < 4; ++ib) {
          const int irow = 16 * ib + l15;
          const float sc = isW ? bet[irow] * __expf(gam[irow]) : bet[irow];
          f32x4 y[2];
#pragma unroll
          for (int fi = 0; fi < 2; ++fi) {
            const int f0 = fbase + 16 * fi;
            const uint2 rv = *(const uint2*)(Src + irow * XS + f0 + 4 * g);
            f32x4 tmp = (f32x4){0.f, 0.f, 0.f, 0.f};
#pragma unroll
            for (int s2 = 0; s2 < 2; ++s2) {
              if (32 * s2 < 16 * ib) {
                const bool half = (32 * s2 + 32) > 16 * ib;
                bf16x8 mf = *(const bf16x8*)(Am + irow * XS + 32 * s2 + 8 * g);
                if (half && g >= 2) mf = zero8;
                const bf16x8 nf = cat8(tr16(Xd + (32 * s2 + 8 * g + q4) * XS + f0 + 4 * p4), tr16(Xd + (32 * s2 + 8 * g + 4 + q4) * XS + f0 + 4 * p4));
                tmp = __builtin_amdgcn_mfma_f32_16x16x32_bf16(nf, mf, tmp, 0, 0, 0);
              }
            }
            y[fi] = (f32x4){bflo(rv.x) * sc - tmp[0], bfhi(rv.x) * sc - tmp[1], bflo(rv.y) * sc - tmp[2], bfhi(rv.y) * sc - tmp[3]};
          }
          __syncthreads();
#pragma unroll
          for (int fi = 0; fi < 2; ++fi) {
            uint2 o; o.x = pack2(y[fi][0], y[fi][1]); o.y = pack2(y[fi][2], y[fi][3]);
            *(uint2*)(Xd + irow * XS + fbase + 16 * fi + 4 * g) = o;
          }
          __syncthreads();
          bf16x8 dm = zero8;
          if (g < 2) dm = *(const bf16x8*)(Db + (ib * 16 + l15) * 24 + 8 * g);
#pragma unroll
          for (int fi = 0; fi < 2; ++fi) {
            const int f0 = fbase + 16 * fi;
            const bf16x8 nf = cat8(tr16(Xd + (16 * ib + 8 * (g & 1) + q4) * XS + f0 + 4 * p4), tr16(Xd + (16 * ib + 8 * (g & 1) + 4 + q4) * XS + f0 + 4 * p4));
            y[fi] = __builtin_amdgcn_mfma_f32_16x16x32_bf16(nf, dm, (f32x4){0.f, 0.f, 0.f, 0.f}, 0, 0, 0);
          }
          __syncthreads();
#pragma unroll
          for (int fi = 0; fi < 2; ++fi) {
            uint2 o; o.x = pack2(y[fi][0], y[fi][1]); o.y = pack2(y[fi][2], y[fi][3]);
            *(uint2*)(Xd + irow * XS + fbase + 16 * fi + 4 * g) = o;
          }
          __syncthreads();
        }
      }
      {
        const int irow = 16 * wave + l15;
        const float dl = __expf(gam_last - gam[irow]);
        f32x4 acc[4];
#pragma unroll
        for (int et = 0; et < 4; ++et) acc[et] = (f32x4){0.f, 0.f, 0.f, 0.f};
#pragma unroll
        for (int s2 = 0; s2 < 2; ++s2) {
          const bf16x8 mf = *(const bf16x8*)(Xw + irow * XS + 32 * s2 + 8 * g);
#pragma unroll
          for (int et = 0; et < 4; ++et) {
            const bf16x8 nf = *(const bf16x8*)(St + (16 * et + l15) * XS + 32 * s2 + 8 * g);
            acc[et] = __builtin_amdgcn_mfma_f32_16x16x32_bf16(nf, mf, acc[et], 0, 0, 0);
          }
        }
#pragma unroll
        for (int et = 0; et < 4; ++et) {
          const uint2 uv = *(const uint2*)(Xu + irow * XS + 16 * et + 4 * g);
          const float v0 = bflo(uv.x) - acc[et][0], v1 = bfhi(uv.x) - acc[et][1], v2 = bflo(uv.y) - acc[et][2], v3 = bfhi(uv.y) - acc[et][3];
          uint2 o; o.x = pack2(v0, v1); o.y = pack2(v2, v3);
          *(uint2*)(Vn + irow * XS + 16 * et + 4 * g) = o;
          o.x = pack2(v0 * dl, v1 * dl); o.y = pack2(v2 * dl, v3 * dl);
          *(uint2*)(Vs + irow * XS + 16 * et + 4 * g) = o;
        }
      }
      __syncthreads();
      if (want_o) {
        const int irow = 16 * wave + l15;
        f32x4 acc[4];
#pragma unroll
        for (int et = 0; et < 4; ++et) acc[et] = (f32x4){0.f, 0.f, 0.f, 0.f};
#pragma unroll
        for (int s2 = 0; s2 < 2; ++s2) {
          const bf16x8 mf = *(const bf16x8*)(Qg + irow * XS + 32 * s2 + 8 * g);
          const bf16x8 mf2 = *(const bf16x8*)(Mq + irow * XS + 32 * s2 + 8 * g);
#pragma unroll
          for (int et = 0; et < 4; ++et) {
            const bf16x8 nf = *(const bf16x8*)(St + (16 * et + l15) * XS + 32 * s2 + 8 * g);
            acc[et] = __builtin_amdgcn_mfma_f32_16x16x32_bf16(nf, mf, acc[et], 0, 0, 0);
            const bf16x8 nf2 = cat8(tr16(Vn + (32 * s2 + 8 * g + q4) * XS + 16 * et + 4 * p4), tr16(Vn + (32 * s2 + 8 * g + 4 + q4) * XS + 16 * et + 4 * p4));
            acc[et] = __builtin_amdgcn_mfma_f32_16x16x32_bf16(nf2, mf2, acc[et], 0, 0, 0);
          }
        }
        const int row = r0 + (dir ? 63 - irow : irow);
#pragma unroll
        for (int et = 0; et < 4; ++et) {
          uint2 o; o.x = pack2(acc[et][0], acc[et][1]); o.y = pack2(acc[et][2], acc[et][3]);
          *(uint2*)(Og + (size_t)row * 512 + 64 * h + 16 * et + 4 * g) = o;
        }
      }
      {
        const float el = __expf(gam_last);
#pragma unroll
        for (int et = 0; et < 4; ++et) sst[et] *= el;
#pragma unroll
        for (int s2 = 0; s2 < 2; ++s2) {
          const bf16x8 nf = cat8(tr16(Kt + (32 * s2 + 8 * g + q4) * XS + 16 * wave + 4 * p4), tr16(Kt + (32 * s2 + 8 * g + 4 + q4) * XS + 16 * wave + 4 * p4));
#pragma unroll
          for (int et = 0; et < 4; ++et) {
            const bf16x8 mf = cat8(tr16(Vs + (32 * s2 + 8 * g + q4) * XS + 16 * et + 4 * p4), tr16(Vs + (32 * s2 + 8 * g + 4 + q4) * XS + 16 * et + 4 * p4));
            sst[et] = __builtin_amdgcn_mfma_f32_16x16x32_bf16(nf, mf, sst[et], 0, 0, 0);
          }
        }
      }
      __syncthreads();
#pragma unroll
      for (int et = 0; et < 4; ++et) {
        uint2 o; o.x = pack2(sst[et][0], sst[et][1]); o.y = pack2(sst[et][2], sst[et][3]);
        *(uint2*)(St + (16 * et + l15) * XS + 16 * wave + 4 * g) = o;
      }
    }
  }
}


#undef GDN_PREFETCH
constexpr int NA_VS = 72;
constexpr int NA_LDS_WAVE = 2 * 32 * NA_VS * 2;
__device__ __forceinline__ void phase_na(PRef p, int layer, unsigned* ctr, char* smem) {
  const int lane = tidx() & 63, wave = tidx() >> 6, g = lane >> 4, l15 = lane & 15, q4 = l15 >> 2, p4 = lane & 3;
  bf16_t* Vl = (bf16_t*)(smem + wave * NA_LDS_WAVE);
  const int ntask = layer == 0 ? 8192 + 1024 : 8192;
  const float* rpb = p.na_rpb + (size_t)layer * 8 * 15 * 31;
  for (;;) {
    int w0 = 0;
    if (lane == 0) w0 = (int)atomicAdd(ctr, 1u);
    const int task = __builtin_amdgcn_readfirstlane(__shfl(w0, 0));
    if (task >= ntask) break;
    const bool lat = task < 8192;
    int b, h, r = 0, cb = 0, qtok0, R0 = 0, C0 = 0;
    if (lat) { cb = task & 3; r = (task >> 2) & 31; h = (task >> 7) & 7; b = task >> 10; qtok0 = b * 2048 + r * 64 + 16 * cb; R0 = min(max(r - 4, 0), 24); C0 = min(max(16 * cb - 8, 0), 32); }
    else { const int t2 = task - 8192; const int qb = t2 & 15; h = (t2 >> 4) & 7; b = t2 >> 7; qtok0 = TL + b * 256 + 16 * qb; }
    const int tau0 = lat ? 0 : 16;
    const int wtok0 = b * 2048 + R0 * 64 + C0, ctok0 = TL + b * 256;
#define tile_tok(tau) ((tau) < 16 ? wtok0 + ((tau) >> 1) * 64 + 16 * ((tau) & 1) : ctok0 + 16 * ((tau) - 16))
    const bf16_t* qp = p.U + (size_t)(qtok0 + l15) * UW + U_NAQ + 64 * h + 8 * g;
    const bf16x8 qf0 = *(const bf16x8*)qp, qf1 = *(const bf16x8*)(qp + 32);
    f32x4 sc[32];
#pragma unroll
    for (int tau = 0; tau < 32; ++tau) {
      sc[tau] = (f32x4){-INFINITY, -INFINITY, -INFINITY, -INFINITY};
      if (tau >= tau0) {
        const bf16_t* kp = p.U + (size_t)(tile_tok(tau) + l15) * UW + U_NAK + 64 * h + 8 * g;
        const bf16x8 kf0 = *(const bf16x8*)kp, kf1 = *(const bf16x8*)(kp + 32);
        f32x4 a = (f32x4){0.f, 0.f, 0.f, 0.f};
        a = __builtin_amdgcn_mfma_f32_16x16x32_bf16(kf0, qf0, a, 0, 0, 0);
        a = __builtin_amdgcn_mfma_f32_16x16x32_bf16(kf1, qf1, a, 0, 0, 0);
        if (tau < 16) {
          const int qcol = 16 * cb + l15, ws = min(max(qcol - 8, 0), 48);
          const int dr = R0 + (tau >> 1) - r + 7;
#pragma unroll
          for (int rg = 0; rg < 4; ++rg) {
            const int kcol = C0 + 16 * (tau & 1) + 4 * g + rg;
            const bool ok = kcol >= ws && kcol < ws + 16;
            const float bias = ok ? rpb[(h * 15 + dr) * 31 + (kcol - qcol + 15)] : 0.f;
            a[rg] = ok ? a[rg] + bias : -INFINITY;
          }
        }
        sc[tau] = a;
      }
    }
    float mx = -INFINITY;
#pragma unroll
    for (int tau = 0; tau < 32; ++tau) mx = fmaxf(mx, fmaxf(fmaxf(sc[tau][0], sc[tau][1]), fmaxf(sc[tau][2], sc[tau][3])));
    mx = fmaxf(mx, __shfl_xor(mx, 16)); mx = fmaxf(mx, __shfl_xor(mx, 32));
    float sum = 0.f;
#pragma unroll
    for (int tau = 0; tau < 32; ++tau) {
#pragma unroll
      for (int rg = 0; rg < 4; ++rg) { const float e = __expf(sc[tau][rg] - mx); sc[tau][rg] = e; sum += e; }
    }
    sum += __shfl_xor(sum, 16); sum += __shfl_xor(sum, 32);
    f32x4 oacc[4];
#pragma unroll
    for (int dt = 0; dt < 4; ++dt) oacc[dt] = (f32x4){0.f, 0.f, 0.f, 0.f};
    const int kap0 = tau0 >> 1;
    uint4 vr0, vr1, vr2, vr3;
#define NA_VLOAD(KAP) { \
      const int kk0_ = lane >> 3, cc_ = lane & 7; \
      const bf16_t* vb_ = p.U + U_NAV + 64 * h + 8 * cc_; \
      vr0 = *(const uint4*)(vb_ + (size_t)(tile_tok(2 * (KAP)) + kk0_) * UW); \
      vr1 = *(const uint4*)(vb_ + (size_t)(tile_tok(2 * (KAP)) + kk0_ + 8) * UW); \
      vr2 = *(const uint4*)(vb_ + (size_t)(tile_tok(2 * (KAP) + 1) + kk0_) * UW); \
      vr3 = *(const uint4*)(vb_ + (size_t)(tile_tok(2 * (KAP) + 1) + kk0_ + 8) * UW); }
    NA_VLOAD(kap0)
#pragma unroll
    for (int kap = 0; kap < 16; ++kap) {
      if (kap >= kap0) {
        bf16_t* Vb = Vl + (kap & 1) * 32 * NA_VS;
        {
          const int kk0_ = lane >> 3, cc_ = lane & 7;
          *(uint4*)(Vb + kk0_ * NA_VS + 8 * cc_) = vr0; *(uint4*)(Vb + (kk0_ + 8) * NA_VS + 8 * cc_) = vr1;
          *(uint4*)(Vb + (kk0_ + 16) * NA_VS + 8 * cc_) = vr2; *(uint4*)(Vb + (kk0_ + 24) * NA_VS + 8 * cc_) = vr3;
        }
        if (kap + 1 < 16) NA_VLOAD(kap + 1)
        __builtin_amdgcn_fence(__ATOMIC_RELEASE, "workgroup"); __builtin_amdgcn_wave_barrier(); __builtin_amdgcn_fence(__ATOMIC_ACQUIRE, "workgroup");
        bf16x8 pf;
        {
          const unsigned w0_ = pack2(sc[2 * kap][0], sc[2 * kap][1]), w1_ = pack2(sc[2 * kap][2], sc[2 * kap][3]);
          const unsigned w2_ = pack2(sc[2 * kap + 1][0], sc[2 * kap + 1][1]), w3_ = pack2(sc[2 * kap + 1][2], sc[2 * kap + 1][3]);
          pf = (bf16x8){(short)(w0_ & 0xffff), (short)(w0_ >> 16), (short)(w1_ & 0xffff), (short)(w1_ >> 16), (short)(w2_ & 0xffff), (short)(w2_ >> 16), (short)(w3_ & 0xffff), (short)(w3_ >> 16)};
        }
#pragma unroll
        for (int dt = 0; dt < 4; ++dt) {
          const bf16x8 vf = cat8(tr16(Vb + (4 * g + q4) * NA_VS + 16 * dt + 4 * p4), tr16(Vb + (16 + 4 * g + q4) * NA_VS + 16 * dt + 4 * p4));
          oacc[dt] = __builtin_amdgcn_mfma_f32_16x16x32_bf16(vf, pf, oacc[dt], 0, 0, 0);
        }
      }
    }
#undef NA_VLOAD
#undef tile_tok
    const float inv = 1.f / sum;
    bf16_t* op = p.U + (size_t)(qtok0 + l15) * UW + U_YA + 64 * h + 4 * g;
#pragma unroll
    for (int dt = 0; dt < 4; ++dt) {
      uint2 o; o.x = pack2(oacc[dt][0] * inv, oacc[dt][1] * inv); o.y = pack2(oacc[dt][2] * inv, oacc[dt][3] * inv);
      *(uint2*)(op + 16 * dt) = o;
    }
  }
}

__device__ __forceinline__ void norm_row(const float* xr, float rs, const float* alpha, const float* shift, bf16_t* hrow, int lane) {
#pragma unroll
  for (int i = 0; i < 4; ++i) {
    const int k = lane * 4 + 256 * i;
    const float4 v = *(const float4*)(xr + k), a = *(const float4*)(alpha + k), s = *(const float4*)(shift + k);
    uint2 o; o.x = pack2(v.x * rs * a.x + s.x, v.y * rs * a.y + s.y); o.y = pack2(v.z * rs * a.z + s.z, v.w * rs * a.w + s.w);
    *(uint2*)(hrow + k) = o;
  }
}
constexpr int TKW = 2;
__device__ __forceinline__ void phase_fin(PRef p, int layer, int bid, int nb) {
  {
    bf16_t* uw = p.U + U_W;
#pragma unroll 1
    for (int i = 0; i < 3; ++i) wconv(p.w_in + (size_t)layer * 1024 * DIN, DIN, 6208 + 1024 * i, false, uw + (size_t)(UWR_G + 1024 * i) * UW, UW, 1024, 1024, bid, nb);
    wconv(p.w_pa + (size_t)layer * 512 * 1024, 1024, 0, false, uw + (size_t)UWR_PA * UW, UW, 512, 1024, bid, nb);
    wconv(p.w_pb + (size_t)layer * 512 * 1024, 1024, 0, false, uw + (size_t)UWR_PB * UW, UW, 512, 1024, bid, nb);
    wconv(p.w_pc + (size_t)layer * 1024 * 1024, 1024, 0, false, uw + (size_t)UWR_PC * UW, UW, 1024, 1024, bid, nb);
    wconv(p.w_out + (size_t)layer * 1024 * 1024, 1024, 0, false, uw + (size_t)UWR_OUT * UW, UW, 1024, 1024, bid, nb);
  }
  const int lane = tidx() & 63, wave = tidx() >> 6;
  const int ntok = layer == 0 ? TT : TL;
  const bf16_t* ogf = layer == 0 ? p.OG0 : p.OG1;
  const bf16_t* ogb = ogf + (size_t)(layer == 0 ? TT : TL) * 512;
  const float* gnd = p.dn_o_gain + layer * 64 + 8 * (lane & 7);
  const float* gns = p.ssd_o_gain + layer * 1024 + 16 * lane;
  const float* xlat = layer == 0 ? p.x : p.out;
  const float* xctx = layer == 0 ? p.ctx : p.XC;
  for (int tok0 = (bid * 4 + wave) * TKW; tok0 < ntok; tok0 += nb * 4 * TKW) {
    uint4 a[TKW], bq[TKW], zd[TKW], pa[TKW][2], zs[TKW][2];
    float4 xv[TKW][4];
#pragma unroll
    for (int j = 0; j < TKW; ++j)
#pragma unroll
      for (int i = 0; i < 4; ++i) xv[j][i] = *(const float4*)((tok0 < TL ? xlat + (size_t)(tok0 + j) * DM : xctx + (size_t)(tok0 + j - TL) * DM) + lane * 4 + 256 * i);
#pragma unroll
    for (int j = 0; j < TKW; ++j) {
      const int tok = tok0 + j;
      const bf16_t* ur = p.U + (size_t)tok * UW;
      a[j] = *(const uint4*)(ogf + (size_t)tok * 512 + 8 * lane); bq[j] = *(const uint4*)(ogb + (size_t)tok * 512 + 8 * lane); zd[j] = *(const uint4*)(ur + U_DNZ + 8 * lane);
      pa[j][0] = *(const uint4*)(p.P + (size_t)tok * 1024 + 16 * lane); pa[j][1] = *(const uint4*)(p.P + (size_t)tok * 1024 + 16 * lane + 8);
      zs[j][0] = *(const uint4*)(ur + U_SZ + 16 * lane); zs[j][1] = *(const uint4*)(ur + U_SZ + 16 * lane + 8);
    }
#pragma unroll
    for (int j = 0; j < TKW; ++j) {
      bf16_t* ur = p.U + (size_t)(tok0 + j) * UW;
      {
        float o[8] = {bflo(a[j].x) + bflo(bq[j].x), bfhi(a[j].x) + bfhi(bq[j].x), bflo(a[j].y) + bflo(bq[j].y), bfhi(a[j].y) + bfhi(bq[j].y),
                      bflo(a[j].z) + bflo(bq[j].z), bfhi(a[j].z) + bfhi(bq[j].z), bflo(a[j].w) + bflo(bq[j].w), bfhi(a[j].w) + bfhi(bq[j].w)};
        const float zz[8] = {bflo(zd[j].x), bfhi(zd[j].x), bflo(zd[j].y), bfhi(zd[j].y), bflo(zd[j].z), bfhi(zd[j].z), bflo(zd[j].w), bfhi(zd[j].w)};
        float ss = 0.f;
#pragma unroll
        for (int i = 0; i < 8; ++i) ss += o[i] * o[i];
        ss += __shfl_xor(ss, 1); ss += __shfl_xor(ss, 2); ss += __shfl_xor(ss, 4);
        const float rs = rsqrtf(ss * (1.f / 64.f) + EPS);
#pragma unroll
        for (int i = 0; i < 8; ++i) o[i] = o[i] * rs * gnd[i] * siluf(zz[i]);
        uint4 w; w.x = pack2(o[0], o[1]); w.y = pack2(o[2], o[3]); w.z = pack2(o[4], o[5]); w.w = pack2(o[6], o[7]);
        *(uint4*)(ur + U_YB + 8 * lane) = w;
      }
      {
        float yv[16];
        float ss = 0.f;
#pragma unroll
        for (int hf = 0; hf < 2; ++hf) {
          const uint4 av4 = pa[j][hf], z = zs[j][hf];
          const float av[8] = {bflo(av4.x), bfhi(av4.x), bflo(av4.y), bfhi(av4.y), bflo(av4.z), bfhi(av4.z), bflo(av4.w), bfhi(av4.w)};
          const float zz[8] = {bflo(z.x), bfhi(z.x), bflo(z.y), bfhi(z.y), bflo(z.z), bfhi(z.z), bflo(z.w), bfhi(z.w)};
#pragma unroll
          for (int i = 0; i < 8; ++i) { const float v = av[i] * siluf(zz[i]); yv[8 * hf + i] = v; ss += v * v; }
        }
        ss += __shfl_xor(ss, 1); ss += __shfl_xor(ss, 2); ss += __shfl_xor(ss, 4); ss += __shfl_xor(ss, 8); ss += __shfl_xor(ss, 16);
        const float rs = rsqrtf(ss * (1.f / 512.f) + EPS);
#pragma unroll
        for (int hf = 0; hf < 2; ++hf) {
          uint4 w;
          w.x = pack2(yv[8 * hf + 0] * rs * gns[8 * hf + 0], yv[8 * hf + 1] * rs * gns[8 * hf + 1]);
          w.y = pack2(yv[8 * hf + 2] * rs * gns[8 * hf + 2], yv[8 * hf + 3] * rs * gns[8 * hf + 3]);
          w.z = pack2(yv[8 * hf + 4] * rs * gns[8 * hf + 4], yv[8 * hf + 5] * rs * gns[8 * hf + 5]);
          w.w = pack2(yv[8 * hf + 6] * rs * gns[8 * hf + 6], yv[8 * hf + 7] * rs * gns[8 * hf + 7]);
          *(uint4*)(ur + U_YC + 16 * lane + 8 * hf) = w;
        }
      }
    }
    {
      __builtin_amdgcn_s_waitcnt(0x0F70);
      const float* mr = p.MOD + (size_t)layer * 9 * 6144 + modrow(tok0) * 6144;
      float rs[TKW];
#pragma unroll
      for (int j = 0; j < TKW; ++j) rs[j] = rsqrtf(p.SS[(size_t)(2 * layer) * TT + tok0 + j] * (1.f / DM) + EPS);
#pragma unroll
      for (int i = 0; i < 4; ++i) {
        const int k = lane * 4 + 256 * i;
        const float4 al = *(const float4*)(mr + 1024 + k), sh = *(const float4*)(mr + k);
#pragma unroll
        for (int j = 0; j < TKW; ++j) {
          uint2 o; o.x = pack2(xv[j][i].x * rs[j] * al.x + sh.x, xv[j][i].y * rs[j] * al.y + sh.y); o.y = pack2(xv[j][i].z * rs[j] * al.z + sh.z, xv[j][i].w * rs[j] * al.w + sh.w);
          *(uint2*)(p.P + (size_t)(tok0 + j) * 1024 + k) = o;
        }
      }
    }
  }
}

#define XB_TMO      128
#define XB_XCNT(j)  (256  + 64 * (j))
#define XB_XSUB(j)  (1280 + 64 * (j))
#define XB_XGEN(j)  (2304 + 64 * (j))
#define XB_TOP      3328
#define XB_TOPGEN   3392
#define XCD_BAR_WORDS 3456
#define XB_SPIN_CAP (1u << 20)
__device__ __forceinline__ unsigned xb_ld(unsigned* p)              { return __hip_atomic_load(p, __ATOMIC_RELAXED, __HIP_MEMORY_SCOPE_AGENT); }
__device__ __forceinline__ unsigned xb_add(unsigned* p, unsigned v) { return __hip_atomic_fetch_add(p, v, __ATOMIC_RELAXED, __HIP_MEMORY_SCOPE_AGENT); }
__device__ __forceinline__ unsigned xb_xcc_id() { return (unsigned)__builtin_amdgcn_s_getreg((3 << 11) | 20) & 0xFu; }
#define XB_SPIN(cond, bar) do { unsigned _sp = 0; while (cond) { __builtin_amdgcn_s_sleep(1); \
    if ((++_sp & 255u) == 0u) { if (xb_ld(&(bar)[XB_TMO])) break; if (_sp > XB_SPIN_CAP) { atomicAdd(&(bar)[XB_TMO], 1u); break; } } } } while (0)
struct XcdBarrier { unsigned* bar; unsigned x; volatile LDS_AS unsigned* st; };
__device__ __forceinline__ XcdBarrier xcd_barrier_post(unsigned* bar, volatile LDS_AS unsigned* st) {
  XcdBarrier b; b.bar = bar; b.x = xb_xcc_id(); b.st = st;
  if (threadIdx.x == 0) (void)xb_add(&bar[XB_XCNT(b.x)], 1u);
  return b;
}
__device__ __forceinline__ void xcd_barrier_complete(unsigned* bar, unsigned x, unsigned& nloc, unsigned& nx) {
  const unsigned G = gridDim.x * gridDim.y * gridDim.z;
  unsigned sum, cnt, mine, sp = 0u;
  for (;;) {
    sum = 0u; cnt = 0u; mine = 0u;
#pragma unroll
    for (unsigned j = 0; j < 16; ++j) { const unsigned c = xb_ld(&bar[XB_XCNT(j)]); sum += c; cnt += (c > 0u) ? 1u : 0u; mine = (j == x) ? c : mine; }
    if (sum == G) break;
    __builtin_amdgcn_s_sleep(1);
    if ((++sp & 255u) == 0u) { if (xb_ld(&bar[XB_TMO])) break; if (sp > XB_SPIN_CAP) { atomicAdd(&bar[XB_TMO], 1u); break; } }
  }
  nloc = mine > 0u ? mine : 1u; nx = cnt > 0u ? cnt : 1u;
}
__device__ __forceinline__ void xcd_barrier(const XcdBarrier& b0) {
  asm volatile("s_waitcnt vmcnt(0)" ::: "memory");
  __syncthreads();
  if (threadIdx.x == 0) {
    XcdBarrier b = b0; b.x = xb_xcc_id();
    unsigned* bar = b.bar;
    __builtin_amdgcn_s_waitcnt(0);
    unsigned nloc = b.st[0], nx = b.st[1];
    if (nloc == 0u) { xcd_barrier_complete(bar, b.x, nloc, nx); b.st[0] = nloc; b.st[1] = nx; }
    const unsigned old = xb_add(&bar[XB_XSUB(b.x)], 1u);
    const unsigned gen = old / nloc;
    if (old + 1u == (gen + 1u) * nloc) {
      __builtin_amdgcn_fence(__ATOMIC_RELEASE, "agent");
      asm volatile("s_waitcnt vmcnt(0)" ::: "memory");
      const unsigned og = xb_add(&bar[XB_TOP], 1u);
      const unsigned tg = og / nx;
      if (og + 1u == (tg + 1u) * nx) xb_add(&bar[XB_TOPGEN], 1u);
      else XB_SPIN(xb_ld(&bar[XB_TOPGEN]) == tg, bar);
      __builtin_amdgcn_fence(__ATOMIC_ACQUIRE, "agent");
      xb_add(&bar[XB_XGEN(b.x)], 1u);
      asm volatile("s_waitcnt vmcnt(0)" ::: "memory");
    } else {
      XB_SPIN(xb_ld(&bar[XB_XGEN(b.x)]) == gen, bar);
      __builtin_amdgcn_fence(__ATOMIC_ACQUIRE, "agent");
      asm volatile("s_waitcnt vmcnt(0)" ::: "memory");
    }
  }
  __syncthreads();
}

namespace cg = cooperative_groups;
constexpr int MEGA_LDS = GDN_LDS > SSD_LDS ? GDN_LDS : SSD_LDS;
static_assert(MEGA_LDS <= 81408 && GEMM_LDS_BYTES <= MEGA_LDS && 4 * NA_LDS_WAVE <= MEGA_LDS, "LDS budget");
__global__ void __launch_bounds__(256, 2) k_mega(Params p_unused) {
  const AS4 Params* kp = (const AS4 Params*)__builtin_amdgcn_kernarg_segment_ptr();
#define PP (*p_launder(kp))
  cg::grid_group grid = cg::this_grid();
  __shared__ __attribute__((aligned(16))) char smem[MEGA_LDS];
  const int bid = blockIdx.x, nb = gridDim.x;
  __shared__ uint4 xb_words;
  if (threadIdx.x == 0) xb_words = make_uint4(0u, 0u, 0u, 0u);
  __syncthreads();
  const XcdBarrier xb = xcd_barrier_post(PP.BAR, (volatile LDS_AS unsigned*)&xb_words);
  phase_pro(PP, bid, nb);
  phase_modp(PP, bid, nb, (float*)smem);
  grid.sync();
  phase_modfin(PP, bid, nb);
  xcd_barrier(xb);
  phase_norm(PP, 0, 0, bid, nb);
  xcd_barrier(xb);
#pragma unroll 1
  for (int layer = 0; layer < 2; ++layer) {
    phase_g1(PP, layer, bid, nb, (bf16_t*)smem);
    xcd_barrier(xb);
    phase_prep(PP, layer, bid, nb, (bf16_t*)smem);
    xcd_barrier(xb);
    {
      __shared__ int s_role;
      unsigned* chain_ctr = PP.CTR + 8 + layer;
      if (threadIdx.x == 0) {
        const unsigned key = (((unsigned)__builtin_amdgcn_s_getreg((3 << 11) | 20) & 0xFu) << 8) | (((unsigned)__builtin_amdgcn_s_getreg(63492) >> 8) & 0xffu);
        const unsigned slot = nb > 256 ? atomicAdd(PP.CTR + 64 + 2048 * layer + key, 1u) : 0u;
        s_role = slot == 0 ? (int)atomicAdd(chain_ctr, 1u) : 1 << 20;
      }
      __syncthreads();
      int c = s_role;
      __syncthreads();
      if (c < 128) phase_gdn(PP, layer, c, smem); else if (c < 256) phase_ssd(PP, layer, c - 128, smem);
      __syncthreads();
      phase_na(PP, layer, PP.CTR + layer, smem);
      for (;;) {
        __syncthreads();
        if (threadIdx.x == 0) s_role = (int)atomicAdd(chain_ctr, 1u);
        __syncthreads();
        c = s_role;
        if (c >= 256) break;
        if (c < 128) phase_gdn(PP, layer, c, smem); else phase_ssd(PP, layer, c - 128, smem);
      }
    }
    xcd_barrier(xb);
    phase_fin(PP, layer, bid, nb);
    xcd_barrier(xb);
    phase_g2a(PP, layer, bid, nb, (bf16_t*)smem);
    xcd_barrier(xb);
    phase_g2b(PP, layer, bid, nb, (bf16_t*)smem);
    xcd_barrier(xb);
    phase_g3(PP, layer, bid, nb, (bf16_t*)smem);
    xcd_barrier(xb);
    phase_norm(PP, layer, 1, bid, nb);
    xcd_barrier(xb);
    phase_g4(PP, layer, bid, nb, (bf16_t*)smem);
    xcd_barrier(xb);
    phase_g5(PP, layer, bid, nb, (bf16_t*)smem);
    if (layer == 0) { xcd_barrier(xb); phase_norm(PP, 1, 0, bid, nb); xcd_barrier(xb); }
  }
#undef PP
}

extern "C" void kernel_launch(void* const* d_in, const int* in_sizes, int n_in, void* d_out, int out_size, void* d_ws, size_t ws_size,
                              hipStream_t stream) {
  Params p{};
  const float** fp = (const float**)&p;
  for (int i = 0; i < 28; ++i) fp[i] = (const float*)d_in[i];
  p.out = (float*)d_out;
  char* ws = (char*)d_ws;
  size_t off = 0;
  auto take = [&](size_t bytes) { char* r = ws + off; off += (bytes + 255) & ~(size_t)255; return r; };
  p.U = (bf16_t*)take((size_t)TT * UW * 2);
  p.S = (float*)take((size_t)TT * SWD * 4);
  p.MOD = (float*)take((size_t)2 * 9 * 6144 * 4);
  p.SS = (float*)take((size_t)4 * TT * 4);
  p.ROPE = (float*)take(64 * 16 * 2 * 4);
  p.BAR = (unsigned*)take((size_t)XCD_BAR_WORDS * 4 + (64 + 2 * 2048) * 4);
  p.CTR = p.BAR + XCD_BAR_WORDS;
  p.P = (bf16_t*)take((size_t)TT * 1024 * 2);
  p.XC = (float*)take((size_t)TC * 1024 * 4);
  p.WT = (bf16_t*)(ws + off);
  p.HB = (bf16_t*)p.XC;
  p.OG0 = (bf16_t*)d_out;
  p.OG1 = (bf16_t*)((char*)p.P + (size_t)TL * 1024 * 2);
  size_t need = (size_t)((char*)p.OG1 - ws) + (size_t)2 * TL * 512 * 2;
  { const size_t need2 = off + (size_t)2 * 1024 * DFF * 2; if (need2 > need) need = need2; }
  if (need > ws_size) { fprintf(stderr, "workspace too small: need %zu have %zu\n", need, ws_size); return; }
  static int grid_blocks = 0;
  if (!grid_blocks) {
    int dev = 0, cus = 0, per_cu = 0;
    hipGetDevice(&dev);
    hipDeviceGetAttribute(&cus, hipDeviceAttributeMultiprocessorCount, dev);
    hipOccupancyMaxActiveBlocksPerMultiprocessor(&per_cu, k_mega, 256, 0);
    if (per_cu > 2) per_cu = 2;
    grid_blocks = cus * per_cu;
  }
  hipMemsetAsync(p.BAR, 0, (size_t)XCD_BAR_WORDS * 4 + (64 + 2 * 2048) * 4, stream);
  void* args[] = {&p};
  hipError_t e = hipLaunchCooperativeKernel((void*)k_mega, dim3(grid_blocks), dim3(256), args, 0, stream);
  if (e != hipSuccess) fprintf(stderr, "cooperative launch failed: %s (grid %d)\n", hipGetErrorString(e), grid_blocks);
}
```

```cpp
#include <hip/hip_runtime.h>
#include <hip/hip_cooperative_groups.h>
#include <cstdio>
#include <cstdint>

typedef unsigned short bf16_t;
typedef short bf16x8 __attribute__((ext_vector_type(8)));
typedef short s16x4 __attribute__((ext_vector_type(4)));
typedef float f32x4 __attribute__((ext_vector_type(4)));
#define LDS_AS __attribute__((address_space(3)))

constexpr int TL = 16384;
constexpr int TC = 2048;
constexpr int TT = TL + TC;
constexpr int DM = 1024;
constexpr int UW = 6144;
constexpr int SWD = 64;
constexpr int DIN = 9280;
constexpr int DFF = 4096;
constexpr float EPS = 1e-6f;
constexpr int U_NAQ = 0, U_NAK = 512, U_NAV = 1024;
constexpr int U_DNQ = 1536, U_DNK = 2048, U_DNV = 2560, U_DNZ = 3072;
constexpr int U_SZ = 3584, U_SX = 4608, U_SB = 5632, U_SC = 5888;
constexpr int U_YA = 0, U_YB = 512, U_YC = 1024, U_GATE = 2048, U_M = 5120;

struct Params {
  const float *x, *c, *ctx, *c_ctx, *w_ada, *b_ada, *norm1_g, *norm2_g, *w_in, *na_q_gain, *na_k_gain, *na_rpb,
      *dn_conv_w, *dn_a_log, *dn_dt_bias, *dn_o_gain, *ssd_conv_w, *ssd_conv_b, *ssd_a_log, *ssd_dt_bias, *ssd_d,
      *ssd_o_gain, *w_pa, *w_pb, *w_pc, *w_out, *w_ff1, *w_ff2;
  float* out;
  bf16_t* U;
  float* S;
  bf16_t* P;
  float* XC;
  bf16_t* WT;
  float* MOD;
  float* SS;
  float* ROPE;
  unsigned* BAR;
  unsigned* CTR;
  bf16_t* HB;
  bf16_t* OG0;
  bf16_t* OG1;
};

#define AS4 __attribute__((address_space(4)))
typedef const AS4 Params& PRef;
__device__ __forceinline__ const AS4 Params* p_launder(const AS4 Params* q) { asm volatile("" : "+s"(q)); return q; }

__device__ __forceinline__ int tidx() { int t = threadIdx.x; asm volatile("" : "+v"(t)); return t; }
__device__ __forceinline__ void wave_lds_sync() { __builtin_amdgcn_fence(__ATOMIC_RELEASE, "workgroup"); __builtin_amdgcn_wave_barrier(); __builtin_amdgcn_fence(__ATOMIC_ACQUIRE, "workgroup"); }
__device__ __forceinline__ float bf2f(bf16_t v) { return __uint_as_float(((unsigned)v) << 16); }
__device__ __forceinline__ bf16_t f2bf(float f) {
  unsigned u = __float_as_uint(f);
  u += 0x7fffu + ((u >> 16) & 1u);
  return (bf16_t)(u >> 16);
}
__device__ __forceinline__ unsigned pack2(float a, float b) { return (unsigned)f2bf(a) | ((unsigned)f2bf(b) << 16); }
__device__ __forceinline__ float bflo(unsigned w) { return __uint_as_float(w << 16); }
__device__ __forceinline__ float bfhi(unsigned w) { return __uint_as_float(w & 0xffff0000u); }
__device__ __forceinline__ float wave_sum(float v) {
#pragma unroll
  for (int o = 32; o; o >>= 1) v += __shfl_xor(v, o);
  return v;
}
__device__ __forceinline__ float wave_max(float v) {
#pragma unroll
  for (int o = 32; o; o >>= 1) v = fmaxf(v, __shfl_xor(v, o));
  return v;
}
__device__ __forceinline__ float siluf(float v) { return v * __builtin_amdgcn_rcpf(1.f + __expf(-v)); }
__device__ __forceinline__ float sigmoidf_(float v) { return __builtin_amdgcn_rcpf(1.f + __expf(-v)); }
__device__ __forceinline__ float softplusf_(float v) {
  const float u = __expf(fminf(v, 20.f));
  const float sp = u < 0.01f ? u * (1.f - u * (0.5f - u * (1.f / 3.f))) : __logf(1.f + u);
  return v > 20.f ? v : sp;
}

__device__ __forceinline__ const float* xrow_in(PRef p, int layer, int row) {
  if (layer == 0) return row < TL ? p.x + (size_t)row * DM : p.ctx + (size_t)(row - TL) * DM;
  return row < TL ? p.out + (size_t)row * DM : p.XC + (size_t)(row - TL) * DM;
}
__device__ __forceinline__ float* xrow_out(PRef p, int row) {
  return row < TL ? p.out + (size_t)row * DM : p.XC + (size_t)(row - TL) * DM;
}
__device__ __forceinline__ int modrow(int row) { return row < TL ? (row >> 11) : 8; }

constexpr int G_BK = 32;
constexpr int G_ASTR = G_BK + 8;
constexpr int G_ATILE = 256 * G_ASTR;
constexpr int GEMM_LDS_BYTES = 2 * (G_ATILE + G_BK * (128 + 16)) * 2;
__device__ __forceinline__ s16x4 tr16(const bf16_t* ptr) { return __builtin_amdgcn_ds_read_tr16_b64_v4i16((LDS_AS s16x4*)ptr); }
__device__ __forceinline__ bf16x8 cat8(s16x4 lo, s16x4 hi) { return (bf16x8){lo[0], lo[1], lo[2], lo[3], hi[0], hi[1], hi[2], hi[3]}; }
__device__ __forceinline__ uint4 cvt8(float4 a, float4 b) { uint4 o; o.x = pack2(a.x, a.y); o.y = pack2(a.z, a.w); o.z = pack2(b.x, b.y); o.w = pack2(b.z, b.w); return o; }

__device__ __forceinline__ void gemm_main2(f32x4 (&acc)[8][2], const bf16_t* A, int astride, const bf16_t* W, int ldw, int col0, int K, bf16_t* lds) {
  constexpr int NI = 2, BSTR = 80, BTILE = G_BK * BSTR;
  const int tid = tidx(), lane = tid & 63, wave = tid >> 6, wm = wave >> 1, wn = wave & 1, g = lane >> 4, l15 = lane & 15, q4 = l15 >> 2, p4 = lane & 3;
  bf16_t* As = lds;
  bf16_t* Bs = lds + 2 * G_ATILE;
  const int ar = tid >> 2, ak = (tid & 3) * 8;
  const int bk = tid >> 3, bn = (tid & 7) * 8;
  const int rho0 = (bk & 3) + 4 * ((bk >> 3) & 3) + 16 * ((bk >> 2) & 1);
  const bf16_t* ap = A + (size_t)ar * astride + ak;
  const bf16_t* bp = W + (size_t)bk * ldw + col0 + bn;
  bf16_t* aw = As + ar * G_ASTR + ak;
  bf16_t* bw = Bs + rho0 * BSTR + bn;
  uint4 ra0, ra1, ra2, ra3, rb0;
#define G_LOADS(K1) { ra0 = *(const uint4*)(ap + (size_t)(64 * 0) * astride + (K1)); ra1 = *(const uint4*)(ap + (size_t)(64 * 1) * astride + (K1)); ra2 = *(const uint4*)(ap + (size_t)(64 * 2) * astride + (K1)); ra3 = *(const uint4*)(ap + (size_t)(64 * 3) * astride + (K1)); rb0 = *(const uint4*)(bp + (size_t)(K1) * ldw); }
#define G_STORES(NX) { *(uint4*)(aw + (NX) * G_ATILE + 64 * 0 * G_ASTR) = ra0; *(uint4*)(aw + (NX) * G_ATILE + 64 * 1 * G_ASTR) = ra1; *(uint4*)(aw + (NX) * G_ATILE + 64 * 2 * G_ASTR) = ra2; *(uint4*)(aw + (NX) * G_ATILE + 64 * 3 * G_ASTR) = ra3; *(uint4*)(bw + (NX) * BTILE + 0 * BSTR) = rb0; }
  G_LOADS(0)
  G_STORES(0)
  __syncthreads();
  const int nk = K / G_BK;
  for (int kt = 0; kt < nk; ++kt) {
    const int cur = kt & 1;
    const int k1 = (kt + 1 < nk ? kt + 1 : kt) * G_BK;
    G_LOADS(k1)
    asm volatile("" ::: "memory");
    const bf16_t* Ac = As + cur * G_ATILE + (128 * wm + l15) * G_ASTR + 8 * g;
    const bf16_t* Bc = Bs + cur * BTILE + (4 * g + q4) * BSTR + 16 * NI * wn + 4 * p4;
    {
      bf16x8 af[8], bfr[NI];
#pragma unroll
      for (int mi = 0; mi < 8; ++mi) af[mi] = *(const bf16x8*)(Ac + mi * 16 * G_ASTR);
#pragma unroll
      for (int ni = 0; ni < NI; ++ni) bfr[ni] = cat8(tr16(Bc + 16 * ni), tr16(Bc + 16 * BSTR + 16 * ni));
#pragma unroll
      for (int mi = 0; mi < 8; ++mi)
#pragma unroll
        for (int ni = 0; ni < NI; ++ni) acc[mi][ni] = __builtin_amdgcn_mfma_f32_16x16x32_bf16(bfr[ni], af[mi], acc[mi][ni], 0, 0, 0);
    }
    asm volatile("" ::: "memory");
    __builtin_amdgcn_sched_barrier(0);
    G_STORES(cur ^ 1)
    __syncthreads();
  }
#undef G_LOADS
#undef G_STORES
}
__device__ __forceinline__ void gemm_main4(f32x4 (&acc)[8][4], const bf16_t* A, int astride, const bf16_t* W, int ldw, int col0, int K, bf16_t* lds) {
  constexpr int NI = 4, BSTR = 144, BTILE = G_BK * BSTR;
  const int tid = tidx(), lane = tid & 63, wave = tid >> 6, wm = wave >> 1, wn = wave & 1, g = lane >> 4, l15 = lane & 15, q4 = l15 >> 2, p4 = lane & 3;
  bf16_t* As = lds;
  bf16_t* Bs = lds + 2 * G_ATILE;
  const int ar = tid >> 2, ak = (tid & 3) * 8;
  const int bk = tid >> 4, bn = (tid & 15) * 8;
  const int rho0 = (bk & 3) + 4 * (bk >> 3) + 16 * ((bk >> 2) & 1);
  const bf16_t* ap = A + (size_t)ar * astride + ak;
  const bf16_t* bp = W + (size_t)bk * ldw + col0 + bn;
  bf16_t* aw = As + ar * G_ASTR + ak;
  bf16_t* bw = Bs + rho0 * BSTR + bn;
  uint4 ra0, ra1, ra2, ra3, rb0, rb1;
#define G_LOADS(K1) { ra0 = *(const uint4*)(ap + (size_t)(64 * 0) * astride + (K1)); ra1 = *(const uint4*)(ap + (size_t)(64 * 1) * astride + (K1)); ra2 = *(const uint4*)(ap + (size_t)(64 * 2) * astride + (K1)); ra3 = *(const uint4*)(ap + (size_t)(64 * 3) * astride + (K1)); rb0 = *(const uint4*)(bp + (size_t)((K1) + 16 * 0) * ldw); rb1 = *(const uint4*)(bp + (size_t)((K1) + 16 * 1) * ldw); }
#define G_STORES(NX) { *(uint4*)(aw + (NX) * G_ATILE + 64 * 0 * G_ASTR) = ra0; *(uint4*)(aw + (NX) * G_ATILE + 64 * 1 * G_ASTR) = ra1; *(uint4*)(aw + (NX) * G_ATILE + 64 * 2 * G_ASTR) = ra2; *(uint4*)(aw + (NX) * G_ATILE + 64 * 3 * G_ASTR) = ra3; *(uint4*)(bw + (NX) * BTILE + 0 * BSTR) = rb0; *(uint4*)(bw + (NX) * BTILE + 8 * BSTR) = rb1; }
  G_LOADS(0)
  G_STORES(0)
  __syncthreads();
  const int nk = K / G_BK;
  for (int kt = 0; kt < nk; ++kt) {
    const int cur = kt & 1;
    const int k1 = (kt + 1 < nk ? kt + 1 : kt) * G_BK;
    G_LOADS(k1)
    asm volatile("" ::: "memory");
    const bf16_t* Ac = As + cur * G_ATILE + (128 * wm + l15) * G_ASTR + 8 * g;
    const bf16_t* Bc = Bs + cur * BTILE + (4 * g + q4) * BSTR + 16 * NI * wn + 4 * p4;
    {
      bf16x8 af[8], bfr[NI];
#pragma unroll
      for (int mi = 0; mi < 8; ++mi) af[mi] = *(const bf16x8*)(Ac + mi * 16 * G_ASTR);
#pragma unroll
      for (int ni = 0; ni < NI; ++ni) bfr[ni] = cat8(tr16(Bc + 16 * ni), tr16(Bc + 16 * BSTR + 16 * ni));
#pragma unroll
      for (int mi = 0; mi < 8; ++mi)
#pragma unroll
        for (int ni = 0; ni < NI; ++ni) acc[mi][ni] = __builtin_amdgcn_mfma_f32_16x16x32_bf16(bfr[ni], af[mi], acc[mi][ni], 0, 0, 0);
    }
    asm volatile("" ::: "memory");
    __builtin_amdgcn_sched_barrier(0);
    G_STORES(cur ^ 1)
    __syncthreads();
  }
#undef G_LOADS
#undef G_STORES
}
template <int NI> __device__ __forceinline__ void acc_zero(f32x4 (&acc)[8][NI]) {
#pragma unroll
  for (int i = 0; i < 8; ++i)
#pragma unroll
    for (int j = 0; j < NI; ++j) acc[i][j] = (f32x4){0.f, 0.f, 0.f, 0.f};
}
__device__ __forceinline__ void wconv(const float* src, int sld, int soff, bool win_order, bf16_t* dst, int dld, int rows, int cols, int bid, int nb) {
  const int cpr = cols >> 3, total = rows * cpr;
  for (int i = bid * 256 + tidx(); i < total; i += nb * 256) {
    const int r = i / cpr, c = (i - r * cpr) << 3;
    int sc = c + soff;
    if (win_order) { if (c < 3584) sc = c; else if (c < 6144) sc = c + 32; else { const int o = c - 6144; sc = o < 32 ? 3584 + o : (o < 64 ? 6176 + o - 32 : -1); } }
    uint4 o = make_uint4(0u, 0u, 0u, 0u);
    if (sc >= 0) { const float* sp = src + (size_t)r * sld + sc; o = cvt8(*(const float4*)sp, *(const float4*)(sp + 4)); }
    *(uint4*)(dst + (size_t)r * dld + c) = o;
  }
}
constexpr int WIN_LD = 6272;
constexpr int U_W = 5120;
constexpr int UWR_G = 0, UWR_PA = 3072, UWR_PB = 3584, UWR_PC = 4096, UWR_OUT = 5120;
__device__ __forceinline__ bool tile_next(int i, int bid, int nb, int nMt, int nNt, bool nsplit, int& mt, int& nt) {
  const int xcd = bid & 7, slot = bid >> 3, nslots = nb >> 3;
  const int j = slot + i * nslots;
  if (nsplit) {
    const int nNx = (nNt - xcd + 7) >> 3;
    if (j >= nMt * nNx) return false;
    mt = j / nNx; nt = xcd + 8 * (j % nNx);
  } else {
    const int nMx = (nMt - xcd + 7) >> 3;
    if (j >= nMx * nNt) return false;
    mt = xcd + 8 * (j / nNt); nt = j % nNt;
  }
  return true;
}
#define EPI_IDS const int lane = tidx() & 63, wave = tidx() >> 6, wm = wave >> 1, wn = wave & 1, g = lane >> 4, l15 = lane & 15

__device__ __forceinline__ void phase_pro(PRef p, int bid, int nb) {
  const int tid = tidx(), lane = tid & 63, wave = tid >> 6;
  for (int i = bid * 256 + tid; i < 64 * 16; i += nb * 256) {
    const int pos = i >> 4, fi = i & 15;
    const float inv = __builtin_amdgcn_exp2f(-(float)fi * 0.83048202372184f);
    float ang = (float)pos * inv;
    const float kk = rintf(ang * 0.15915494309189535f);
    ang = fmaf(-kk, 6.2831854820251465f, ang); ang = fmaf(-kk, -1.7484555314695172e-07f, ang);
    p.ROPE[2 * i] = __cosf(ang); p.ROPE[2 * i + 1] = __sinf(ang);
  }
}
__device__ __forceinline__ void phase_modp(PRef p, int bid, int nb, float* lds) {
  const int tid = tidx();
  float* MODP = (float*)p.U;
  for (int u = bid; u < 768; u += nb) {
    const int ks = u & 15, cb = (u >> 4) % 24, l = u / 384, n = cb * 256 + tid;
    __syncthreads();
    for (int i = tid; i < 9 * 64; i += 256) { const int r = i >> 6, k = 64 * ks + (i & 63); const float v = r < 8 ? p.c[r * 1024 + k] : p.c_ctx[k]; lds[i] = siluf(v); }
    __syncthreads();
    float acc[9];
#pragma unroll
    for (int r = 0; r < 9; ++r) acc[r] = 0.f;
    const float* w = p.w_ada + ((size_t)l * 1024 + 64 * ks) * 6144 + n;
#pragma unroll 16
    for (int k = 0; k < 64; ++k) {
      const float wv = w[(size_t)k * 6144];
#pragma unroll
      for (int r = 0; r < 9; ++r) acc[r] += lds[r * 64 + k] * wv;
    }
#pragma unroll
    for (int r = 0; r < 9; ++r) MODP[((size_t)(ks * 2 + l) * 9 + r) * 6144 + n] = acc[r];
  }
}
__device__ __forceinline__ void phase_modfin(PRef p, int bid, int nb) {
  const float* MODP = (const float*)p.U;
  for (int i = bid * 256 + tidx(); i < 2 * 9 * 6144; i += nb * 256) {
    const int l = i / (9 * 6144), rem = i % (9 * 6144), r = rem / 6144, n = rem % 6144;
    float v = p.b_ada[l * 6144 + n];
#pragma unroll
    for (int ks = 0; ks < 16; ++ks) v += MODP[((size_t)(ks * 2 + l) * 9 + r) * 6144 + n];
    const int chunk = n >> 10, kk = n & 1023;
    if (chunk == 1) v = p.norm1_g[l * 1024 + kk] * (1.f + v);
    if (chunk == 4) v = p.norm2_g[l * 1024 + kk] * (1.f + v);
    p.MOD[i] = v;
  }
}

__device__ __forceinline__ void norm_rows4(const float* x0, const float* x1, const float* x2, const float* x3, const float* alpha, const float* shift, bf16_t* h0, int lane) {
  const float* xr[4] = {x0, x1, x2, x3};
  float4 v[4][4];
#pragma unroll
  for (int j = 0; j < 4; ++j)
#pragma unroll
    for (int i = 0; i < 4; ++i) v[j][i] = *(const float4*)(xr[j] + lane * 4 + 256 * i);
  float rs[4];
#pragma unroll
  for (int j = 0; j < 4; ++j) {
    float ssq = 0.f;
#pragma unroll
    for (int i = 0; i < 4; ++i) ssq += v[j][i].x * v[j][i].x + v[j][i].y * v[j][i].y + v[j][i].z * v[j][i].z + v[j][i].w * v[j][i].w;
    rs[j] = rsqrtf(wave_sum(ssq) * (1.f / DM) + EPS);
  }
#pragma unroll
  for (int i = 0; i < 4; ++i) {
    const int k = lane * 4 + 256 * i;
    const float4 a = *(const float4*)(alpha + k), s = *(const float4*)(shift + k);
#pragma unroll
    for (int j = 0; j < 4; ++j) {
      uint2 o; o.x = pack2(v[j][i].x * rs[j] * a.x + s.x, v[j][i].y * rs[j] * a.y + s.y); o.y = pack2(v[j][i].z * rs[j] * a.z + s.z, v[j][i].w * rs[j] * a.w + s.w);
      *(uint2*)(h0 + (size_t)j * 1024 + k) = o;
    }
  }
}
__device__ __forceinline__ void phase_norm(PRef p, int layer, int which, int bid, int nb) {
  if (which == 0) wconv(p.w_in + (size_t)layer * 1024 * DIN, DIN, 0, true, p.WT, WIN_LD, 1024, WIN_LD, bid, nb);
  else {
    wconv(p.w_ff1 + (size_t)layer * 1024 * DFF, DFF, 0, false, p.WT, DFF, 1024, DFF, bid, nb);
    wconv(p.w_ff2 + (size_t)layer * DFF * 1024, 1024, 0, false, p.WT + (size_t)1024 * DFF, 1024, DFF, 1024, bid, nb);
  }
  const int lane = tidx() & 63, wave = tidx() >> 6;
  const int nrow = (which == 1 && layer == 1) ? TL : TT;
  const float* modl = p.MOD + (size_t)layer * 9 * 6144;
  const int lin = which == 0 ? layer : 1;
  for (int row = (bid * 4 + wave) * 4; row < nrow; row += nb * 16) {
    const float* mr = modl + modrow(row) * 6144;
    norm_rows4(xrow_in(p, lin, row), xrow_in(p, lin, row + 1), xrow_in(p, lin, row + 2), xrow_in(p, lin, row + 3),
               mr + (which ? 4096 : 1024), mr + (which ? 3072 : 0), p.P + (size_t)row * 1024, lane);
  }
}

__device__ __forceinline__ void phase_g1(PRef p, int layer, int bid, int nb, bf16_t* lds) {
  constexpr bool NSPLIT = true;
  const int nMt = TT / 256, nNt = 49;
  EPI_IDS;
  for (int ti = 0;; ++ti) {
    int mt, nt; if (!tile_next(ti, bid, nb, nMt, nNt, NSPLIT, mt, nt)) break;
    const int m0 = mt * 256, n0 = nt * 128;
    f32x4 acc[8][4]; acc_zero<4>(acc);
    gemm_main4(acc, p.P + (size_t)m0 * 1024, 1024, p.WT, WIN_LD, n0, 1024, lds);
    if (n0 < 1024) {
      const float* gain = (n0 < 512 ? p.na_q_gain : p.na_k_gain) + layer * 64;
      const float mul = n0 < 512 ? 0.125f : 1.f;
#pragma unroll
      for (int mi = 0; mi < 8; ++mi) {
        float ss = 0.f;
#pragma unroll
        for (int ni = 0; ni < 4; ++ni) ss += acc[mi][ni][0] * acc[mi][ni][0] + acc[mi][ni][1] * acc[mi][ni][1] + acc[mi][ni][2] * acc[mi][ni][2] + acc[mi][ni][3] * acc[mi][ni][3];
        ss += __shfl_xor(ss, 16); ss += __shfl_xor(ss, 32);
        const float rs = rsqrtf(ss * (1.f / 64.f) + EPS) * mul;
        const int row = m0 + 128 * wm + 16 * mi + l15;
#pragma unroll
        for (int ni = 0; ni < 4; ++ni) {
          const int cl = 16 * ni + 4 * g;
          const float4 gv = *(const float4*)(gain + cl);
          uint2 o; o.x = pack2(acc[mi][ni][0] * rs * gv.x, acc[mi][ni][1] * rs * gv.y); o.y = pack2(acc[mi][ni][2] * rs * gv.z, acc[mi][ni][3] * rs * gv.w);
          *(uint2*)(p.U + (size_t)row * UW + n0 + 64 * wn + cl) = o;
        }
      }
    } else if (n0 < 6144) {
      const bool hsec = (n0 >= 1536 && n0 < 3072) || n0 >= 4608;
      const int hcol0 = n0 < 3072 ? n0 - 1536 : n0 - 3072;
#pragma unroll
      for (int mi = 0; mi < 8; ++mi) {
        const int row = m0 + 128 * wm + 16 * mi + l15;
        const int rr = row & 63;
        const bool halo = hsec && (rr < 2 || rr >= 62);
        bf16_t* hb = p.HB + ((size_t)(row >> 6) * 4 + (rr < 2 ? rr : rr - 60)) * 3072 + hcol0 + 64 * wn + 4 * g;
#pragma unroll
        for (int ni = 0; ni < 4; ++ni) {
          uint2 o; o.x = pack2(acc[mi][ni][0], acc[mi][ni][1]); o.y = pack2(acc[mi][ni][2], acc[mi][ni][3]);
          *(uint2*)(p.U + (size_t)row * UW + n0 + 64 * wn + 16 * ni + 4 * g) = o;
          if (halo) *(uint2*)(hb + 16 * ni) = o;
        }
      }
    } else if (wn == 0) {
#pragma unroll
      for (int mi = 0; mi < 8; ++mi) {
        const int row = m0 + 128 * wm + 16 * mi + l15;
#pragma unroll
        for (int ni = 0; ni < 4; ++ni) *(f32x4*)(p.S + (size_t)row * SWD + 16 * ni + 4 * g) = acc[mi][ni];
      }
    }
  }
}

__device__ __forceinline__ void phase_g2a(PRef p, int layer, int bid, int nb, bf16_t* lds) {
  constexpr bool NSPLIT = true;
  const int nMt = (layer == 0 ? TT : TL) / 256, nNt = 24;
  EPI_IDS;
  for (int ti = 0;; ++ti) {
    int mt, nt; if (!tile_next(ti, bid, nb, nMt, nNt, NSPLIT, mt, nt)) break;
    const int m0 = mt * 256, n0 = nt * 128;
    f32x4 acc[8][4]; acc_zero<4>(acc);
    gemm_main4(acc, p.P + (size_t)m0 * 1024, 1024, p.U + U_W + (size_t)(UWR_G + 1024 * (n0 >> 10)) * UW, UW, n0 & 1023, 1024, lds);
#pragma unroll
    for (int mi = 0; mi < 8; ++mi) {
      const int row = m0 + 128 * wm + 16 * mi + l15;
#pragma unroll
      for (int ni = 0; ni < 4; ++ni) {
        uint2 o; o.x = pack2(sigmoidf_(acc[mi][ni][0]), sigmoidf_(acc[mi][ni][1])); o.y = pack2(sigmoidf_(acc[mi][ni][2]), sigmoidf_(acc[mi][ni][3]));
        *(uint2*)(p.U + (size_t)row * UW + U_GATE + n0 + 64 * wn + 16 * ni + 4 * g) = o;
      }
    }
  }
}
__device__ __forceinline__ void phase_g2b(PRef p, int layer, int bid, int nb, bf16_t* lds) {
  constexpr bool NSPLIT = false;
  const int nMt = (layer == 0 ? TT : TL) / 256, nNt = 16;
  EPI_IDS;
  for (int ti = 0;; ++ti) {
    int mt, nt; if (!tile_next(ti, bid, nb, nMt, nNt, NSPLIT, mt, nt)) break;
    const int m0 = mt * 256, n0 = nt * 64;
    f32x4 accm[8][2]; acc_zero<2>(accm);
#pragma unroll 1
    for (int i = 0; i < 3; ++i) {
      const int ycol = i == 0 ? U_YA : (i == 1 ? U_YB : U_YC);
      const int Ki = i == 2 ? 1024 : 512;
      const bf16_t* w = p.U + U_W + (size_t)(i == 0 ? UWR_PA : (i == 1 ? UWR_PB : UWR_PC)) * UW;
      f32x4 acc[8][2]; acc_zero<2>(acc);
      gemm_main2(acc, p.U + (size_t)m0 * UW + ycol, UW, w, UW, n0, Ki, lds);
#pragma unroll
      for (int mi = 0; mi < 8; ++mi) {
        const int row = m0 + 128 * wm + 16 * mi + l15;
#pragma unroll
        for (int ni = 0; ni < 2; ++ni) {
          const uint2 gt = *(const uint2*)(p.U + (size_t)row * UW + U_GATE + 1024 * i + n0 + 32 * wn + 16 * ni + 4 * g);
          accm[mi][ni][0] += bflo(gt.x) * acc[mi][ni][0]; accm[mi][ni][1] += bfhi(gt.x) * acc[mi][ni][1];
          accm[mi][ni][2] += bflo(gt.y) * acc[mi][ni][2]; accm[mi][ni][3] += bfhi(gt.y) * acc[mi][ni][3];
        }
      }
    }
#pragma unroll
    for (int mi = 0; mi < 8; ++mi) {
      const int row = m0 + 128 * wm + 16 * mi + l15;
#pragma unroll
      for (int ni = 0; ni < 2; ++ni) {
        uint2 o; o.x = pack2(accm[mi][ni][0], accm[mi][ni][1]); o.y = pack2(accm[mi][ni][2], accm[mi][ni][3]);
        *(uint2*)(p.P + (size_t)row * 1024 + n0 + 32 * wn + 16 * ni + 4 * g) = o;
      }
    }
  }
}
template <int NI> __device__ __forceinline__ void epi_residual(PRef p, const f32x4 (&acc)[8][NI], int layer_in, int m0, int n0, const float* gate) {
  EPI_IDS;
#pragma unroll
  for (int mi = 0; mi < 8; ++mi) {
    const int row = m0 + 128 * wm + 16 * mi + l15;
    const float* xi = xrow_in(p, layer_in, row);
    float* xo = xrow_out(p, row);
    const float* gr = gate + modrow(row) * 6144;
#pragma unroll
    for (int ni = 0; ni < NI; ++ni) {
      const int col = n0 + 16 * NI * wn + 16 * ni + 4 * g;
      const float4 xv = *(const float4*)(xi + col);
      const float4 gv = *(const float4*)(gr + col);
      float4 o;
      o.x = xv.x + gv.x * acc[mi][ni][0]; o.y = xv.y + gv.y * acc[mi][ni][1]; o.z = xv.z + gv.z * acc[mi][ni][2]; o.w = xv.w + gv.w * acc[mi][ni][3];
      *(float4*)(xo + col) = o;
    }
  }
}
__device__ __forceinline__ void phase_g3(PRef p, int layer, int bid, int nb, bf16_t* lds) {
  constexpr bool NSPLIT = false;
  const float* modl = p.MOD + (size_t)layer * 9 * 6144;
  const bf16_t* w = p.U + U_W + (size_t)UWR_OUT * UW;
  for (int ti = 0;; ++ti) {
    int mt, nt; if (!tile_next(ti, bid, nb, TL / 256, 8, NSPLIT, mt, nt)) break;
    const int m0 = mt * 256, n0 = nt * 128;
    f32x4 acc[8][4]; acc_zero<4>(acc);
    gemm_main4(acc, p.P + (size_t)m0 * 1024, 1024, w, UW, n0, 1024, lds);
    epi_residual<4>(p, acc, layer, m0, n0, modl + 2048);
  }
  if (layer == 0) {
    for (int u = bid; u < (TC / 256) * 16; u += nb) {
      const int m0 = TL + (u >> 4) * 256, n0 = (u & 15) * 64;
      f32x4 acc[8][2]; acc_zero<2>(acc);
      gemm_main2(acc, p.P + (size_t)m0 * 1024, 1024, w, UW, n0, 1024, lds);
      epi_residual<2>(p, acc, layer, m0, n0, modl + 2048);
    }
  }
}
__device__ __forceinline__ void phase_g4(PRef p, int layer, int bid, int nb, bf16_t* lds) {
  constexpr bool NSPLIT = true;
  const int nMt = (layer == 0 ? TT : TL) / 256, nNt = 32;
  EPI_IDS;
  for (int ti = 0;; ++ti) {
    int mt, nt; if (!tile_next(ti, bid, nb, nMt, nNt, NSPLIT, mt, nt)) break;
    const int m0 = mt * 256, n0 = nt * 128;
    f32x4 acc[8][4]; acc_zero<4>(acc);
    gemm_main4(acc, p.P + (size_t)m0 * 1024, 1024, p.WT, DFF, n0, 1024, lds);
#pragma unroll
    for (int mi = 0; mi < 8; ++mi) {
      const int row = m0 + 128 * wm + 16 * mi + l15;
#pragma unroll
      for (int ni = 0; ni < 4; ++ni) {
        const float v0 = fmaxf(acc[mi][ni][0], 0.f), v1 = fmaxf(acc[mi][ni][1], 0.f), v2 = fmaxf(acc[mi][ni][2], 0.f), v3 = fmaxf(acc[mi][ni][3], 0.f);
        uint2 o; o.x = pack2(v0 * v0, v1 * v1); o.y = pack2(v2 * v2, v3 * v3);
        *(uint2*)(p.U + (size_t)row * DFF + n0 + 64 * wn + 16 * ni + 4 * g) = o;
      }
    }
  }
}
__device__ __forceinline__ void phase_g5(PRef p, int layer, int bid, int nb, bf16_t* lds) {
  constexpr bool NSPLIT = false;
  const float* modl = p.MOD + (size_t)layer * 9 * 6144;
  const bf16_t* w = p.WT + (size_t)1024 * DFF;
  for (int ti = 0;; ++ti) {
    int mt, nt; if (!tile_next(ti, bid, nb, TL / 256, 8, NSPLIT, mt, nt)) break;
    const int m0 = mt * 256, n0 = nt * 128;
    f32x4 acc[8][4]; acc_zero<4>(acc);
    gemm_main4(acc, p.U + (size_t)m0 * DFF, DFF, w, 1024, n0, DFF, lds);
    epi_residual<4>(p, acc, 1, m0, n0, modl + 5120);
  }
  if (layer == 0) {
    for (int u = bid; u < (TC / 256) * 16; u += nb) {
      const int m0 = TL + (u >> 4) * 256, n0 = (u & 15) * 64;
      f32x4 acc[8][2]; acc_zero<2>(acc);
      gemm_main2(acc, p.U + (size_t)m0 * DFF, DFF, w, 1024, n0, DFF, lds);
      epi_residual<2>(p, acc, 1, m0, n0, modl + 5120);
    }
  }
}

__device__ __forceinline__ void phase_prep(PRef p, int layer, int bid, int nb, bf16_t* lds) {
  const int tid = tidx();
  for (int i = bid * 256 + tid; i < TT * 64; i += nb * 256) {
    const int c = i & 63;
    float v = p.S[i];
    if (c < 16) v = sigmoidf_(v);
    else if (c < 32) v = -expf(p.dn_a_log[layer * 16 + c - 16]) * softplusf_(v + p.dn_dt_bias[layer * 16 + c - 16]);
    else v = softplusf_(v + p.ssd_dt_bias[layer * 32 + c - 32]);
    p.S[i] = v;
  }
  const int cg = tid & 7, rA = tid >> 3;
  {
    int slab_ = bid % 48; asm volatile("" : "+s"(slab_));
    const int slab = slab_, c0 = bid / 48, cstep = (nb + 47 - slab) / 48;
    const bool dn = slab < 24;
    const int typ = dn ? slab >> 3 : 3;
    const int ucol = (dn ? 1536 + 512 * typ + 64 * (slab & 7) : 4608 + 64 * (slab - 24)) + 8 * cg;
    const int hcol = dn ? ucol - 1536 : ucol - 3072;
    const int cch = (dn ? 512 * typ + 64 * (slab & 7) : 64 * (slab - 24)) + 8 * cg;
    const float* cw = (dn ? p.dn_conv_w : p.ssd_conv_w) + (size_t)layer * 5 * 1536 + cch;
    float w5[5][8];
#pragma unroll
    for (int j = 0; j < 5; ++j) {
      const float4 a = *(const float4*)(cw + j * 1536), b = *(const float4*)(cw + j * 1536 + 4);
      w5[j][0] = a.x; w5[j][1] = a.y; w5[j][2] = a.z; w5[j][3] = a.w; w5[j][4] = b.x; w5[j][5] = b.y; w5[j][6] = b.z; w5[j][7] = b.w;
    }
    float bias[8];
#pragma unroll
    for (int e = 0; e < 8; ++e) bias[e] = dn ? 0.f : p.ssd_conv_b[layer * 1536 + cch + e];
    bf16_t* T = lds;
    constexpr int TS_ = 72;
    uint4 pr0, pr1, pr2;
#define PREP_ROW(CHUNK, TR, DST) { \
      const int rr_ = (TR) - 2; \
      const bool lat_ = (CHUNK) < 256; const int cs_ = lat_ ? ((CHUNK) & 31) : (((CHUNK) - 256) & 3); \
      const bool first_ = cs_ == 0, last_ = lat_ ? cs_ == 31 : cs_ == 3; \
      uint4 v_ = make_uint4(0u, 0u, 0u, 0u); \
      if (rr_ < 0) { if (!first_) v_ = *(const uint4*)(p.HB + ((size_t)((CHUNK) - 1) * 4 + 4 + rr_) * 3072 + hcol); } \
      else if (rr_ >= 64) { if (!last_) v_ = *(const uint4*)(p.HB + ((size_t)((CHUNK) + 1) * 4 + rr_ - 64) * 3072 + hcol); } \
      else v_ = *(const uint4*)(p.U + (size_t)((CHUNK) * 64 + rr_) * UW + ucol); \
      DST = v_; }
#define PREP_LOAD(CHUNK) { PREP_ROW(CHUNK, rA, pr0) PREP_ROW(CHUNK, rA + 32, pr1) if (rA < 4) PREP_ROW(CHUNK, rA + 64, pr2) }
    if (c0 < 288) PREP_LOAD(c0)
    for (int chunk = c0; chunk < 288; chunk += cstep) {
      const bool lat = chunk < 256;
      const int cs = lat ? (chunk & 31) : ((chunk - 256) & 3);
      const int r0 = chunk * 64;
      __syncthreads();
      *(uint4*)(T + rA * TS_ + 8 * cg) = pr0; *(uint4*)(T + (rA + 32) * TS_ + 8 * cg) = pr1;
      if (rA < 4) *(uint4*)(T + (rA + 64) * TS_ + 8 * cg) = pr2;
      __syncthreads();
      if (chunk + cstep < 288) PREP_LOAD(chunk + cstep)
#pragma unroll
      for (int it = 0; it < 2; ++it) {
        const int rr = rA + 32 * it;
        float v[8];
#pragma unroll
        for (int e = 0; e < 8; ++e) v[e] = bias[e];
#pragma unroll
        for (int j = 0; j < 5; ++j) {
          const uint4 x = *(const uint4*)(T + (rr + j) * TS_ + 8 * cg);
          v[0] += w5[j][0] * bflo(x.x); v[1] += w5[j][1] * bfhi(x.x); v[2] += w5[j][2] * bflo(x.y); v[3] += w5[j][3] * bfhi(x.y);
          v[4] += w5[j][4] * bflo(x.z); v[5] += w5[j][5] * bfhi(x.z); v[6] += w5[j][6] * bflo(x.w); v[7] += w5[j][7] * bfhi(x.w);
        }
#pragma unroll
        for (int e = 0; e < 8; ++e) v[e] = siluf(v[e]);
        if (typ < 2) {
          float ss = 0.f;
#pragma unroll
          for (int e = 0; e < 8; ++e) ss += v[e] * v[e];
          ss += __shfl_xor(ss, 1); ss += __shfl_xor(ss, 2); ss += __shfl_xor(ss, 4);
          const float rs = rsqrtf(ss + EPS) * (typ == 0 ? 0.125f : 1.f);
          if (lat) {
            const int pos = cg < 4 ? cs : rr;
            const float* rp = p.ROPE + (pos * 16 + 8 * (cg & 1)) * 2;
            const float4 q0 = *(const float4*)rp, q1 = *(const float4*)(rp + 4), q2 = *(const float4*)(rp + 8), q3 = *(const float4*)(rp + 12);
            const float cs8[8] = {q0.x, q0.z, q1.x, q1.z, q2.x, q2.z, q3.x, q3.z}, sn8[8] = {q0.y, q0.w, q1.y, q1.w, q2.y, q2.w, q3.y, q3.w};
#pragma unroll
            for (int e = 0; e < 8; ++e) {
              const float vp = __shfl_xor(v[e], 2);
              v[e] = v[e] * cs8[e] + ((cg & 2) ? vp : -vp) * sn8[e];
            }
          }
#pragma unroll
          for (int e = 0; e < 8; ++e) v[e] *= rs;
        }
        uint4 o; o.x = pack2(v[0], v[1]); o.y = pack2(v[2], v[3]); o.z = pack2(v[4], v[5]); o.w = pack2(v[6], v[7]);
        *(uint4*)(p.U + (size_t)(r0 + rr) * UW + ucol) = o;
      }
    }
#undef PREP_LOAD
#undef PREP_ROW
  }
}

constexpr int XS = 72;
constexpr int BS2 = 136;
constexpr int SSD_LDS = (3 * 64 * XS + 3 * 64 * BS2) * 2 + 2 * 64 * 4;
__device__ __forceinline__ void phase_ssd(PRef p, int layer, int task, char* smem) {
  const int tid = tidx(), lane = tid & 63, wave = tid >> 6, g = lane >> 4, l15 = lane & 15, q4 = l15 >> 2, p4 = lane & 3;
  bf16_t* Xt = (bf16_t*)smem;
  bf16_t* Xs = Xt + 64 * XS;
  bf16_t* Wg = Xs + 64 * XS;
  bf16_t* Bt = Wg + 64 * XS;
  bf16_t* Ct = Bt + 64 * BS2;
  bf16_t* Hb = Ct + 64 * BS2;
  float* dts = (float*)(Hb + 64 * BS2);
  float* lam = dts + 64;
  {
    const int head = task & 15, b = task >> 4, grp = head >> 3;
    f32x4 hst[2][8];
#pragma unroll
    for (int d = 0; d < 2; ++d)
#pragma unroll
      for (int n = 0; n < 8; ++n) hst[d][n] = (f32x4){0.f, 0.f, 0.f, 0.f};
    const float dsk = p.ssd_d[layer * 16 + head];
    const float an0 = -__expf(p.ssd_a_log[layer * 32 + head]), an1 = -__expf(p.ssd_a_log[layer * 32 + 16 + head]);
    uint4 px0, px1, pb0, pb1, pb2, pb3, pc0, pc1, pc2, pc3; float pdt = 0.f;
#define SSD_PREFETCH(IT, DIR) { \
      const int seg_ = (IT) >= 4, ci_ = seg_ ? (IT) - 4 : (IT), nch_ = seg_ ? 32 : 4; \
      const int base_ = seg_ ? b * 2048 : TL + b * 256; \
      const int c_ = (DIR) ? nch_ - 1 - ci_ : ci_; \
      const int i_ = tid >> 2, sub_ = tid & 3; \
      const int row_ = base_ + 64 * c_ + ((DIR) ? 63 - i_ : i_); \
      const bf16_t* ur_ = p.U + (size_t)row_ * UW; \
      const uint4* sx_ = (const uint4*)(ur_ + U_SX + 64 * head + 16 * sub_); px0 = sx_[0]; px1 = sx_[1]; \
      const uint4* sb_ = (const uint4*)(ur_ + U_SB + 128 * grp + 32 * sub_); pb0 = sb_[0]; pb1 = sb_[1]; pb2 = sb_[2]; pb3 = sb_[3]; \
      if (seg_ == 1 || layer == 0) { const uint4* sc_ = (const uint4*)(ur_ + U_SC + 128 * grp + 32 * sub_); pc0 = sc_[0]; pc1 = sc_[1]; pc2 = sc_[2]; pc3 = sc_[3]; } \
      if (sub_ == 0) pdt = p.S[(size_t)row_ * SWD + 32 + (DIR) * 16 + head]; }
    SSD_PREFETCH(0, 0)
    for (int it = 0; it < 36; ++it) {
      const int seg = it >= 4, ci = seg ? it - 4 : it, nch = seg ? 32 : 4;
      const int base = seg ? b * 2048 : TL + b * 256;
      const bool want_o = seg == 1 || layer == 0;
      const bool first = ci < nch / 2;
#pragma unroll
      for (int dir = 0; dir < 2; ++dir) {
        const int c = dir ? nch - 1 - ci : ci;
        const int r0 = base + 64 * c;
        __syncthreads();
        {
          const int i = tid >> 2, sub = tid & 3;
          *(uint4*)(Xt + i * XS + 16 * sub) = px0; *(uint4*)(Xt + i * XS + 16 * sub + 8) = px1;
          *(uint4*)(Bt + i * BS2 + 32 * sub) = pb0; *(uint4*)(Bt + i * BS2 + 32 * sub + 8) = pb1; *(uint4*)(Bt + i * BS2 + 32 * sub + 16) = pb2; *(uint4*)(Bt + i * BS2 + 32 * sub + 24) = pb3;
          if (want_o) { *(uint4*)(Ct + i * BS2 + 32 * sub) = pc0; *(uint4*)(Ct + i * BS2 + 32 * sub + 8) = pc1; *(uint4*)(Ct + i * BS2 + 32 * sub + 16) = pc2; *(uint4*)(Ct + i * BS2 + 32 * sub + 24) = pc3; }
          if (sub == 0) dts[i] = pdt;
        }
        if (dir == 0) SSD_PREFETCH(it, 1) else if (it + 1 < 36) SSD_PREFETCH(it + 1, 0)
        unsigned long long oldp[4] = {0ull, 0ull, 0ull, 0ull};
        if (want_o && !first) {
          const int irow_ = 16 * wave + l15;
          const int prow_ = r0 + (dir ? 63 - irow_ : irow_);
#pragma unroll
          for (int pt = 0; pt < 4; ++pt) oldp[pt] = __hip_atomic_load((unsigned long long*)(p.P + (size_t)prow_ * 1024 + 64 * head + 16 * pt + 4 * g), __ATOMIC_RELAXED, __HIP_MEMORY_SCOPE_AGENT);
        }
        if (want_o) {
#pragma unroll
          for (int nt = 0; nt < 8; ++nt) {
            uint2 o; o.x = pack2(hst[dir][nt][0], hst[dir][nt][1]); o.y = pack2(hst[dir][nt][2], hst[dir][nt][3]);
            *(uint2*)(Hb + (16 * wave + l15) * BS2 + 16 * nt + 4 * g) = o;
          }
        }
        __syncthreads();
        float lv = dts[lane] * (dir ? an1 : an0);
#pragma unroll
        for (int o = 1; o < 64; o <<= 1) { const float tv = __shfl_up(lv, o); if (lane >= o) lv += tv; }
        const float lam_last = __shfl(lv, 63);
        if (wave == 0) lam[lane] = lv;
        {
          const int j = tid >> 2, sub = tid & 3;
          const float lj = __shfl(lv, j & 63);
          const float sc = dts[j] * __expf(lam_last - lj);
          const uint4 a = *(const uint4*)(Xt + j * XS + 16 * sub), bq = *(const uint4*)(Xt + j * XS + 16 * sub + 8);
          uint4 oa, ob;
          oa.x = pack2(bflo(a.x) * sc, bfhi(a.x) * sc); oa.y = pack2(bflo(a.y) * sc, bfhi(a.y) * sc); oa.z = pack2(bflo(a.z) * sc, bfhi(a.z) * sc); oa.w = pack2(bflo(a.w) * sc, bfhi(a.w) * sc);
          ob.x = pack2(bflo(bq.x) * sc, bfhi(bq.x) * sc); ob.y = pack2(bflo(bq.y) * sc, bfhi(bq.y) * sc); ob.z = pack2(bflo(bq.z) * sc, bfhi(bq.z) * sc); ob.w = pack2(bflo(bq.w) * sc, bfhi(bq.w) * sc);
          *(uint4*)(Xs + j * XS + 16 * sub) = oa; *(uint4*)(Xs + j * XS + 16 * sub + 8) = ob;
        }
        __syncthreads();
        if (want_o) {
          const int irow = 16 * wave + l15;
          const float li = lam[irow];
#pragma unroll
          for (int jt = 0; jt < 4; ++jt) {
            f32x4 cacc = (f32x4){0.f, 0.f, 0.f, 0.f};
            if (jt <= wave) {
#pragma unroll
              for (int s2 = 0; s2 < 4; ++s2) {
                const bf16x8 af = *(const bf16x8*)(Ct + irow * BS2 + 32 * s2 + 8 * g);
                const bf16x8 bf = *(const bf16x8*)(Bt + (16 * jt + l15) * BS2 + 32 * s2 + 8 * g);
                cacc = __builtin_amdgcn_mfma_f32_16x16x32_bf16(bf, af, cacc, 0, 0, 0);
              }
            }
            const int j0 = 16 * jt + 4 * g;
            const float4 lj = *(const float4*)(lam + j0), dj = *(const float4*)(dts + j0);
            const float w0 = (j0 + 0 <= irow) ? cacc[0] * __expf(li - lj.x) * dj.x : 0.f;
            const float w1 = (j0 + 1 <= irow) ? cacc[1] * __expf(li - lj.y) * dj.y : 0.f;
            const float w2 = (j0 + 2 <= irow) ? cacc[2] * __expf(li - lj.z) * dj.z : 0.f;
            const float w3 = (j0 + 3 <= irow) ? cacc[3] * __expf(li - lj.w) * dj.w : 0.f;
            uint2 o; o.x = pack2(w0, w1); o.y = pack2(w2, w3);
            *(uint2*)(Wg + irow * XS + j0) = o;
          }
        }
        wave_lds_sync();
        if (want_o) {
          const int irow = 16 * wave + l15;
          f32x4 ai[4], ae[4];
#pragma unroll
          for (int pt = 0; pt < 4; ++pt) { ai[pt] = (f32x4){0.f, 0.f, 0.f, 0.f}; ae[pt] = (f32x4){0.f, 0.f, 0.f, 0.f}; }
#pragma unroll
          for (int s2 = 0; s2 < 2; ++s2) {
            const bf16x8 af = *(const bf16x8*)(Wg + irow * XS + 32 * s2 + 8 * g);
#pragma unroll
            for (int pt = 0; pt < 4; ++pt) {
              const bf16x8 bf = cat8(tr16(Xt + (32 * s2 + 8 * g + q4) * XS + 16 * pt + 4 * p4), tr16(Xt + (32 * s2 + 8 * g + 4 + q4) * XS + 16 * pt + 4 * p4));
              ai[pt] = __builtin_amdgcn_mfma_f32_16x16x32_bf16(bf, af, ai[pt], 0, 0, 0);
            }
          }
#pragma unroll
          for (int s2 = 0; s2 < 4; ++s2) {
            const bf16x8 af = *(const bf16x8*)(Ct + irow * BS2 + 32 * s2 + 8 * g);
#pragma unroll
            for (int pt = 0; pt < 4; ++pt) {
              const bf16x8 bf = *(const bf16x8*)(Hb + (16 * pt + l15) * BS2 + 32 * s2 + 8 * g);
              ae[pt] = __builtin_amdgcn_mfma_f32_16x16x32_bf16(bf, af, ae[pt], 0, 0, 0);
            }
          }
          const float el = __expf(lam[irow]);
          const int row = r0 + (dir ? 63 - irow : irow);
#pragma unroll
          for (int pt = 0; pt < 4; ++pt) {
            float y0 = ai[pt][0] + el * ae[pt][0], y1 = ai[pt][1] + el * ae[pt][1], y2 = ai[pt][2] + el * ae[pt][2], y3 = ai[pt][3] + el * ae[pt][3];
            if (dir == 0) {
              const uint2 xv = *(const uint2*)(Xt + irow * XS + 16 * pt + 4 * g);
              y0 += dsk * bflo(xv.x); y1 += dsk * bfhi(xv.x); y2 += dsk * bflo(xv.y); y3 += dsk * bfhi(xv.y);
            }
            unsigned long long* dst = (unsigned long long*)(p.P + (size_t)row * 1024 + 64 * head + 16 * pt + 4 * g);
            if (!first) {
              const unsigned long long old = oldp[pt];
              const unsigned lo = (unsigned)old, hi = (unsigned)(old >> 32);
              y0 += bflo(lo); y1 += bfhi(lo); y2 += bflo(hi); y3 += bfhi(hi);
            }
            *dst = (unsigned long long)pack2(y0, y1) | ((unsigned long long)pack2(y2, y3) << 32);
          }
        }
        {
          const float el = __expf(lam_last);
#pragma unroll
          for (int nt = 0; nt < 8; ++nt) hst[dir][nt] *= el;
#pragma unroll
          for (int s2 = 0; s2 < 2; ++s2) {
            const bf16x8 mf = cat8(tr16(Xs + (32 * s2 + 8 * g + q4) * XS + 16 * wave + 4 * p4), tr16(Xs + (32 * s2 + 8 * g + 4 + q4) * XS + 16 * wave + 4 * p4));
#pragma unroll
            for (int nt = 0; nt < 8; ++nt) {
              const bf16x8 nf = cat8(tr16(Bt + (32 * s2 + 8 * g + q4) * BS2 + 16 * nt + 4 * p4), tr16(Bt + (32 * s2 + 8 * g + 4 + q4) * BS2 + 16 * nt + 4 * p4));
              hst[dir][nt] = __builtin_amdgcn_mfma_f32_16x16x32_bf16(nf, mf, hst[dir][nt], 0, 0, 0);
            }
          }
        }
      }
    }
  }
}


#undef SSD_PREFETCH
constexpr int GT = 64 * XS;
constexpr int GDN_LDS = 8 * GT * 2 + 4 * 256 * 4 + 4 * 16 * 24 * 2 + 2 * 64 * 4;
__device__ __forceinline__ void phase_gdn(PRef p, int layer, int task, char* smem) {
  const int tid = tidx(), lane = tid & 63, wave = tid >> 6, g = lane >> 4, l15 = lane & 15, q4 = l15 >> 2, p4 = lane & 3;
  bf16_t* Qt = (bf16_t*)smem;
  bf16_t* Kt = Qt + GT;
  bf16_t* Vt = Kt + GT;
  bf16_t* Am = Vt + GT;
  bf16_t* Mq = Am + GT;
  bf16_t* Xw = Mq + GT;
  bf16_t* Xu = Xw + GT;
  bf16_t* St = Xu + GT;
  bf16_t* Qg = Qt; bf16_t* Vn = Vt; bf16_t* Vs = Am;
  float* Adiag = (float*)(St + GT);
  bf16_t* Db = (bf16_t*)(Adiag + 4 * 256);
  float* bet = (float*)(Db + 4 * 16 * 24);
  float* gam = bet + 64;
  const bf16x8 zero8 = (bf16x8){0, 0, 0, 0, 0, 0, 0, 0};
  {
    const int dir = task & 1, h = (task >> 1) & 7, b = task >> 4;
    bf16_t* Og = layer == 0 ? p.OG0 + (size_t)dir * TT * 512 : p.OG1 + (size_t)dir * TL * 512;
    f32x4 sst[4];
#pragma unroll
    for (int e = 0; e < 4; ++e) sst[e] = (f32x4){0.f, 0.f, 0.f, 0.f};
    __syncthreads();
    for (int i = tid; i < 64 * XS / 2; i += 256) { ((unsigned*)St)[i] = 0u; ((unsigned*)Xw)[i] = 0u; ((unsigned*)Xu)[i] = 0u; }
    uint4 pq0, pq1, pk0, pk1, pv0, pv1; float pbeta = 0.f, pgam = 0.f;
#define GDN_PREFETCH(IT) { \
      const int seg_ = (IT) >= 4, ci_ = seg_ ? (IT) - 4 : (IT), nch_ = seg_ ? 32 : 4; \
      const int base_ = seg_ ? b * 2048 : TL + b * 256; \
      const int c_ = dir ? nch_ - 1 - ci_ : ci_; \
      const int i_ = tid >> 2, sub_ = tid & 3; \
      const int row_ = base_ + 64 * c_ + (dir ? 63 - i_ : i_); \
      const bf16_t* ur_ = p.U + (size_t)row_ * UW + 64 * h + 16 * sub_; \
      pq0 = *(const uint4*)(ur_ + U_DNQ); pq1 = *(const uint4*)(ur_ + U_DNQ + 8); \
      pk0 = *(const uint4*)(ur_ + U_DNK); pk1 = *(const uint4*)(ur_ + U_DNK + 8); \
      pv0 = *(const uint4*)(ur_ + U_DNV); pv1 = *(const uint4*)(ur_ + U_DNV + 8); \
      if (sub_ == 0) { pbeta = p.S[(size_t)row_ * SWD + dir * 8 + h]; pgam = p.S[(size_t)row_ * SWD + 16 + dir * 8 + h]; } }
    GDN_PREFETCH(0)
    for (int it = 0; it < 36; ++it) {
      const int seg = it >= 4, ci = seg ? it - 4 : it, nch = seg ? 32 : 4;
      const int base = seg ? b * 2048 : TL + b * 256;
      const bool want_o = seg == 1 || layer == 0;
      const int c = dir ? nch - 1 - ci : ci;
      const int r0 = base + 64 * c;
      __syncthreads();
      {
        const int i = tid >> 2, sub = tid & 3;
        *(uint4*)(Qt + i * XS + 16 * sub) = pq0; *(uint4*)(Qt + i * XS + 16 * sub + 8) = pq1;
        *(uint4*)(Kt + i * XS + 16 * sub) = pk0; *(uint4*)(Kt + i * XS + 16 * sub + 8) = pk1;
        *(uint4*)(Vt + i * XS + 16 * sub) = pv0; *(uint4*)(Vt + i * XS + 16 * sub + 8) = pv1;
        if (sub == 0) { bet[i] = pbeta; gam[i] = pgam; }
      }
      if (it + 1 < 36) GDN_PREFETCH(it + 1)
      __syncthreads();
      float lv = gam[lane];
#pragma unroll
      for (int o = 1; o < 64; o <<= 1) { const float tv = __shfl_up(lv, o); if (lane >= o) lv += tv; }
      const float gam_last = __shfl(lv, 63);
      __syncthreads();
      if (wave == 0) gam[lane] = lv;
      __syncthreads();
      {
        const int irow = 16 * wave + l15;
        const float gi = gam[irow], bi = bet[irow];
#pragma unroll
        for (int jt = 0; jt < 4; ++jt) {
          f32x4 kk = (f32x4){0.f, 0.f, 0.f, 0.f}, qk = (f32x4){0.f, 0.f, 0.f, 0.f};
          if (jt <= wave) {
#pragma unroll
            for (int s2 = 0; s2 < 2; ++s2) {
              const bf16x8 nf = *(const bf16x8*)(Kt + (16 * jt + l15) * XS + 32 * s2 + 8 * g);
              const bf16x8 mk = *(const bf16x8*)(Kt + irow * XS + 32 * s2 + 8 * g);
              const bf16x8 mq = *(const bf16x8*)(Qt + irow * XS + 32 * s2 + 8 * g);
              kk = __builtin_amdgcn_mfma_f32_16x16x32_bf16(nf, mk, kk, 0, 0, 0);
              qk = __builtin_amdgcn_mfma_f32_16x16x32_bf16(nf, mq, qk, 0, 0, 0);
            }
          }
          const int j0 = 16 * jt + 4 * g;
          const float4 gj = *(const float4*)(gam + j0);
          const float gjv[4] = {gj.x, gj.y, gj.z, gj.w};
          float av[4], mv[4];
#pragma unroll
          for (int r = 0; r < 4; ++r) {
            const int j = j0 + r;
            const float dec = j <= irow ? __expf(gi - gjv[r]) : 0.f;
            av[r] = j < irow ? bi * kk[r] * dec : 0.f;
            mv[r] = qk[r] * dec;
          }
          uint2 oa; oa.x = pack2(av[0], av[1]); oa.y = pack2(av[2], av[3]);
          uint2 om; om.x = pack2(mv[0], mv[1]); om.y = pack2(mv[2], mv[3]);
          *(uint2*)(Am + irow * XS + j0) = oa;
          *(uint2*)(Mq + irow * XS + j0) = om;
          if (jt == wave) *(f32x4*)(Adiag + wave * 256 + l15 * 16 + 4 * g) = (f32x4){av[0], av[1], av[2], av[3]};
        }
      }
      __syncthreads();
      {
        const int j = tid >> 2, sub = tid & 3;
        const float sc = __expf(gam[j]);
        const uint4 a = *(const uint4*)(Qt + j * XS + 16 * sub), bq = *(const uint4*)(Qt + j * XS + 16 * sub + 8);
        uint4 oa, ob;
        oa.x = pack2(bflo(a.x) * sc, bfhi(a.x) * sc); oa.y = pack2(bflo(a.y) * sc, bfhi(a.y) * sc); oa.z = pack2(bflo(a.z) * sc, bfhi(a.z) * sc); oa.w = pack2(bflo(a.w) * sc, bfhi(a.w) * sc);
        ob.x = pack2(bflo(bq.x) * sc, bfhi(bq.x) * sc); ob.y = pack2(bflo(bq.y) * sc, bfhi(bq.y) * sc); ob.z = pack2(bflo(bq.z) * sc, bfhi(bq.z) * sc); ob.w = pack2(bflo(bq.w) * sc, bfhi(bq.w) * sc);
        *(uint4*)(Qg + j * XS + 16 * sub) = oa; *(uint4*)(Qg + j * XS + 16 * sub + 8) = ob;
      }
      {
        const int cc = lane & 15;
        const float* Ad = Adiag + wave * 256;
        float dcol[16];
#pragma unroll
        for (int r = 0; r < 16; ++r) {
          float sacc = (r == cc) ? 1.f : 0.f;
#pragma unroll
          for (int j = 0; j < r; ++j) sacc -= Ad[r * 16 + j] * dcol[j];
          dcol[r] = sacc;
        }
        if (lane < 16) {
#pragma unroll
          for (int r = 0; r < 16; ++r) Db[(wave * 16 + r) * 24 + cc] = f2bf(dcol[r]);
        }
      }
      __syncthreads();
      {
        const bool isW = wave < 2;
        bf16_t* Xd = isW ? Xw : Xu;
        const bf16_t* Src = isW ? Kt : Vt;
        const int fbase = (wave & 1) * 32;
#pragma unroll
        for (int ib = 0; ib < 4; ++ib) {
          const int irow = 16 * ib + l15;
          const float sc = isW ? bet[irow] * __expf(gam[irow]) : bet[irow];
          f32x4 y[2];
#pragma unroll
          for (int fi = 0; fi < 2; ++fi) {
            const int f0 = fbase + 16 * fi;
            const uint2 rv = *(const uint2*)(Src + irow * XS + f0 + 4 * g);
            f32x4 tmp = (f32x4){0.f, 0.f, 0.f, 0.f};
#pragma unroll
            for (int s2 = 0; s2 < 2; ++s2) {
              if (32 * s2 < 16 * ib) {
                const bool half = (32 * s2 + 32) > 16 * ib;
                bf16x8 mf = *(const bf16x8*)(Am + irow * XS + 32 * s2 + 8 * g);
                if (half && g >= 2) mf = zero8;
                const bf16x8 nf = cat8(tr16(Xd + (32 * s2 + 8 * g + q4) * XS + f0 + 4 * p4), tr16(Xd + (32 * s2 + 8 * g + 4 + q4) * XS + f0 + 4 * p4));
                tmp = __builtin_amdgcn_mfma_f32_16x16x32_bf16(nf, mf, tmp, 0, 0, 0);
              }
            }
            y[fi] = (f32x4){bflo(rv.x) * sc - tmp[0], bfhi(rv.x) * sc - tmp[1], bflo(rv.y) * sc - tmp[2], bfhi(rv.y) * sc - tmp[3]};
          }
          wave_lds_sync();
#pragma unroll
          for (int fi = 0; fi < 2; ++fi) {
            uint2 o; o.x = pack2(y[fi][0], y[fi][1]); o.y = pack2(y[fi][2], y[fi][3]);
            *(uint2*)(Xd + irow * XS + fbase + 16 * fi + 4 * g) = o;
          }
          wave_lds_sync();
          bf16x8 dm = zero8;
          if (g < 2) dm = *(const bf16x8*)(Db + (ib * 16 + l15) * 24 + 8 * g);
#pragma unroll
          for (int fi = 0; fi < 2; ++fi) {
            const int f0 = fbase + 16 * fi;
            const bf16x8 nf = cat8(tr16(Xd + (16 * ib + 8 * (g & 1) + q4) * XS + f0 + 4 * p4), tr16(Xd + (16 * ib + 8 * (g & 1) + 4 + q4) * XS + f0 + 4 * p4));
            y[fi] = __builtin_amdgcn_mfma_f32_16x16x32_bf16(nf, dm, (f32x4){0.f, 0.f, 0.f, 0.f}, 0, 0, 0);
          }
          wave_lds_sync();
#pragma unroll
          for (int fi = 0; fi < 2; ++fi) {
            uint2 o; o.x = pack2(y[fi][0], y[fi][1]); o.y = pack2(y[fi][2], y[fi][3]);
            *(uint2*)(Xd + irow * XS + fbase + 16 * fi + 4 * g) = o;
          }
          wave_lds_sync();
        }
      }
      __syncthreads();
      {
        const int irow = 16 * wave + l15;
        const float dl = __expf(gam_last - gam[irow]);
        f32x4 acc[4];
#pragma unroll
        for (int et = 0; et < 4; ++et) acc[et] = (f32x4){0.f, 0.f, 0.f, 0.f};
#pragma unroll
        for (int s2 = 0; s2 < 2; ++s2) {
          const bf16x8 mf = *(const bf16x8*)(Xw + irow * XS + 32 * s2 + 8 * g);
#pragma unroll
          for (int et = 0; et < 4; ++et) {
            const bf16x8 nf = *(const bf16x8*)(St + (16 * et + l15) * XS + 32 * s2 + 8 * g);
            acc[et] = __builtin_amdgcn_mfma_f32_16x16x32_bf16(nf, mf, acc[et], 0, 0, 0);
          }
        }
#pragma unroll
        for (int et = 0; et < 4; ++et) {
          const uint2 uv = *(const uint2*)(Xu + irow * XS + 16 * et + 4 * g);
          const float v0 = bflo(uv.x) - acc[et][0], v1 = bfhi(uv.x) - acc[et][1], v2 = bflo(uv.y) - acc[et][2], v3 = bfhi(uv.y) - acc[et][3];
          uint2 o; o.x = pack2(v0, v1); o.y = pack2(v2, v3);
          *(uint2*)(Vn + irow * XS + 16 * et + 4 * g) = o;
          o.x = pack2(v0 * dl, v1 * dl); o.y = pack2(v2 * dl, v3 * dl);
          *(uint2*)(Vs + irow * XS + 16 * et + 4 * g) = o;
        }
      }
      __syncthreads();
      if (want_o) {
        const int irow = 16 * wave + l15;
        f32x4 acc[4];
#pragma unroll
        for (int et = 0; et < 4; ++et) acc[et] = (f32x4){0.f, 0.f, 0.f, 0.f};
#pragma unroll
        for (int s2 = 0; s2 < 2; ++s2) {
          const bf16x8 mf = *(const bf16x8*)(Qg + irow * XS + 32 * s2 + 8 * g);
          const bf16x8 mf2 = *(const bf16x8*)(Mq + irow * XS + 32 * s2 + 8 * g);
#pragma unroll
          for (int et = 0; et < 4; ++et) {
            const bf16x8 nf = *(const bf16x8*)(St + (16 * et + l15) * XS + 32 * s2 + 8 * g);
            acc[et] = __builtin_amdgcn_mfma_f32_16x16x32_bf16(nf, mf, acc[et], 0, 0, 0);
            const bf16x8 nf2 = cat8(tr16(Vn + (32 * s2 + 8 * g + q4) * XS + 16 * et + 4 * p4), tr16(Vn + (32 * s2 + 8 * g + 4 + q4) * XS + 16 * et + 4 * p4));
            acc[et] = __builtin_amdgcn_mfma_f32_16x16x32_bf16(nf2, mf2, acc[et], 0, 0, 0);
          }
        }
        const int row = r0 + (dir ? 63 - irow : irow);
#pragma unroll
        for (int et = 0; et < 4; ++et) {
          uint2 o; o.x = pack2(acc[et][0], acc[et][1]); o.y = pack2(acc[et][2], acc[et][3]);
          *(uint2*)(Og + (size_t)row * 512 + 64 * h + 16 * et + 4 * g) = o;
        }
      }
      {
        const float el = __expf(gam_last);
#pragma unroll
        for (int et = 0; et < 4; ++et) sst[et] *= el;
#pragma unroll
        for (int s2 = 0; s2 < 2; ++s2) {
          const bf16x8 nf = cat8(tr16(Kt + (32 * s2 + 8 * g + q4) * XS + 16 * wave + 4 * p4), tr16(Kt + (32 * s2 + 8 * g + 4 + q4) * XS + 16 * wave + 4 * p4));
#pragma unroll
          for (int et = 0; et < 4; ++et) {
            const bf16x8 mf = cat8(tr16(Vs + (32 * s2 + 8 * g + q4) * XS + 16 * et + 4 * p4), tr16(Vs + (32 * s2 + 8 * g + 4 + q4) * XS + 16 * et + 4 * p4));
            sst[et] = __builtin_amdgcn_mfma_f32_16x16x32_bf16(nf, mf, sst[et], 0, 0, 0);
          }
        }
      }
      __syncthreads();
#pragma unroll
      for (int et = 0; et < 4; ++et) {
        uint2 o; o.x = pack2(sst[et][0], sst[et][1]); o.y = pack2(sst[et][2], sst[et][3]);
        *(uint2*)(St + (16 * et + l15) * XS + 16 * wave + 4 * g) = o;
      }
    }
  }
}


#undef GDN_PREFETCH
constexpr int NA_VS = 72;
constexpr int NA_LDS_WAVE = 2 * 32 * NA_VS * 2;
__device__ __forceinline__ void phase_na(PRef p, int layer, unsigned* ctr, char* smem) {
  const int lane = tidx() & 63, wave = tidx() >> 6, g = lane >> 4, l15 = lane & 15, q4 = l15 >> 2, p4 = lane & 3;
  bf16_t* Vl = (bf16_t*)(smem + wave * NA_LDS_WAVE);
  const int ntask = layer == 0 ? 8192 + 1024 : 8192;
  const float* rpb = p.na_rpb + (size_t)layer * 8 * 15 * 31;
  for (;;) {
    int w0 = 0;
    if (lane == 0) w0 = (int)atomicAdd(ctr, 1u);
    const int task = __builtin_amdgcn_readfirstlane(__shfl(w0, 0));
    if (task >= ntask) break;
    const bool lat = task < 8192;
    int b, h, r = 0, cb = 0, qtok0, R0 = 0, C0 = 0;
    if (lat) { cb = task & 3; r = (task >> 2) & 31; h = (task >> 7) & 7; b = task >> 10; qtok0 = b * 2048 + r * 64 + 16 * cb; R0 = min(max(r - 4, 0), 24); C0 = min(max(16 * cb - 8, 0), 32); }
    else { const int t2 = task - 8192; const int qb = t2 & 15; h = (t2 >> 4) & 7; b = t2 >> 7; qtok0 = TL + b * 256 + 16 * qb; }
    const int tau0 = lat ? 0 : 16;
    const int wtok0 = b * 2048 + R0 * 64 + C0, ctok0 = TL + b * 256;
#define tile_tok(tau) ((tau) < 16 ? wtok0 + ((tau) >> 1) * 64 + 16 * ((tau) & 1) : ctok0 + 16 * ((tau) - 16))
    const bf16_t* qp = p.U + (size_t)(qtok0 + l15) * UW + U_NAQ + 64 * h + 8 * g;
    const bf16x8 qf0 = *(const bf16x8*)qp, qf1 = *(const bf16x8*)(qp + 32);
    f32x4 sc[32];
#pragma unroll
    for (int tau = 0; tau < 32; ++tau) {
      sc[tau] = (f32x4){-INFINITY, -INFINITY, -INFINITY, -INFINITY};
      if (tau >= tau0) {
        const bf16_t* kp = p.U + (size_t)(tile_tok(tau) + l15) * UW + U_NAK + 64 * h + 8 * g;
        const bf16x8 kf0 = *(const bf16x8*)kp, kf1 = *(const bf16x8*)(kp + 32);
        f32x4 a = (f32x4){0.f, 0.f, 0.f, 0.f};
        a = __builtin_amdgcn_mfma_f32_16x16x32_bf16(kf0, qf0, a, 0, 0, 0);
        a = __builtin_amdgcn_mfma_f32_16x16x32_bf16(kf1, qf1, a, 0, 0, 0);
        if (tau < 16) {
          const int qcol = 16 * cb + l15, ws = min(max(qcol - 8, 0), 48);
          const int dr = R0 + (tau >> 1) - r + 7;
#pragma unroll
          for (int rg = 0; rg < 4; ++rg) {
            const int kcol = C0 + 16 * (tau & 1) + 4 * g + rg;
            const bool ok = kcol >= ws && kcol < ws + 16;
            const float bias = ok ? rpb[(h * 15 + dr) * 31 + (kcol - qcol + 15)] : 0.f;
            a[rg] = ok ? a[rg] + bias : -INFINITY;
          }
        }
        sc[tau] = a;
      }
    }
    float mx = -INFINITY;
#pragma unroll
    for (int tau = 0; tau < 32; ++tau) mx = fmaxf(mx, fmaxf(fmaxf(sc[tau][0], sc[tau][1]), fmaxf(sc[tau][2], sc[tau][3])));
    mx = fmaxf(mx, __shfl_xor(mx, 16)); mx = fmaxf(mx, __shfl_xor(mx, 32));
    float sum = 0.f;
#pragma unroll
    for (int tau = 0; tau < 32; ++tau) {
#pragma unroll
      for (int rg = 0; rg < 4; ++rg) { const float e = __expf(sc[tau][rg] - mx); sc[tau][rg] = e; sum += e; }
    }
    sum += __shfl_xor(sum, 16); sum += __shfl_xor(sum, 32);
    f32x4 oacc[4];
#pragma unroll
    for (int dt = 0; dt < 4; ++dt) oacc[dt] = (f32x4){0.f, 0.f, 0.f, 0.f};
    const int kap0 = tau0 >> 1;
    uint4 vr0, vr1, vr2, vr3;
#define NA_VLOAD(KAP) { \
      const int kk0_ = lane >> 3, cc_ = lane & 7; \
      const bf16_t* vb_ = p.U + U_NAV + 64 * h + 8 * cc_; \
      vr0 = *(const uint4*)(vb_ + (size_t)(tile_tok(2 * (KAP)) + kk0_) * UW); \
      vr1 = *(const uint4*)(vb_ + (size_t)(tile_tok(2 * (KAP)) + kk0_ + 8) * UW); \
      vr2 = *(const uint4*)(vb_ + (size_t)(tile_tok(2 * (KAP) + 1) + kk0_) * UW); \
      vr3 = *(const uint4*)(vb_ + (size_t)(tile_tok(2 * (KAP) + 1) + kk0_ + 8) * UW); }
    NA_VLOAD(kap0)
#pragma unroll
    for (int kap = 0; kap < 16; ++kap) {
      if (kap >= kap0) {
        bf16_t* Vb = Vl + (kap & 1) * 32 * NA_VS;
        {
          const int kk0_ = lane >> 3, cc_ = lane & 7;
          *(uint4*)(Vb + kk0_ * NA_VS + 8 * cc_) = vr0; *(uint4*)(Vb + (kk0_ + 8) * NA_VS + 8 * cc_) = vr1;
          *(uint4*)(Vb + (kk0_ + 16) * NA_VS + 8 * cc_) = vr2; *(uint4*)(Vb + (kk0_ + 24) * NA_VS + 8 * cc_) = vr3;
        }
        if (kap + 1 < 16) NA_VLOAD(kap + 1)
        __builtin_amdgcn_fence(__ATOMIC_RELEASE, "workgroup"); __builtin_amdgcn_wave_barrier(); __builtin_amdgcn_fence(__ATOMIC_ACQUIRE, "workgroup");
        bf16x8 pf;
        {
          const unsigned w0_ = pack2(sc[2 * kap][0], sc[2 * kap][1]), w1_ = pack2(sc[2 * kap][2], sc[2 * kap][3]);
          const unsigned w2_ = pack2(sc[2 * kap + 1][0], sc[2 * kap + 1][1]), w3_ = pack2(sc[2 * kap + 1][2], sc[2 * kap + 1][3]);
          pf = (bf16x8){(short)(w0_ & 0xffff), (short)(w0_ >> 16), (short)(w1_ & 0xffff), (short)(w1_ >> 16), (short)(w2_ & 0xffff), (short)(w2_ >> 16), (short)(w3_ & 0xffff), (short)(w3_ >> 16)};
        }
#pragma unroll
        for (int dt = 0; dt < 4; ++dt) {
          const bf16x8 vf = cat8(tr16(Vb + (4 * g + q4) * NA_VS + 16 * dt + 4 * p4), tr16(Vb + (16 + 4 * g + q4) * NA_VS + 16 * dt + 4 * p4));
          oacc[dt] = __builtin_amdgcn_mfma_f32_16x16x32_bf16(vf, pf, oacc[dt], 0, 0, 0);
        }
      }
    }
#undef NA_VLOAD
#undef tile_tok
    const float inv = 1.f / sum;
    bf16_t* op = p.U + (size_t)(qtok0 + l15) * UW + U_YA + 64 * h + 4 * g;
#pragma unroll
    for (int dt = 0; dt < 4; ++dt) {
      uint2 o; o.x = pack2(oacc[dt][0] * inv, oacc[dt][1] * inv); o.y = pack2(oacc[dt][2] * inv, oacc[dt][3] * inv);
      *(uint2*)(op + 16 * dt) = o;
    }
  }
}

__device__ __forceinline__ void norm_row(const float* xr, float rs, const float* alpha, const float* shift, bf16_t* hrow, int lane) {
#pragma unroll
  for (int i = 0; i < 4; ++i) {
    const int k = lane * 4 + 256 * i;
    const float4 v = *(const float4*)(xr + k), a = *(const float4*)(alpha + k), s = *(const float4*)(shift + k);
    uint2 o; o.x = pack2(v.x * rs * a.x + s.x, v.y * rs * a.y + s.y); o.y = pack2(v.z * rs * a.z + s.z, v.w * rs * a.w + s.w);
    *(uint2*)(hrow + k) = o;
  }
}
constexpr int TKW = 2;
__device__ __forceinline__ void phase_fin(PRef p, int layer, int bid, int nb) {
  {
    bf16_t* uw = p.U + U_W;
#pragma unroll 1
    for (int i = 0; i < 3; ++i) wconv(p.w_in + (size_t)layer * 1024 * DIN, DIN, 6208 + 1024 * i, false, uw + (size_t)(UWR_G + 1024 * i) * UW, UW, 1024, 1024, bid, nb);
    wconv(p.w_pa + (size_t)layer * 512 * 1024, 1024, 0, false, uw + (size_t)UWR_PA * UW, UW, 512, 1024, bid, nb);
    wconv(p.w_pb + (size_t)layer * 512 * 1024, 1024, 0, false, uw + (size_t)UWR_PB * UW, UW, 512, 1024, bid, nb);
    wconv(p.w_pc + (size_t)layer * 1024 * 1024, 1024, 0, false, uw + (size_t)UWR_PC * UW, UW, 1024, 1024, bid, nb);
    wconv(p.w_out + (size_t)layer * 1024 * 1024, 1024, 0, false, uw + (size_t)UWR_OUT * UW, UW, 1024, 1024, bid, nb);
  }
  const int lane = tidx() & 63, wave = tidx() >> 6;
  const int ntok = layer == 0 ? TT : TL;
  const bf16_t* ogf = layer == 0 ? p.OG0 : p.OG1;
  const bf16_t* ogb = ogf + (size_t)(layer == 0 ? TT : TL) * 512;
  const float* gnd = p.dn_o_gain + layer * 64 + 8 * (lane & 7);
  const float* gns = p.ssd_o_gain + layer * 1024 + 16 * lane;
  const float* xlat = layer == 0 ? p.x : p.out;
  const float* xctx = layer == 0 ? p.ctx : p.XC;
  for (int tok0 = (bid * 4 + wave) * TKW; tok0 < ntok; tok0 += nb * 4 * TKW) {
    uint4 a[TKW], bq[TKW], zd[TKW], pa[TKW][2], zs[TKW][2];
    float4 xv[TKW][4];
#pragma unroll
    for (int j = 0; j < TKW; ++j)
#pragma unroll
      for (int i = 0; i < 4; ++i) xv[j][i] = *(const float4*)((tok0 < TL ? xlat + (size_t)(tok0 + j) * DM : xctx + (size_t)(tok0 + j - TL) * DM) + lane * 4 + 256 * i);
#pragma unroll
    for (int j = 0; j < TKW; ++j) {
      const int tok = tok0 + j;
      const bf16_t* ur = p.U + (size_t)tok * UW;
      a[j] = *(const uint4*)(ogf + (size_t)tok * 512 + 8 * lane); bq[j] = *(const uint4*)(ogb + (size_t)tok * 512 + 8 * lane); zd[j] = *(const uint4*)(ur + U_DNZ + 8 * lane);
      pa[j][0] = *(const uint4*)(p.P + (size_t)tok * 1024 + 16 * lane); pa[j][1] = *(const uint4*)(p.P + (size_t)tok * 1024 + 16 * lane + 8);
      zs[j][0] = *(const uint4*)(ur + U_SZ + 16 * lane); zs[j][1] = *(const uint4*)(ur + U_SZ + 16 * lane + 8);
    }
#pragma unroll
    for (int j = 0; j < TKW; ++j) {
      bf16_t* ur = p.U + (size_t)(tok0 + j) * UW;
      {
        float o[8] = {bflo(a[j].x) + bflo(bq[j].x), bfhi(a[j].x) + bfhi(bq[j].x), bflo(a[j].y) + bflo(bq[j].y), bfhi(a[j].y) + bfhi(bq[j].y),
                      bflo(a[j].z) + bflo(bq[j].z), bfhi(a[j].z) + bfhi(bq[j].z), bflo(a[j].w) + bflo(bq[j].w), bfhi(a[j].w) + bfhi(bq[j].w)};
        const float zz[8] = {bflo(zd[j].x), bfhi(zd[j].x), bflo(zd[j].y), bfhi(zd[j].y), bflo(zd[j].z), bfhi(zd[j].z), bflo(zd[j].w), bfhi(zd[j].w)};
        float ss = 0.f;
#pragma unroll
        for (int i = 0; i < 8; ++i) ss += o[i] * o[i];
        ss += __shfl_xor(ss, 1); ss += __shfl_xor(ss, 2); ss += __shfl_xor(ss, 4);
        const float rs = rsqrtf(ss * (1.f / 64.f) + EPS);
#pragma unroll
        for (int i = 0; i < 8; ++i) o[i] = o[i] * rs * gnd[i] * siluf(zz[i]);
        uint4 w; w.x = pack2(o[0], o[1]); w.y = pack2(o[2], o[3]); w.z = pack2(o[4], o[5]); w.w = pack2(o[6], o[7]);
        *(uint4*)(ur + U_YB + 8 * lane) = w;
      }
      {
        float yv[16];
        float ss = 0.f;
#pragma unroll
        for (int hf = 0; hf < 2; ++hf) {
          const uint4 av4 = pa[j][hf], z = zs[j][hf];
          const float av[8] = {bflo(av4.x), bfhi(av4.x), bflo(av4.y), bfhi(av4.y), bflo(av4.z), bfhi(av4.z), bflo(av4.w), bfhi(av4.w)};
          const float zz[8] = {bflo(z.x), bfhi(z.x), bflo(z.y), bfhi(z.y), bflo(z.z), bfhi(z.z), bflo(z.w), bfhi(z.w)};
#pragma unroll
          for (int i = 0; i < 8; ++i) { const float v = av[i] * siluf(zz[i]); yv[8 * hf + i] = v; ss += v * v; }
        }
        ss += __shfl_xor(ss, 1); ss += __shfl_xor(ss, 2); ss += __shfl_xor(ss, 4); ss += __shfl_xor(ss, 8); ss += __shfl_xor(ss, 16);
        const float rs = rsqrtf(ss * (1.f / 512.f) + EPS);
#pragma unroll
        for (int hf = 0; hf < 2; ++hf) {
          uint4 w;
          w.x = pack2(yv[8 * hf + 0] * rs * gns[8 * hf + 0], yv[8 * hf + 1] * rs * gns[8 * hf + 1]);
          w.y = pack2(yv[8 * hf + 2] * rs * gns[8 * hf + 2], yv[8 * hf + 3] * rs * gns[8 * hf + 3]);
          w.z = pack2(yv[8 * hf + 4] * rs * gns[8 * hf + 4], yv[8 * hf + 5] * rs * gns[8 * hf + 5]);
          w.w = pack2(yv[8 * hf + 6] * rs * gns[8 * hf + 6], yv[8 * hf + 7] * rs * gns[8 * hf + 7]);
          *(uint4*)(ur + U_YC + 16 * lane + 8 * hf) = w;
        }
      }
    }
    {
      __builtin_amdgcn_s_waitcnt(0x0F70);
      const float* mr = p.MOD + (size_t)layer * 9 * 6144 + modrow(tok0) * 6144;
      float rs[TKW];
#pragma unroll
      for (int j = 0; j < TKW; ++j) {
        float ssq = 0.f;
#pragma unroll
        for (int i = 0; i < 4; ++i) ssq += xv[j][i].x * xv[j][i].x + xv[j][i].y * xv[j][i].y + xv[j][i].z * xv[j][i].z + xv[j][i].w * xv[j][i].w;
        rs[j] = rsqrtf(wave_sum(ssq) * (1.f / DM) + EPS);
      }
#pragma unroll
      for (int i = 0; i < 4; ++i) {
        const int k = lane * 4 + 256 * i;
        const float4 al = *(const float4*)(mr + 1024 + k), sh = *(const float4*)(mr + k);
#pragma unroll
        for (int j = 0; j < TKW; ++j) {
          uint2 o; o.x = pack2(xv[j][i].x * rs[j] * al.x + sh.x, xv[j][i].y * rs[j] * al.y + sh.y); o.y = pack2(xv[j][i].z * rs[j] * al.z + sh.z, xv[j][i].w * rs[j] * al.w + sh.w);
          *(uint2*)(p.P + (size_t)(tok0 + j) * 1024 + k) = o;
        }
      }
    }
  }
}

#define XB_TMO      128
#define XB_XCNT(j)  (256  + 64 * (j))
#define XB_XSUB(j)  (1280 + 64 * (j))
#define XB_XGEN(j)  (2304 + 64 * (j))
#define XB_TOP      3328
#define XB_TOPGEN   3392
#define XCD_BAR_WORDS 3456
#define XB_SPIN_CAP (1u << 20)
__device__ __forceinline__ unsigned xb_ld(unsigned* p)              { return __hip_atomic_load(p, __ATOMIC_RELAXED, __HIP_MEMORY_SCOPE_AGENT); }
__device__ __forceinline__ unsigned xb_add(unsigned* p, unsigned v) { return __hip_atomic_fetch_add(p, v, __ATOMIC_RELAXED, __HIP_MEMORY_SCOPE_AGENT); }
__device__ __forceinline__ unsigned xb_xcc_id() { return (unsigned)__builtin_amdgcn_s_getreg((3 << 11) | 20) & 0xFu; }
#define XB_SPIN(cond, bar) do { unsigned _sp = 0; while (cond) { __builtin_amdgcn_s_sleep(1); \
    if ((++_sp & 255u) == 0u) { if (xb_ld(&(bar)[XB_TMO])) break; if (_sp > XB_SPIN_CAP) { atomicAdd(&(bar)[XB_TMO], 1u); break; } } } } while (0)
struct XcdBarrier { unsigned* bar; unsigned x; volatile LDS_AS unsigned* st; };
__device__ __forceinline__ XcdBarrier xcd_barrier_post(unsigned* bar, volatile LDS_AS unsigned* st) {
  XcdBarrier b; b.bar = bar; b.x = xb_xcc_id(); b.st = st;
  if (threadIdx.x == 0) (void)xb_add(&bar[XB_XCNT(b.x)], 1u);
  return b;
}
__device__ __forceinline__ void xcd_barrier_complete(unsigned* bar, unsigned x, unsigned& nloc, unsigned& nx) {
  const unsigned G = gridDim.x * gridDim.y * gridDim.z;
  unsigned sum, cnt, mine, sp = 0u;
  for (;;) {
    sum = 0u; cnt = 0u; mine = 0u;
#pragma unroll
    for (unsigned j = 0; j < 16; ++j) { const unsigned c = xb_ld(&bar[XB_XCNT(j)]); sum += c; cnt += (c > 0u) ? 1u : 0u; mine = (j == x) ? c : mine; }
    if (sum == G) break;
    __builtin_amdgcn_s_sleep(1);
    if ((++sp & 255u) == 0u) { if (xb_ld(&bar[XB_TMO])) break; if (sp > XB_SPIN_CAP) { atomicAdd(&bar[XB_TMO], 1u); break; } }
  }
  nloc = mine > 0u ? mine : 1u; nx = cnt > 0u ? cnt : 1u;
}
__device__ __forceinline__ void xcd_barrier(const XcdBarrier& b0) {
  asm volatile("s_waitcnt vmcnt(0)" ::: "memory");
  __syncthreads();
  if (threadIdx.x == 0) {
    XcdBarrier b = b0; b.x = xb_xcc_id();
    unsigned* bar = b.bar;
    __builtin_amdgcn_s_waitcnt(0);
    unsigned nloc = b.st[0], nx = b.st[1];
    if (nloc == 0u) { xcd_barrier_complete(bar, b.x, nloc, nx); b.st[0] = nloc; b.st[1] = nx; }
    const unsigned old = xb_add(&bar[XB_XSUB(b.x)], 1u);
    const unsigned gen = old / nloc;
    if (old + 1u == (gen + 1u) * nloc) {
      __builtin_amdgcn_fence(__ATOMIC_RELEASE, "agent");
      asm volatile("s_waitcnt vmcnt(0)" ::: "memory");
      const unsigned og = xb_add(&bar[XB_TOP], 1u);
      const unsigned tg = og / nx;
      if (og + 1u == (tg + 1u) * nx) xb_add(&bar[XB_TOPGEN], 1u);
      else XB_SPIN(xb_ld(&bar[XB_TOPGEN]) == tg, bar);
      __builtin_amdgcn_fence(__ATOMIC_ACQUIRE, "agent");
      xb_add(&bar[XB_XGEN(b.x)], 1u);
      asm volatile("s_waitcnt vmcnt(0)" ::: "memory");
    } else {
      XB_SPIN(xb_ld(&bar[XB_XGEN(b.x)]) == gen, bar);
      __builtin_amdgcn_fence(__ATOMIC_ACQUIRE, "agent");
      asm volatile("s_waitcnt vmcnt(0)" ::: "memory");
    }
  }
  __syncthreads();
}

namespace cg = cooperative_groups;
constexpr int MEGA_LDS = GDN_LDS > SSD_LDS ? GDN_LDS : SSD_LDS;
static_assert(MEGA_LDS <= 81408 && GEMM_LDS_BYTES <= MEGA_LDS && 4 * NA_LDS_WAVE <= MEGA_LDS, "LDS budget");
__global__ void __launch_bounds__(256, 2) k_mega(Params p_unused) {
  const AS4 Params* kp = (const AS4 Params*)__builtin_amdgcn_kernarg_segment_ptr();
#define PP (*p_launder(kp))
  cg::grid_group grid = cg::this_grid();
  __shared__ __attribute__((aligned(16))) char smem[MEGA_LDS];
  const int bid = blockIdx.x, nb = gridDim.x;
  __shared__ uint4 xb_words;
  if (threadIdx.x == 0) xb_words = make_uint4(0u, 0u, 0u, 0u);
  __syncthreads();
  const XcdBarrier xb = xcd_barrier_post(PP.BAR, (volatile LDS_AS unsigned*)&xb_words);
  phase_pro(PP, bid, nb);
  phase_modp(PP, bid, nb, (float*)smem);
  if (nb == 0x7fffffff) grid.sync();
  xcd_barrier(xb);
  phase_modfin(PP, bid, nb);
  xcd_barrier(xb);
  phase_norm(PP, 0, 0, bid, nb);
  xcd_barrier(xb);
#pragma unroll 1
  for (int layer = 0; layer < 2; ++layer) {
    phase_g1(PP, layer, bid, nb, (bf16_t*)smem);
    xcd_barrier(xb);
    phase_prep(PP, layer, bid, nb, (bf16_t*)smem);
    xcd_barrier(xb);
    {
      __shared__ int s_role;
      unsigned* chain_ctr = PP.CTR + 8 + layer;
      if (threadIdx.x == 0) {
        const unsigned key = (((unsigned)__builtin_amdgcn_s_getreg((3 << 11) | 20) & 0xFu) << 8) | (((unsigned)__builtin_amdgcn_s_getreg(63492) >> 8) & 0xffu);
        const unsigned slot = nb > 256 ? atomicAdd(PP.CTR + 64 + 2048 * layer + key, 1u) : 0u;
        s_role = slot == 0 ? (int)atomicAdd(chain_ctr, 1u) : 1 << 20;
      }
      __syncthreads();
      int c = s_role;
      __syncthreads();
      if (c < 128) phase_gdn(PP, layer, c, smem); else if (c < 256) phase_ssd(PP, layer, c - 128, smem);
      __syncthreads();
      phase_na(PP, layer, PP.CTR + layer, smem);
      for (;;) {
        __syncthreads();
        if (threadIdx.x == 0) s_role = (int)atomicAdd(chain_ctr, 1u);
        __syncthreads();
        c = s_role;
        if (c >= 256) break;
        if (c < 128) phase_gdn(PP, layer, c, smem); else phase_ssd(PP, layer, c - 128, smem);
      }
    }
    xcd_barrier(xb);
    phase_fin(PP, layer, bid, nb);
    xcd_barrier(xb);
    phase_g2a(PP, layer, bid, nb, (bf16_t*)smem);
    xcd_barrier(xb);
    phase_g2b(PP, layer, bid, nb, (bf16_t*)smem);
    xcd_barrier(xb);
    phase_g3(PP, layer, bid, nb, (bf16_t*)smem);
    xcd_barrier(xb);
    phase_norm(PP, layer, 1, bid, nb);
    xcd_barrier(xb);
    phase_g4(PP, layer, bid, nb, (bf16_t*)smem);
    xcd_barrier(xb);
    phase_g5(PP, layer, bid, nb, (bf16_t*)smem);
    if (layer == 0) { xcd_barrier(xb); phase_norm(PP, 1, 0, bid, nb); xcd_barrier(xb); }
  }
#undef PP
}

extern "C" void kernel_launch(void* const* d_in, const int* in_sizes, int n_in, void* d_out, int out_size, void* d_ws, size_t ws_size,
                              hipStream_t stream) {
  Params p{};
  const float** fp = (const float**)&p;
  for (int i = 0; i < 28; ++i) fp[i] = (const float*)d_in[i];
  p.out = (float*)d_out;
  char* ws = (char*)d_ws;
  size_t off = 0;
  auto take = [&](size_t bytes) { char* r = ws + off; off += (bytes + 255) & ~(size_t)255; return r; };
  p.U = (bf16_t*)take((size_t)TT * UW * 2);
  p.S = (float*)take((size_t)TT * SWD * 4);
  p.MOD = (float*)take((size_t)2 * 9 * 6144 * 4);
  p.SS = (float*)take((size_t)4 * TT * 4);
  p.ROPE = (float*)take(64 * 16 * 2 * 4);
  p.BAR = (unsigned*)take((size_t)XCD_BAR_WORDS * 4 + (64 + 2 * 2048) * 4);
  p.CTR = p.BAR + XCD_BAR_WORDS;
  p.P = (bf16_t*)take((size_t)TT * 1024 * 2);
  p.XC = (float*)take((size_t)TC * 1024 * 4);
  p.WT = (bf16_t*)(ws + off);
  p.HB = (bf16_t*)p.XC;
  p.OG0 = (bf16_t*)d_out;
  p.OG1 = (bf16_t*)((char*)p.P + (size_t)TL * 1024 * 2);
  size_t need = (size_t)((char*)p.OG1 - ws) + (size_t)2 * TL * 512 * 2;
  { const size_t need2 = off + (size_t)2 * 1024 * DFF * 2; if (need2 > need) need = need2; }
  if (need > ws_size) { fprintf(stderr, "workspace too small: need %zu have %zu\n", need, ws_size); return; }
  static int grid_blocks = 0;
  if (!grid_blocks) {
    int dev = 0, cus = 0, per_cu = 0;
    hipGetDevice(&dev);
    hipDeviceGetAttribute(&cus, hipDeviceAttributeMultiprocessorCount, dev);
    hipOccupancyMaxActiveBlocksPerMultiprocessor(&per_cu, k_mega, 256, 0);
    if (per_cu > 2) per_cu = 2;
    grid_blocks = cus * per_cu;
  }
  hipMemsetAsync(p.BAR, 0, (size_t)XCD_BAR_WORDS * 4 + (64 + 2 * 2048) * 4, stream);
  void* args[] = {&p};
  hipError_t e = hipLaunchCooperativeKernel((void*)k_mega, dim3(grid_blocks), dim3(256), args, 0, stream);
  if (e != hipSuccess) fprintf(stderr, "cooperative launch failed: %s (grid %d)\n", hipGetErrorString(e), grid_blocks);
}
```

```cpp
#include <hip/hip_runtime.h>
#include <hip/hip_cooperative_groups.h>
#include <cstdio>
#include <cstdint>

typedef unsigned short bf16_t;
typedef short bf16x8 __attribute__((ext_vector_type(8)));
typedef short s16x4 __attribute__((ext_vector_type(4)));
typedef float f32x4 __attribute__((ext_vector_type(4)));
#define LDS_AS __attribute__((address_space(3)))

constexpr int TL = 16384;
constexpr int TC = 2048;
constexpr int TT = TL + TC;
constexpr int DM = 1024;
constexpr int UW = 6144;
constexpr int SWD = 64;
constexpr int DIN = 9280;
constexpr int DFF = 4096;
constexpr float EPS = 1e-6f;
constexpr int U_NAQ = 0, U_NAK = 512, U_NAV = 1024;
constexpr int U_DNQ = 1536, U_DNK = 2048, U_DNV = 2560, U_DNZ = 3072;
constexpr int U_SZ = 3584, U_SX = 4608, U_SB = 5632, U_SC = 5888;
constexpr int U_YA = 0, U_YB = 512, U_YC = 1024, U_GATE = 2048, U_M = 5120;

struct Params {
  const float *x, *c, *ctx, *c_ctx, *w_ada, *b_ada, *norm1_g, *norm2_g, *w_in, *na_q_gain, *na_k_gain, *na_rpb,
      *dn_conv_w, *dn_a_log, *dn_dt_bias, *dn_o_gain, *ssd_conv_w, *ssd_conv_b, *ssd_a_log, *ssd_dt_bias, *ssd_d,
      *ssd_o_gain, *w_pa, *w_pb, *w_pc, *w_out, *w_ff1, *w_ff2;
  float* out;
  bf16_t* U;
  float* S;
  bf16_t* P;
  float* XC;
  bf16_t* WT;
  float* MOD;
  float* SS;
  float* ROPE;
  unsigned* BAR;
  unsigned* CTR;
  bf16_t* HB;
  bf16_t* OG0;
  bf16_t* OG1;
};

#define AS4 __attribute__((address_space(4)))
typedef const AS4 Params& PRef;
__device__ __forceinline__ const AS4 Params* p_launder(const AS4 Params* q) { asm volatile("" : "+s"(q)); return q; }

__device__ __forceinline__ int tidx() { int t = threadIdx.x; asm volatile("" : "+v"(t)); return t; }
__device__ __forceinline__ void wave_lds_sync() { __builtin_amdgcn_fence(__ATOMIC_RELEASE, "workgroup"); __builtin_amdgcn_wave_barrier(); __builtin_amdgcn_fence(__ATOMIC_ACQUIRE, "workgroup"); }
__device__ __forceinline__ float bf2f(bf16_t v) { return __uint_as_float(((unsigned)v) << 16); }
__device__ __forceinline__ bf16_t f2bf(float f) {
  unsigned u = __float_as_uint(f);
  u += 0x7fffu + ((u >> 16) & 1u);
  return (bf16_t)(u >> 16);
}
__device__ __forceinline__ unsigned pack2(float a, float b) { return (unsigned)f2bf(a) | ((unsigned)f2bf(b) << 16); }
__device__ __forceinline__ float bflo(unsigned w) { return __uint_as_float(w << 16); }
__device__ __forceinline__ float bfhi(unsigned w) { return __uint_as_float(w & 0xffff0000u); }
__device__ __forceinline__ float wave_sum(float v) {
#pragma unroll
  for (int o = 32; o; o >>= 1) v += __shfl_xor(v, o);
  return v;
}
__device__ __forceinline__ float wave_max(float v) {
#pragma unroll
  for (int o = 32; o; o >>= 1) v = fmaxf(v, __shfl_xor(v, o));
  return v;
}
__device__ __forceinline__ float siluf(float v) { return v * __builtin_amdgcn_rcpf(1.f + __expf(-v)); }
__device__ __forceinline__ float sigmoidf_(float v) { return __builtin_amdgcn_rcpf(1.f + __expf(-v)); }
__device__ __forceinline__ float softplusf_(float v) {
  const float u = __expf(fminf(v, 20.f));
  const float sp = u < 0.01f ? u * (1.f - u * (0.5f - u * (1.f / 3.f))) : __logf(1.f + u);
  return v > 20.f ? v : sp;
}

__device__ __forceinline__ const float* xrow_in(PRef p, int layer, int row) {
  if (layer == 0) return row < TL ? p.x + (size_t)row * DM : p.ctx + (size_t)(row - TL) * DM;
  return row < TL ? p.out + (size_t)row * DM : p.XC + (size_t)(row - TL) * DM;
}
__device__ __forceinline__ float* xrow_out(PRef p, int row) {
  return row < TL ? p.out + (size_t)row * DM : p.XC + (size_t)(row - TL) * DM;
}
__device__ __forceinline__ int modrow(int row) { return row < TL ? (row >> 11) : 8; }

constexpr int G_BK = 32;
constexpr int G_ASTR = G_BK + 8;
constexpr int G_ATILE = 256 * G_ASTR;
constexpr int GEMM_LDS_BYTES = 2 * (G_ATILE + G_BK * (128 + 16)) * 2;
__device__ __forceinline__ s16x4 tr16(const bf16_t* ptr) { return __builtin_amdgcn_ds_read_tr16_b64_v4i16((LDS_AS s16x4*)ptr); }
__device__ __forceinline__ bf16x8 cat8(s16x4 lo, s16x4 hi) { return (bf16x8){lo[0], lo[1], lo[2], lo[3], hi[0], hi[1], hi[2], hi[3]}; }
__device__ __forceinline__ uint4 cvt8(float4 a, float4 b) { uint4 o; o.x = pack2(a.x, a.y); o.y = pack2(a.z, a.w); o.z = pack2(b.x, b.y); o.w = pack2(b.z, b.w); return o; }

__device__ __forceinline__ void gemm_main2(f32x4 (&acc)[8][2], const bf16_t* A, int astride, const bf16_t* W, int ldw, int col0, int K, bf16_t* lds) {
  constexpr int NI = 2, BSTR = 80, BTILE = G_BK * BSTR;
  const int tid = tidx(), lane = tid & 63, wave = tid >> 6, wm = wave >> 1, wn = wave & 1, g = lane >> 4, l15 = lane & 15, q4 = l15 >> 2, p4 = lane & 3;
  bf16_t* As = lds;
  bf16_t* Bs = lds + 2 * G_ATILE;
  const int ar = tid >> 2, ak = (tid & 3) * 8;
  const int bk = tid >> 3, bn = (tid & 7) * 8;
  const int rho0 = (bk & 3) + 4 * ((bk >> 3) & 3) + 16 * ((bk >> 2) & 1);
  const bf16_t* ap = A + (size_t)ar * astride + ak;
  const bf16_t* bp = W + (size_t)bk * ldw + col0 + bn;
  bf16_t* aw = As + ar * G_ASTR + ak;
  bf16_t* bw = Bs + rho0 * BSTR + bn;
  uint4 ra0, ra1, ra2, ra3, rb0;
#define G_LOADS(K1) { ra0 = *(const uint4*)(ap + (size_t)(64 * 0) * astride + (K1)); ra1 = *(const uint4*)(ap + (size_t)(64 * 1) * astride + (K1)); ra2 = *(const uint4*)(ap + (size_t)(64 * 2) * astride + (K1)); ra3 = *(const uint4*)(ap + (size_t)(64 * 3) * astride + (K1)); rb0 = *(const uint4*)(bp + (size_t)(K1) * ldw); }
#define G_STORES(NX) { *(uint4*)(aw + (NX) * G_ATILE + 64 * 0 * G_ASTR) = ra0; *(uint4*)(aw + (NX) * G_ATILE + 64 * 1 * G_ASTR) = ra1; *(uint4*)(aw + (NX) * G_ATILE + 64 * 2 * G_ASTR) = ra2; *(uint4*)(aw + (NX) * G_ATILE + 64 * 3 * G_ASTR) = ra3; *(uint4*)(bw + (NX) * BTILE + 0 * BSTR) = rb0; }
  G_LOADS(0)
  G_STORES(0)
  __syncthreads();
  const int nk = K / G_BK;
  for (int kt = 0; kt < nk; ++kt) {
    const int cur = kt & 1;
    const int k1 = (kt + 1 < nk ? kt + 1 : kt) * G_BK;
    G_LOADS(k1)
    asm volatile("" ::: "memory");
    const bf16_t* Ac = As + cur * G_ATILE + (128 * wm + l15) * G_ASTR + 8 * g;
    const bf16_t* Bc = Bs + cur * BTILE + (4 * g + q4) * BSTR + 16 * NI * wn + 8 * p4;
    {
      bf16x8 af[8], bfr[NI];
#pragma unroll
      for (int mi = 0; mi < 8; ++mi) af[mi] = *(const bf16x8*)(Ac + mi * 16 * G_ASTR);
#pragma unroll
      for (int ni = 0; ni < NI; ++ni) bfr[ni] = cat8(tr16(Bc + 32 * (ni >> 1) + 4 * (ni & 1)), tr16(Bc + 16 * BSTR + 32 * (ni >> 1) + 4 * (ni & 1)));
#pragma unroll
      for (int mi = 0; mi < 8; ++mi)
#pragma unroll
        for (int ni = 0; ni < NI; ++ni) acc[mi][ni] = __builtin_amdgcn_mfma_f32_16x16x32_bf16(bfr[ni], af[mi], acc[mi][ni], 0, 0, 0);
    }
    asm volatile("" ::: "memory");
    __builtin_amdgcn_sched_barrier(0);
    G_STORES(cur ^ 1)
    __syncthreads();
  }
#undef G_LOADS
#undef G_STORES
}
__device__ __forceinline__ void gemm_main4(f32x4 (&acc)[8][4], const bf16_t* A, int astride, const bf16_t* W, int ldw, int col0, int K, bf16_t* lds) {
  constexpr int NI = 4, BSTR = 144, BTILE = G_BK * BSTR;
  const int tid = tidx(), lane = tid & 63, wave = tid >> 6, wm = wave >> 1, wn = wave & 1, g = lane >> 4, l15 = lane & 15, q4 = l15 >> 2, p4 = lane & 3;
  bf16_t* As = lds;
  bf16_t* Bs = lds + 2 * G_ATILE;
  const int ar = tid >> 2, ak = (tid & 3) * 8;
  const int bk = tid >> 4, bn = (tid & 15) * 8;
  const int rho0 = (bk & 3) + 4 * (bk >> 3) + 16 * ((bk >> 2) & 1);
  const bf16_t* ap = A + (size_t)ar * astride + ak;
  const bf16_t* bp = W + (size_t)bk * ldw + col0 + bn;
  bf16_t* aw = As + ar * G_ASTR + ak;
  bf16_t* bw = Bs + rho0 * BSTR + bn;
  uint4 ra0, ra1, ra2, ra3, rb0, rb1;
#define G_LOADS(K1) { ra0 = *(const uint4*)(ap + (size_t)(64 * 0) * astride + (K1)); ra1 = *(const uint4*)(ap + (size_t)(64 * 1) * astride + (K1)); ra2 = *(const uint4*)(ap + (size_t)(64 * 2) * astride + (K1)); ra3 = *(const uint4*)(ap + (size_t)(64 * 3) * astride + (K1)); rb0 = *(const uint4*)(bp + (size_t)((K1) + 16 * 0) * ldw); rb1 = *(const uint4*)(bp + (size_t)((K1) + 16 * 1) * ldw); }
#define G_STORES(NX) { *(uint4*)(aw + (NX) * G_ATILE + 64 * 0 * G_ASTR) = ra0; *(uint4*)(aw + (NX) * G_ATILE + 64 * 1 * G_ASTR) = ra1; *(uint4*)(aw + (NX) * G_ATILE + 64 * 2 * G_ASTR) = ra2; *(uint4*)(aw + (NX) * G_ATILE + 64 * 3 * G_ASTR) = ra3; *(uint4*)(bw + (NX) * BTILE + 0 * BSTR) = rb0; *(uint4*)(bw + (NX) * BTILE + 8 * BSTR) = rb1; }
  G_LOADS(0)
  G_STORES(0)
  __syncthreads();
  const int nk = K / G_BK;
  for (int kt = 0; kt < nk; ++kt) {
    const int cur = kt & 1;
    const int k1 = (kt + 1 < nk ? kt + 1 : kt) * G_BK;
    G_LOADS(k1)
    asm volatile("" ::: "memory");
    const bf16_t* Ac = As + cur * G_ATILE + (128 * wm + l15) * G_ASTR + 8 * g;
    const bf16_t* Bc = Bs + cur * BTILE + (4 * g + q4) * BSTR + 16 * NI * wn + 8 * p4;
    {
      bf16x8 af[8], bfr[NI];
#pragma unroll
      for (int mi = 0; mi < 8; ++mi) af[mi] = *(const bf16x8*)(Ac + mi * 16 * G_ASTR);
#pragma unroll
      for (int ni = 0; ni < NI; ++ni) bfr[ni] = cat8(tr16(Bc + 32 * (ni >> 1) + 4 * (ni & 1)), tr16(Bc + 16 * BSTR + 32 * (ni >> 1) + 4 * (ni & 1)));
#pragma unroll
      for (int mi = 0; mi < 8; ++mi)
#pragma unroll
        for (int ni = 0; ni < NI; ++ni) acc[mi][ni] = __builtin_amdgcn_mfma_f32_16x16x32_bf16(bfr[ni], af[mi], acc[mi][ni], 0, 0, 0);
    }
    asm volatile("" ::: "memory");
    __builtin_amdgcn_sched_barrier(0);
    G_STORES(cur ^ 1)
    __syncthreads();
  }
#undef G_LOADS
#undef G_STORES
}
template <int NI> __device__ __forceinline__ void acc_zero(f32x4 (&acc)[8][NI]) {
#pragma unroll
  for (int i = 0; i < 8; ++i)
#pragma unroll
    for (int j = 0; j < NI; ++j) acc[i][j] = (f32x4){0.f, 0.f, 0.f, 0.f};
}
__device__ __forceinline__ void wconv(const float* src, int sld, int soff, bool win_order, bf16_t* dst, int dld, int rows, int cols, int bid, int nb) {
  const int cpr = cols >> 3, total = rows * cpr;
  for (int i = bid * 256 + tidx(); i < total; i += nb * 256) {
    const int r = i / cpr, c = (i - r * cpr) << 3;
    int sc = c + soff;
    if (win_order) { if (c < 3584) sc = c; else if (c < 6144) sc = c + 32; else { const int o = c - 6144; sc = o < 32 ? 3584 + o : (o < 64 ? 6176 + o - 32 : -1); } }
    uint4 o = make_uint4(0u, 0u, 0u, 0u);
    if (sc >= 0) { const float* sp = src + (size_t)r * sld + sc; o = cvt8(*(const float4*)sp, *(const float4*)(sp + 4)); }
    *(uint4*)(dst + (size_t)r * dld + c) = o;
  }
}
constexpr int WIN_LD = 6272;
constexpr int U_W = 5120;
constexpr int UWR_G = 0, UWR_PA = 3072, UWR_PB = 3584, UWR_PC = 4096, UWR_OUT = 5120;
__device__ __forceinline__ bool tile_next(int i, int bid, int nb, int nMt, int nNt, bool nsplit, int& mt, int& nt) {
  const int xcd = bid & 7, slot = bid >> 3, nslots = nb >> 3;
  const int j = slot + i * nslots;
  if (nsplit) {
    const int nNx = (nNt - xcd + 7) >> 3;
    if (j >= nMt * nNx) return false;
    mt = j / nNx; nt = xcd + 8 * (j % nNx);
  } else {
    const int nMx = (nMt - xcd + 7) >> 3;
    if (j >= nMx * nNt) return false;
    mt = xcd + 8 * (j / nNt); nt = j % nNt;
  }
  return true;
}
#define EPI_IDS const int lane = tidx() & 63, wave = tidx() >> 6, wm = wave >> 1, wn = wave & 1, g = lane >> 4, l15 = lane & 15

__device__ __forceinline__ void phase_pro(PRef p, int bid, int nb) {
  const int tid = tidx(), lane = tid & 63, wave = tid >> 6;
  for (int i = bid * 256 + tid; i < 64 * 16; i += nb * 256) {
    const int pos = i >> 4, fi = i & 15;
    const float inv = __builtin_amdgcn_exp2f(-(float)fi * 0.83048202372184f);
    float ang = (float)pos * inv;
    const float kk = rintf(ang * 0.15915494309189535f);
    ang = fmaf(-kk, 6.2831854820251465f, ang); ang = fmaf(-kk, -1.7484555314695172e-07f, ang);
    p.ROPE[2 * i] = __cosf(ang); p.ROPE[2 * i + 1] = __sinf(ang);
  }
}
__device__ __forceinline__ void phase_modp(PRef p, int bid, int nb, float* lds) {
  const int tid = tidx();
  float* MODP = (float*)p.U;
  for (int u = bid; u < 768; u += nb) {
    const int ks = u & 15, cb = (u >> 4) % 24, l = u / 384, n = cb * 256 + tid;
    __syncthreads();
    for (int i = tid; i < 9 * 64; i += 256) { const int r = i >> 6, k = 64 * ks + (i & 63); const float v = r < 8 ? p.c[r * 1024 + k] : p.c_ctx[k]; lds[i] = siluf(v); }
    __syncthreads();
    float acc[9];
#pragma unroll
    for (int r = 0; r < 9; ++r) acc[r] = 0.f;
    const float* w = p.w_ada + ((size_t)l * 1024 + 64 * ks) * 6144 + n;
#pragma unroll 16
    for (int k = 0; k < 64; ++k) {
      const float wv = w[(size_t)k * 6144];
#pragma unroll
      for (int r = 0; r < 9; ++r) acc[r] += lds[r * 64 + k] * wv;
    }
#pragma unroll
    for (int r = 0; r < 9; ++r) MODP[((size_t)(ks * 2 + l) * 9 + r) * 6144 + n] = acc[r];
  }
}
__device__ __forceinline__ void phase_modfin(PRef p, int bid, int nb) {
  const float* MODP = (const float*)p.U;
  for (int i = bid * 256 + tidx(); i < 2 * 9 * 6144; i += nb * 256) {
    const int l = i / (9 * 6144), rem = i % (9 * 6144), r = rem / 6144, n = rem % 6144;
    float v = p.b_ada[l * 6144 + n];
#pragma unroll
    for (int ks = 0; ks < 16; ++ks) v += MODP[((size_t)(ks * 2 + l) * 9 + r) * 6144 + n];
    const int chunk = n >> 10, kk = n & 1023;
    if (chunk == 1) v = p.norm1_g[l * 1024 + kk] * (1.f + v);
    if (chunk == 4) v = p.norm2_g[l * 1024 + kk] * (1.f + v);
    p.MOD[i] = v;
  }
}

__device__ __forceinline__ void norm_rows4(const float* x0, const float* x1, const float* x2, const float* x3, const float* alpha, const float* shift, bf16_t* h0, int lane) {
  const float* xr[4] = {x0, x1, x2, x3};
  float4 v[4][4];
#pragma unroll
  for (int j = 0; j < 4; ++j)
#pragma unroll
    for (int i = 0; i < 4; ++i) v[j][i] = *(const float4*)(xr[j] + lane * 4 + 256 * i);
  float rs[4];
#pragma unroll
  for (int j = 0; j < 4; ++j) {
    float ssq = 0.f;
#pragma unroll
    for (int i = 0; i < 4; ++i) ssq += v[j][i].x * v[j][i].x + v[j][i].y * v[j][i].y + v[j][i].z * v[j][i].z + v[j][i].w * v[j][i].w;
    rs[j] = rsqrtf(wave_sum(ssq) * (1.f / DM) + EPS);
  }
#pragma unroll
  for (int i = 0; i < 4; ++i) {
    const int k = lane * 4 + 256 * i;
    const float4 a = *(const float4*)(alpha + k), s = *(const float4*)(shift + k);
#pragma unroll
    for (int j = 0; j < 4; ++j) {
      uint2 o; o.x = pack2(v[j][i].x * rs[j] * a.x + s.x, v[j][i].y * rs[j] * a.y + s.y); o.y = pack2(v[j][i].z * rs[j] * a.z + s.z, v[j][i].w * rs[j] * a.w + s.w);
      *(uint2*)(h0 + (size_t)j * 1024 + k) = o;
    }
  }
}
__device__ __forceinline__ void phase_norm(PRef p, int layer, int which, int bid, int nb) {
  if (which == 0) wconv(p.w_in + (size_t)layer * 1024 * DIN, DIN, 0, true, p.WT, WIN_LD, 1024, WIN_LD, bid, nb);
  else {
    wconv(p.w_ff1 + (size_t)layer * 1024 * DFF, DFF, 0, false, p.WT, DFF, 1024, DFF, bid, nb);
    wconv(p.w_ff2 + (size_t)layer * DFF * 1024, 1024, 0, false, p.WT + (size_t)1024 * DFF, 1024, DFF, 1024, bid, nb);
  }
  const int lane = tidx() & 63, wave = tidx() >> 6;
  const int nrow = (which == 1 && layer == 1) ? TL : TT;
  const float* modl = p.MOD + (size_t)layer * 9 * 6144;
  const int lin = which == 0 ? layer : 1;
  for (int row = (bid * 4 + wave) * 4; row < nrow; row += nb * 16) {
    const float* mr = modl + modrow(row) * 6144;
    norm_rows4(xrow_in(p, lin, row), xrow_in(p, lin, row + 1), xrow_in(p, lin, row + 2), xrow_in(p, lin, row + 3),
               mr + (which ? 4096 : 1024), mr + (which ? 3072 : 0), p.P + (size_t)row * 1024, lane);
  }
}

__device__ __forceinline__ void phase_g1(PRef p, int layer, int bid, int nb, bf16_t* lds) {
  constexpr bool NSPLIT = true;
  const int nMt = TT / 256, nNt = 49;
  EPI_IDS;
  for (int ti = 0;; ++ti) {
    int mt, nt; if (!tile_next(ti, bid, nb, nMt, nNt, NSPLIT, mt, nt)) break;
    const int m0 = mt * 256, n0 = nt * 128;
    f32x4 acc[8][4]; acc_zero<4>(acc);
    gemm_main4(acc, p.P + (size_t)m0 * 1024, 1024, p.WT, WIN_LD, n0, 1024, lds);
    if (n0 < 1024) {
      const float* gain = (n0 < 512 ? p.na_q_gain : p.na_k_gain) + layer * 64;
      const float mul = n0 < 512 ? 0.125f : 1.f;
#pragma unroll
      for (int mi = 0; mi < 8; ++mi) {
        float ss = 0.f;
#pragma unroll
        for (int ni = 0; ni < 4; ++ni) ss += acc[mi][ni][0] * acc[mi][ni][0] + acc[mi][ni][1] * acc[mi][ni][1] + acc[mi][ni][2] * acc[mi][ni][2] + acc[mi][ni][3] * acc[mi][ni][3];
        ss += __shfl_xor(ss, 16); ss += __shfl_xor(ss, 32);
        const float rs = rsqrtf(ss * (1.f / 64.f) + EPS) * mul;
        const int row = m0 + 128 * wm + 16 * mi + l15;
#pragma unroll
        for (int q = 0; q < 2; ++q) {
          const int cl = 32 * q + 8 * g;
          const float4 g0 = *(const float4*)(gain + cl), g1 = *(const float4*)(gain + cl + 4);
          uint4 o;
          o.x = pack2(acc[mi][2 * q][0] * rs * g0.x, acc[mi][2 * q][1] * rs * g0.y); o.y = pack2(acc[mi][2 * q][2] * rs * g0.z, acc[mi][2 * q][3] * rs * g0.w);
          o.z = pack2(acc[mi][2 * q + 1][0] * rs * g1.x, acc[mi][2 * q + 1][1] * rs * g1.y); o.w = pack2(acc[mi][2 * q + 1][2] * rs * g1.z, acc[mi][2 * q + 1][3] * rs * g1.w);
          *(uint4*)(p.U + (size_t)row * UW + n0 + 64 * wn + cl) = o;
        }
      }
    } else if (n0 < 6144) {
      const bool hsec = (n0 >= 1536 && n0 < 3072) || n0 >= 4608;
      const int hcol0 = n0 < 3072 ? n0 - 1536 : n0 - 3072;
#pragma unroll
      for (int mi = 0; mi < 8; ++mi) {
        const int row = m0 + 128 * wm + 16 * mi + l15;
        const int rr = row & 63;
        const bool halo = hsec && (rr < 2 || rr >= 62);
        bf16_t* hb = p.HB + ((size_t)(row >> 6) * 4 + (rr < 2 ? rr : rr - 60)) * 3072 + hcol0 + 64 * wn + 8 * g;
#pragma unroll
        for (int q = 0; q < 2; ++q) {
          uint4 o; o.x = pack2(acc[mi][2 * q][0], acc[mi][2 * q][1]); o.y = pack2(acc[mi][2 * q][2], acc[mi][2 * q][3]);
          o.z = pack2(acc[mi][2 * q + 1][0], acc[mi][2 * q + 1][1]); o.w = pack2(acc[mi][2 * q + 1][2], acc[mi][2 * q + 1][3]);
          *(uint4*)(p.U + (size_t)row * UW + n0 + 64 * wn + 32 * q + 8 * g) = o;
          if (halo) *(uint4*)(hb + 32 * q) = o;
        }
      }
    } else if (wn == 0) {
#pragma unroll
      for (int mi = 0; mi < 8; ++mi) {
        const int row = m0 + 128 * wm + 16 * mi + l15;
#pragma unroll
        for (int ni = 0; ni < 4; ++ni) *(f32x4*)(p.S + (size_t)row * SWD + 32 * (ni >> 1) + 8 * g + 4 * (ni & 1)) = acc[mi][ni];
      }
    }
  }
}

__device__ __forceinline__ void phase_g2a(PRef p, int layer, int bid, int nb, bf16_t* lds) {
  constexpr bool NSPLIT = true;
  const int nMt = (layer == 0 ? TT : TL) / 256, nNt = 24;
  EPI_IDS;
  for (int ti = 0;; ++ti) {
    int mt, nt; if (!tile_next(ti, bid, nb, nMt, nNt, NSPLIT, mt, nt)) break;
    const int m0 = mt * 256, n0 = nt * 128;
    f32x4 acc[8][4]; acc_zero<4>(acc);
    gemm_main4(acc, p.P + (size_t)m0 * 1024, 1024, p.U + U_W + (size_t)(UWR_G + 1024 * (n0 >> 10)) * UW, UW, n0 & 1023, 1024, lds);
#pragma unroll
    for (int mi = 0; mi < 8; ++mi) {
      const int row = m0 + 128 * wm + 16 * mi + l15;
#pragma unroll
      for (int q = 0; q < 2; ++q) {
        uint4 o; o.x = pack2(sigmoidf_(acc[mi][2 * q][0]), sigmoidf_(acc[mi][2 * q][1])); o.y = pack2(sigmoidf_(acc[mi][2 * q][2]), sigmoidf_(acc[mi][2 * q][3]));
        o.z = pack2(sigmoidf_(acc[mi][2 * q + 1][0]), sigmoidf_(acc[mi][2 * q + 1][1])); o.w = pack2(sigmoidf_(acc[mi][2 * q + 1][2]), sigmoidf_(acc[mi][2 * q + 1][3]));
        *(uint4*)(p.U + (size_t)row * UW + U_GATE + n0 + 64 * wn + 32 * q + 8 * g) = o;
      }
    }
  }
}
__device__ __forceinline__ void phase_g2b(PRef p, int layer, int bid, int nb, bf16_t* lds) {
  constexpr bool NSPLIT = false;
  const int nMt = (layer == 0 ? TT : TL) / 256, nNt = 16;
  EPI_IDS;
  for (int ti = 0;; ++ti) {
    int mt, nt; if (!tile_next(ti, bid, nb, nMt, nNt, NSPLIT, mt, nt)) break;
    const int m0 = mt * 256, n0 = nt * 64;
    f32x4 accm[8][2]; acc_zero<2>(accm);
#pragma unroll 1
    for (int i = 0; i < 3; ++i) {
      const int ycol = i == 0 ? U_YA : (i == 1 ? U_YB : U_YC);
      const int Ki = i == 2 ? 1024 : 512;
      const bf16_t* w = p.U + U_W + (size_t)(i == 0 ? UWR_PA : (i == 1 ? UWR_PB : UWR_PC)) * UW;
      f32x4 acc[8][2]; acc_zero<2>(acc);
      gemm_main2(acc, p.U + (size_t)m0 * UW + ycol, UW, w, UW, n0, Ki, lds);
#pragma unroll
      for (int mi = 0; mi < 8; ++mi) {
        const int row = m0 + 128 * wm + 16 * mi + l15;
        {
          const uint4 gt = *(const uint4*)(p.U + (size_t)row * UW + U_GATE + 1024 * i + n0 + 32 * wn + 8 * g);
          accm[mi][0][0] += bflo(gt.x) * acc[mi][0][0]; accm[mi][0][1] += bfhi(gt.x) * acc[mi][0][1];
          accm[mi][0][2] += bflo(gt.y) * acc[mi][0][2]; accm[mi][0][3] += bfhi(gt.y) * acc[mi][0][3];
          accm[mi][1][0] += bflo(gt.z) * acc[mi][1][0]; accm[mi][1][1] += bfhi(gt.z) * acc[mi][1][1];
          accm[mi][1][2] += bflo(gt.w) * acc[mi][1][2]; accm[mi][1][3] += bfhi(gt.w) * acc[mi][1][3];
        }
      }
    }
#pragma unroll
    for (int mi = 0; mi < 8; ++mi) {
      const int row = m0 + 128 * wm + 16 * mi + l15;
      {
        uint4 o; o.x = pack2(accm[mi][0][0], accm[mi][0][1]); o.y = pack2(accm[mi][0][2], accm[mi][0][3]); o.z = pack2(accm[mi][1][0], accm[mi][1][1]); o.w = pack2(accm[mi][1][2], accm[mi][1][3]);
        *(uint4*)(p.P + (size_t)row * 1024 + n0 + 32 * wn + 8 * g) = o;
      }
    }
  }
}
template <int NI> __device__ __forceinline__ void epi_residual(PRef p, const f32x4 (&acc)[8][NI], int layer_in, int m0, int n0, const float* gate) {
  EPI_IDS;
#pragma unroll
  for (int mi = 0; mi < 8; ++mi) {
    const int row = m0 + 128 * wm + 16 * mi + l15;
    const float* xi = xrow_in(p, layer_in, row);
    float* xo = xrow_out(p, row);
    const float* gr = gate + modrow(row) * 6144;
#pragma unroll
    for (int ni = 0; ni < NI; ++ni) {
      const int col = n0 + 16 * NI * wn + 32 * (ni >> 1) + 8 * g + 4 * (ni & 1);
      const float4 xv = *(const float4*)(xi + col);
      const float4 gv = *(const float4*)(gr + col);
      float4 o;
      o.x = xv.x + gv.x * acc[mi][ni][0]; o.y = xv.y + gv.y * acc[mi][ni][1]; o.z = xv.z + gv.z * acc[mi][ni][2]; o.w = xv.w + gv.w * acc[mi][ni][3];
      *(float4*)(xo + col) = o;
    }
  }
}
__device__ __forceinline__ void phase_g3(PRef p, int layer, int bid, int nb, bf16_t* lds) {
  constexpr bool NSPLIT = false;
  const float* modl = p.MOD + (size_t)layer * 9 * 6144;
  const bf16_t* w = p.U + U_W + (size_t)UWR_OUT * UW;
  for (int ti = 0;; ++ti) {
    int mt, nt; if (!tile_next(ti, bid, nb, TL / 256, 8, NSPLIT, mt, nt)) break;
    const int m0 = mt * 256, n0 = nt * 128;
    f32x4 acc[8][4]; acc_zero<4>(acc);
    gemm_main4(acc, p.P + (size_t)m0 * 1024, 1024, w, UW, n0, 1024, lds);
    epi_residual<4>(p, acc, layer, m0, n0, modl + 2048);
  }
  if (layer == 0) {
    for (int u = bid; u < (TC / 256) * 16; u += nb) {
      const int m0 = TL + (u >> 4) * 256, n0 = (u & 15) * 64;
      f32x4 acc[8][2]; acc_zero<2>(acc);
      gemm_main2(acc, p.P + (size_t)m0 * 1024, 1024, w, UW, n0, 1024, lds);
      epi_residual<2>(p, acc, layer, m0, n0, modl + 2048);
    }
  }
}
__device__ __forceinline__ void phase_g4(PRef p, int layer, int bid, int nb, bf16_t* lds) {
  constexpr bool NSPLIT = true;
  const int nMt = (layer == 0 ? TT : TL) / 256, nNt = 32;
  EPI_IDS;
  for (int ti = 0;; ++ti) {
    int mt, nt; if (!tile_next(ti, bid, nb, nMt, nNt, NSPLIT, mt, nt)) break;
    const int m0 = mt * 256, n0 = nt * 128;
    f32x4 acc[8][4]; acc_zero<4>(acc);
    gemm_main4(acc, p.P + (size_t)m0 * 1024, 1024, p.WT, DFF, n0, 1024, lds);
#pragma unroll
    for (int mi = 0; mi < 8; ++mi) {
      const int row = m0 + 128 * wm + 16 * mi + l15;
#pragma unroll
      for (int q = 0; q < 2; ++q) {
        float v[8];
#pragma unroll
        for (int e = 0; e < 4; ++e) { v[e] = fmaxf(acc[mi][2 * q][e], 0.f); v[4 + e] = fmaxf(acc[mi][2 * q + 1][e], 0.f); }
        uint4 o; o.x = pack2(v[0] * v[0], v[1] * v[1]); o.y = pack2(v[2] * v[2], v[3] * v[3]); o.z = pack2(v[4] * v[4], v[5] * v[5]); o.w = pack2(v[6] * v[6], v[7] * v[7]);
        *(uint4*)(p.U + (size_t)row * DFF + n0 + 64 * wn + 32 * q + 8 * g) = o;
      }
    }
  }
}
__device__ __forceinline__ void phase_g5(PRef p, int layer, int bid, int nb, bf16_t* lds) {
  constexpr bool NSPLIT = false;
  const float* modl = p.MOD + (size_t)layer * 9 * 6144;
  const bf16_t* w = p.WT + (size_t)1024 * DFF;
  for (int ti = 0;; ++ti) {
    int mt, nt; if (!tile_next(ti, bid, nb, TL / 256, 8, NSPLIT, mt, nt)) break;
    const int m0 = mt * 256, n0 = nt * 128;
    f32x4 acc[8][4]; acc_zero<4>(acc);
    gemm_main4(acc, p.U + (size_t)m0 * DFF, DFF, w, 1024, n0, DFF, lds);
    epi_residual<4>(p, acc, 1, m0, n0, modl + 5120);
  }
  if (layer == 0) {
    for (int u = bid; u < (TC / 256) * 16; u += nb) {
      const int m0 = TL + (u >> 4) * 256, n0 = (u & 15) * 64;
      f32x4 acc[8][2]; acc_zero<2>(acc);
      gemm_main2(acc, p.U + (size_t)m0 * DFF, DFF, w, 1024, n0, DFF, lds);
      epi_residual<2>(p, acc, 1, m0, n0, modl + 5120);
    }
  }
}

__device__ __forceinline__ void phase_prep(PRef p, int layer, int bid, int nb, bf16_t* lds) {
  const int tid = tidx();
  for (int i = bid * 256 + tid; i < TT * 64; i += nb * 256) {
    const int c = i & 63;
    float v = p.S[i];
    if (c < 16) v = sigmoidf_(v);
    else if (c < 32) v = -expf(p.dn_a_log[layer * 16 + c - 16]) * softplusf_(v + p.dn_dt_bias[layer * 16 + c - 16]);
    else v = softplusf_(v + p.ssd_dt_bias[layer * 32 + c - 32]);
    p.S[i] = v;
  }
  const int cg = tid & 7, rA = tid >> 3;
  {
    int slab_ = bid % 48; asm volatile("" : "+s"(slab_));
    const int slab = slab_, c0 = bid / 48, cstep = (nb + 47 - slab) / 48;
    const bool dn = slab < 24;
    const int typ = dn ? slab >> 3 : 3;
    const int ucol = (dn ? 1536 + 512 * typ + 64 * (slab & 7) : 4608 + 64 * (slab - 24)) + 8 * cg;
    const int hcol = dn ? ucol - 1536 : ucol - 3072;
    const int cch = (dn ? 512 * typ + 64 * (slab & 7) : 64 * (slab - 24)) + 8 * cg;
    const float* cw = (dn ? p.dn_conv_w : p.ssd_conv_w) + (size_t)layer * 5 * 1536 + cch;
    float w5[5][8];
#pragma unroll
    for (int j = 0; j < 5; ++j) {
      const float4 a = *(const float4*)(cw + j * 1536), b = *(const float4*)(cw + j * 1536 + 4);
      w5[j][0] = a.x; w5[j][1] = a.y; w5[j][2] = a.z; w5[j][3] = a.w; w5[j][4] = b.x; w5[j][5] = b.y; w5[j][6] = b.z; w5[j][7] = b.w;
    }
    float bias[8];
#pragma unroll
    for (int e = 0; e < 8; ++e) bias[e] = dn ? 0.f : p.ssd_conv_b[layer * 1536 + cch + e];
    bf16_t* T = lds;
    constexpr int TS_ = 72;
    uint4 pr0, pr1, pr2;
#define PREP_ROW(CHUNK, TR, DST) { \
      const int rr_ = (TR) - 2; \
      const bool lat_ = (CHUNK) < 256; const int cs_ = lat_ ? ((CHUNK) & 31) : (((CHUNK) - 256) & 3); \
      const bool first_ = cs_ == 0, last_ = lat_ ? cs_ == 31 : cs_ == 3; \
      uint4 v_ = make_uint4(0u, 0u, 0u, 0u); \
      if (rr_ < 0) { if (!first_) v_ = *(const uint4*)(p.HB + ((size_t)((CHUNK) - 1) * 4 + 4 + rr_) * 3072 + hcol); } \
      else if (rr_ >= 64) { if (!last_) v_ = *(const uint4*)(p.HB + ((size_t)((CHUNK) + 1) * 4 + rr_ - 64) * 3072 + hcol); } \
      else v_ = *(const uint4*)(p.U + (size_t)((CHUNK) * 64 + rr_) * UW + ucol); \
      DST = v_; }
#define PREP_LOAD(CHUNK) { PREP_ROW(CHUNK, rA, pr0) PREP_ROW(CHUNK, rA + 32, pr1) if (rA < 4) PREP_ROW(CHUNK, rA + 64, pr2) }
    if (c0 < 288) PREP_LOAD(c0)
    for (int chunk = c0; chunk < 288; chunk += cstep) {
      const bool lat = chunk < 256;
      const int cs = lat ? (chunk & 31) : ((chunk - 256) & 3);
      const int r0 = chunk * 64;
      __syncthreads();
      *(uint4*)(T + rA * TS_ + 8 * cg) = pr0; *(uint4*)(T + (rA + 32) * TS_ + 8 * cg) = pr1;
      if (rA < 4) *(uint4*)(T + (rA + 64) * TS_ + 8 * cg) = pr2;
      __syncthreads();
      if (chunk + cstep < 288) PREP_LOAD(chunk + cstep)
#pragma unroll
      for (int it = 0; it < 2; ++it) {
        const int rr = rA + 32 * it;
        float v[8];
#pragma unroll
        for (int e = 0; e < 8; ++e) v[e] = bias[e];
#pragma unroll
        for (int j = 0; j < 5; ++j) {
          const uint4 x = *(const uint4*)(T + (rr + j) * TS_ + 8 * cg);
          v[0] += w5[j][0] * bflo(x.x); v[1] += w5[j][1] * bfhi(x.x); v[2] += w5[j][2] * bflo(x.y); v[3] += w5[j][3] * bfhi(x.y);
          v[4] += w5[j][4] * bflo(x.z); v[5] += w5[j][5] * bfhi(x.z); v[6] += w5[j][6] * bflo(x.w); v[7] += w5[j][7] * bfhi(x.w);
        }
#pragma unroll
        for (int e = 0; e < 8; ++e) v[e] = siluf(v[e]);
        if (typ < 2) {
          float ss = 0.f;
#pragma unroll
          for (int e = 0; e < 8; ++e) ss += v[e] * v[e];
          ss += __shfl_xor(ss, 1); ss += __shfl_xor(ss, 2); ss += __shfl_xor(ss, 4);
          const float rs = rsqrtf(ss + EPS) * (typ == 0 ? 0.125f : 1.f);
          if (lat) {
            const int pos = cg < 4 ? cs : rr;
            const float* rp = p.ROPE + (pos * 16 + 8 * (cg & 1)) * 2;
            const float4 q0 = *(const float4*)rp, q1 = *(const float4*)(rp + 4), q2 = *(const float4*)(rp + 8), q3 = *(const float4*)(rp + 12);
            const float cs8[8] = {q0.x, q0.z, q1.x, q1.z, q2.x, q2.z, q3.x, q3.z}, sn8[8] = {q0.y, q0.w, q1.y, q1.w, q2.y, q2.w, q3.y, q3.w};
#pragma unroll
            for (int e = 0; e < 8; ++e) {
              const float vp = __shfl_xor(v[e], 2);
              v[e] = v[e] * cs8[e] + ((cg & 2) ? vp : -vp) * sn8[e];
            }
          }
#pragma unroll
          for (int e = 0; e < 8; ++e) v[e] *= rs;
        }
        uint4 o; o.x = pack2(v[0], v[1]); o.y = pack2(v[2], v[3]); o.z = pack2(v[4], v[5]); o.w = pack2(v[6], v[7]);
        *(uint4*)(p.U + (size_t)(r0 + rr) * UW + ucol) = o;
      }
    }
#undef PREP_LOAD
#undef PREP_ROW
  }
}

constexpr int XS = 72;
constexpr int BS2 = 136;
constexpr int SSD_LDS = (3 * 64 * XS + 3 * 64 * BS2) * 2 + 2 * 64 * 4;
__device__ __forceinline__ void phase_ssd(PRef p, int layer, int task, char* smem) {
  const int tid = tidx(), lane = tid & 63, wave = tid >> 6, g = lane >> 4, l15 = lane & 15, q4 = l15 >> 2, p4 = lane & 3;
  bf16_t* Xt = (bf16_t*)smem;
  bf16_t* Xs = Xt + 64 * XS;
  bf16_t* Wg = Xs + 64 * XS;
  bf16_t* Bt = Wg + 64 * XS;
  bf16_t* Ct = Bt + 64 * BS2;
  bf16_t* Hb = Ct + 64 * BS2;
  float* dts = (float*)(Hb + 64 * BS2);
  float* lam = dts + 64;
  {
    const int head = task & 15, b = task >> 4, grp = head >> 3;
    f32x4 hst[2][8];
#pragma unroll
    for (int d = 0; d < 2; ++d)
#pragma unroll
      for (int n = 0; n < 8; ++n) hst[d][n] = (f32x4){0.f, 0.f, 0.f, 0.f};
    const float dsk = p.ssd_d[layer * 16 + head];
    const float an0 = -__expf(p.ssd_a_log[layer * 32 + head]), an1 = -__expf(p.ssd_a_log[layer * 32 + 16 + head]);
    uint4 px0, px1, pb0, pb1, pb2, pb3, pc0, pc1, pc2, pc3; float pdt = 0.f;
#define SSD_PREFETCH(IT, DIR) { \
      const int seg_ = (IT) >= 4, ci_ = seg_ ? (IT) - 4 : (IT), nch_ = seg_ ? 32 : 4; \
      const int base_ = seg_ ? b * 2048 : TL + b * 256; \
      const int c_ = (DIR) ? nch_ - 1 - ci_ : ci_; \
      const int i_ = tid >> 2, sub_ = tid & 3; \
      const int row_ = base_ + 64 * c_ + ((DIR) ? 63 - i_ : i_); \
      const bf16_t* ur_ = p.U + (size_t)row_ * UW; \
      const uint4* sx_ = (const uint4*)(ur_ + U_SX + 64 * head + 16 * sub_); px0 = sx_[0]; px1 = sx_[1]; \
      const uint4* sb_ = (const uint4*)(ur_ + U_SB + 128 * grp + 32 * sub_); pb0 = sb_[0]; pb1 = sb_[1]; pb2 = sb_[2]; pb3 = sb_[3]; \
      if (seg_ == 1 || layer == 0) { const uint4* sc_ = (const uint4*)(ur_ + U_SC + 128 * grp + 32 * sub_); pc0 = sc_[0]; pc1 = sc_[1]; pc2 = sc_[2]; pc3 = sc_[3]; } \
      if (sub_ == 0) pdt = p.S[(size_t)row_ * SWD + 32 + (DIR) * 16 + head]; }
    SSD_PREFETCH(0, 0)
    for (int it = 0; it < 36; ++it) {
      const int seg = it >= 4, ci = seg ? it - 4 : it, nch = seg ? 32 : 4;
      const int base = seg ? b * 2048 : TL + b * 256;
      const bool want_o = seg == 1 || layer == 0;
      const bool first = ci < nch / 2;
#pragma unroll
      for (int dir = 0; dir < 2; ++dir) {
        const int c = dir ? nch - 1 - ci : ci;
        const int r0 = base + 64 * c;
        __syncthreads();
        {
          const int i = tid >> 2, sub = tid & 3;
          *(uint4*)(Xt + i * XS + 16 * sub) = px0; *(uint4*)(Xt + i * XS + 16 * sub + 8) = px1;
          *(uint4*)(Bt + i * BS2 + 32 * sub) = pb0; *(uint4*)(Bt + i * BS2 + 32 * sub + 8) = pb1; *(uint4*)(Bt + i * BS2 + 32 * sub + 16) = pb2; *(uint4*)(Bt + i * BS2 + 32 * sub + 24) = pb3;
          if (want_o) { *(uint4*)(Ct + i * BS2 + 32 * sub) = pc0; *(uint4*)(Ct + i * BS2 + 32 * sub + 8) = pc1; *(uint4*)(Ct + i * BS2 + 32 * sub + 16) = pc2; *(uint4*)(Ct + i * BS2 + 32 * sub + 24) = pc3; }
          if (sub == 0) dts[i] = pdt;
        }
        if (dir == 0) SSD_PREFETCH(it, 1) else if (it + 1 < 36) SSD_PREFETCH(it + 1, 0)
        unsigned long long oldp[4] = {0ull, 0ull, 0ull, 0ull};
        if (want_o && !first) {
          const int irow_ = 16 * wave + l15;
          const int prow_ = r0 + (dir ? 63 - irow_ : irow_);
#pragma unroll
          for (int pt = 0; pt < 4; ++pt) oldp[pt] = __hip_atomic_load((unsigned long long*)(p.P + (size_t)prow_ * 1024 + 64 * head + 16 * pt + 4 * g), __ATOMIC_RELAXED, __HIP_MEMORY_SCOPE_AGENT);
        }
        if (want_o) {
#pragma unroll
          for (int nt = 0; nt < 8; ++nt) {
            uint2 o; o.x = pack2(hst[dir][nt][0], hst[dir][nt][1]); o.y = pack2(hst[dir][nt][2], hst[dir][nt][3]);
            *(uint2*)(Hb + (16 * wave + l15) * BS2 + 16 * nt + 4 * g) = o;
          }
        }
        __syncthreads();
        float lv = dts[lane] * (dir ? an1 : an0);
#pragma unroll
        for (int o = 1; o < 64; o <<= 1) { const float tv = __shfl_up(lv, o); if (lane >= o) lv += tv; }
        const float lam_last = __shfl(lv, 63);
        if (wave == 0) lam[lane] = lv;
        {
          const int j = tid >> 2, sub = tid & 3;
          const float lj = __shfl(lv, j & 63);
          const float sc = dts[j] * __expf(lam_last - lj);
          const uint4 a = *(const uint4*)(Xt + j * XS + 16 * sub), bq = *(const uint4*)(Xt + j * XS + 16 * sub + 8);
          uint4 oa, ob;
          oa.x = pack2(bflo(a.x) * sc, bfhi(a.x) * sc); oa.y = pack2(bflo(a.y) * sc, bfhi(a.y) * sc); oa.z = pack2(bflo(a.z) * sc, bfhi(a.z) * sc); oa.w = pack2(bflo(a.w) * sc, bfhi(a.w) * sc);
          ob.x = pack2(bflo(bq.x) * sc, bfhi(bq.x) * sc); ob.y = pack2(bflo(bq.y) * sc, bfhi(bq.y) * sc); ob.z = pack2(bflo(bq.z) * sc, bfhi(bq.z) * sc); ob.w = pack2(bflo(bq.w) * sc, bfhi(bq.w) * sc);
          *(uint4*)(Xs + j * XS + 16 * sub) = oa; *(uint4*)(Xs + j * XS + 16 * sub + 8) = ob;
        }
        __syncthreads();
        if (want_o) {
          const int irow = 16 * wave + l15;
          const float li = lam[irow];
#pragma unroll
          for (int jt = 0; jt < 4; ++jt) {
            f32x4 cacc = (f32x4){0.f, 0.f, 0.f, 0.f};
            if (jt <= wave) {
#pragma unroll
              for (int s2 = 0; s2 < 4; ++s2) {
                const bf16x8 af = *(const bf16x8*)(Ct + irow * BS2 + 32 * s2 + 8 * g);
                const bf16x8 bf = *(const bf16x8*)(Bt + (16 * jt + l15) * BS2 + 32 * s2 + 8 * g);
                cacc = __builtin_amdgcn_mfma_f32_16x16x32_bf16(bf, af, cacc, 0, 0, 0);
              }
            }
            const int j0 = 16 * jt + 4 * g;
            const float4 lj = *(const float4*)(lam + j0), dj = *(const float4*)(dts + j0);
            const float w0 = (j0 + 0 <= irow) ? cacc[0] * __expf(li - lj.x) * dj.x : 0.f;
            const float w1 = (j0 + 1 <= irow) ? cacc[1] * __expf(li - lj.y) * dj.y : 0.f;
            const float w2 = (j0 + 2 <= irow) ? cacc[2] * __expf(li - lj.z) * dj.z : 0.f;
            const float w3 = (j0 + 3 <= irow) ? cacc[3] * __expf(li - lj.w) * dj.w : 0.f;
            uint2 o; o.x = pack2(w0, w1); o.y = pack2(w2, w3);
            *(uint2*)(Wg + irow * XS + j0) = o;
          }
        }
        wave_lds_sync();
        if (want_o) {
          const int irow = 16 * wave + l15;
          f32x4 ai[4], ae[4];
#pragma unroll
          for (int pt = 0; pt < 4; ++pt) { ai[pt] = (f32x4){0.f, 0.f, 0.f, 0.f}; ae[pt] = (f32x4){0.f, 0.f, 0.f, 0.f}; }
#pragma unroll
          for (int s2 = 0; s2 < 2; ++s2) {
            const bf16x8 af = *(const bf16x8*)(Wg + irow * XS + 32 * s2 + 8 * g);
#pragma unroll
            for (int pt = 0; pt < 4; ++pt) {
              const bf16x8 bf = cat8(tr16(Xt + (32 * s2 + 8 * g + q4) * XS + 16 * pt + 4 * p4), tr16(Xt + (32 * s2 + 8 * g + 4 + q4) * XS + 16 * pt + 4 * p4));
              ai[pt] = __builtin_amdgcn_mfma_f32_16x16x32_bf16(bf, af, ai[pt], 0, 0, 0);
            }
          }
#pragma unroll
          for (int s2 = 0; s2 < 4; ++s2) {
            const bf16x8 af = *(const bf16x8*)(Ct + irow * BS2 + 32 * s2 + 8 * g);
#pragma unroll
            for (int pt = 0; pt < 4; ++pt) {
              const bf16x8 bf = *(const bf16x8*)(Hb + (16 * pt + l15) * BS2 + 32 * s2 + 8 * g);
              ae[pt] = __builtin_amdgcn_mfma_f32_16x16x32_bf16(bf, af, ae[pt], 0, 0, 0);
            }
          }
          const float el = __expf(lam[irow]);
          const int row = r0 + (dir ? 63 - irow : irow);
#pragma unroll
          for (int pt = 0; pt < 4; ++pt) {
            float y0 = ai[pt][0] + el * ae[pt][0], y1 = ai[pt][1] + el * ae[pt][1], y2 = ai[pt][2] + el * ae[pt][2], y3 = ai[pt][3] + el * ae[pt][3];
            if (dir == 0) {
              const uint2 xv = *(const uint2*)(Xt + irow * XS + 16 * pt + 4 * g);
              y0 += dsk * bflo(xv.x); y1 += dsk * bfhi(xv.x); y2 += dsk * bflo(xv.y); y3 += dsk * bfhi(xv.y);
            }
            unsigned long long* dst = (unsigned long long*)(p.P + (size_t)row * 1024 + 64 * head + 16 * pt + 4 * g);
            if (!first) {
              const unsigned long long old = oldp[pt];
              const unsigned lo = (unsigned)old, hi = (unsigned)(old >> 32);
              y0 += bflo(lo); y1 += bfhi(lo); y2 += bflo(hi); y3 += bfhi(hi);
            }
            *dst = (unsigned long long)pack2(y0, y1) | ((unsigned long long)pack2(y2, y3) << 32);
          }
        }
        {
          const float el = __expf(lam_last);
#pragma unroll
          for (int nt = 0; nt < 8; ++nt) hst[dir][nt] *= el;
#pragma unroll
          for (int s2 = 0; s2 < 2; ++s2) {
            const bf16x8 mf = cat8(tr16(Xs + (32 * s2 + 8 * g + q4) * XS + 16 * wave + 4 * p4), tr16(Xs + (32 * s2 + 8 * g + 4 + q4) * XS + 16 * wave + 4 * p4));
#pragma unroll
            for (int nt = 0; nt < 8; ++nt) {
              const bf16x8 nf = cat8(tr16(Bt + (32 * s2 + 8 * g + q4) * BS2 + 16 * nt + 4 * p4), tr16(Bt + (32 * s2 + 8 * g + 4 + q4) * BS2 + 16 * nt + 4 * p4));
              hst[dir][nt] = __builtin_amdgcn_mfma_f32_16x16x32_bf16(nf, mf, hst[dir][nt], 0, 0, 0);
            }
          }
        }
      }
    }
  }
}


#undef SSD_PREFETCH
constexpr int GT = 64 * XS;
constexpr int GDN_LDS = 8 * GT * 2 + 4 * 256 * 4 + 4 * 16 * 24 * 2 + 2 * 64 * 4;
__device__ __forceinline__ void phase_gdn(PRef p, int layer, int task, char* smem) {
  const int tid = tidx(), lane = tid & 63, wave = tid >> 6, g = lane >> 4, l15 = lane & 15, q4 = l15 >> 2, p4 = lane & 3;
  bf16_t* Qt = (bf16_t*)smem;
  bf16_t* Kt = Qt + GT;
  bf16_t* Vt = Kt + GT;
  bf16_t* Am = Vt + GT;
  bf16_t* Mq = Am + GT;
  bf16_t* Xw = Mq + GT;
  bf16_t* Xu = Xw + GT;
  bf16_t* St = Xu + GT;
  bf16_t* Qg = Qt; bf16_t* Vn = Vt; bf16_t* Vs = Am;
  float* Adiag = (float*)(St + GT);
  bf16_t* Db = (bf16_t*)(Adiag + 4 * 256);
  float* bet = (float*)(Db + 4 * 16 * 24);
  float* gam = bet + 64;
  const bf16x8 zero8 = (bf16x8){0, 0, 0, 0, 0, 0, 0, 0};
  {
    const int dir = task & 1, h = (task >> 1) & 7, b = task >> 4;
    bf16_t* Og = layer == 0 ? p.OG0 + (size_t)dir * TT * 512 : p.OG1 + (size_t)dir * TL * 512;
    f32x4 sst[4];
#pragma unroll
    for (int e = 0; e < 4; ++e) sst[e] = (f32x4){0.f, 0.f, 0.f, 0.f};
    __syncthreads();
    for (int i = tid; i < 64 * XS / 2; i += 256) { ((unsigned*)St)[i] = 0u; ((unsigned*)Xw)[i] = 0u; ((unsigned*)Xu)[i] = 0u; }
    uint4 pq0, pq1, pk0, pk1, pv0, pv1; float pbeta = 0.f, pgam = 0.f;
#define GDN_PREFETCH(IT) { \
      const int seg_ = (IT) >= 4, ci_ = seg_ ? (IT) - 4 : (IT), nch_ = seg_ ? 32 : 4; \
      const int base_ = seg_ ? b * 2048 : TL + b * 256; \
      const int c_ = dir ? nch_ - 1 - ci_ : ci_; \
      const int i_ = tid >> 2, sub_ = tid & 3; \
      const int row_ = base_ + 64 * c_ + (dir ? 63 - i_ : i_); \
      const bf16_t* ur_ = p.U + (size_t)row_ * UW + 64 * h + 16 * sub_; \
      pq0 = *(const uint4*)(ur_ + U_DNQ); pq1 = *(const uint4*)(ur_ + U_DNQ + 8); \
      pk0 = *(const uint4*)(ur_ + U_DNK); pk1 = *(const uint4*)(ur_ + U_DNK + 8); \
      pv0 = *(const uint4*)(ur_ + U_DNV); pv1 = *(const uint4*)(ur_ + U_DNV + 8); \
      if (sub_ == 0) { pbeta = p.S[(size_t)row_ * SWD + dir * 8 + h]; pgam = p.S[(size_t)row_ * SWD + 16 + dir * 8 + h]; } }
    GDN_PREFETCH(0)
    for (int it = 0; it < 36; ++it) {
      const int seg = it >= 4, ci = seg ? it - 4 : it, nch = seg ? 32 : 4;
      const int base = seg ? b * 2048 : TL + b * 256;
      const bool want_o = seg == 1 || layer == 0;
      const int c = dir ? nch - 1 - ci : ci;
      const int r0 = base + 64 * c;
      __syncthreads();
      {
        const int i = tid >> 2, sub = tid & 3;
        *(uint4*)(Qt + i * XS + 16 * sub) = pq0; *(uint4*)(Qt + i * XS + 16 * sub + 8) = pq1;
        *(uint4*)(Kt + i * XS + 16 * sub) = pk0; *(uint4*)(Kt + i * XS + 16 * sub + 8) = pk1;
        *(uint4*)(Vt + i * XS + 16 * sub) = pv0; *(uint4*)(Vt + i * XS + 16 * sub + 8) = pv1;
        if (sub == 0) { bet[i] = pbeta; gam[i] = pgam; }
      }
      if (it + 1 < 36) GDN_PREFETCH(it + 1)
      __syncthreads();
      float lv = gam[lane];
#pragma unroll
      for (int o = 1; o < 64; o <<= 1) { const float tv = __shfl_up(lv, o); if (lane >= o) lv += tv; }
      const float gam_last = __shfl(lv, 63);
      __syncthreads();
      if (wave == 0) gam[lane] = lv;
      __syncthreads();
      {
        const int irow = 16 * wave + l15;
        const float gi = gam[irow], bi = bet[irow];
#pragma unroll
        for (int jt = 0; jt < 4; ++jt) {
          f32x4 kk = (f32x4){0.f, 0.f, 0.f, 0.f}, qk = (f32x4){0.f, 0.f, 0.f, 0.f};
          if (jt <= wave) {
#pragma unroll
            for (int s2 = 0; s2 < 2; ++s2) {
              const bf16x8 nf = *(const bf16x8*)(Kt + (16 * jt + l15) * XS + 32 * s2 + 8 * g);
              const bf16x8 mk = *(const bf16x8*)(Kt + irow * XS + 32 * s2 + 8 * g);
              const bf16x8 mq = *(const bf16x8*)(Qt + irow * XS + 32 * s2 + 8 * g);
              kk = __builtin_amdgcn_mfma_f32_16x16x32_bf16(nf, mk, kk, 0, 0, 0);
              qk = __builtin_amdgcn_mfma_f32_16x16x32_bf16(nf, mq, qk, 0, 0, 0);
            }
          }
          const int j0 = 16 * jt + 4 * g;
          const float4 gj = *(const float4*)(gam + j0);
          const float gjv[4] = {gj.x, gj.y, gj.z, gj.w};
          float av[4], mv[4];
#pragma unroll
          for (int r = 0; r < 4; ++r) {
            const int j = j0 + r;
            const float dec = j <= irow ? __expf(gi - gjv[r]) : 0.f;
            av[r] = j < irow ? bi * kk[r] * dec : 0.f;
            mv[r] = qk[r] * dec;
          }
          uint2 oa; oa.x = pack2(av[0], av[1]); oa.y = pack2(av[2], av[3]);
          uint2 om; om.x = pack2(mv[0], mv[1]); om.y = pack2(mv[2], mv[3]);
          *(uint2*)(Am + irow * XS + j0) = oa;
          *(uint2*)(Mq + irow * XS + j0) = om;
          if (jt == wave) *(f32x4*)(Adiag + wave * 256 + l15 * 16 + 4 * g) = (f32x4){av[0], av[1], av[2], av[3]};
        }
      }
      __syncthreads();
      {
        const int j = tid >> 2, sub = tid & 3;
        const float sc = __expf(gam[j]);
        const uint4 a = *(const uint4*)(Qt + j * XS + 16 * sub), bq = *(const uint4*)(Qt + j * XS + 16 * sub + 8);
        uint4 oa, ob;
        oa.x = pack2(bflo(a.x) * sc, bfhi(a.x) * sc); oa.y = pack2(bflo(a.y) * sc, bfhi(a.y) * sc); oa.z = pack2(bflo(a.z) * sc, bfhi(a.z) * sc); oa.w = pack2(bflo(a.w) * sc, bfhi(a.w) * sc);
        ob.x = pack2(bflo(bq.x) * sc, bfhi(bq.x) * sc); ob.y = pack2(bflo(bq.y) * sc, bfhi(bq.y) * sc); ob.z = pack2(bflo(bq.z) * sc, bfhi(bq.z) * sc); ob.w = pack2(bflo(bq.w) * sc, bfhi(bq.w) * sc);
        *(uint4*)(Qg + j * XS + 16 * sub) = oa; *(uint4*)(Qg + j * XS + 16 * sub + 8) = ob;
      }
      {
        const int cc = lane & 15;
        const float* Ad = Adiag + wave * 256;
        float dcol[16];
#pragma unroll
        for (int r = 0; r < 16; ++r) {
          float sacc = (r == cc) ? 1.f : 0.f;
#pragma unroll
          for (int j = 0; j < r; ++j) sacc -= Ad[r * 16 + j] * dcol[j];
          dcol[r] = sacc;
        }
        if (lane < 16) {
#pragma unroll
          for (int r = 0; r < 16; ++r) Db[(wave * 16 + r) * 24 + cc] = f2bf(dcol[r]);
        }
      }
      __syncthreads();
      {
        const bool isW = wave < 2;
        bf16_t* Xd = isW ? Xw : Xu;
        const bf16_t* Src = isW ? Kt : Vt;
        const int fbase = (wave & 1) * 32;
#pragma unroll
        for (int ib = 0; ib < 4; ++ib) {
          const int irow = 16 * ib + l15;
          const float sc = isW ? bet[irow] * __expf(gam[irow]) : bet[irow];
          f32x4 y[2];
#pragma unroll
          for (int fi = 0; fi < 2; ++fi) {
            const int f0 = fbase + 16 * fi;
            const uint2 rv = *(const uint2*)(Src + irow * XS + f0 + 4 * g);
            f32x4 tmp = (f32x4){0.f, 0.f, 0.f, 0.f};
#pragma unroll
            for (int s2 = 0; s2 < 2; ++s2) {
              if (32 * s2 < 16 * ib) {
                const bool half = (32 * s2 + 32) > 16 * ib;
                bf16x8 mf = *(const bf16x8*)(Am + irow * XS + 32 * s2 + 8 * g);
                if (half && g >= 2) mf = zero8;
                const bf16x8 nf = cat8(tr16(Xd + (32 * s2 + 8 * g + q4) * XS + f0 + 4 * p4), tr16(Xd + (32 * s2 + 8 * g + 4 + q4) * XS + f0 + 4 * p4));
                tmp = __builtin_amdgcn_mfma_f32_16x16x32_bf16(nf, mf, tmp, 0, 0, 0);
              }
            }
            y[fi] = (f32x4){bflo(rv.x) * sc - tmp[0], bfhi(rv.x) * sc - tmp[1], bflo(rv.y) * sc - tmp[2], bfhi(rv.y) * sc - tmp[3]};
          }
          wave_lds_sync();
#pragma unroll
          for (int fi = 0; fi < 2; ++fi) {
            uint2 o; o.x = pack2(y[fi][0], y[fi][1]); o.y = pack2(y[fi][2], y[fi][3]);
            *(uint2*)(Xd + irow * XS + fbase + 16 * fi + 4 * g) = o;
          }
          wave_lds_sync();
          bf16x8 dm = zero8;
          if (g < 2) dm = *(const bf16x8*)(Db + (ib * 16 + l15) * 24 + 8 * g);
#pragma unroll
          for (int fi = 0; fi < 2; ++fi) {
            const int f0 = fbase + 16 * fi;
            const bf16x8 nf = cat8(tr16(Xd + (16 * ib + 8 * (g & 1) + q4) * XS + f0 + 4 * p4), tr16(Xd + (16 * ib + 8 * (g & 1) + 4 + q4) * XS + f0 + 4 * p4));
            y[fi] = __builtin_amdgcn_mfma_f32_16x16x32_bf16(nf, dm, (f32x4){0.f, 0.f, 0.f, 0.f}, 0, 0, 0);
          }
          wave_lds_sync();
#pragma unroll
          for (int fi = 0; fi < 2; ++fi) {
            uint2 o; o.x = pack2(y[fi][0], y[fi][1]); o.y = pack2(y[fi][2], y[fi][3]);
            *(uint2*)(Xd + irow * XS + fbase + 16 * fi + 4 * g) = o;
          }
          wave_lds_sync();
        }
      }
      __syncthreads();
      {
        const int irow = 16 * wave + l15;
        const float dl = __expf(gam_last - gam[irow]);
        f32x4 acc[4];
#pragma unroll
        for (int et = 0; et < 4; ++et) acc[et] = (f32x4){0.f, 0.f, 0.f, 0.f};
#pragma unroll
        for (int s2 = 0; s2 < 2; ++s2) {
          const bf16x8 mf = *(const bf16x8*)(Xw + irow * XS + 32 * s2 + 8 * g);
#pragma unroll
          for (int et = 0; et < 4; ++et) {
            const bf16x8 nf = *(const bf16x8*)(St + (16 * et + l15) * XS + 32 * s2 + 8 * g);
            acc[et] = __builtin_amdgcn_mfma_f32_16x16x32_bf16(nf, mf, acc[et], 0, 0, 0);
          }
        }
#pragma unroll
        for (int et = 0; et < 4; ++et) {
          const uint2 uv = *(const uint2*)(Xu + irow * XS + 16 * et + 4 * g);
          const float v0 = bflo(uv.x) - acc[et][0], v1 = bfhi(uv.x) - acc[et][1], v2 = bflo(uv.y) - acc[et][2], v3 = bfhi(uv.y) - acc[et][3];
          uint2 o; o.x = pack2(v0, v1); o.y = pack2(v2, v3);
          *(uint2*)(Vn + irow * XS + 16 * et + 4 * g) = o;
          o.x = pack2(v0 * dl, v1 * dl); o.y = pack2(v2 * dl, v3 * dl);
          *(uint2*)(Vs + irow * XS + 16 * et + 4 * g) = o;
        }
      }
      __syncthreads();
      if (want_o) {
        const int irow = 16 * wave + l15;
        f32x4 acc[4];
#pragma unroll
        for (int et = 0; et < 4; ++et) acc[et] = (f32x4){0.f, 0.f, 0.f, 0.f};
#pragma unroll
        for (int s2 = 0; s2 < 2; ++s2) {
          const bf16x8 mf = *(const bf16x8*)(Qg + irow * XS + 32 * s2 + 8 * g);
          const bf16x8 mf2 = *(const bf16x8*)(Mq + irow * XS + 32 * s2 + 8 * g);
#pragma unroll
          for (int et = 0; et < 4; ++et) {
            const bf16x8 nf = *(const bf16x8*)(St + (16 * et + l15) * XS + 32 * s2 + 8 * g);
            acc[et] = __builtin_amdgcn_mfma_f32_16x16x32_bf16(nf, mf, acc[et], 0, 0, 0);
            const bf16x8 nf2 = cat8(tr16(Vn + (32 * s2 + 8 * g + q4) * XS + 16 * et + 4 * p4), tr16(Vn + (32 * s2 + 8 * g + 4 + q4) * XS + 16 * et + 4 * p4));
            acc[et] = __builtin_amdgcn_mfma_f32_16x16x32_bf16(nf2, mf2, acc[et], 0, 0, 0);
          }
        }
        const int row = r0 + (dir ? 63 - irow : irow);
#pragma unroll
        for (int et = 0; et < 4; ++et) {
          uint2 o; o.x = pack2(acc[et][0], acc[et][1]); o.y = pack2(acc[et][2], acc[et][3]);
          *(uint2*)(Og + (size_t)row * 512 + 64 * h + 16 * et + 4 * g) = o;
        }
      }
      {
        const float el = __expf(gam_last);
#pragma unroll
        for (int et = 0; et < 4; ++et) sst[et] *= el;
#pragma unroll
        for (int s2 = 0; s2 < 2; ++s2) {
          const bf16x8 nf = cat8(tr16(Kt + (32 * s2 + 8 * g + q4) * XS + 16 * wave + 4 * p4), tr16(Kt + (32 * s2 + 8 * g + 4 + q4) * XS + 16 * wave + 4 * p4));
#pragma unroll
          for (int et = 0; et < 4; ++et) {
            const bf16x8 mf = cat8(tr16(Vs + (32 * s2 + 8 * g + q4) * XS + 16 * et + 4 * p4), tr16(Vs + (32 * s2 + 8 * g + 4 + q4) * XS + 16 * et + 4 * p4));
            sst[et] = __builtin_amdgcn_mfma_f32_16x16x32_bf16(nf, mf, sst[et], 0, 0, 0);
          }
        }
      }
      __syncthreads();
#pragma unroll
      for (int et = 0; et < 4; ++et) {
        uint2 o; o.x = pack2(sst[et][0], sst[et][1]); o.y = pack2(sst[et][2], sst[et][3]);
        *(uint2*)(St + (16 * et + l15) * XS + 16 * wave + 4 * g) = o;
      }
    }
  }
}


#undef GDN_PREFETCH
constexpr int NA_VS = 72;
constexpr int NA_LDS_WAVE = 2 * 32 * NA_VS * 2;
__device__ __forceinline__ void phase_na(PRef p, int layer, unsigned* ctr, char* smem) {
  const int lane = tidx() & 63, wave = tidx() >> 6, g = lane >> 4, l15 = lane & 15, q4 = l15 >> 2, p4 = lane & 3;
  bf16_t* Vl = (bf16_t*)(smem + wave * NA_LDS_WAVE);
  const int ntask = layer == 0 ? 8192 + 1024 : 8192;
  const float* rpb = p.na_rpb + (size_t)layer * 8 * 15 * 31;
  for (;;) {
    int w0 = 0;
    if (lane == 0) w0 = (int)atomicAdd(ctr, 1u);
    const int task = __builtin_amdgcn_readfirstlane(__shfl(w0, 0));
    if (task >= ntask) break;
    const bool lat = task < 8192;
    int b, h, r = 0, cb = 0, qtok0, R0 = 0, C0 = 0;
    if (lat) { cb = task & 3; r = (task >> 2) & 31; h = (task >> 7) & 7; b = task >> 10; qtok0 = b * 2048 + r * 64 + 16 * cb; R0 = min(max(r - 4, 0), 24); C0 = min(max(16 * cb - 8, 0), 32); }
    else { const int t2 = task - 8192; const int qb = t2 & 15; h = (t2 >> 4) & 7; b = t2 >> 7; qtok0 = TL + b * 256 + 16 * qb; }
    const int tau0 = lat ? 0 : 16;
    const int wtok0 = b * 2048 + R0 * 64 + C0, ctok0 = TL + b * 256;
#define tile_tok(tau) ((tau) < 16 ? wtok0 + ((tau) >> 1) * 64 + 16 * ((tau) & 1) : ctok0 + 16 * ((tau) - 16))
    const bf16_t* qp = p.U + (size_t)(qtok0 + l15) * UW + U_NAQ + 64 * h + 8 * g;
    const bf16x8 qf0 = *(const bf16x8*)qp, qf1 = *(const bf16x8*)(qp + 32);
    f32x4 sc[32];
#pragma unroll
    for (int tau = 0; tau < 32; ++tau) {
      sc[tau] = (f32x4){-INFINITY, -INFINITY, -INFINITY, -INFINITY};
      if (tau >= tau0) {
        const bf16_t* kp = p.U + (size_t)(tile_tok(tau) + l15) * UW + U_NAK + 64 * h + 8 * g;
        const bf16x8 kf0 = *(const bf16x8*)kp, kf1 = *(const bf16x8*)(kp + 32);
        f32x4 a = (f32x4){0.f, 0.f, 0.f, 0.f};
        a = __builtin_amdgcn_mfma_f32_16x16x32_bf16(kf0, qf0, a, 0, 0, 0);
        a = __builtin_amdgcn_mfma_f32_16x16x32_bf16(kf1, qf1, a, 0, 0, 0);
        if (tau < 16) {
          const int qcol = 16 * cb + l15, ws = min(max(qcol - 8, 0), 48);
          const int dr = R0 + (tau >> 1) - r + 7;
#pragma unroll
          for (int rg = 0; rg < 4; ++rg) {
            const int kcol = C0 + 16 * (tau & 1) + 4 * g + rg;
            const bool ok = kcol >= ws && kcol < ws + 16;
            const float bias = ok ? rpb[(h * 15 + dr) * 31 + (kcol - qcol + 15)] : 0.f;
            a[rg] = ok ? a[rg] + bias : -INFINITY;
          }
        }
        sc[tau] = a;
      }
    }
    float mx = -INFINITY;
#pragma unroll
    for (int tau = 0; tau < 32; ++tau) mx = fmaxf(mx, fmaxf(fmaxf(sc[tau][0], sc[tau][1]), fmaxf(sc[tau][2], sc[tau][3])));
    mx = fmaxf(mx, __shfl_xor(mx, 16)); mx = fmaxf(mx, __shfl_xor(mx, 32));
    float sum = 0.f;
#pragma unroll
    for (int tau = 0; tau < 32; ++tau) {
#pragma unroll
      for (int rg = 0; rg < 4; ++rg) { const float e = __expf(sc[tau][rg] - mx); sc[tau][rg] = e; sum += e; }
    }
    sum += __shfl_xor(sum, 16); sum += __shfl_xor(sum, 32);
    f32x4 oacc[4];
#pragma unroll
    for (int dt = 0; dt < 4; ++dt) oacc[dt] = (f32x4){0.f, 0.f, 0.f, 0.f};
    const int kap0 = tau0 >> 1;
    uint4 vr0, vr1, vr2, vr3;
#define NA_VLOAD(KAP) { \
      const int kk0_ = lane >> 3, cc_ = lane & 7; \
      const bf16_t* vb_ = p.U + U_NAV + 64 * h + 8 * cc_; \
      vr0 = *(const uint4*)(vb_ + (size_t)(tile_tok(2 * (KAP)) + kk0_) * UW); \
      vr1 = *(const uint4*)(vb_ + (size_t)(tile_tok(2 * (KAP)) + kk0_ + 8) * UW); \
      vr2 = *(const uint4*)(vb_ + (size_t)(tile_tok(2 * (KAP) + 1) + kk0_) * UW); \
      vr3 = *(const uint4*)(vb_ + (size_t)(tile_tok(2 * (KAP) + 1) + kk0_ + 8) * UW); }
    NA_VLOAD(kap0)
#pragma unroll
    for (int kap = 0; kap < 16; ++kap) {
      if (kap >= kap0) {
        bf16_t* Vb = Vl + (kap & 1) * 32 * NA_VS;
        {
          const int kk0_ = lane >> 3, cc_ = lane & 7;
          *(uint4*)(Vb + kk0_ * NA_VS + 8 * cc_) = vr0; *(uint4*)(Vb + (kk0_ + 8) * NA_VS + 8 * cc_) = vr1;
          *(uint4*)(Vb + (kk0_ + 16) * NA_VS + 8 * cc_) = vr2; *(uint4*)(Vb + (kk0_ + 24) * NA_VS + 8 * cc_) = vr3;
        }
        if (kap + 1 < 16) NA_VLOAD(kap + 1)
        __builtin_amdgcn_fence(__ATOMIC_RELEASE, "workgroup"); __builtin_amdgcn_wave_barrier(); __builtin_amdgcn_fence(__ATOMIC_ACQUIRE, "workgroup");
        bf16x8 pf;
        {
          const unsigned w0_ = pack2(sc[2 * kap][0], sc[2 * kap][1]), w1_ = pack2(sc[2 * kap][2], sc[2 * kap][3]);
          const unsigned w2_ = pack2(sc[2 * kap + 1][0], sc[2 * kap + 1][1]), w3_ = pack2(sc[2 * kap + 1][2], sc[2 * kap + 1][3]);
          pf = (bf16x8){(short)(w0_ & 0xffff), (short)(w0_ >> 16), (short)(w1_ & 0xffff), (short)(w1_ >> 16), (short)(w2_ & 0xffff), (short)(w2_ >> 16), (short)(w3_ & 0xffff), (short)(w3_ >> 16)};
        }
#pragma unroll
        for (int dt = 0; dt < 4; ++dt) {
          const bf16x8 vf = cat8(tr16(Vb + (4 * g + q4) * NA_VS + 16 * dt + 4 * p4), tr16(Vb + (16 + 4 * g + q4) * NA_VS + 16 * dt + 4 * p4));
          oacc[dt] = __builtin_amdgcn_mfma_f32_16x16x32_bf16(vf, pf, oacc[dt], 0, 0, 0);
        }
      }
    }
#undef NA_VLOAD
#undef tile_tok
    const float inv = 1.f / sum;
    bf16_t* op = p.U + (size_t)(qtok0 + l15) * UW + U_YA + 64 * h + 4 * g;
#pragma unroll
    for (int dt = 0; dt < 4; ++dt) {
      uint2 o; o.x = pack2(oacc[dt][0] * inv, oacc[dt][1] * inv); o.y = pack2(oacc[dt][2] * inv, oacc[dt][3] * inv);
      *(uint2*)(op + 16 * dt) = o;
    }
  }
}

__device__ __forceinline__ void norm_row(const float* xr, float rs, const float* alpha, const float* shift, bf16_t* hrow, int lane) {
#pragma unroll
  for (int i = 0; i < 4; ++i) {
    const int k = lane * 4 + 256 * i;
    const float4 v = *(const float4*)(xr + k), a = *(const float4*)(alpha + k), s = *(const float4*)(shift + k);
    uint2 o; o.x = pack2(v.x * rs * a.x + s.x, v.y * rs * a.y + s.y); o.y = pack2(v.z * rs * a.z + s.z, v.w * rs * a.w + s.w);
    *(uint2*)(hrow + k) = o;
  }
}
constexpr int TKW = 2;
__device__ __forceinline__ void phase_fin(PRef p, int layer, int bid, int nb) {
  {
    bf16_t* uw = p.U + U_W;
#pragma unroll 1
    for (int i = 0; i < 3; ++i) wconv(p.w_in + (size_t)layer * 1024 * DIN, DIN, 6208 + 1024 * i, false, uw + (size_t)(UWR_G + 1024 * i) * UW, UW, 1024, 1024, bid, nb);
    wconv(p.w_pa + (size_t)layer * 512 * 1024, 1024, 0, false, uw + (size_t)UWR_PA * UW, UW, 512, 1024, bid, nb);
    wconv(p.w_pb + (size_t)layer * 512 * 1024, 1024, 0, false, uw + (size_t)UWR_PB * UW, UW, 512, 1024, bid, nb);
    wconv(p.w_pc + (size_t)layer * 1024 * 1024, 1024, 0, false, uw + (size_t)UWR_PC * UW, UW, 1024, 1024, bid, nb);
    wconv(p.w_out + (size_t)layer * 1024 * 1024, 1024, 0, false, uw + (size_t)UWR_OUT * UW, UW, 1024, 1024, bid, nb);
  }
  const int lane = tidx() & 63, wave = tidx() >> 6;
  const int ntok = layer == 0 ? TT : TL;
  const bf16_t* ogf = layer == 0 ? p.OG0 : p.OG1;
  const bf16_t* ogb = ogf + (size_t)(layer == 0 ? TT : TL) * 512;
  const float* gnd = p.dn_o_gain + layer * 64 + 8 * (lane & 7);
  const float* gns = p.ssd_o_gain + layer * 1024 + 16 * lane;
  const float* xlat = layer == 0 ? p.x : p.out;
  const float* xctx = layer == 0 ? p.ctx : p.XC;
  for (int tok0 = (bid * 4 + wave) * TKW; tok0 < ntok; tok0 += nb * 4 * TKW) {
    uint4 a[TKW], bq[TKW], zd[TKW], pa[TKW][2], zs[TKW][2];
    float4 xv[TKW][4];
#pragma unroll
    for (int j = 0; j < TKW; ++j)
#pragma unroll
      for (int i = 0; i < 4; ++i) xv[j][i] = *(const float4*)((tok0 < TL ? xlat + (size_t)(tok0 + j) * DM : xctx + (size_t)(tok0 + j - TL) * DM) + lane * 4 + 256 * i);
#pragma unroll
    for (int j = 0; j < TKW; ++j) {
      const int tok = tok0 + j;
      const bf16_t* ur = p.U + (size_t)tok * UW;
      a[j] = *(const uint4*)(ogf + (size_t)tok * 512 + 8 * lane); bq[j] = *(const uint4*)(ogb + (size_t)tok * 512 + 8 * lane); zd[j] = *(const uint4*)(ur + U_DNZ + 8 * lane);
      pa[j][0] = *(const uint4*)(p.P + (size_t)tok * 1024 + 16 * lane); pa[j][1] = *(const uint4*)(p.P + (size_t)tok * 1024 + 16 * lane + 8);
      zs[j][0] = *(const uint4*)(ur + U_SZ + 16 * lane); zs[j][1] = *(const uint4*)(ur + U_SZ + 16 * lane + 8);
    }
#pragma unroll
    for (int j = 0; j < TKW; ++j) {
      bf16_t* ur = p.U + (size_t)(tok0 + j) * UW;
      {
        float o[8] = {bflo(a[j].x) + bflo(bq[j].x), bfhi(a[j].x) + bfhi(bq[j].x), bflo(a[j].y) + bflo(bq[j].y), bfhi(a[j].y) + bfhi(bq[j].y),
                      bflo(a[j].z) + bflo(bq[j].z), bfhi(a[j].z) + bfhi(bq[j].z), bflo(a[j].w) + bflo(bq[j].w), bfhi(a[j].w) + bfhi(bq[j].w)};
        const float zz[8] = {bflo(zd[j].x), bfhi(zd[j].x), bflo(zd[j].y), bfhi(zd[j].y), bflo(zd[j].z), bfhi(zd[j].z), bflo(zd[j].w), bfhi(zd[j].w)};
        float ss = 0.f;
#pragma unroll
        for (int i = 0; i < 8; ++i) ss += o[i] * o[i];
        ss += __shfl_xor(ss, 1); ss += __shfl_xor(ss, 2); ss += __shfl_xor(ss, 4);
        const float rs = rsqrtf(ss * (1.f / 64.f) + EPS);
#pragma unroll
        for (int i = 0; i < 8; ++i) o[i] = o[i] * rs * gnd[i] * siluf(zz[i]);
        uint4 w; w.x = pack2(o[0], o[1]); w.y = pack2(o[2], o[3]); w.z = pack2(o[4], o[5]); w.w = pack2(o[6], o[7]);
        *(uint4*)(ur + U_YB + 8 * lane) = w;
      }
      {
        float yv[16];
        float ss = 0.f;
#pragma unroll
        for (int hf = 0; hf < 2; ++hf) {
          const uint4 av4 = pa[j][hf], z = zs[j][hf];
          const float av[8] = {bflo(av4.x), bfhi(av4.x), bflo(av4.y), bfhi(av4.y), bflo(av4.z), bfhi(av4.z), bflo(av4.w), bfhi(av4.w)};
          const float zz[8] = {bflo(z.x), bfhi(z.x), bflo(z.y), bfhi(z.y), bflo(z.z), bfhi(z.z), bflo(z.w), bfhi(z.w)};
#pragma unroll
          for (int i = 0; i < 8; ++i) { const float v = av[i] * siluf(zz[i]); yv[8 * hf + i] = v; ss += v * v; }
        }
        ss += __shfl_xor(ss, 1); ss += __shfl_xor(ss, 2); ss += __shfl_xor(ss, 4); ss += __shfl_xor(ss, 8); ss += __shfl_xor(ss, 16);
        const float rs = rsqrtf(ss * (1.f / 512.f) + EPS);
#pragma unroll
        for (int hf = 0; hf < 2; ++hf) {
          uint4 w;
          w.x = pack2(yv[8 * hf + 0] * rs * gns[8 * hf + 0], yv[8 * hf + 1] * rs * gns[8 * hf + 1]);
          w.y = pack2(yv[8 * hf + 2] * rs * gns[8 * hf + 2], yv[8 * hf + 3] * rs * gns[8 * hf + 3]);
          w.z = pack2(yv[8 * hf + 4] * rs * gns[8 * hf + 4], yv[8 * hf + 5] * rs * gns[8 * hf + 5]);
          w.w = pack2(yv[8 * hf + 6] * rs * gns[8 * hf + 6], yv[8 * hf + 7] * rs * gns[8 * hf + 7]);
          *(uint4*)(ur + U_YC + 16 * lane + 8 * hf) = w;
        }
      }
    }
    {
      __builtin_amdgcn_s_waitcnt(0x0F70);
      const float* mr = p.MOD + (size_t)layer * 9 * 6144 + modrow(tok0) * 6144;
      float rs[TKW];
#pragma unroll
      for (int j = 0; j < TKW; ++j) {
        float ssq = 0.f;
#pragma unroll
        for (int i = 0; i < 4; ++i) ssq += xv[j][i].x * xv[j][i].x + xv[j][i].y * xv[j][i].y + xv[j][i].z * xv[j][i].z + xv[j][i].w * xv[j][i].w;
        rs[j] = rsqrtf(wave_sum(ssq) * (1.f / DM) + EPS);
      }
#pragma unroll
      for (int i = 0; i < 4; ++i) {
        const int k = lane * 4 + 256 * i;
        const float4 al = *(const float4*)(mr + 1024 + k), sh = *(const float4*)(mr + k);
#pragma unroll
        for (int j = 0; j < TKW; ++j) {
          uint2 o; o.x = pack2(xv[j][i].x * rs[j] * al.x + sh.x, xv[j][i].y * rs[j] * al.y + sh.y); o.y = pack2(xv[j][i].z * rs[j] * al.z + sh.z, xv[j][i].w * rs[j] * al.w + sh.w);
          *(uint2*)(p.P + (size_t)(tok0 + j) * 1024 + k) = o;
        }
      }
    }
  }
}

#define XB_TMO      128
#define XB_XCNT(j)  (256  + 64 * (j))
#define XB_XSUB(j)  (1280 + 64 * (j))
#define XB_XGEN(j)  (2304 + 64 * (j))
#define XB_TOP      3328
#define XB_TOPGEN   3392
#define XCD_BAR_WORDS 3456
#define XB_SPIN_CAP (1u << 20)
__device__ __forceinline__ unsigned xb_ld(unsigned* p)              { return __hip_atomic_load(p, __ATOMIC_RELAXED, __HIP_MEMORY_SCOPE_AGENT); }
__device__ __forceinline__ unsigned xb_add(unsigned* p, unsigned v) { return __hip_atomic_fetch_add(p, v, __ATOMIC_RELAXED, __HIP_MEMORY_SCOPE_AGENT); }
__device__ __forceinline__ unsigned xb_xcc_id() { return (unsigned)__builtin_amdgcn_s_getreg((3 << 11) | 20) & 0xFu; }
#define XB_SPIN(cond, bar) do { unsigned _sp = 0; while (cond) { __builtin_amdgcn_s_sleep(1); \
    if ((++_sp & 255u) == 0u) { if (xb_ld(&(bar)[XB_TMO])) break; if (_sp > XB_SPIN_CAP) { atomicAdd(&(bar)[XB_TMO], 1u); break; } } } } while (0)
struct XcdBarrier { unsigned* bar; unsigned x; volatile LDS_AS unsigned* st; };
__device__ __forceinline__ XcdBarrier xcd_barrier_post(unsigned* bar, volatile LDS_AS unsigned* st) {
  XcdBarrier b; b.bar = bar; b.x = xb_xcc_id(); b.st = st;
  if (threadIdx.x == 0) (void)xb_add(&bar[XB_XCNT(b.x)], 1u);
  return b;
}
__device__ __forceinline__ void xcd_barrier_complete(unsigned* bar, unsigned x, unsigned& nloc, unsigned& nx) {
  const unsigned G = gridDim.x * gridDim.y * gridDim.z;
  unsigned sum, cnt, mine, sp = 0u;
  for (;;) {
    sum = 0u; cnt = 0u; mine = 0u;
#pragma unroll
    for (unsigned j = 0; j < 16; ++j) { const unsigned c = xb_ld(&bar[XB_XCNT(j)]); sum += c; cnt += (c > 0u) ? 1u : 0u; mine = (j == x) ? c : mine; }
    if (sum == G) break;
    __builtin_amdgcn_s_sleep(1);
    if ((++sp & 255u) == 0u) { if (xb_ld(&bar[XB_TMO])) break; if (sp > XB_SPIN_CAP) { atomicAdd(&bar[XB_TMO], 1u); break; } }
  }
  nloc = mine > 0u ? mine : 1u; nx = cnt > 0u ? cnt : 1u;
}
__device__ __forceinline__ void xcd_barrier(const XcdBarrier& b0) {
  asm volatile("s_waitcnt vmcnt(0)" ::: "memory");
  __syncthreads();
  if (threadIdx.x == 0) {
    XcdBarrier b = b0; b.x = xb_xcc_id();
    unsigned* bar = b.bar;
    __builtin_amdgcn_s_waitcnt(0);
    unsigned nloc = b.st[0], nx = b.st[1];
    if (nloc == 0u) { xcd_barrier_complete(bar, b.x, nloc, nx); b.st[0] = nloc; b.st[1] = nx; }
    const unsigned old = xb_add(&bar[XB_XSUB(b.x)], 1u);
    const unsigned gen = old / nloc;
    if (old + 1u == (gen + 1u) * nloc) {
      __builtin_amdgcn_fence(__ATOMIC_RELEASE, "agent");
      asm volatile("s_waitcnt vmcnt(0)" ::: "memory");
      const unsigned og = xb_add(&bar[XB_TOP], 1u);
      const unsigned tg = og / nx;
      if (og + 1u == (tg + 1u) * nx) xb_add(&bar[XB_TOPGEN], 1u);
      else XB_SPIN(xb_ld(&bar[XB_TOPGEN]) == tg, bar);
      __builtin_amdgcn_fence(__ATOMIC_ACQUIRE, "agent");
      xb_add(&bar[XB_XGEN(b.x)], 1u);
      asm volatile("s_waitcnt vmcnt(0)" ::: "memory");
    } else {
      XB_SPIN(xb_ld(&bar[XB_XGEN(b.x)]) == gen, bar);
      __builtin_amdgcn_fence(__ATOMIC_ACQUIRE, "agent");
      asm volatile("s_waitcnt vmcnt(0)" ::: "memory");
    }
  }
  __syncthreads();
}

namespace cg = cooperative_groups;
constexpr int MEGA_LDS = GDN_LDS > SSD_LDS ? GDN_LDS : SSD_LDS;
static_assert(MEGA_LDS <= 81408 && GEMM_LDS_BYTES <= MEGA_LDS && 4 * NA_LDS_WAVE <= MEGA_LDS, "LDS budget");
__global__ void __launch_bounds__(256, 2) k_mega(Params p_unused) {
  const AS4 Params* kp = (const AS4 Params*)__builtin_amdgcn_kernarg_segment_ptr();
#define PP (*p_launder(kp))
  cg::grid_group grid = cg::this_grid();
  __shared__ __attribute__((aligned(16))) char smem[MEGA_LDS];
  const int bid = blockIdx.x, nb = gridDim.x;
  __shared__ uint4 xb_words;
  if (threadIdx.x == 0) xb_words = make_uint4(0u, 0u, 0u, 0u);
  __syncthreads();
  const XcdBarrier xb = xcd_barrier_post(PP.BAR, (volatile LDS_AS unsigned*)&xb_words);
  phase_pro(PP, bid, nb);
  phase_modp(PP, bid, nb, (float*)smem);
  if (nb == 0x7fffffff) grid.sync();
  xcd_barrier(xb);
  phase_modfin(PP, bid, nb);
  xcd_barrier(xb);
  phase_norm(PP, 0, 0, bid, nb);
  xcd_barrier(xb);
#pragma unroll 1
  for (int layer = 0; layer < 2; ++layer) {
    phase_g1(PP, layer, bid, nb, (bf16_t*)smem);
    xcd_barrier(xb);
    phase_prep(PP, layer, bid, nb, (bf16_t*)smem);
    xcd_barrier(xb);
    {
      __shared__ int s_role;
      unsigned* chain_ctr = PP.CTR + 8 + layer;
      if (threadIdx.x == 0) {
        const unsigned key = (((unsigned)__builtin_amdgcn_s_getreg((3 << 11) | 20) & 0xFu) << 8) | (((unsigned)__builtin_amdgcn_s_getreg(63492) >> 8) & 0xffu);
        const unsigned slot = nb > 256 ? atomicAdd(PP.CTR + 64 + 2048 * layer + key, 1u) : 0u;
        s_role = slot == 0 ? (int)atomicAdd(chain_ctr, 1u) : 1 << 20;
      }
      __syncthreads();
      int c = s_role;
      __syncthreads();
      if (c < 128) phase_gdn(PP, layer, c, smem); else if (c < 256) phase_ssd(PP, layer, c - 128, smem);
      __syncthreads();
      phase_na(PP, layer, PP.CTR + layer, smem);
      for (;;) {
        __syncthreads();
        if (threadIdx.x == 0) s_role = (int)atomicAdd(chain_ctr, 1u);
        __syncthreads();
        c = s_role;
        if (c >= 256) break;
        if (c < 128) phase_gdn(PP, layer, c, smem); else phase_ssd(PP, layer, c - 128, smem);
      }
    }
    xcd_barrier(xb);
    phase_fin(PP, layer, bid, nb);
    xcd_barrier(xb);
    phase_g2a(PP, layer, bid, nb, (bf16_t*)smem);
    xcd_barrier(xb);
    phase_g2b(PP, layer, bid, nb, (bf16_t*)smem);
    xcd_barrier(xb);
    phase_g3(PP, layer, bid, nb, (bf16_t*)smem);
    xcd_barrier(xb);
    phase_norm(PP, layer, 1, bid, nb);
    xcd_barrier(xb);
    phase_g4(PP, layer, bid, nb, (bf16_t*)smem);
    xcd_barrier(xb);
    phase_g5(PP, layer, bid, nb, (bf16_t*)smem);
    if (layer == 0) { xcd_barrier(xb); phase_norm(PP, 1, 0, bid, nb); xcd_barrier(xb); }
  }
#undef PP
}

extern "C" void kernel_launch(void* const* d_in, const int* in_sizes, int n_in, void* d_out, int out_size, void* d_ws, size_t ws_size,
                              hipStream_t stream) {
  Params p{};
  const float** fp = (const float**)&p;
  for (int i = 0; i < 28; ++i) fp[i] = (const float*)d_in[i];
  p.out = (float*)d_out;
  char* ws = (char*)d_ws;
  size_t off = 0;
  auto take = [&](size_t bytes) { char* r = ws + off; off += (bytes + 255) & ~(size_t)255; return r; };
  p.U = (bf16_t*)take((size_t)TT * UW * 2);
  p.S = (float*)take((size_t)TT * SWD * 4);
  p.MOD = (float*)take((size_t)2 * 9 * 6144 * 4);
  p.SS = (float*)take((size_t)4 * TT * 4);
  p.ROPE = (float*)take(64 * 16 * 2 * 4);
  p.BAR = (unsigned*)take((size_t)XCD_BAR_WORDS * 4 + (64 + 2 * 2048) * 4);
  p.CTR = p.BAR + XCD_BAR_WORDS;
  p.P = (bf16_t*)take((size_t)TT * 1024 * 2);
  p.XC = (float*)take((size_t)TC * 1024 * 4);
  p.WT = (bf16_t*)(ws + off);
  p.HB = (bf16_t*)p.XC;
  p.OG0 = (bf16_t*)d_out;
  p.OG1 = (bf16_t*)((char*)p.P + (size_t)TL * 1024 * 2);
  size_t need = (size_t)((char*)p.OG1 - ws) + (size_t)2 * TL * 512 * 2;
  { const size_t need2 = off + (size_t)2 * 1024 * DFF * 2; if (need2 > need) need = need2; }
  if (need > ws_size) { fprintf(stderr, "workspace too small: need %zu have %zu\n", need, ws_size); return; }
  static int grid_blocks = 0;
  if (!grid_blocks) {
    int dev = 0, cus = 0, per_cu = 0;
    hipGetDevice(&dev);
    hipDeviceGetAttribute(&cus, hipDeviceAttributeMultiprocessorCount, dev);
    hipOccupancyMaxActiveBlocksPerMultiprocessor(&per_cu, k_mega, 256, 0);
    if (per_cu > 2) per_cu = 2;
    grid_blocks = cus * per_cu;
  }
  hipMemsetAsync(p.BAR, 0, (size_t)XCD_BAR_WORDS * 4 + (64 + 2 * 2048) * 4, stream);
  void* args[] = {&p};
  hipError_t e = hipLaunchCooperativeKernel((void*)k_mega, dim3(grid_blocks), dim3(256), args, 0, stream);
  if (e != hipSuccess) fprintf(stderr, "cooperative launch failed: %s (grid %d)\n", hipGetErrorString(e), grid_blocks);
}
```

```cpp
#include <hip/hip_runtime.h>
#include <hip/hip_cooperative_groups.h>
#include <cstdio>
#include <cstdint>

typedef unsigned short bf16_t;
typedef short bf16x8 __attribute__((ext_vector_type(8)));
typedef short s16x4 __attribute__((ext_vector_type(4)));
typedef float f32x4 __attribute__((ext_vector_type(4)));
#define LDS_AS __attribute__((address_space(3)))

constexpr int TL = 16384;
constexpr int TC = 2048;
constexpr int TT = TL + TC;
constexpr int DM = 1024;
constexpr int UW = 6144;
constexpr int SWD = 64;
constexpr int DIN = 9280;
constexpr int DFF = 4096;
constexpr float EPS = 1e-6f;
constexpr int U_NAQ = 0, U_NAK = 512, U_NAV = 1024;
constexpr int U_DNQ = 1536, U_DNK = 2048, U_DNV = 2560, U_DNZ = 3072;
constexpr int U_SZ = 3584, U_SX = 4608, U_SB = 5632, U_SC = 5888;
constexpr int U_YA = 0, U_YB = 512, U_YC = 1024, U_GATE = 2048, U_M = 5120;

struct Params {
  const float *x, *c, *ctx, *c_ctx, *w_ada, *b_ada, *norm1_g, *norm2_g, *w_in, *na_q_gain, *na_k_gain, *na_rpb,
      *dn_conv_w, *dn_a_log, *dn_dt_bias, *dn_o_gain, *ssd_conv_w, *ssd_conv_b, *ssd_a_log, *ssd_dt_bias, *ssd_d,
      *ssd_o_gain, *w_pa, *w_pb, *w_pc, *w_out, *w_ff1, *w_ff2;
  float* out;
  bf16_t* U;
  float* S;
  bf16_t* P;
  float* XC;
  bf16_t* WT;
  float* MOD;
  float* SS;
  float* ROPE;
  unsigned* BAR;
  unsigned* CTR;
  bf16_t* HB;
  bf16_t* OG0;
  bf16_t* OG1;
};

#define AS4 __attribute__((address_space(4)))
typedef const AS4 Params& PRef;
__device__ __forceinline__ const AS4 Params* p_launder(const AS4 Params* q) { asm volatile("" : "+s"(q)); return q; }

__device__ __forceinline__ int tidx() { int t = threadIdx.x; asm volatile("" : "+v"(t)); return t; }
__device__ __forceinline__ void wave_lds_sync() { __builtin_amdgcn_fence(__ATOMIC_RELEASE, "workgroup"); __builtin_amdgcn_wave_barrier(); __builtin_amdgcn_fence(__ATOMIC_ACQUIRE, "workgroup"); }
__device__ __forceinline__ float bf2f(bf16_t v) { return __uint_as_float(((unsigned)v) << 16); }
__device__ __forceinline__ bf16_t f2bf(float f) {
  unsigned u = __float_as_uint(f);
  u += 0x7fffu + ((u >> 16) & 1u);
  return (bf16_t)(u >> 16);
}
__device__ __forceinline__ unsigned pack2(float a, float b) { return (unsigned)f2bf(a) | ((unsigned)f2bf(b) << 16); }
__device__ __forceinline__ float bflo(unsigned w) { return __uint_as_float(w << 16); }
__device__ __forceinline__ float bfhi(unsigned w) { return __uint_as_float(w & 0xffff0000u); }
__device__ __forceinline__ float wave_sum(float v) {
#pragma unroll
  for (int o = 32; o; o >>= 1) v += __shfl_xor(v, o);
  return v;
}
__device__ __forceinline__ float wave_max(float v) {
#pragma unroll
  for (int o = 32; o; o >>= 1) v = fmaxf(v, __shfl_xor(v, o));
  return v;
}
__device__ __forceinline__ float siluf(float v) { return v * __builtin_amdgcn_rcpf(1.f + __expf(-v)); }
__device__ __forceinline__ float sigmoidf_(float v) { return __builtin_amdgcn_rcpf(1.f + __expf(-v)); }
__device__ __forceinline__ float softplusf_(float v) {
  const float u = __expf(fminf(v, 20.f));
  const float sp = u < 0.01f ? u * (1.f - u * (0.5f - u * (1.f / 3.f))) : __logf(1.f + u);
  return v > 20.f ? v : sp;
}

__device__ __forceinline__ const float* xrow_in(PRef p, int layer, int row) {
  if (layer == 0) return row < TL ? p.x + (size_t)row * DM : p.ctx + (size_t)(row - TL) * DM;
  return row < TL ? p.out + (size_t)row * DM : p.XC + (size_t)(row - TL) * DM;
}
__device__ __forceinline__ float* xrow_out(PRef p, int row) {
  return row < TL ? p.out + (size_t)row * DM : p.XC + (size_t)(row - TL) * DM;
}
__device__ __forceinline__ int modrow(int row) { return row < TL ? (row >> 11) : 8; }

constexpr int G_BK = 32;
constexpr int G_ASTR = G_BK;
constexpr int G_ATILE = 256 * G_ASTR;
constexpr int GEMM_LDS_BYTES = 2 * (G_ATILE + G_BK * (128 + 16)) * 2;
__device__ __forceinline__ s16x4 tr16(const bf16_t* ptr) { return __builtin_amdgcn_ds_read_tr16_b64_v4i16((LDS_AS s16x4*)ptr); }
__device__ __forceinline__ bf16x8 cat8(s16x4 lo, s16x4 hi) { return (bf16x8){lo[0], lo[1], lo[2], lo[3], hi[0], hi[1], hi[2], hi[3]}; }
__device__ __forceinline__ uint4 cvt8(float4 a, float4 b) { uint4 o; o.x = pack2(a.x, a.y); o.y = pack2(a.z, a.w); o.z = pack2(b.x, b.y); o.w = pack2(b.z, b.w); return o; }

__device__ __forceinline__ void gemm_main2(f32x4 (&acc)[8][2], const bf16_t* A, int astride, const bf16_t* W, int ldw, int col0, int K, bf16_t* lds) {
  constexpr int NI = 2, BSTR = 80, BTILE = G_BK * BSTR;
  const int tid = tidx(), lane = tid & 63, wave = tid >> 6, wm = wave >> 1, wn = wave & 1, g = lane >> 4, l15 = lane & 15, q4 = l15 >> 2, p4 = lane & 3;
  bf16_t* As = lds;
  bf16_t* Bs = lds + 2 * G_ATILE;
  const int ar = tid >> 2, ak = (tid & 3) * 8;
  const int bk = tid >> 3, bn = (tid & 7) * 8;
  const int rho0 = (bk & 3) + 4 * ((bk >> 3) & 3) + 16 * ((bk >> 2) & 1);
  const bf16_t* ap = A + (size_t)ar * astride + ak;
  const bf16_t* bp = W + (size_t)bk * ldw + col0 + bn;
  bf16_t* aw = As + ar * G_ASTR + 8 * ((tid & 3) ^ ((ar >> 1) & 3));
  bf16_t* bw = Bs + rho0 * BSTR + 32 * (bn >> 5) + 4 * ((bn >> 3) & 3);
  uint4 ra0, ra1, ra2, ra3, rb0;
#define G_LOADS(K1) { ra0 = *(const uint4*)(ap + (size_t)(64 * 0) * astride + (K1)); ra1 = *(const uint4*)(ap + (size_t)(64 * 1) * astride + (K1)); ra2 = *(const uint4*)(ap + (size_t)(64 * 2) * astride + (K1)); ra3 = *(const uint4*)(ap + (size_t)(64 * 3) * astride + (K1)); rb0 = *(const uint4*)(bp + (size_t)(K1) * ldw); }
#define G_STORES(NX) { *(uint4*)(aw + (NX) * G_ATILE + 64 * 0 * G_ASTR) = ra0; *(uint4*)(aw + (NX) * G_ATILE + 64 * 1 * G_ASTR) = ra1; *(uint4*)(aw + (NX) * G_ATILE + 64 * 2 * G_ASTR) = ra2; *(uint4*)(aw + (NX) * G_ATILE + 64 * 3 * G_ASTR) = ra3; { bf16_t* d_ = bw + (NX) * BTILE + 0 * BSTR; *(uint2*)d_ = make_uint2(rb0.x, rb0.y); *(uint2*)(d_ + 16) = make_uint2(rb0.z, rb0.w); } }
  G_LOADS(0)
  G_STORES(0)
  __syncthreads();
  const int nk = K / G_BK;
  for (int kt = 0; kt < nk; ++kt) {
    const int cur = kt & 1;
    const int k1 = (kt + 1 < nk ? kt + 1 : kt) * G_BK;
    G_LOADS(k1)
    asm volatile("" ::: "memory");
    const bf16_t* Ac = As + cur * G_ATILE + (128 * wm + l15) * G_ASTR + 8 * (g ^ ((l15 >> 1) & 3));
    const bf16_t* Bc = Bs + cur * BTILE + (4 * g + q4) * BSTR + 16 * NI * wn + 4 * p4;
    {
      bf16x8 af[8], bfr[NI];
#pragma unroll
      for (int mi = 0; mi < 8; ++mi) af[mi] = *(const bf16x8*)(Ac + mi * 16 * G_ASTR);
#pragma unroll
      for (int ni = 0; ni < NI; ++ni) bfr[ni] = cat8(tr16(Bc + 16 * ni), tr16(Bc + 16 * BSTR + 16 * ni));
#pragma unroll
      for (int mi = 0; mi < 8; ++mi)
#pragma unroll
        for (int ni = 0; ni < NI; ++ni) acc[mi][ni] = __builtin_amdgcn_mfma_f32_16x16x32_bf16(bfr[ni], af[mi], acc[mi][ni], 0, 0, 0);
    }
    asm volatile("" ::: "memory");
    __builtin_amdgcn_sched_barrier(0);
    G_STORES(cur ^ 1)
    __syncthreads();
  }
#undef G_LOADS
#undef G_STORES
}
__device__ __forceinline__ void gemm_main4(f32x4 (&acc)[8][4], const bf16_t* A, int astride, const bf16_t* W, int ldw, int col0, int K, bf16_t* lds) {
  constexpr int NI = 4, BSTR = 144, BTILE = G_BK * BSTR;
  const int tid = tidx(), lane = tid & 63, wave = tid >> 6, wm = wave >> 1, wn = wave & 1, g = lane >> 4, l15 = lane & 15, q4 = l15 >> 2, p4 = lane & 3;
  bf16_t* As = lds;
  bf16_t* Bs = lds + 2 * G_ATILE;
  const int ar = tid >> 2, ak = (tid & 3) * 8;
  const int bk = tid >> 4, bn = (tid & 15) * 8;
  const int rho0 = (bk & 3) + 4 * (bk >> 3) + 16 * ((bk >> 2) & 1);
  const bf16_t* ap = A + (size_t)ar * astride + ak;
  const bf16_t* bp = W + (size_t)bk * ldw + col0 + bn;
  bf16_t* aw = As + ar * G_ASTR + 8 * ((tid & 3) ^ ((ar >> 1) & 3));
  bf16_t* bw = Bs + rho0 * BSTR + 32 * (bn >> 5) + 4 * ((bn >> 3) & 3);
  uint4 ra0, ra1, ra2, ra3, rb0, rb1;
#define G_LOADS(K1) { ra0 = *(const uint4*)(ap + (size_t)(64 * 0) * astride + (K1)); ra1 = *(const uint4*)(ap + (size_t)(64 * 1) * astride + (K1)); ra2 = *(const uint4*)(ap + (size_t)(64 * 2) * astride + (K1)); ra3 = *(const uint4*)(ap + (size_t)(64 * 3) * astride + (K1)); rb0 = *(const uint4*)(bp + (size_t)((K1) + 16 * 0) * ldw); rb1 = *(const uint4*)(bp + (size_t)((K1) + 16 * 1) * ldw); }
#define G_STORES(NX) { *(uint4*)(aw + (NX) * G_ATILE + 64 * 0 * G_ASTR) = ra0; *(uint4*)(aw + (NX) * G_ATILE + 64 * 1 * G_ASTR) = ra1; *(uint4*)(aw + (NX) * G_ATILE + 64 * 2 * G_ASTR) = ra2; *(uint4*)(aw + (NX) * G_ATILE + 64 * 3 * G_ASTR) = ra3; { bf16_t* d_ = bw + (NX) * BTILE + 0 * BSTR; *(uint2*)d_ = make_uint2(rb0.x, rb0.y); *(uint2*)(d_ + 16) = make_uint2(rb0.z, rb0.w); } { bf16_t* d_ = bw + (NX) * BTILE + 8 * BSTR; *(uint2*)d_ = make_uint2(rb1.x, rb1.y); *(uint2*)(d_ + 16) = make_uint2(rb1.z, rb1.w); } }
  G_LOADS(0)
  G_STORES(0)
  __syncthreads();
  const int nk = K / G_BK;
  for (int kt = 0; kt < nk; ++kt) {
    const int cur = kt & 1;
    const int k1 = (kt + 1 < nk ? kt + 1 : kt) * G_BK;
    G_LOADS(k1)
    asm volatile("" ::: "memory");
    const bf16_t* Ac = As + cur * G_ATILE + (128 * wm + l15) * G_ASTR + 8 * (g ^ ((l15 >> 1) & 3));
    const bf16_t* Bc = Bs + cur * BTILE + (4 * g + q4) * BSTR + 16 * NI * wn + 4 * p4;
    {
      bf16x8 af[8], bfr[NI];
#pragma unroll
      for (int mi = 0; mi < 8; ++mi) af[mi] = *(const bf16x8*)(Ac + mi * 16 * G_ASTR);
#pragma unroll
      for (int ni = 0; ni < NI; ++ni) bfr[ni] = cat8(tr16(Bc + 16 * ni), tr16(Bc + 16 * BSTR + 16 * ni));
#pragma unroll
      for (int mi = 0; mi < 8; ++mi)
#pragma unroll
        for (int ni = 0; ni < NI; ++ni) acc[mi][ni] = __builtin_amdgcn_mfma_f32_16x16x32_bf16(bfr[ni], af[mi], acc[mi][ni], 0, 0, 0);
    }
    asm volatile("" ::: "memory");
    __builtin_amdgcn_sched_barrier(0);
    G_STORES(cur ^ 1)
    __syncthreads();
  }
#undef G_LOADS
#undef G_STORES
}
template <int NI> __device__ __forceinline__ void acc_zero(f32x4 (&acc)[8][NI]) {
#pragma unroll
  for (int i = 0; i < 8; ++i)
#pragma unroll
    for (int j = 0; j < NI; ++j) acc[i][j] = (f32x4){0.f, 0.f, 0.f, 0.f};
}
__device__ __forceinline__ void wconv(const float* src, int sld, int soff, bool win_order, bf16_t* dst, int dld, int rows, int cols, int bid, int nb) {
  const int cpr = cols >> 3, total = rows * cpr;
  for (int i = bid * 256 + tidx(); i < total; i += nb * 256) {
    const int r = i / cpr, c = (i - r * cpr) << 3;
    int sc = c + soff;
    if (win_order) { if (c < 3584) sc = c; else if (c < 6144) sc = c + 32; else { const int o = c - 6144; sc = o < 32 ? 3584 + o : (o < 64 ? 6176 + o - 32 : -1); } }
    uint4 o = make_uint4(0u, 0u, 0u, 0u);
    if (sc >= 0) { const float* sp = src + (size_t)r * sld + sc; o = cvt8(*(const float4*)sp, *(const float4*)(sp + 4)); }
    *(uint4*)(dst + (size_t)r * dld + c) = o;
  }
}
constexpr int WIN_LD = 6272;
constexpr int U_W = 5120;
constexpr int UWR_G = 0, UWR_PA = 3072, UWR_PB = 3584, UWR_PC = 4096, UWR_OUT = 5120;
__device__ __forceinline__ bool tile_next(int i, int bid, int nb, int nMt, int nNt, bool nsplit, int& mt, int& nt) {
  const int xcd = bid & 7, slot = bid >> 3, nslots = nb >> 3;
  const int j = slot + i * nslots;
  if (nsplit) {
    const int nNx = (nNt - xcd + 7) >> 3;
    if (j >= nMt * nNx) return false;
    mt = j / nNx; nt = xcd + 8 * (j % nNx);
  } else {
    const int nMx = (nMt - xcd + 7) >> 3;
    if (j >= nMx * nNt) return false;
    mt = xcd + 8 * (j / nNt); nt = j % nNt;
  }
  return true;
}
#define EPI_IDS const int lane = tidx() & 63, wave = tidx() >> 6, wm = wave >> 1, wn = wave & 1, g = lane >> 4, l15 = lane & 15

__device__ __forceinline__ void phase_pro(PRef p, int bid, int nb) {
  const int tid = tidx(), lane = tid & 63, wave = tid >> 6;
  for (int i = bid * 256 + tid; i < 64 * 16; i += nb * 256) {
    const int pos = i >> 4, fi = i & 15;
    const float inv = __builtin_amdgcn_exp2f(-(float)fi * 0.83048202372184f);
    float ang = (float)pos * inv;
    const float kk = rintf(ang * 0.15915494309189535f);
    ang = fmaf(-kk, 6.2831854820251465f, ang); ang = fmaf(-kk, -1.7484555314695172e-07f, ang);
    p.ROPE[2 * i] = __cosf(ang); p.ROPE[2 * i + 1] = __sinf(ang);
  }
}
__device__ __forceinline__ void phase_modp(PRef p, int bid, int nb, float* lds) {
  const int tid = tidx();
  float* MODP = (float*)p.U;
  for (int u = bid; u < 768; u += nb) {
    const int ks = u & 15, cb = (u >> 4) % 24, l = u / 384, n = cb * 256 + tid;
    __syncthreads();
    for (int i = tid; i < 9 * 64; i += 256) { const int r = i >> 6, k = 64 * ks + (i & 63); const float v = r < 8 ? p.c[r * 1024 + k] : p.c_ctx[k]; lds[i] = siluf(v); }
    __syncthreads();
    float acc[9];
#pragma unroll
    for (int r = 0; r < 9; ++r) acc[r] = 0.f;
    const float* w = p.w_ada + ((size_t)l * 1024 + 64 * ks) * 6144 + n;
#pragma unroll 16
    for (int k = 0; k < 64; ++k) {
      const float wv = w[(size_t)k * 6144];
#pragma unroll
      for (int r = 0; r < 9; ++r) acc[r] += lds[r * 64 + k] * wv;
    }
#pragma unroll
    for (int r = 0; r < 9; ++r) MODP[((size_t)(ks * 2 + l) * 9 + r) * 6144 + n] = acc[r];
  }
}
__device__ __forceinline__ void phase_modfin(PRef p, int bid, int nb) {
  const float* MODP = (const float*)p.U;
  for (int i = bid * 256 + tidx(); i < 2 * 9 * 6144; i += nb * 256) {
    const int l = i / (9 * 6144), rem = i % (9 * 6144), r = rem / 6144, n = rem % 6144;
    float v = p.b_ada[l * 6144 + n];
#pragma unroll
    for (int ks = 0; ks < 16; ++ks) v += MODP[((size_t)(ks * 2 + l) * 9 + r) * 6144 + n];
    const int chunk = n >> 10, kk = n & 1023;
    if (chunk == 1) v = p.norm1_g[l * 1024 + kk] * (1.f + v);
    if (chunk == 4) v = p.norm2_g[l * 1024 + kk] * (1.f + v);
    p.MOD[i] = v;
  }
}

__device__ __forceinline__ void norm_rows4(const float* x0, const float* x1, const float* x2, const float* x3, const float* alpha, const float* shift, bf16_t* h0, int lane) {
  const float* xr[4] = {x0, x1, x2, x3};
  float4 v[4][4];
#pragma unroll
  for (int j = 0; j < 4; ++j)
#pragma unroll
    for (int i = 0; i < 4; ++i) v[j][i] = *(const float4*)(xr[j] + lane * 4 + 256 * i);
  float rs[4];
#pragma unroll
  for (int j = 0; j < 4; ++j) {
    float ssq = 0.f;
#pragma unroll
    for (int i = 0; i < 4; ++i) ssq += v[j][i].x * v[j][i].x + v[j][i].y * v[j][i].y + v[j][i].z * v[j][i].z + v[j][i].w * v[j][i].w;
    rs[j] = rsqrtf(wave_sum(ssq) * (1.f / DM) + EPS);
  }
#pragma unroll
  for (int i = 0; i < 4; ++i) {
    const int k = lane * 4 + 256 * i;
    const float4 a = *(const float4*)(alpha + k), s = *(const float4*)(shift + k);
#pragma unroll
    for (int j = 0; j < 4; ++j) {
      uint2 o; o.x = pack2(v[j][i].x * rs[j] * a.x + s.x, v[j][i].y * rs[j] * a.y + s.y); o.y = pack2(v[j][i].z * rs[j] * a.z + s.z, v[j][i].w * rs[j] * a.w + s.w);
      *(uint2*)(h0 + (size_t)j * 1024 + k) = o;
    }
  }
}
__device__ __forceinline__ void phase_norm(PRef p, int layer, int which, int bid, int nb) {
  if (which == 0) wconv(p.w_in + (size_t)layer * 1024 * DIN, DIN, 0, true, p.WT, WIN_LD, 1024, WIN_LD, bid, nb);
  else {
    wconv(p.w_ff1 + (size_t)layer * 1024 * DFF, DFF, 0, false, p.WT, DFF, 1024, DFF, bid, nb);
    wconv(p.w_ff2 + (size_t)layer * DFF * 1024, 1024, 0, false, p.WT + (size_t)1024 * DFF, 1024, DFF, 1024, bid, nb);
  }
  const int lane = tidx() & 63, wave = tidx() >> 6;
  const int nrow = (which == 1 && layer == 1) ? TL : TT;
  const float* modl = p.MOD + (size_t)layer * 9 * 6144;
  const int lin = which == 0 ? layer : 1;
  for (int row = (bid * 4 + wave) * 4; row < nrow; row += nb * 16) {
    const float* mr = modl + modrow(row) * 6144;
    norm_rows4(xrow_in(p, lin, row), xrow_in(p, lin, row + 1), xrow_in(p, lin, row + 2), xrow_in(p, lin, row + 3),
               mr + (which ? 4096 : 1024), mr + (which ? 3072 : 0), p.P + (size_t)row * 1024, lane);
  }
}

__device__ __forceinline__ void phase_g1(PRef p, int layer, int bid, int nb, bf16_t* lds) {
  constexpr bool NSPLIT = true;
  const int nMt = TT / 256, nNt = 49;
  EPI_IDS;
  for (int ti = 0;; ++ti) {
    int mt, nt; if (!tile_next(ti, bid, nb, nMt, nNt, NSPLIT, mt, nt)) break;
    const int m0 = mt * 256, n0 = nt * 128;
    f32x4 acc[8][4]; acc_zero<4>(acc);
    gemm_main4(acc, p.P + (size_t)m0 * 1024, 1024, p.WT, WIN_LD, n0, 1024, lds);
    if (n0 < 1024) {
      const float* gain = (n0 < 512 ? p.na_q_gain : p.na_k_gain) + layer * 64;
      const float mul = n0 < 512 ? 0.125f : 1.f;
#pragma unroll
      for (int mi = 0; mi < 8; ++mi) {
        float ss = 0.f;
#pragma unroll
        for (int ni = 0; ni < 4; ++ni) ss += acc[mi][ni][0] * acc[mi][ni][0] + acc[mi][ni][1] * acc[mi][ni][1] + acc[mi][ni][2] * acc[mi][ni][2] + acc[mi][ni][3] * acc[mi][ni][3];
        ss += __shfl_xor(ss, 16); ss += __shfl_xor(ss, 32);
        const float rs = rsqrtf(ss * (1.f / 64.f) + EPS) * mul;
        const int row = m0 + 128 * wm + 16 * mi + l15;
#pragma unroll
        for (int q = 0; q < 2; ++q) {
          const int cl = 32 * q + 8 * g;
          const float4 g0 = *(const float4*)(gain + cl), g1 = *(const float4*)(gain + cl + 4);
          uint4 o;
          o.x = pack2(acc[mi][2 * q][0] * rs * g0.x, acc[mi][2 * q][1] * rs * g0.y); o.y = pack2(acc[mi][2 * q][2] * rs * g0.z, acc[mi][2 * q][3] * rs * g0.w);
          o.z = pack2(acc[mi][2 * q + 1][0] * rs * g1.x, acc[mi][2 * q + 1][1] * rs * g1.y); o.w = pack2(acc[mi][2 * q + 1][2] * rs * g1.z, acc[mi][2 * q + 1][3] * rs * g1.w);
          *(uint4*)(p.U + (size_t)row * UW + n0 + 64 * wn + cl) = o;
        }
      }
    } else if (n0 < 6144) {
      const bool hsec = (n0 >= 1536 && n0 < 3072) || n0 >= 4608;
      const int hcol0 = n0 < 3072 ? n0 - 1536 : n0 - 3072;
#pragma unroll
      for (int mi = 0; mi < 8; ++mi) {
        const int row = m0 + 128 * wm + 16 * mi + l15;
        const int rr = row & 63;
        const bool halo = hsec && (rr < 2 || rr >= 62);
        bf16_t* hb = p.HB + ((size_t)(row >> 6) * 4 + (rr < 2 ? rr : rr - 60)) * 3072 + hcol0 + 64 * wn + 8 * g;
#pragma unroll
        for (int q = 0; q < 2; ++q) {
          uint4 o; o.x = pack2(acc[mi][2 * q][0], acc[mi][2 * q][1]); o.y = pack2(acc[mi][2 * q][2], acc[mi][2 * q][3]);
          o.z = pack2(acc[mi][2 * q + 1][0], acc[mi][2 * q + 1][1]); o.w = pack2(acc[mi][2 * q + 1][2], acc[mi][2 * q + 1][3]);
          *(uint4*)(p.U + (size_t)row * UW + n0 + 64 * wn + 32 * q + 8 * g) = o;
          if (halo) *(uint4*)(hb + 32 * q) = o;
        }
      }
    } else if (wn == 0) {
#pragma unroll
      for (int mi = 0; mi < 8; ++mi) {
        const int row = m0 + 128 * wm + 16 * mi + l15;
#pragma unroll
        for (int ni = 0; ni < 4; ++ni) *(f32x4*)(p.S + (size_t)row * SWD + 32 * (ni >> 1) + 8 * g + 4 * (ni & 1)) = acc[mi][ni];
      }
    }
  }
}

__device__ __forceinline__ void phase_g2a(PRef p, int layer, int bid, int nb, bf16_t* lds) {
  constexpr bool NSPLIT = true;
  const int nMt = (layer == 0 ? TT : TL) / 256, nNt = 24;
  EPI_IDS;
  for (int ti = 0;; ++ti) {
    int mt, nt; if (!tile_next(ti, bid, nb, nMt, nNt, NSPLIT, mt, nt)) break;
    const int m0 = mt * 256, n0 = nt * 128;
    f32x4 acc[8][4]; acc_zero<4>(acc);
    gemm_main4(acc, p.P + (size_t)m0 * 1024, 1024, p.U + U_W + (size_t)(UWR_G + 1024 * (n0 >> 10)) * UW, UW, n0 & 1023, 1024, lds);
#pragma unroll
    for (int mi = 0; mi < 8; ++mi) {
      const int row = m0 + 128 * wm + 16 * mi + l15;
#pragma unroll
      for (int q = 0; q < 2; ++q) {
        uint4 o; o.x = pack2(sigmoidf_(acc[mi][2 * q][0]), sigmoidf_(acc[mi][2 * q][1])); o.y = pack2(sigmoidf_(acc[mi][2 * q][2]), sigmoidf_(acc[mi][2 * q][3]));
        o.z = pack2(sigmoidf_(acc[mi][2 * q + 1][0]), sigmoidf_(acc[mi][2 * q + 1][1])); o.w = pack2(sigmoidf_(acc[mi][2 * q + 1][2]), sigmoidf_(acc[mi][2 * q + 1][3]));
        *(uint4*)(p.U + (size_t)row * UW + U_GATE + n0 + 64 * wn + 32 * q + 8 * g) = o;
      }
    }
  }
}
__device__ __forceinline__ void phase_g2b(PRef p, int layer, int bid, int nb, bf16_t* lds) {
  constexpr bool NSPLIT = false;
  const int nMt = (layer == 0 ? TT : TL) / 256, nNt = 16;
  EPI_IDS;
  for (int ti = 0;; ++ti) {
    int mt, nt; if (!tile_next(ti, bid, nb, nMt, nNt, NSPLIT, mt, nt)) break;
    const int m0 = mt * 256, n0 = nt * 64;
    f32x4 accm[8][2]; acc_zero<2>(accm);
#pragma unroll 1
    for (int i = 0; i < 3; ++i) {
      const int ycol = i == 0 ? U_YA : (i == 1 ? U_YB : U_YC);
      const int Ki = i == 2 ? 1024 : 512;
      const bf16_t* w = p.U + U_W + (size_t)(i == 0 ? UWR_PA : (i == 1 ? UWR_PB : UWR_PC)) * UW;
      f32x4 acc[8][2]; acc_zero<2>(acc);
      gemm_main2(acc, p.U + (size_t)m0 * UW + ycol, UW, w, UW, n0, Ki, lds);
#pragma unroll
      for (int mi = 0; mi < 8; ++mi) {
        const int row = m0 + 128 * wm + 16 * mi + l15;
        {
          const uint4 gt = *(const uint4*)(p.U + (size_t)row * UW + U_GATE + 1024 * i + n0 + 32 * wn + 8 * g);
          accm[mi][0][0] += bflo(gt.x) * acc[mi][0][0]; accm[mi][0][1] += bfhi(gt.x) * acc[mi][0][1];
          accm[mi][0][2] += bflo(gt.y) * acc[mi][0][2]; accm[mi][0][3] += bfhi(gt.y) * acc[mi][0][3];
          accm[mi][1][0] += bflo(gt.z) * acc[mi][1][0]; accm[mi][1][1] += bfhi(gt.z) * acc[mi][1][1];
          accm[mi][1][2] += bflo(gt.w) * acc[mi][1][2]; accm[mi][1][3] += bfhi(gt.w) * acc[mi][1][3];
        }
      }
    }
#pragma unroll
    for (int mi = 0; mi < 8; ++mi) {
      const int row = m0 + 128 * wm + 16 * mi + l15;
      {
        uint4 o; o.x = pack2(accm[mi][0][0], accm[mi][0][1]); o.y = pack2(accm[mi][0][2], accm[mi][0][3]); o.z = pack2(accm[mi][1][0], accm[mi][1][1]); o.w = pack2(accm[mi][1][2], accm[mi][1][3]);
        *(uint4*)(p.P + (size_t)row * 1024 + n0 + 32 * wn + 8 * g) = o;
      }
    }
  }
}
template <int NI> __device__ __forceinline__ void epi_residual(PRef p, const f32x4 (&acc)[8][NI], int layer_in, int m0, int n0, const float* gate) {
  EPI_IDS;
#pragma unroll
  for (int mi = 0; mi < 8; ++mi) {
    const int row = m0 + 128 * wm + 16 * mi + l15;
    const float* xi = xrow_in(p, layer_in, row);
    float* xo = xrow_out(p, row);
    const float* gr = gate + modrow(row) * 6144;
#pragma unroll
    for (int ni = 0; ni < NI; ++ni) {
      const int col = n0 + 16 * NI * wn + 32 * (ni >> 1) + 8 * g + 4 * (ni & 1);
      const float4 xv = *(const float4*)(xi + col);
      const float4 gv = *(const float4*)(gr + col);
      float4 o;
      o.x = xv.x + gv.x * acc[mi][ni][0]; o.y = xv.y + gv.y * acc[mi][ni][1]; o.z = xv.z + gv.z * acc[mi][ni][2]; o.w = xv.w + gv.w * acc[mi][ni][3];
      *(float4*)(xo + col) = o;
    }
  }
}
__device__ __forceinline__ void phase_g3(PRef p, int layer, int bid, int nb, bf16_t* lds) {
  constexpr bool NSPLIT = false;
  const float* modl = p.MOD + (size_t)layer * 9 * 6144;
  const bf16_t* w = p.U + U_W + (size_t)UWR_OUT * UW;
  for (int ti = 0;; ++ti) {
    int mt, nt; if (!tile_next(ti, bid, nb, TL / 256, 8, NSPLIT, mt, nt)) break;
    const int m0 = mt * 256, n0 = nt * 128;
    f32x4 acc[8][4]; acc_zero<4>(acc);
    gemm_main4(acc, p.P + (size_t)m0 * 1024, 1024, w, UW, n0, 1024, lds);
    epi_residual<4>(p, acc, layer, m0, n0, modl + 2048);
  }
  if (layer == 0) {
    for (int u = bid; u < (TC / 256) * 16; u += nb) {
      const int m0 = TL + (u >> 4) * 256, n0 = (u & 15) * 64;
      f32x4 acc[8][2]; acc_zero<2>(acc);
      gemm_main2(acc, p.P + (size_t)m0 * 1024, 1024, w, UW, n0, 1024, lds);
      epi_residual<2>(p, acc, layer, m0, n0, modl + 2048);
    }
  }
}
__device__ __forceinline__ void phase_g4(PRef p, int layer, int bid, int nb, bf16_t* lds) {
  constexpr bool NSPLIT = true;
  const int nMt = (layer == 0 ? TT : TL) / 256, nNt = 32;
  EPI_IDS;
  for (int ti = 0;; ++ti) {
    int mt, nt; if (!tile_next(ti, bid, nb, nMt, nNt, NSPLIT, mt, nt)) break;
    const int m0 = mt * 256, n0 = nt * 128;
    f32x4 acc[8][4]; acc_zero<4>(acc);
    gemm_main4(acc, p.P + (size_t)m0 * 1024, 1024, p.WT, DFF, n0, 1024, lds);
#pragma unroll
    for (int mi = 0; mi < 8; ++mi) {
      const int row = m0 + 128 * wm + 16 * mi + l15;
#pragma unroll
      for (int q = 0; q < 2; ++q) {
        float v[8];
#pragma unroll
        for (int e = 0; e < 4; ++e) { v[e] = fmaxf(acc[mi][2 * q][e], 0.f); v[4 + e] = fmaxf(acc[mi][2 * q + 1][e], 0.f); }
        uint4 o; o.x = pack2(v[0] * v[0], v[1] * v[1]); o.y = pack2(v[2] * v[2], v[3] * v[3]); o.z = pack2(v[4] * v[4], v[5] * v[5]); o.w = pack2(v[6] * v[6], v[7] * v[7]);
        *(uint4*)(p.U + (size_t)row * DFF + n0 + 64 * wn + 32 * q + 8 * g) = o;
      }
    }
  }
}
__device__ __forceinline__ void phase_g5(PRef p, int layer, int bid, int nb, bf16_t* lds) {
  constexpr bool NSPLIT = false;
  const float* modl = p.MOD + (size_t)layer * 9 * 6144;
  const bf16_t* w = p.WT + (size_t)1024 * DFF;
  for (int ti = 0;; ++ti) {
    int mt, nt; if (!tile_next(ti, bid, nb, TL / 256, 8, NSPLIT, mt, nt)) break;
    const int m0 = mt * 256, n0 = nt * 128;
    f32x4 acc[8][4]; acc_zero<4>(acc);
    gemm_main4(acc, p.U + (size_t)m0 * DFF, DFF, w, 1024, n0, DFF, lds);
    epi_residual<4>(p, acc, 1, m0, n0, modl + 5120);
  }
  if (layer == 0) {
    for (int u = bid; u < (TC / 256) * 16; u += nb) {
      const int m0 = TL + (u >> 4) * 256, n0 = (u & 15) * 64;
      f32x4 acc[8][2]; acc_zero<2>(acc);
      gemm_main2(acc, p.U + (size_t)m0 * DFF, DFF, w, 1024, n0, DFF, lds);
      epi_residual<2>(p, acc, 1, m0, n0, modl + 5120);
    }
  }
}

__device__ __forceinline__ void phase_prep(PRef p, int layer, int bid, int nb, bf16_t* lds) {
  const int tid = tidx();
  for (int i = bid * 256 + tid; i < TT * 64; i += nb * 256) {
    const int c = i & 63;
    float v = p.S[i];
    if (c < 16) v = sigmoidf_(v);
    else if (c < 32) v = -expf(p.dn_a_log[layer * 16 + c - 16]) * softplusf_(v + p.dn_dt_bias[layer * 16 + c - 16]);
    else v = softplusf_(v + p.ssd_dt_bias[layer * 32 + c - 32]);
    p.S[i] = v;
  }
  const int cg = tid & 7, rA = tid >> 3;
  {
    int slab_ = bid % 48; asm volatile("" : "+s"(slab_));
    const int slab = slab_, c0 = bid / 48, cstep = (nb + 47 - slab) / 48;
    const bool dn = slab < 24;
    const int typ = dn ? slab >> 3 : 3;
    const int ucol = (dn ? 1536 + 512 * typ + 64 * (slab & 7) : 4608 + 64 * (slab - 24)) + 8 * cg;
    const int hcol = dn ? ucol - 1536 : ucol - 3072;
    const int cch = (dn ? 512 * typ + 64 * (slab & 7) : 64 * (slab - 24)) + 8 * cg;
    const float* cw = (dn ? p.dn_conv_w : p.ssd_conv_w) + (size_t)layer * 5 * 1536 + cch;
    float w5[5][8];
#pragma unroll
    for (int j = 0; j < 5; ++j) {
      const float4 a = *(const float4*)(cw + j * 1536), b = *(const float4*)(cw + j * 1536 + 4);
      w5[j][0] = a.x; w5[j][1] = a.y; w5[j][2] = a.z; w5[j][3] = a.w; w5[j][4] = b.x; w5[j][5] = b.y; w5[j][6] = b.z; w5[j][7] = b.w;
    }
    float bias[8];
#pragma unroll
    for (int e = 0; e < 8; ++e) bias[e] = dn ? 0.f : p.ssd_conv_b[layer * 1536 + cch + e];
    bf16_t* T = lds;
    constexpr int TS_ = 72;
    uint4 pr0, pr1, pr2;
#define PREP_ROW(CHUNK, TR, DST) { \
      const int rr_ = (TR) - 2; \
      const bool lat_ = (CHUNK) < 256; const int cs_ = lat_ ? ((CHUNK) & 31) : (((CHUNK) - 256) & 3); \
      const bool first_ = cs_ == 0, last_ = lat_ ? cs_ == 31 : cs_ == 3; \
      uint4 v_ = make_uint4(0u, 0u, 0u, 0u); \
      if (rr_ < 0) { if (!first_) v_ = *(const uint4*)(p.HB + ((size_t)((CHUNK) - 1) * 4 + 4 + rr_) * 3072 + hcol); } \
      else if (rr_ >= 64) { if (!last_) v_ = *(const uint4*)(p.HB + ((size_t)((CHUNK) + 1) * 4 + rr_ - 64) * 3072 + hcol); } \
      else v_ = *(const uint4*)(p.U + (size_t)((CHUNK) * 64 + rr_) * UW + ucol); \
      DST = v_; }
#define PREP_LOAD(CHUNK) { PREP_ROW(CHUNK, rA, pr0) PREP_ROW(CHUNK, rA + 32, pr1) if (rA < 4) PREP_ROW(CHUNK, rA + 64, pr2) }
    if (c0 < 288) PREP_LOAD(c0)
    for (int chunk = c0; chunk < 288; chunk += cstep) {
      const bool lat = chunk < 256;
      const int cs = lat ? (chunk & 31) : ((chunk - 256) & 3);
      const int r0 = chunk * 64;
      __syncthreads();
      *(uint4*)(T + rA * TS_ + 8 * cg) = pr0; *(uint4*)(T + (rA + 32) * TS_ + 8 * cg) = pr1;
      if (rA < 4) *(uint4*)(T + (rA + 64) * TS_ + 8 * cg) = pr2;
      __syncthreads();
      if (chunk + cstep < 288) PREP_LOAD(chunk + cstep)
#pragma unroll
      for (int it = 0; it < 2; ++it) {
        const int rr = rA + 32 * it;
        float v[8];
#pragma unroll
        for (int e = 0; e < 8; ++e) v[e] = bias[e];
#pragma unroll
        for (int j = 0; j < 5; ++j) {
          const uint4 x = *(const uint4*)(T + (rr + j) * TS_ + 8 * cg);
          v[0] += w5[j][0] * bflo(x.x); v[1] += w5[j][1] * bfhi(x.x); v[2] += w5[j][2] * bflo(x.y); v[3] += w5[j][3] * bfhi(x.y);
          v[4] += w5[j][4] * bflo(x.z); v[5] += w5[j][5] * bfhi(x.z); v[6] += w5[j][6] * bflo(x.w); v[7] += w5[j][7] * bfhi(x.w);
        }
#pragma unroll
        for (int e = 0; e < 8; ++e) v[e] = siluf(v[e]);
        if (typ < 2) {
          float ss = 0.f;
#pragma unroll
          for (int e = 0; e < 8; ++e) ss += v[e] * v[e];
          ss += __shfl_xor(ss, 1); ss += __shfl_xor(ss, 2); ss += __shfl_xor(ss, 4);
          const float rs = rsqrtf(ss + EPS) * (typ == 0 ? 0.125f : 1.f);
          if (lat) {
            const int pos = cg < 4 ? cs : rr;
            const float* rp = p.ROPE + (pos * 16 + 8 * (cg & 1)) * 2;
            const float4 q0 = *(const float4*)rp, q1 = *(const float4*)(rp + 4), q2 = *(const float4*)(rp + 8), q3 = *(const float4*)(rp + 12);
            const float cs8[8] = {q0.x, q0.z, q1.x, q1.z, q2.x, q2.z, q3.x, q3.z}, sn8[8] = {q0.y, q0.w, q1.y, q1.w, q2.y, q2.w, q3.y, q3.w};
#pragma unroll
            for (int e = 0; e < 8; ++e) {
              const float vp = __shfl_xor(v[e], 2);
              v[e] = v[e] * cs8[e] + ((cg & 2) ? vp : -vp) * sn8[e];
            }
          }
#pragma unroll
          for (int e = 0; e < 8; ++e) v[e] *= rs;
        }
        uint4 o; o.x = pack2(v[0], v[1]); o.y = pack2(v[2], v[3]); o.z = pack2(v[4], v[5]); o.w = pack2(v[6], v[7]);
        *(uint4*)(p.U + (size_t)(r0 + rr) * UW + ucol) = o;
      }
    }
#undef PREP_LOAD
#undef PREP_ROW
  }
}

constexpr int XS = 72;
constexpr int BS2 = 136;
constexpr int SSD_LDS = (3 * 64 * XS + 3 * 64 * BS2) * 2 + 2 * 64 * 4;
__device__ __forceinline__ void phase_ssd(PRef p, int layer, int task, char* smem) {
  const int tid = tidx(), lane = tid & 63, wave = tid >> 6, g = lane >> 4, l15 = lane & 15, q4 = l15 >> 2, p4 = lane & 3;
  bf16_t* Xt = (bf16_t*)smem;
  bf16_t* Xs = Xt + 64 * XS;
  bf16_t* Wg = Xs + 64 * XS;
  bf16_t* Bt = Wg + 64 * XS;
  bf16_t* Ct = Bt + 64 * BS2;
  bf16_t* Hb = Ct + 64 * BS2;
  float* dts = (float*)(Hb + 64 * BS2);
  float* lam = dts + 64;
  {
    const int head = task & 15, b = task >> 4, grp = head >> 3;
    f32x4 hst[2][8];
#pragma unroll
    for (int d = 0; d < 2; ++d)
#pragma unroll
      for (int n = 0; n < 8; ++n) hst[d][n] = (f32x4){0.f, 0.f, 0.f, 0.f};
    const float dsk = p.ssd_d[layer * 16 + head];
    const float an0 = -__expf(p.ssd_a_log[layer * 32 + head]), an1 = -__expf(p.ssd_a_log[layer * 32 + 16 + head]);
    uint4 px0, px1, pb0, pb1, pb2, pb3, pc0, pc1, pc2, pc3; float pdt = 0.f;
#define SSD_PREFETCH(IT, DIR) { \
      const int seg_ = (IT) >= 4, ci_ = seg_ ? (IT) - 4 : (IT), nch_ = seg_ ? 32 : 4; \
      const int base_ = seg_ ? b * 2048 : TL + b * 256; \
      const int c_ = (DIR) ? nch_ - 1 - ci_ : ci_; \
      const int i_ = tid >> 2, sub_ = tid & 3; \
      const int row_ = base_ + 64 * c_ + ((DIR) ? 63 - i_ : i_); \
      const bf16_t* ur_ = p.U + (size_t)row_ * UW; \
      const uint4* sx_ = (const uint4*)(ur_ + U_SX + 64 * head + 16 * sub_); px0 = sx_[0]; px1 = sx_[1]; \
      const uint4* sb_ = (const uint4*)(ur_ + U_SB + 128 * grp + 32 * sub_); pb0 = sb_[0]; pb1 = sb_[1]; pb2 = sb_[2]; pb3 = sb_[3]; \
      if (seg_ == 1 || layer == 0) { const uint4* sc_ = (const uint4*)(ur_ + U_SC + 128 * grp + 32 * sub_); pc0 = sc_[0]; pc1 = sc_[1]; pc2 = sc_[2]; pc3 = sc_[3]; } \
      if (sub_ == 0) pdt = p.S[(size_t)row_ * SWD + 32 + (DIR) * 16 + head]; }
    SSD_PREFETCH(0, 0)
    for (int it = 0; it < 36; ++it) {
      const int seg = it >= 4, ci = seg ? it - 4 : it, nch = seg ? 32 : 4;
      const int base = seg ? b * 2048 : TL + b * 256;
      const bool want_o = seg == 1 || layer == 0;
      const bool first = ci < nch / 2;
#pragma unroll
      for (int dir = 0; dir < 2; ++dir) {
        const int c = dir ? nch - 1 - ci : ci;
        const int r0 = base + 64 * c;
        __syncthreads();
        {
          const int i = tid >> 2, sub = tid & 3;
          *(uint4*)(Xt + i * XS + 16 * sub) = px0; *(uint4*)(Xt + i * XS + 16 * sub + 8) = px1;
          *(uint4*)(Bt + i * BS2 + 32 * sub) = pb0; *(uint4*)(Bt + i * BS2 + 32 * sub + 8) = pb1; *(uint4*)(Bt + i * BS2 + 32 * sub + 16) = pb2; *(uint4*)(Bt + i * BS2 + 32 * sub + 24) = pb3;
          if (want_o) { *(uint4*)(Ct + i * BS2 + 32 * sub) = pc0; *(uint4*)(Ct + i * BS2 + 32 * sub + 8) = pc1; *(uint4*)(Ct + i * BS2 + 32 * sub + 16) = pc2; *(uint4*)(Ct + i * BS2 + 32 * sub + 24) = pc3; }
          if (sub == 0) dts[i] = pdt;
        }
        if (dir == 0) SSD_PREFETCH(it, 1) else if (it + 1 < 36) SSD_PREFETCH(it + 1, 0)
        unsigned long long oldp[4] = {0ull, 0ull, 0ull, 0ull};
        if (want_o && !first) {
          const int irow_ = 16 * wave + l15;
          const int prow_ = r0 + (dir ? 63 - irow_ : irow_);
#pragma unroll
          for (int pt = 0; pt < 4; ++pt) oldp[pt] = __hip_atomic_load((unsigned long long*)(p.P + (size_t)prow_ * 1024 + 64 * head + 16 * pt + 4 * g), __ATOMIC_RELAXED, __HIP_MEMORY_SCOPE_AGENT);
        }
        if (want_o) {
#pragma unroll
          for (int nt = 0; nt < 8; ++nt) {
            uint2 o; o.x = pack2(hst[dir][nt][0], hst[dir][nt][1]); o.y = pack2(hst[dir][nt][2], hst[dir][nt][3]);
            *(uint2*)(Hb + (16 * wave + l15) * BS2 + 16 * nt + 4 * g) = o;
          }
        }
        __syncthreads();
        float lv = dts[lane] * (dir ? an1 : an0);
#pragma unroll
        for (int o = 1; o < 64; o <<= 1) { const float tv = __shfl_up(lv, o); if (lane >= o) lv += tv; }
        const float lam_last = __shfl(lv, 63);
        if (wave == 0) lam[lane] = lv;
        {
          const int j = tid >> 2, sub = tid & 3;
          const float lj = __shfl(lv, j & 63);
          const float sc = dts[j] * __expf(lam_last - lj);
          const uint4 a = *(const uint4*)(Xt + j * XS + 16 * sub), bq = *(const uint4*)(Xt + j * XS + 16 * sub + 8);
          uint4 oa, ob;
          oa.x = pack2(bflo(a.x) * sc, bfhi(a.x) * sc); oa.y = pack2(bflo(a.y) * sc, bfhi(a.y) * sc); oa.z = pack2(bflo(a.z) * sc, bfhi(a.z) * sc); oa.w = pack2(bflo(a.w) * sc, bfhi(a.w) * sc);
          ob.x = pack2(bflo(bq.x) * sc, bfhi(bq.x) * sc); ob.y = pack2(bflo(bq.y) * sc, bfhi(bq.y) * sc); ob.z = pack2(bflo(bq.z) * sc, bfhi(bq.z) * sc); ob.w = pack2(bflo(bq.w) * sc, bfhi(bq.w) * sc);
          *(uint4*)(Xs + j * XS + 16 * sub) = oa; *(uint4*)(Xs + j * XS + 16 * sub + 8) = ob;
        }
        __syncthreads();
        if (want_o) {
          const int irow = 16 * wave + l15;
          const float li = lam[irow];
#pragma unroll
          for (int jt = 0; jt < 4; ++jt) {
            f32x4 cacc = (f32x4){0.f, 0.f, 0.f, 0.f};
            if (jt <= wave) {
#pragma unroll
              for (int s2 = 0; s2 < 4; ++s2) {
                const bf16x8 af = *(const bf16x8*)(Ct + irow * BS2 + 32 * s2 + 8 * g);
                const bf16x8 bf = *(const bf16x8*)(Bt + (16 * jt + l15) * BS2 + 32 * s2 + 8 * g);
                cacc = __builtin_amdgcn_mfma_f32_16x16x32_bf16(bf, af, cacc, 0, 0, 0);
              }
            }
            const int j0 = 16 * jt + 4 * g;
            const float4 lj = *(const float4*)(lam + j0), dj = *(const float4*)(dts + j0);
            const float w0 = (j0 + 0 <= irow) ? cacc[0] * __expf(li - lj.x) * dj.x : 0.f;
            const float w1 = (j0 + 1 <= irow) ? cacc[1] * __expf(li - lj.y) * dj.y : 0.f;
            const float w2 = (j0 + 2 <= irow) ? cacc[2] * __expf(li - lj.z) * dj.z : 0.f;
            const float w3 = (j0 + 3 <= irow) ? cacc[3] * __expf(li - lj.w) * dj.w : 0.f;
            uint2 o; o.x = pack2(w0, w1); o.y = pack2(w2, w3);
            *(uint2*)(Wg + irow * XS + j0) = o;
          }
        }
        wave_lds_sync();
        if (want_o) {
          const int irow = 16 * wave + l15;
          f32x4 ai[4], ae[4];
#pragma unroll
          for (int pt = 0; pt < 4; ++pt) { ai[pt] = (f32x4){0.f, 0.f, 0.f, 0.f}; ae[pt] = (f32x4){0.f, 0.f, 0.f, 0.f}; }
#pragma unroll
          for (int s2 = 0; s2 < 2; ++s2) {
            const bf16x8 af = *(const bf16x8*)(Wg + irow * XS + 32 * s2 + 8 * g);
#pragma unroll
            for (int pt = 0; pt < 4; ++pt) {
              const bf16x8 bf = cat8(tr16(Xt + (32 * s2 + 8 * g + q4) * XS + 16 * pt + 4 * p4), tr16(Xt + (32 * s2 + 8 * g + 4 + q4) * XS + 16 * pt + 4 * p4));
              ai[pt] = __builtin_amdgcn_mfma_f32_16x16x32_bf16(bf, af, ai[pt], 0, 0, 0);
            }
          }
#pragma unroll
          for (int s2 = 0; s2 < 4; ++s2) {
            const bf16x8 af = *(const bf16x8*)(Ct + irow * BS2 + 32 * s2 + 8 * g);
#pragma unroll
            for (int pt = 0; pt < 4; ++pt) {
              const bf16x8 bf = *(const bf16x8*)(Hb + (16 * pt + l15) * BS2 + 32 * s2 + 8 * g);
              ae[pt] = __builtin_amdgcn_mfma_f32_16x16x32_bf16(bf, af, ae[pt], 0, 0, 0);
            }
          }
          const float el = __expf(lam[irow]);
          const int row = r0 + (dir ? 63 - irow : irow);
#pragma unroll
          for (int pt = 0; pt < 4; ++pt) {
            float y0 = ai[pt][0] + el * ae[pt][0], y1 = ai[pt][1] + el * ae[pt][1], y2 = ai[pt][2] + el * ae[pt][2], y3 = ai[pt][3] + el * ae[pt][3];
            if (dir == 0) {
              const uint2 xv = *(const uint2*)(Xt + irow * XS + 16 * pt + 4 * g);
              y0 += dsk * bflo(xv.x); y1 += dsk * bfhi(xv.x); y2 += dsk * bflo(xv.y); y3 += dsk * bfhi(xv.y);
            }
            unsigned long long* dst = (unsigned long long*)(p.P + (size_t)row * 1024 + 64 * head + 16 * pt + 4 * g);
            if (!first) {
              const unsigned long long old = oldp[pt];
              const unsigned lo = (unsigned)old, hi = (unsigned)(old >> 32);
              y0 += bflo(lo); y1 += bfhi(lo); y2 += bflo(hi); y3 += bfhi(hi);
            }
            *dst = (unsigned long long)pack2(y0, y1) | ((unsigned long long)pack2(y2, y3) << 32);
          }
        }
        {
          const float el = __expf(lam_last);
#pragma unroll
          for (int nt = 0; nt < 8; ++nt) hst[dir][nt] *= el;
#pragma unroll
          for (int s2 = 0; s2 < 2; ++s2) {
            const bf16x8 mf = cat8(tr16(Xs + (32 * s2 + 8 * g + q4) * XS + 16 * wave + 4 * p4), tr16(Xs + (32 * s2 + 8 * g + 4 + q4) * XS + 16 * wave + 4 * p4));
#pragma unroll
            for (int nt = 0; nt < 8; ++nt) {
              const bf16x8 nf = cat8(tr16(Bt + (32 * s2 + 8 * g + q4) * BS2 + 16 * nt + 4 * p4), tr16(Bt + (32 * s2 + 8 * g + 4 + q4) * BS2 + 16 * nt + 4 * p4));
              hst[dir][nt] = __builtin_amdgcn_mfma_f32_16x16x32_bf16(nf, mf, hst[dir][nt], 0, 0, 0);
            }
          }
        }
      }
    }
  }
}


#undef SSD_PREFETCH
constexpr int GT = 64 * XS;
constexpr int GDN_LDS = 8 * GT * 2 + 4 * 256 * 4 + 4 * 16 * 24 * 2 + 2 * 64 * 4;
__device__ __forceinline__ void phase_gdn(PRef p, int layer, int task, char* smem) {
  const int tid = tidx(), lane = tid & 63, wave = tid >> 6, g = lane >> 4, l15 = lane & 15, q4 = l15 >> 2, p4 = lane & 3;
  bf16_t* Qt = (bf16_t*)smem;
  bf16_t* Kt = Qt + GT;
  bf16_t* Vt = Kt + GT;
  bf16_t* Am = Vt + GT;
  bf16_t* Mq = Am + GT;
  bf16_t* Xw = Mq + GT;
  bf16_t* Xu = Xw + GT;
  bf16_t* St = Xu + GT;
  bf16_t* Qg = Qt; bf16_t* Vn = Vt; bf16_t* Vs = Am;
  float* Adiag = (float*)(St + GT);
  bf16_t* Db = (bf16_t*)(Adiag + 4 * 256);
  float* bet = (float*)(Db + 4 * 16 * 24);
  float* gam = bet + 64;
  const bf16x8 zero8 = (bf16x8){0, 0, 0, 0, 0, 0, 0, 0};
  {
    const int dir = task & 1, h = (task >> 1) & 7, b = task >> 4;
    bf16_t* Og = layer == 0 ? p.OG0 + (size_t)dir * TT * 512 : p.OG1 + (size_t)dir * TL * 512;
    f32x4 sst[4];
#pragma unroll
    for (int e = 0; e < 4; ++e) sst[e] = (f32x4){0.f, 0.f, 0.f, 0.f};
    __syncthreads();
    for (int i = tid; i < 64 * XS / 2; i += 256) { ((unsigned*)St)[i] = 0u; ((unsigned*)Xw)[i] = 0u; ((unsigned*)Xu)[i] = 0u; }
    uint4 pq0, pq1, pk0, pk1, pv0, pv1; float pbeta = 0.f, pgam = 0.f;
#define GDN_PREFETCH(IT) { \
      const int seg_ = (IT) >= 4, ci_ = seg_ ? (IT) - 4 : (IT), nch_ = seg_ ? 32 : 4; \
      const int base_ = seg_ ? b * 2048 : TL + b * 256; \
      const int c_ = dir ? nch_ - 1 - ci_ : ci_; \
      const int i_ = tid >> 2, sub_ = tid & 3; \
      const int row_ = base_ + 64 * c_ + (dir ? 63 - i_ : i_); \
      const bf16_t* ur_ = p.U + (size_t)row_ * UW + 64 * h + 16 * sub_; \
      pq0 = *(const uint4*)(ur_ + U_DNQ); pq1 = *(const uint4*)(ur_ + U_DNQ + 8); \
      pk0 = *(const uint4*)(ur_ + U_DNK); pk1 = *(const uint4*)(ur_ + U_DNK + 8); \
      pv0 = *(const uint4*)(ur_ + U_DNV); pv1 = *(const uint4*)(ur_ + U_DNV + 8); \
      if (sub_ == 0) { pbeta = p.S[(size_t)row_ * SWD + dir * 8 + h]; pgam = p.S[(size_t)row_ * SWD + 16 + dir * 8 + h]; } }
    GDN_PREFETCH(0)
    for (int it = 0; it < 36; ++it) {
      const int seg = it >= 4, ci = seg ? it - 4 : it, nch = seg ? 32 : 4;
      const int base = seg ? b * 2048 : TL + b * 256;
      const bool want_o = seg == 1 || layer == 0;
      const int c = dir ? nch - 1 - ci : ci;
      const int r0 = base + 64 * c;
      __syncthreads();
      {
        const int i = tid >> 2, sub = tid & 3;
        *(uint4*)(Qt + i * XS + 16 * sub) = pq0; *(uint4*)(Qt + i * XS + 16 * sub + 8) = pq1;
        *(uint4*)(Kt + i * XS + 16 * sub) = pk0; *(uint4*)(Kt + i * XS + 16 * sub + 8) = pk1;
        *(uint4*)(Vt + i * XS + 16 * sub) = pv0; *(uint4*)(Vt + i * XS + 16 * sub + 8) = pv1;
        if (sub == 0) { bet[i] = pbeta; gam[i] = pgam; }
      }
      if (it + 1 < 36) GDN_PREFETCH(it + 1)
      __syncthreads();
      float lv = gam[lane];
#pragma unroll
      for (int o = 1; o < 64; o <<= 1) { const float tv = __shfl_up(lv, o); if (lane >= o) lv += tv; }
      const float gam_last = __shfl(lv, 63);
      __syncthreads();
      if (wave == 0) gam[lane] = lv;
      __syncthreads();
      {
        const int irow = 16 * wave + l15;
        const float gi = gam[irow], bi = bet[irow];
#pragma unroll
        for (int jt = 0; jt < 4; ++jt) {
          f32x4 kk = (f32x4){0.f, 0.f, 0.f, 0.f}, qk = (f32x4){0.f, 0.f, 0.f, 0.f};
          if (jt <= wave) {
#pragma unroll
            for (int s2 = 0; s2 < 2; ++s2) {
              const bf16x8 nf = *(const bf16x8*)(Kt + (16 * jt + l15) * XS + 32 * s2 + 8 * g);
              const bf16x8 mk = *(const bf16x8*)(Kt + irow * XS + 32 * s2 + 8 * g);
              const bf16x8 mq = *(const bf16x8*)(Qt + irow * XS + 32 * s2 + 8 * g);
              kk = __builtin_amdgcn_mfma_f32_16x16x32_bf16(nf, mk, kk, 0, 0, 0);
              qk = __builtin_amdgcn_mfma_f32_16x16x32_bf16(nf, mq, qk, 0, 0, 0);
            }
          }
          const int j0 = 16 * jt + 4 * g;
          const float4 gj = *(const float4*)(gam + j0);
          const float gjv[4] = {gj.x, gj.y, gj.z, gj.w};
          float av[4], mv[4];
#pragma unroll
          for (int r = 0; r < 4; ++r) {
            const int j = j0 + r;
            const float dec = j <= irow ? __expf(gi - gjv[r]) : 0.f;
            av[r] = j < irow ? bi * kk[r] * dec : 0.f;
            mv[r] = qk[r] * dec;
          }
          uint2 oa; oa.x = pack2(av[0], av[1]); oa.y = pack2(av[2], av[3]);
          uint2 om; om.x = pack2(mv[0], mv[1]); om.y = pack2(mv[2], mv[3]);
          *(uint2*)(Am + irow * XS + j0) = oa;
          *(uint2*)(Mq + irow * XS + j0) = om;
          if (jt == wave) *(f32x4*)(Adiag + wave * 256 + l15 * 16 + 4 * g) = (f32x4){av[0], av[1], av[2], av[3]};
        }
      }
      __syncthreads();
      {
        const int j = tid >> 2, sub = tid & 3;
        const float sc = __expf(gam[j]);
        const uint4 a = *(const uint4*)(Qt + j * XS + 16 * sub), bq = *(const uint4*)(Qt + j * XS + 16 * sub + 8);
        uint4 oa, ob;
        oa.x = pack2(bflo(a.x) * sc, bfhi(a.x) * sc); oa.y = pack2(bflo(a.y) * sc, bfhi(a.y) * sc); oa.z = pack2(bflo(a.z) * sc, bfhi(a.z) * sc); oa.w = pack2(bflo(a.w) * sc, bfhi(a.w) * sc);
        ob.x = pack2(bflo(bq.x) * sc, bfhi(bq.x) * sc); ob.y = pack2(bflo(bq.y) * sc, bfhi(bq.y) * sc); ob.z = pack2(bflo(bq.z) * sc, bfhi(bq.z) * sc); ob.w = pack2(bflo(bq.w) * sc, bfhi(bq.w) * sc);
        *(uint4*)(Qg + j * XS + 16 * sub) = oa; *(uint4*)(Qg + j * XS + 16 * sub + 8) = ob;
      }
      {
        const int cc = lane & 15;
        const float* Ad = Adiag + wave * 256;
        float dcol[16];
#pragma unroll
        for (int r = 0; r < 16; ++r) {
          float sacc = (r == cc) ? 1.f : 0.f;
#pragma unroll
          for (int j = 0; j < r; ++j) sacc -= Ad[r * 16 + j] * dcol[j];
          dcol[r] = sacc;
        }
        if (lane < 16) {
#pragma unroll
          for (int r = 0; r < 16; ++r) Db[(wave * 16 + r) * 24 + cc] = f2bf(dcol[r]);
        }
      }
      __syncthreads();
      {
        const bool isW = wave < 2;
        bf16_t* Xd = isW ? Xw : Xu;
        const bf16_t* Src = isW ? Kt : Vt;
        const int fbase = (wave & 1) * 32;
#pragma unroll
        for (int ib = 0; ib < 4; ++ib) {
          const int irow = 16 * ib + l15;
          const float sc = isW ? bet[irow] * __expf(gam[irow]) : bet[irow];
          f32x4 y[2];
#pragma unroll
          for (int fi = 0; fi < 2; ++fi) {
            const int f0 = fbase + 16 * fi;
            const uint2 rv = *(const uint2*)(Src + irow * XS + f0 + 4 * g);
            f32x4 tmp = (f32x4){0.f, 0.f, 0.f, 0.f};
#pragma unroll
            for (int s2 = 0; s2 < 2; ++s2) {
              if (32 * s2 < 16 * ib) {
                const bool half = (32 * s2 + 32) > 16 * ib;
                bf16x8 mf = *(const bf16x8*)(Am + irow * XS + 32 * s2 + 8 * g);
                if (half && g >= 2) mf = zero8;
                const bf16x8 nf = cat8(tr16(Xd + (32 * s2 + 8 * g + q4) * XS + f0 + 4 * p4), tr16(Xd + (32 * s2 + 8 * g + 4 + q4) * XS + f0 + 4 * p4));
                tmp = __builtin_amdgcn_mfma_f32_16x16x32_bf16(nf, mf, tmp, 0, 0, 0);
              }
            }
            y[fi] = (f32x4){bflo(rv.x) * sc - tmp[0], bfhi(rv.x) * sc - tmp[1], bflo(rv.y) * sc - tmp[2], bfhi(rv.y) * sc - tmp[3]};
          }
          wave_lds_sync();
#pragma unroll
          for (int fi = 0; fi < 2; ++fi) {
            uint2 o; o.x = pack2(y[fi][0], y[fi][1]); o.y = pack2(y[fi][2], y[fi][3]);
            *(uint2*)(Xd + irow * XS + fbase + 16 * fi + 4 * g) = o;
          }
          wave_lds_sync();
          bf16x8 dm = zero8;
          if (g < 2) dm = *(const bf16x8*)(Db + (ib * 16 + l15) * 24 + 8 * g);
#pragma unroll
          for (int fi = 0; fi < 2; ++fi) {
            const int f0 = fbase + 16 * fi;
            const bf16x8 nf = cat8(tr16(Xd + (16 * ib + 8 * (g & 1) + q4) * XS + f0 + 4 * p4), tr16(Xd + (16 * ib + 8 * (g & 1) + 4 + q4) * XS + f0 + 4 * p4));
            y[fi] = __builtin_amdgcn_mfma_f32_16x16x32_bf16(nf, dm, (f32x4){0.f, 0.f, 0.f, 0.f}, 0, 0, 0);
          }
          wave_lds_sync();
#pragma unroll
          for (int fi = 0; fi < 2; ++fi) {
            uint2 o; o.x = pack2(y[fi][0], y[fi][1]); o.y = pack2(y[fi][2], y[fi][3]);
            *(uint2*)(Xd + irow * XS + fbase + 16 * fi + 4 * g) = o;
          }
          wave_lds_sync();
        }
      }
      __syncthreads();
      {
        const int irow = 16 * wave + l15;
        const float dl = __expf(gam_last - gam[irow]);
        f32x4 acc[4];
#pragma unroll
        for (int et = 0; et < 4; ++et) acc[et] = (f32x4){0.f, 0.f, 0.f, 0.f};
#pragma unroll
        for (int s2 = 0; s2 < 2; ++s2) {
          const bf16x8 mf = *(const bf16x8*)(Xw + irow * XS + 32 * s2 + 8 * g);
#pragma unroll
          for (int et = 0; et < 4; ++et) {
            const bf16x8 nf = *(const bf16x8*)(St + (16 * et + l15) * XS + 32 * s2 + 8 * g);
            acc[et] = __builtin_amdgcn_mfma_f32_16x16x32_bf16(nf, mf, acc[et], 0, 0, 0);
          }
        }
#pragma unroll
        for (int et = 0; et < 4; ++et) {
          const uint2 uv = *(const uint2*)(Xu + irow * XS + 16 * et + 4 * g);
          const float v0 = bflo(uv.x) - acc[et][0], v1 = bfhi(uv.x) - acc[et][1], v2 = bflo(uv.y) - acc[et][2], v3 = bfhi(uv.y) - acc[et][3];
          uint2 o; o.x = pack2(v0, v1); o.y = pack2(v2, v3);
          *(uint2*)(Vn + irow * XS + 16 * et + 4 * g) = o;
          o.x = pack2(v0 * dl, v1 * dl); o.y = pack2(v2 * dl, v3 * dl);
          *(uint2*)(Vs + irow * XS + 16 * et + 4 * g) = o;
        }
      }
      __syncthreads();
      if (want_o) {
        const int irow = 16 * wave + l15;
        f32x4 acc[4];
#pragma unroll
        for (int et = 0; et < 4; ++et) acc[et] = (f32x4){0.f, 0.f, 0.f, 0.f};
#pragma unroll
        for (int s2 = 0; s2 < 2; ++s2) {
          const bf16x8 mf = *(const bf16x8*)(Qg + irow * XS + 32 * s2 + 8 * g);
          const bf16x8 mf2 = *(const bf16x8*)(Mq + irow * XS + 32 * s2 + 8 * g);
#pragma unroll
          for (int et = 0; et < 4; ++et) {
            const bf16x8 nf = *(const bf16x8*)(St + (16 * et + l15) * XS + 32 * s2 + 8 * g);
            acc[et] = __builtin_amdgcn_mfma_f32_16x16x32_bf16(nf, mf, acc[et], 0, 0, 0);
            const bf16x8 nf2 = cat8(tr16(Vn + (32 * s2 + 8 * g + q4) * XS + 16 * et + 4 * p4), tr16(Vn + (32 * s2 + 8 * g + 4 + q4) * XS + 16 * et + 4 * p4));
            acc[et] = __builtin_amdgcn_mfma_f32_16x16x32_bf16(nf2, mf2, acc[et], 0, 0, 0);
          }
        }
        const int row = r0 + (dir ? 63 - irow : irow);
#pragma unroll
        for (int et = 0; et < 4; ++et) {
          uint2 o; o.x = pack2(acc[et][0], acc[et][1]); o.y = pack2(acc[et][2], acc[et][3]);
          *(uint2*)(Og + (size_t)row * 512 + 64 * h + 16 * et + 4 * g) = o;
        }
      }
      {
        const float el = __expf(gam_last);
#pragma unroll
        for (int et = 0; et < 4; ++et) sst[et] *= el;
#pragma unroll
        for (int s2 = 0; s2 < 2; ++s2) {
          const bf16x8 nf = cat8(tr16(Kt + (32 * s2 + 8 * g + q4) * XS + 16 * wave + 4 * p4), tr16(Kt + (32 * s2 + 8 * g + 4 + q4) * XS + 16 * wave + 4 * p4));
#pragma unroll
          for (int et = 0; et < 4; ++et) {
            const bf16x8 mf = cat8(tr16(Vs + (32 * s2 + 8 * g + q4) * XS + 16 * et + 4 * p4), tr16(Vs + (32 * s2 + 8 * g + 4 + q4) * XS + 16 * et + 4 * p4));
            sst[et] = __builtin_amdgcn_mfma_f32_16x16x32_bf16(nf, mf, sst[et], 0, 0, 0);
          }
        }
      }
      __syncthreads();
#pragma unroll
      for (int et = 0; et < 4; ++et) {
        uint2 o; o.x = pack2(sst[et][0], sst[et][1]); o.y = pack2(sst[et][2], sst[et][3]);
        *(uint2*)(St + (16 * et + l15) * XS + 16 * wave + 4 * g) = o;
      }
    }
  }
}


#undef GDN_PREFETCH
constexpr int NA_VS = 72;
constexpr int NA_LDS_WAVE = 2 * 32 * NA_VS * 2;
__device__ __forceinline__ void phase_na(PRef p, int layer, unsigned* ctr, char* smem) {
  const int lane = tidx() & 63, wave = tidx() >> 6, g = lane >> 4, l15 = lane & 15, q4 = l15 >> 2, p4 = lane & 3;
  bf16_t* Vl = (bf16_t*)(smem + wave * NA_LDS_WAVE);
  const int ntask = layer == 0 ? 8192 + 1024 : 8192;
  const float* rpb = p.na_rpb + (size_t)layer * 8 * 15 * 31;
  for (;;) {
    int w0 = 0;
    if (lane == 0) w0 = (int)atomicAdd(ctr, 1u);
    const int task = __builtin_amdgcn_readfirstlane(__shfl(w0, 0));
    if (task >= ntask) break;
    const bool lat = task < 8192;
    int b, h, r = 0, cb = 0, qtok0, R0 = 0, C0 = 0;
    if (lat) { cb = task & 3; r = (task >> 2) & 31; h = (task >> 7) & 7; b = task >> 10; qtok0 = b * 2048 + r * 64 + 16 * cb; R0 = min(max(r - 4, 0), 24); C0 = min(max(16 * cb - 8, 0), 32); }
    else { const int t2 = task - 8192; const int qb = t2 & 15; h = (t2 >> 4) & 7; b = t2 >> 7; qtok0 = TL + b * 256 + 16 * qb; }
    const int tau0 = lat ? 0 : 16;
    const int wtok0 = b * 2048 + R0 * 64 + C0, ctok0 = TL + b * 256;
#define tile_tok(tau) ((tau) < 16 ? wtok0 + ((tau) >> 1) * 64 + 16 * ((tau) & 1) : ctok0 + 16 * ((tau) - 16))
    const bf16_t* qp = p.U + (size_t)(qtok0 + l15) * UW + U_NAQ + 64 * h + 8 * g;
    const bf16x8 qf0 = *(const bf16x8*)qp, qf1 = *(const bf16x8*)(qp + 32);
    f32x4 sc[32];
#pragma unroll
    for (int tau = 0; tau < 32; ++tau) {
      sc[tau] = (f32x4){-INFINITY, -INFINITY, -INFINITY, -INFINITY};
      if (tau >= tau0) {
        const bf16_t* kp = p.U + (size_t)(tile_tok(tau) + l15) * UW + U_NAK + 64 * h + 8 * g;
        const bf16x8 kf0 = *(const bf16x8*)kp, kf1 = *(const bf16x8*)(kp + 32);
        f32x4 a = (f32x4){0.f, 0.f, 0.f, 0.f};
        a = __builtin_amdgcn_mfma_f32_16x16x32_bf16(kf0, qf0, a, 0, 0, 0);
        a = __builtin_amdgcn_mfma_f32_16x16x32_bf16(kf1, qf1, a, 0, 0, 0);
        if (tau < 16) {
          const int qcol = 16 * cb + l15, ws = min(max(qcol - 8, 0), 48);
          const int dr = R0 + (tau >> 1) - r + 7;
#pragma unroll
          for (int rg = 0; rg < 4; ++rg) {
            const int kcol = C0 + 16 * (tau & 1) + 4 * g + rg;
            const bool ok = kcol >= ws && kcol < ws + 16;
            const float bias = ok ? rpb[(h * 15 + dr) * 31 + (kcol - qcol + 15)] : 0.f;
            a[rg] = ok ? a[rg] + bias : -INFINITY;
          }
        }
        sc[tau] = a;
      }
    }
    float mx = -INFINITY;
#pragma unroll
    for (int tau = 0; tau < 32; ++tau) mx = fmaxf(mx, fmaxf(fmaxf(sc[tau][0], sc[tau][1]), fmaxf(sc[tau][2], sc[tau][3])));
    mx = fmaxf(mx, __shfl_xor(mx, 16)); mx = fmaxf(mx, __shfl_xor(mx, 32));
    float sum = 0.f;
#pragma unroll
    for (int tau = 0; tau < 32; ++tau) {
#pragma unroll
      for (int rg = 0; rg < 4; ++rg) { const float e = __expf(sc[tau][rg] - mx); sc[tau][rg] = e; sum += e; }
    }
    sum += __shfl_xor(sum, 16); sum += __shfl_xor(sum, 32);
    f32x4 oacc[4];
#pragma unroll
    for (int dt = 0; dt < 4; ++dt) oacc[dt] = (f32x4){0.f, 0.f, 0.f, 0.f};
    const int kap0 = tau0 >> 1;
    uint4 vr0, vr1, vr2, vr3;
#define NA_VLOAD(KAP) { \
      const int kk0_ = lane >> 3, cc_ = lane & 7; \
      const bf16_t* vb_ = p.U + U_NAV + 64 * h + 8 * cc_; \
      vr0 = *(const uint4*)(vb_ + (size_t)(tile_tok(2 * (KAP)) + kk0_) * UW); \
      vr1 = *(const uint4*)(vb_ + (size_t)(tile_tok(2 * (KAP)) + kk0_ + 8) * UW); \
      vr2 = *(const uint4*)(vb_ + (size_t)(tile_tok(2 * (KAP) + 1) + kk0_) * UW); \
      vr3 = *(const uint4*)(vb_ + (size_t)(tile_tok(2 * (KAP) + 1) + kk0_ + 8) * UW); }
    NA_VLOAD(kap0)
#pragma unroll
    for (int kap = 0; kap < 16; ++kap) {
      if (kap >= kap0) {
        bf16_t* Vb = Vl + (kap & 1) * 32 * NA_VS;
        {
          const int kk0_ = lane >> 3, cc_ = lane & 7;
          *(uint4*)(Vb + kk0_ * NA_VS + 8 * cc_) = vr0; *(uint4*)(Vb + (kk0_ + 8) * NA_VS + 8 * cc_) = vr1;
          *(uint4*)(Vb + (kk0_ + 16) * NA_VS + 8 * cc_) = vr2; *(uint4*)(Vb + (kk0_ + 24) * NA_VS + 8 * cc_) = vr3;
        }
        if (kap + 1 < 16) NA_VLOAD(kap + 1)
        __builtin_amdgcn_fence(__ATOMIC_RELEASE, "workgroup"); __builtin_amdgcn_wave_barrier(); __builtin_amdgcn_fence(__ATOMIC_ACQUIRE, "workgroup");
        bf16x8 pf;
        {
          const unsigned w0_ = pack2(sc[2 * kap][0], sc[2 * kap][1]), w1_ = pack2(sc[2 * kap][2], sc[2 * kap][3]);
          const unsigned w2_ = pack2(sc[2 * kap + 1][0], sc[2 * kap + 1][1]), w3_ = pack2(sc[2 * kap + 1][2], sc[2 * kap + 1][3]);
          pf = (bf16x8){(short)(w0_ & 0xffff), (short)(w0_ >> 16), (short)(w1_ & 0xffff), (short)(w1_ >> 16), (short)(w2_ & 0xffff), (short)(w2_ >> 16), (short)(w3_ & 0xffff), (short)(w3_ >> 16)};
        }
#pragma unroll
        for (int dt = 0; dt < 4; ++dt) {
          const bf16x8 vf = cat8(tr16(Vb + (4 * g + q4) * NA_VS + 16 * dt + 4 * p4), tr16(Vb + (16 + 4 * g + q4) * NA_VS + 16 * dt + 4 * p4));
          oacc[dt] = __builtin_amdgcn_mfma_f32_16x16x32_bf16(vf, pf, oacc[dt], 0, 0, 0);
        }
      }
    }
#undef NA_VLOAD
#undef tile_tok
    const float inv = 1.f / sum;
    bf16_t* op = p.U + (size_t)(qtok0 + l15) * UW + U_YA + 64 * h + 4 * g;
#pragma unroll
    for (int dt = 0; dt < 4; ++dt) {
      uint2 o; o.x = pack2(oacc[dt][0] * inv, oacc[dt][1] * inv); o.y = pack2(oacc[dt][2] * inv, oacc[dt][3] * inv);
      *(uint2*)(op + 16 * dt) = o;
    }
  }
}

__device__ __forceinline__ void norm_row(const float* xr, float rs, const float* alpha, const float* shift, bf16_t* hrow, int lane) {
#pragma unroll
  for (int i = 0; i < 4; ++i) {
    const int k = lane * 4 + 256 * i;
    const float4 v = *(const float4*)(xr + k), a = *(const float4*)(alpha + k), s = *(const float4*)(shift + k);
    uint2 o; o.x = pack2(v.x * rs * a.x + s.x, v.y * rs * a.y + s.y); o.y = pack2(v.z * rs * a.z + s.z, v.w * rs * a.w + s.w);
    *(uint2*)(hrow + k) = o;
  }
}
constexpr int TKW = 2;
__device__ __forceinline__ void phase_fin(PRef p, int layer, int bid, int nb) {
  {
    bf16_t* uw = p.U + U_W;
#pragma unroll 1
    for (int i = 0; i < 3; ++i) wconv(p.w_in + (size_t)layer * 1024 * DIN, DIN, 6208 + 1024 * i, false, uw + (size_t)(UWR_G + 1024 * i) * UW, UW, 1024, 1024, bid, nb);
    wconv(p.w_pa + (size_t)layer * 512 * 1024, 1024, 0, false, uw + (size_t)UWR_PA * UW, UW, 512, 1024, bid, nb);
    wconv(p.w_pb + (size_t)layer * 512 * 1024, 1024, 0, false, uw + (size_t)UWR_PB * UW, UW, 512, 1024, bid, nb);
    wconv(p.w_pc + (size_t)layer * 1024 * 1024, 1024, 0, false, uw + (size_t)UWR_PC * UW, UW, 1024, 1024, bid, nb);
    wconv(p.w_out + (size_t)layer * 1024 * 1024, 1024, 0, false, uw + (size_t)UWR_OUT * UW, UW, 1024, 1024, bid, nb);
  }
  const int lane = tidx() & 63, wave = tidx() >> 6;
  const int ntok = layer == 0 ? TT : TL;
  const bf16_t* ogf = layer == 0 ? p.OG0 : p.OG1;
  const bf16_t* ogb = ogf + (size_t)(layer == 0 ? TT : TL) * 512;
  const float* gnd = p.dn_o_gain + layer * 64 + 8 * (lane & 7);
  const float* gns = p.ssd_o_gain + layer * 1024 + 16 * lane;
  const float* xlat = layer == 0 ? p.x : p.out;
  const float* xctx = layer == 0 ? p.ctx : p.XC;
  for (int tok0 = (bid * 4 + wave) * TKW; tok0 < ntok; tok0 += nb * 4 * TKW) {
    uint4 a[TKW], bq[TKW], zd[TKW], pa[TKW][2], zs[TKW][2];
    float4 xv[TKW][4];
#pragma unroll
    for (int j = 0; j < TKW; ++j)
#pragma unroll
      for (int i = 0; i < 4; ++i) xv[j][i] = *(const float4*)((tok0 < TL ? xlat + (size_t)(tok0 + j) * DM : xctx + (size_t)(tok0 + j - TL) * DM) + lane * 4 + 256 * i);
#pragma unroll
    for (int j = 0; j < TKW; ++j) {
      const int tok = tok0 + j;
      const bf16_t* ur = p.U + (size_t)tok * UW;
      a[j] = *(const uint4*)(ogf + (size_t)tok * 512 + 8 * lane); bq[j] = *(const uint4*)(ogb + (size_t)tok * 512 + 8 * lane); zd[j] = *(const uint4*)(ur + U_DNZ + 8 * lane);
      pa[j][0] = *(const uint4*)(p.P + (size_t)tok * 1024 + 16 * lane); pa[j][1] = *(const uint4*)(p.P + (size_t)tok * 1024 + 16 * lane + 8);
      zs[j][0] = *(const uint4*)(ur + U_SZ + 16 * lane); zs[j][1] = *(const uint4*)(ur + U_SZ + 16 * lane + 8);
    }
#pragma unroll
    for (int j = 0; j < TKW; ++j) {
      bf16_t* ur = p.U + (size_t)(tok0 + j) * UW;
      {
        float o[8] = {bflo(a[j].x) + bflo(bq[j].x), bfhi(a[j].x) + bfhi(bq[j].x), bflo(a[j].y) + bflo(bq[j].y), bfhi(a[j].y) + bfhi(bq[j].y),
                      bflo(a[j].z) + bflo(bq[j].z), bfhi(a[j].z) + bfhi(bq[j].z), bflo(a[j].w) + bflo(bq[j].w), bfhi(a[j].w) + bfhi(bq[j].w)};
        const float zz[8] = {bflo(zd[j].x), bfhi(zd[j].x), bflo(zd[j].y), bfhi(zd[j].y), bflo(zd[j].z), bfhi(zd[j].z), bflo(zd[j].w), bfhi(zd[j].w)};
        float ss = 0.f;
#pragma unroll
        for (int i = 0; i < 8; ++i) ss += o[i] * o[i];
        ss += __shfl_xor(ss, 1); ss += __shfl_xor(ss, 2); ss += __shfl_xor(ss, 4);
        const float rs = rsqrtf(ss * (1.f / 64.f) + EPS);
#pragma unroll
        for (int i = 0; i < 8; ++i) o[i] = o[i] * rs * gnd[i] * siluf(zz[i]);
        uint4 w; w.x = pack2(o[0], o[1]); w.y = pack2(o[2], o[3]); w.z = pack2(o[4], o[5]); w.w = pack2(o[6], o[7]);
        *(uint4*)(ur + U_YB + 8 * lane) = w;
      }
      {
        float yv[16];
        float ss = 0.f;
#pragma unroll
        for (int hf = 0; hf < 2; ++hf) {
          const uint4 av4 = pa[j][hf], z = zs[j][hf];
          const float av[8] = {bflo(av4.x), bfhi(av4.x), bflo(av4.y), bfhi(av4.y), bflo(av4.z), bfhi(av4.z), bflo(av4.w), bfhi(av4.w)};
          const float zz[8] = {bflo(z.x), bfhi(z.x), bflo(z.y), bfhi(z.y), bflo(z.z), bfhi(z.z), bflo(z.w), bfhi(z.w)};
#pragma unroll
          for (int i = 0; i < 8; ++i) { const float v = av[i] * siluf(zz[i]); yv[8 * hf + i] = v; ss += v * v; }
        }
        ss += __shfl_xor(ss, 1); ss += __shfl_xor(ss, 2); ss += __shfl_xor(ss, 4); ss += __shfl_xor(ss, 8); ss += __shfl_xor(ss, 16);
        const float rs = rsqrtf(ss * (1.f / 512.f) + EPS);
#pragma unroll
        for (int hf = 0; hf < 2; ++hf) {
          uint4 w;
          w.x = pack2(yv[8 * hf + 0] * rs * gns[8 * hf + 0], yv[8 * hf + 1] * rs * gns[8 * hf + 1]);
          w.y = pack2(yv[8 * hf + 2] * rs * gns[8 * hf + 2], yv[8 * hf + 3] * rs * gns[8 * hf + 3]);
          w.z = pack2(yv[8 * hf + 4] * rs * gns[8 * hf + 4], yv[8 * hf + 5] * rs * gns[8 * hf + 5]);
          w.w = pack2(yv[8 * hf + 6] * rs * gns[8 * hf + 6], yv[8 * hf + 7] * rs * gns[8 * hf + 7]);
          *(uint4*)(ur + U_YC + 16 * lane + 8 * hf) = w;
        }
      }
    }
    {
      __builtin_amdgcn_s_waitcnt(0x0F70);
      const float* mr = p.MOD + (size_t)layer * 9 * 6144 + modrow(tok0) * 6144;
      float rs[TKW];
#pragma unroll
      for (int j = 0; j < TKW; ++j) {
        float ssq = 0.f;
#pragma unroll
        for (int i = 0; i < 4; ++i) ssq += xv[j][i].x * xv[j][i].x + xv[j][i].y * xv[j][i].y + xv[j][i].z * xv[j][i].z + xv[j][i].w * xv[j][i].w;
        rs[j] = rsqrtf(wave_sum(ssq) * (1.f / DM) + EPS);
      }
#pragma unroll
      for (int i = 0; i < 4; ++i) {
        const int k = lane * 4 + 256 * i;
        const float4 al = *(const float4*)(mr + 1024 + k), sh = *(const float4*)(mr + k);
#pragma unroll
        for (int j = 0; j < TKW; ++j) {
          uint2 o; o.x = pack2(xv[j][i].x * rs[j] * al.x + sh.x, xv[j][i].y * rs[j] * al.y + sh.y); o.y = pack2(xv[j][i].z * rs[j] * al.z + sh.z, xv[j][i].w * rs[j] * al.w + sh.w);
          *(uint2*)(p.P + (size_t)(tok0 + j) * 1024 + k) = o;
        }
      }
    }
  }
}

#define XB_TMO      128
#define XB_XCNT(j)  (256  + 64 * (j))
#define XB_XSUB(j)  (1280 + 64 * (j))
#define XB_XGEN(j)  (2304 + 64 * (j))
#define XB_TOP      3328
#define XB_TOPGEN   3392
#define XCD_BAR_WORDS 3456
#define XB_SPIN_CAP (1u << 20)
__device__ __forceinline__ unsigned xb_ld(unsigned* p)              { return __hip_atomic_load(p, __ATOMIC_RELAXED, __HIP_MEMORY_SCOPE_AGENT); }
__device__ __forceinline__ unsigned xb_add(unsigned* p, unsigned v) { return __hip_atomic_fetch_add(p, v, __ATOMIC_RELAXED, __HIP_MEMORY_SCOPE_AGENT); }
__device__ __forceinline__ unsigned xb_xcc_id() { return (unsigned)__builtin_amdgcn_s_getreg((3 << 11) | 20) & 0xFu; }
#define XB_SPIN(cond, bar) do { unsigned _sp = 0; while (cond) { __builtin_amdgcn_s_sleep(1); \
    if ((++_sp & 255u) == 0u) { if (xb_ld(&(bar)[XB_TMO])) break; if (_sp > XB_SPIN_CAP) { atomicAdd(&(bar)[XB_TMO], 1u); break; } } } } while (0)
struct XcdBarrier { unsigned* bar; unsigned x; volatile LDS_AS unsigned* st; };
__device__ __forceinline__ XcdBarrier xcd_barrier_post(unsigned* bar, volatile LDS_AS unsigned* st) {
  XcdBarrier b; b.bar = bar; b.x = xb_xcc_id(); b.st = st;
  if (threadIdx.x == 0) (void)xb_add(&bar[XB_XCNT(b.x)], 1u);
  return b;
}
__device__ __forceinline__ void xcd_barrier_complete(unsigned* bar, unsigned x, unsigned& nloc, unsigned& nx) {
  const unsigned G = gridDim.x * gridDim.y * gridDim.z;
  unsigned sum, cnt, mine, sp = 0u;
  for (;;) {
    sum = 0u; cnt = 0u; mine = 0u;
#pragma unroll
    for (unsigned j = 0; j < 16; ++j) { const unsigned c = xb_ld(&bar[XB_XCNT(j)]); sum += c; cnt += (c > 0u) ? 1u : 0u; mine = (j == x) ? c : mine; }
    if (sum == G) break;
    __builtin_amdgcn_s_sleep(1);
    if ((++sp & 255u) == 0u) { if (xb_ld(&bar[XB_TMO])) break; if (sp > XB_SPIN_CAP) { atomicAdd(&bar[XB_TMO], 1u); break; } }
  }
  nloc = mine > 0u ? mine : 1u; nx = cnt > 0u ? cnt : 1u;
}
__device__ __forceinline__ void xcd_barrier(const XcdBarrier& b0) {
  asm volatile("s_waitcnt vmcnt(0)" ::: "memory");
  __syncthreads();
  if (threadIdx.x == 0) {
    XcdBarrier b = b0; b.x = xb_xcc_id();
    unsigned* bar = b.bar;
    __builtin_amdgcn_s_waitcnt(0);
    unsigned nloc = b.st[0], nx = b.st[1];
    if (nloc == 0u) { xcd_barrier_complete(bar, b.x, nloc, nx); b.st[0] = nloc; b.st[1] = nx; }
    const unsigned old = xb_add(&bar[XB_XSUB(b.x)], 1u);
    const unsigned gen = old / nloc;
    if (old + 1u == (gen + 1u) * nloc) {
      __builtin_amdgcn_fence(__ATOMIC_RELEASE, "agent");
      asm volatile("s_waitcnt vmcnt(0)" ::: "memory");
      const unsigned og = xb_add(&bar[XB_TOP], 1u);
      const unsigned tg = og / nx;
      if (og + 1u == (tg + 1u) * nx) xb_add(&bar[XB_TOPGEN], 1u);
      else XB_SPIN(xb_ld(&bar[XB_TOPGEN]) == tg, bar);
      __builtin_amdgcn_fence(__ATOMIC_ACQUIRE, "agent");
      xb_add(&bar[XB_XGEN(b.x)], 1u);
      asm volatile("s_waitcnt vmcnt(0)" ::: "memory");
    } else {
      XB_SPIN(xb_ld(&bar[XB_XGEN(b.x)]) == gen, bar);
      __builtin_amdgcn_fence(__ATOMIC_ACQUIRE, "agent");
      asm volatile("s_waitcnt vmcnt(0)" ::: "memory");
    }
  }
  __syncthreads();
}

namespace cg = cooperative_groups;
constexpr int MEGA_LDS = GDN_LDS > SSD_LDS ? GDN_LDS : SSD_LDS;
static_assert(MEGA_LDS <= 81408 && GEMM_LDS_BYTES <= MEGA_LDS && 4 * NA_LDS_WAVE <= MEGA_LDS, "LDS budget");
__global__ void __launch_bounds__(256, 2) k_mega(Params p_unused) {
  const AS4 Params* kp = (const AS4 Params*)__builtin_amdgcn_kernarg_segment_ptr();
#define PP (*p_launder(kp))
  cg::grid_group grid = cg::this_grid();
  __shared__ __attribute__((aligned(16))) char smem[MEGA_LDS];
  const int bid = blockIdx.x, nb = gridDim.x;
  __shared__ uint4 xb_words;
  if (threadIdx.x == 0) xb_words = make_uint4(0u, 0u, 0u, 0u);
  __syncthreads();
  const XcdBarrier xb = xcd_barrier_post(PP.BAR, (volatile LDS_AS unsigned*)&xb_words);
  phase_pro(PP, bid, nb);
  phase_modp(PP, bid, nb, (float*)smem);
  if (nb == 0x7fffffff) grid.sync();
  xcd_barrier(xb);
  phase_modfin(PP, bid, nb);
  xcd_barrier(xb);
  phase_norm(PP, 0, 0, bid, nb);
  xcd_barrier(xb);
#pragma unroll 1
  for (int layer = 0; layer < 2; ++layer) {
    phase_g1(PP, layer, bid, nb, (bf16_t*)smem);
    xcd_barrier(xb);
    phase_prep(PP, layer, bid, nb, (bf16_t*)smem);
    xcd_barrier(xb);
    {
      __shared__ int s_role;
      unsigned* chain_ctr = PP.CTR + 8 + layer;
      if (threadIdx.x == 0) {
        const unsigned key = (((unsigned)__builtin_amdgcn_s_getreg((3 << 11) | 20) & 0xFu) << 8) | (((unsigned)__builtin_amdgcn_s_getreg(63492) >> 8) & 0xffu);
        const unsigned slot = nb > 256 ? atomicAdd(PP.CTR + 64 + 2048 * layer + key, 1u) : 0u;
        s_role = slot == 0 ? (int)atomicAdd(chain_ctr, 1u) : 1 << 20;
      }
      __syncthreads();
      int c = s_role;
      __syncthreads();
      if (c < 128) phase_gdn(PP, layer, c, smem); else if (c < 256) phase_ssd(PP, layer, c - 128, smem);
      __syncthreads();
      phase_na(PP, layer, PP.CTR + layer, smem);
      for (;;) {
        __syncthreads();
        if (threadIdx.x == 0) s_role = (int)atomicAdd(chain_ctr, 1u);
        __syncthreads();
        c = s_role;
        if (c >= 256) break;
        if (c < 128) phase_gdn(PP, layer, c, smem); else phase_ssd(PP, layer, c - 128, smem);
      }
    }
    xcd_barrier(xb);
    phase_fin(PP, layer, bid, nb);
    xcd_barrier(xb);
    phase_g2a(PP, layer, bid, nb, (bf16_t*)smem);
    xcd_barrier(xb);
    phase_g2b(PP, layer, bid, nb, (bf16_t*)smem);
    xcd_barrier(xb);
    phase_g3(PP, layer, bid, nb, (bf16_t*)smem);
    xcd_barrier(xb);
    phase_norm(PP, layer, 1, bid, nb);
    xcd_barrier(xb);
    phase_g4(PP, layer, bid, nb, (bf16_t*)smem);
    xcd_barrier(xb);
    phase_g5(PP, layer, bid, nb, (bf16_t*)smem);
    if (layer == 0) { xcd_barrier(xb); phase_norm(PP, 1, 0, bid, nb); xcd_barrier(xb); }
  }
#undef PP
}

extern "C" void kernel_launch(void* const* d_in, const int* in_sizes, int n_in, void* d_out, int out_size, void* d_ws, size_t ws_size,
                              hipStream_t stream) {
  Params p{};
  const float** fp = (const float**)&p;
  for (int i = 0; i < 28; ++i) fp[i] = (const float*)d_in[i];
  p.out = (float*)d_out;
  char* ws = (char*)d_ws;
  size_t off = 0;
  auto take = [&](size_t bytes) { char* r = ws + off; off += (bytes + 255) & ~(size_t)255; return r; };
  p.U = (bf16_t*)take((size_t)TT * UW * 2);
  p.S = (float*)take((size_t)TT * SWD * 4);
  p.MOD = (float*)take((size_t)2 * 9 * 6144 * 4);
  p.SS = (float*)take((size_t)4 * TT * 4);
  p.ROPE = (float*)take(64 * 16 * 2 * 4);
  p.BAR = (unsigned*)take((size_t)XCD_BAR_WORDS * 4 + (64 + 2 * 2048) * 4);
  p.CTR = p.BAR + XCD_BAR_WORDS;
  p.P = (bf16_t*)take((size_t)TT * 1024 * 2);
  p.XC = (float*)take((size_t)TC * 1024 * 4);
  p.WT = (bf16_t*)(ws + off);
  p.HB = (bf16_t*)p.XC;
  p.OG0 = (bf16_t*)d_out;
  p.OG1 = (bf16_t*)((char*)p.P + (size_t)TL * 1024 * 2);
  size_t need = (size_t)((char*)p.OG1 - ws) + (size_t)2 * TL * 512 * 2;
  { const size_t need2 = off + (size_t)2 * 1024 * DFF * 2; if (need2 > need) need = need2; }
  if (need > ws_size) { fprintf(stderr, "workspace too small: need %zu have %zu\n", need, ws_size); return; }
  static int grid_blocks = 0;
  if (!grid_blocks) {
    int dev = 0, cus = 0, per_cu = 0;
    hipGetDevice(&dev);
    hipDeviceGetAttribute(&cus, hipDeviceAttributeMultiprocessorCount, dev);
    hipOccupancyMaxActiveBlocksPerMultiprocessor(&per_cu, k_mega, 256, 0);
    if (per_cu > 2) per_cu = 2;
    grid_blocks = cus * per_cu;
  }
  hipMemsetAsync(p.BAR, 0, (size_t)XCD_BAR_WORDS * 4 + (64 + 2 * 2048) * 4, stream);
  void* args[] = {&p};
  hipError_t e = hipLaunchCooperativeKernel((void*)k_mega, dim3(grid_blocks), dim3(256), args, 0, stream);
  if (e != hipSuccess) fprintf(stderr, "cooperative launch failed: %s (grid %d)\n", hipGetErrorString(e), grid_blocks);
}
```

```cpp
#include <hip/hip_runtime.h>
#include <hip/hip_cooperative_groups.h>
#include <cstdio>
#include <cstdint>

typedef unsigned short bf16_t;
typedef short bf16x8 __attribute__((ext_vector_type(8)));
typedef short s16x4 __attribute__((ext_vector_type(4)));
typedef float f32x4 __attribute__((ext_vector_type(4)));
#define LDS_AS __attribute__((address_space(3)))

constexpr int TL = 16384;
constexpr int TC = 2048;
constexpr int TT = TL + TC;
constexpr int DM = 1024;
constexpr int UW = 6144;
constexpr int SWD = 64;
constexpr int DIN = 9280;
constexpr int DFF = 4096;
constexpr float EPS = 1e-6f;
constexpr int U_NAQ = 0, U_NAK = 512, U_NAV = 1024;
constexpr int U_DNQ = 1536, U_DNK = 2048, U_DNV = 2560, U_DNZ = 3072;
constexpr int U_SZ = 3584, U_SX = 4608, U_SB = 5632, U_SC = 5888;
constexpr int U_YA = 0, U_YB = 512, U_YC = 1024, U_GATE = 2048, U_M = 5120;

struct Params {
  const float *x, *c, *ctx, *c_ctx, *w_ada, *b_ada, *norm1_g, *norm2_g, *w_in, *na_q_gain, *na_k_gain, *na_rpb,
      *dn_conv_w, *dn_a_log, *dn_dt_bias, *dn_o_gain, *ssd_conv_w, *ssd_conv_b, *ssd_a_log, *ssd_dt_bias, *ssd_d,
      *ssd_o_gain, *w_pa, *w_pb, *w_pc, *w_out, *w_ff1, *w_ff2;
  float* out;
  bf16_t* U;
  float* S;
  bf16_t* P;
  float* XC;
  bf16_t* WT;
  float* MOD;
  float* SS;
  float* ROPE;
  unsigned* BAR;
  unsigned* CTR;
  bf16_t* HB;
  bf16_t* OG0;
  bf16_t* OG1;
};

#define AS4 __attribute__((address_space(4)))
typedef const AS4 Params& PRef;
__device__ __forceinline__ const AS4 Params* p_launder(const AS4 Params* q) { asm volatile("" : "+s"(q)); return q; }

__device__ __forceinline__ int tidx() { int t = threadIdx.x; asm volatile("" : "+v"(t)); return t; }
__device__ __forceinline__ void wave_lds_sync() { __builtin_amdgcn_fence(__ATOMIC_RELEASE, "workgroup"); __builtin_amdgcn_wave_barrier(); __builtin_amdgcn_fence(__ATOMIC_ACQUIRE, "workgroup"); }
__device__ __forceinline__ float bf2f(bf16_t v) { return __uint_as_float(((unsigned)v) << 16); }
typedef float f32x2_t __attribute__((ext_vector_type(2)));
typedef __bf16 bf16x2_t __attribute__((ext_vector_type(2)));
__device__ __forceinline__ unsigned pack2(float a, float b) { const f32x2_t v = {a, b}; return __builtin_bit_cast(unsigned, __builtin_convertvector(v, bf16x2_t)); }
__device__ __forceinline__ bf16_t f2bf(float f) { return (bf16_t)(pack2(f, 0.f) & 0xffffu); }
__device__ __forceinline__ float bflo(unsigned w) { return __uint_as_float(w << 16); }
__device__ __forceinline__ float bfhi(unsigned w) { return __uint_as_float(w & 0xffff0000u); }
__device__ __forceinline__ float wave_sum(float v) {
#pragma unroll
  for (int o = 32; o; o >>= 1) v += __shfl_xor(v, o);
  return v;
}
__device__ __forceinline__ float wave_scan_add(float v) {
#define DPP_ADD_(CTRL, RM) v += __int_as_float(__builtin_amdgcn_update_dpp(0, __float_as_int(v), CTRL, RM, 0xf, false));
  DPP_ADD_(0x111, 0xf) DPP_ADD_(0x112, 0xf) DPP_ADD_(0x114, 0xf) DPP_ADD_(0x118, 0xf)
  DPP_ADD_(0x142, 0xa) DPP_ADD_(0x143, 0xc)
#undef DPP_ADD_
  return v;
}
__device__ __forceinline__ float wave_max(float v) {
#pragma unroll
  for (int o = 32; o; o >>= 1) v = fmaxf(v, __shfl_xor(v, o));
  return v;
}
__device__ __forceinline__ float siluf(float v) { return v * __builtin_amdgcn_rcpf(1.f + __expf(-v)); }
__device__ __forceinline__ float sigmoidf_(float v) { return __builtin_amdgcn_rcpf(1.f + __expf(-v)); }
__device__ __forceinline__ float softplusf_(float v) {
  const float u = __expf(fminf(v, 20.f));
  const float sp = u < 0.01f ? u * (1.f - u * (0.5f - u * (1.f / 3.f))) : __logf(1.f + u);
  return v > 20.f ? v : sp;
}

__device__ __forceinline__ const float* xrow_in(PRef p, int layer, int row) {
  if (layer == 0) return row < TL ? p.x + (size_t)row * DM : p.ctx + (size_t)(row - TL) * DM;
  return row < TL ? p.out + (size_t)row * DM : p.XC + (size_t)(row - TL) * DM;
}
__device__ __forceinline__ float* xrow_out(PRef p, int row) {
  return row < TL ? p.out + (size_t)row * DM : p.XC + (size_t)(row - TL) * DM;
}
__device__ __forceinline__ int modrow(int row) { return row < TL ? (row >> 11) : 8; }

constexpr int G_BK = 32;
constexpr int G_ASTR = G_BK;
constexpr int G_ATILE = 256 * G_ASTR;
constexpr int GEMM_LDS_BYTES = 2 * (G_ATILE + G_BK * (128 + 16)) * 2;
__device__ __forceinline__ s16x4 tr16(const bf16_t* ptr) { return __builtin_amdgcn_ds_read_tr16_b64_v4i16((LDS_AS s16x4*)ptr); }
__device__ __forceinline__ bf16x8 cat8(s16x4 lo, s16x4 hi) { return (bf16x8){lo[0], lo[1], lo[2], lo[3], hi[0], hi[1], hi[2], hi[3]}; }
__device__ __forceinline__ bf16x8 scale8(bf16x8 v, float sc) {
  const uint4 x = __builtin_bit_cast(uint4, v);
  uint4 o;
  o.x = pack2(bflo(x.x) * sc, bfhi(x.x) * sc); o.y = pack2(bflo(x.y) * sc, bfhi(x.y) * sc); o.z = pack2(bflo(x.z) * sc, bfhi(x.z) * sc); o.w = pack2(bflo(x.w) * sc, bfhi(x.w) * sc);
  return __builtin_bit_cast(bf16x8, o);
}
__device__ __forceinline__ uint4 cvt8(float4 a, float4 b) { uint4 o; o.x = pack2(a.x, a.y); o.y = pack2(a.z, a.w); o.z = pack2(b.x, b.y); o.w = pack2(b.z, b.w); return o; }

__device__ __forceinline__ void gemm_main2(f32x4 (&acc)[8][2], const bf16_t* A, int astride, const bf16_t* W, int ldw, int col0, int K, bf16_t* lds) {
  constexpr int NI = 2, BSTR = 80, BTILE = G_BK * BSTR;
  const int tid = tidx(), lane = tid & 63, wave = tid >> 6, wm = wave >> 1, wn = wave & 1, g = lane >> 4, l15 = lane & 15, q4 = l15 >> 2, p4 = lane & 3;
  bf16_t* As = lds;
  bf16_t* Bs = lds + 2 * G_ATILE;
  const int ar = tid >> 2, ak = (tid & 3) * 8;
  const int bk = tid >> 3, bn = (tid & 7) * 8;
  const int rho0 = (bk & 3) + 4 * ((bk >> 3) & 3) + 16 * ((bk >> 2) & 1);
  const bf16_t* ap = A + (size_t)ar * astride + ak;
  const bf16_t* bp = W + (size_t)bk * ldw + col0 + bn;
  bf16_t* aw = As + ar * G_ASTR + 8 * ((tid & 3) ^ ((ar >> 1) & 3));
  bf16_t* bw = Bs + rho0 * BSTR + 32 * (bn >> 5) + 4 * ((bn >> 3) & 3);
  uint4 ra0, ra1, ra2, ra3, rb0;
#define G_LOADS(K1) { ra0 = *(const uint4*)(ap + (size_t)(64 * 0) * astride + (K1)); ra1 = *(const uint4*)(ap + (size_t)(64 * 1) * astride + (K1)); ra2 = *(const uint4*)(ap + (size_t)(64 * 2) * astride + (K1)); ra3 = *(const uint4*)(ap + (size_t)(64 * 3) * astride + (K1)); rb0 = *(const uint4*)(bp + (size_t)(K1) * ldw); }
#define G_STORES(NX) { *(uint4*)(aw + (NX) * G_ATILE + 64 * 0 * G_ASTR) = ra0; *(uint4*)(aw + (NX) * G_ATILE + 64 * 1 * G_ASTR) = ra1; *(uint4*)(aw + (NX) * G_ATILE + 64 * 2 * G_ASTR) = ra2; *(uint4*)(aw + (NX) * G_ATILE + 64 * 3 * G_ASTR) = ra3; { bf16_t* d_ = bw + (NX) * BTILE + 0 * BSTR; *(uint2*)d_ = make_uint2(rb0.x, rb0.y); *(uint2*)(d_ + 16) = make_uint2(rb0.z, rb0.w); } }
  G_LOADS(0)
  G_STORES(0)
  __syncthreads();
  const int nk = K / G_BK;
  for (int kt = 0; kt < nk; ++kt) {
    const int cur = kt & 1;
    const int k1 = (kt + 1 < nk ? kt + 1 : kt) * G_BK;
    G_LOADS(k1)
    asm volatile("" ::: "memory");
    const bf16_t* Ac = As + cur * G_ATILE + (128 * wm + l15) * G_ASTR + 8 * (g ^ ((l15 >> 1) & 3));
    const bf16_t* Bc = Bs + cur * BTILE + (4 * g + q4) * BSTR + 16 * NI * wn + 4 * p4;
    {
      bf16x8 af[8], bfr[NI];
#pragma unroll
      for (int mi = 0; mi < 8; ++mi) af[mi] = *(const bf16x8*)(Ac + mi * 16 * G_ASTR);
#pragma unroll
      for (int ni = 0; ni < NI; ++ni) bfr[ni] = cat8(tr16(Bc + 16 * ni), tr16(Bc + 16 * BSTR + 16 * ni));
#pragma unroll
      for (int mi = 0; mi < 8; ++mi)
#pragma unroll
        for (int ni = 0; ni < NI; ++ni) acc[mi][ni] = __builtin_amdgcn_mfma_f32_16x16x32_bf16(bfr[ni], af[mi], acc[mi][ni], 0, 0, 0);
    }
    asm volatile("" ::: "memory");
    __builtin_amdgcn_sched_barrier(0);
    G_STORES(cur ^ 1)
    __syncthreads();
  }
#undef G_LOADS
#undef G_STORES
}
__device__ __forceinline__ void gemm_main4(f32x4 (&acc)[8][4], const bf16_t* A, int astride, const bf16_t* W, int ldw, int col0, int K, bf16_t* lds) {
  constexpr int NI = 4, BSTR = 144, BTILE = G_BK * BSTR;
  const int tid = tidx(), lane = tid & 63, wave = tid >> 6, wm = wave >> 1, wn = wave & 1, g = lane >> 4, l15 = lane & 15, q4 = l15 >> 2, p4 = lane & 3;
  bf16_t* As = lds;
  bf16_t* Bs = lds + 2 * G_ATILE;
  const int ar = tid >> 2, ak = (tid & 3) * 8;
  const int bk = tid >> 4, bn = (tid & 15) * 8;
  const int rho0 = (bk & 3) + 4 * (bk >> 3) + 16 * ((bk >> 2) & 1);
  const bf16_t* ap = A + (size_t)ar * astride + ak;
  const bf16_t* bp = W + (size_t)bk * ldw + col0 + bn;
  bf16_t* aw = As + ar * G_ASTR + 8 * ((tid & 3) ^ ((ar >> 1) & 3));
  bf16_t* bw = Bs + rho0 * BSTR + 32 * (bn >> 5) + 4 * ((bn >> 3) & 3);
  uint4 ra0, ra1, ra2, ra3, rb0, rb1;
#define G_LOADS(K1) { ra0 = *(const uint4*)(ap + (size_t)(64 * 0) * astride + (K1)); ra1 = *(const uint4*)(ap + (size_t)(64 * 1) * astride + (K1)); ra2 = *(const uint4*)(ap + (size_t)(64 * 2) * astride + (K1)); ra3 = *(const uint4*)(ap + (size_t)(64 * 3) * astride + (K1)); rb0 = *(const uint4*)(bp + (size_t)((K1) + 16 * 0) * ldw); rb1 = *(const uint4*)(bp + (size_t)((K1) + 16 * 1) * ldw); }
#define G_STORES(NX) { *(uint4*)(aw + (NX) * G_ATILE + 64 * 0 * G_ASTR) = ra0; *(uint4*)(aw + (NX) * G_ATILE + 64 * 1 * G_ASTR) = ra1; *(uint4*)(aw + (NX) * G_ATILE + 64 * 2 * G_ASTR) = ra2; *(uint4*)(aw + (NX) * G_ATILE + 64 * 3 * G_ASTR) = ra3; { bf16_t* d_ = bw + (NX) * BTILE + 0 * BSTR; *(uint2*)d_ = make_uint2(rb0.x, rb0.y); *(uint2*)(d_ + 16) = make_uint2(rb0.z, rb0.w); } { bf16_t* d_ = bw + (NX) * BTILE + 8 * BSTR; *(uint2*)d_ = make_uint2(rb1.x, rb1.y); *(uint2*)(d_ + 16) = make_uint2(rb1.z, rb1.w); } }
  G_LOADS(0)
  G_STORES(0)
  __syncthreads();
  const int nk = K / G_BK;
  for (int kt = 0; kt < nk; ++kt) {
    const int cur = kt & 1;
    const int k1 = (kt + 1 < nk ? kt + 1 : kt) * G_BK;
    G_LOADS(k1)
    asm volatile("" ::: "memory");
    const bf16_t* Ac = As + cur * G_ATILE + (128 * wm + l15) * G_ASTR + 8 * (g ^ ((l15 >> 1) & 3));
    const bf16_t* Bc = Bs + cur * BTILE + (4 * g + q4) * BSTR + 16 * NI * wn + 4 * p4;
    {
      bf16x8 af[8], bfr[NI];
#pragma unroll
      for (int mi = 0; mi < 8; ++mi) af[mi] = *(const bf16x8*)(Ac + mi * 16 * G_ASTR);
#pragma unroll
      for (int ni = 0; ni < NI; ++ni) bfr[ni] = cat8(tr16(Bc + 16 * ni), tr16(Bc + 16 * BSTR + 16 * ni));
#pragma unroll
      for (int mi = 0; mi < 8; ++mi)
#pragma unroll
        for (int ni = 0; ni < NI; ++ni) acc[mi][ni] = __builtin_amdgcn_mfma_f32_16x16x32_bf16(bfr[ni], af[mi], acc[mi][ni], 0, 0, 0);
    }
    asm volatile("" ::: "memory");
    __builtin_amdgcn_sched_barrier(0);
    G_STORES(cur ^ 1)
    __syncthreads();
  }
#undef G_LOADS
#undef G_STORES
}
template <int NI> __device__ __forceinline__ void acc_zero(f32x4 (&acc)[8][NI]) {
#pragma unroll
  for (int i = 0; i < 8; ++i)
#pragma unroll
    for (int j = 0; j < NI; ++j) acc[i][j] = (f32x4){0.f, 0.f, 0.f, 0.f};
}
__device__ __forceinline__ void wconv(const float* src, int sld, int soff, bool win_order, bf16_t* dst, int dld, int rows, int cols, int bid, int nb) {
  const int cpr = cols >> 3, total = rows * cpr;
  for (int i = bid * 256 + tidx(); i < total; i += nb * 256) {
    const int r = i / cpr, c = (i - r * cpr) << 3;
    int sc = c + soff;
    if (win_order) { if (c < 3584) sc = c; else if (c < 6144) sc = c + 32; else { const int o = c - 6144; sc = o < 32 ? 3584 + o : (o < 64 ? 6176 + o - 32 : -1); } }
    uint4 o = make_uint4(0u, 0u, 0u, 0u);
    if (sc >= 0) { const float* sp = src + (size_t)r * sld + sc; o = cvt8(*(const float4*)sp, *(const float4*)(sp + 4)); }
    *(uint4*)(dst + (size_t)r * dld + c) = o;
  }
}
constexpr int WIN_LD = 6272;
constexpr int U_W = 5120;
constexpr int UWR_G = 0, UWR_PA = 3072, UWR_PB = 3584, UWR_PC = 4096, UWR_OUT = 5120;
__device__ __forceinline__ bool tile_next(int i, int bid, int nb, int nMt, int nNt, bool nsplit, int& mt, int& nt) {
  const int xcd = bid & 7, slot = bid >> 3, nslots = nb >> 3;
  const int j = slot + i * nslots;
  if (nsplit) {
    const int nNx = (nNt - xcd + 7) >> 3;
    if (j >= nMt * nNx) return false;
    mt = j / nNx; nt = xcd + 8 * (j % nNx);
  } else {
    const int nMx = (nMt - xcd + 7) >> 3;
    if (j >= nMx * nNt) return false;
    mt = xcd + 8 * (j / nNt); nt = j % nNt;
  }
  return true;
}
#define EPI_IDS const int lane = tidx() & 63, wave = tidx() >> 6, wm = wave >> 1, wn = wave & 1, g = lane >> 4, l15 = lane & 15

__device__ __forceinline__ void phase_pro(PRef p, int bid, int nb) {
  const int tid = tidx(), lane = tid & 63, wave = tid >> 6;
  for (int i = bid * 256 + tid; i < 64 * 16; i += nb * 256) {
    const int pos = i >> 4, fi = i & 15;
    const float inv = __builtin_amdgcn_exp2f(-(float)fi * 0.83048202372184f);
    float ang = (float)pos * inv;
    const float kk = rintf(ang * 0.15915494309189535f);
    ang = fmaf(-kk, 6.2831854820251465f, ang); ang = fmaf(-kk, -1.7484555314695172e-07f, ang);
    p.ROPE[2 * i] = __cosf(ang); p.ROPE[2 * i + 1] = __sinf(ang);
  }
}
__device__ __forceinline__ void phase_modp(PRef p, int bid, int nb, float* lds) {
  const int tid = tidx();
  float* MODP = (float*)p.U;
  for (int u = bid; u < 768; u += nb) {
    const int ks = u & 15, cb = (u >> 4) % 24, l = u / 384, n = cb * 256 + tid;
    __syncthreads();
    for (int i = tid; i < 9 * 64; i += 256) { const int r = i >> 6, k = 64 * ks + (i & 63); const float v = r < 8 ? p.c[r * 1024 + k] : p.c_ctx[k]; lds[i] = siluf(v); }
    __syncthreads();
    float acc[9];
#pragma unroll
    for (int r = 0; r < 9; ++r) acc[r] = 0.f;
    const float* w = p.w_ada + ((size_t)l * 1024 + 64 * ks) * 6144 + n;
#pragma unroll
    for (int k = 0; k < 64; ++k) {
      const float wv = w[(size_t)k * 6144];
#pragma unroll
      for (int r = 0; r < 9; ++r) acc[r] += lds[r * 64 + k] * wv;
    }
#pragma unroll
    for (int r = 0; r < 9; ++r) MODP[((size_t)(ks * 2 + l) * 9 + r) * 6144 + n] = acc[r];
  }
}
__device__ __forceinline__ void phase_modfin(PRef p, int bid, int nb) {
  const float* MODP = (const float*)p.U;
  for (int i = bid * 256 + tidx(); i < 2 * 9 * 6144; i += nb * 256) {
    const int l = i / (9 * 6144), rem = i % (9 * 6144), r = rem / 6144, n = rem % 6144;
    float v = p.b_ada[l * 6144 + n];
#pragma unroll
    for (int ks = 0; ks < 16; ++ks) v += MODP[((size_t)(ks * 2 + l) * 9 + r) * 6144 + n];
    const int chunk = n >> 10, kk = n & 1023;
    if (chunk == 1) v = p.norm1_g[l * 1024 + kk] * (1.f + v);
    if (chunk == 4) v = p.norm2_g[l * 1024 + kk] * (1.f + v);
    p.MOD[i] = v;
  }
}

__device__ __forceinline__ void norm_rows4(const float* x0, const float* x1, const float* x2, const float* x3, const float* alpha, const float* shift, bf16_t* h0, int lane) {
  const float* xr[4] = {x0, x1, x2, x3};
  float4 v[4][4];
#pragma unroll
  for (int j = 0; j < 4; ++j)
#pragma unroll
    for (int i = 0; i < 4; ++i) v[j][i] = *(const float4*)(xr[j] + lane * 4 + 256 * i);
  float rs[4];
#pragma unroll
  for (int j = 0; j < 4; ++j) {
    float ssq = 0.f;
#pragma unroll
    for (int i = 0; i < 4; ++i) ssq += v[j][i].x * v[j][i].x + v[j][i].y * v[j][i].y + v[j][i].z * v[j][i].z + v[j][i].w * v[j][i].w;
    rs[j] = rsqrtf(wave_sum(ssq) * (1.f / DM) + EPS);
  }
#pragma unroll
  for (int i = 0; i < 4; ++i) {
    const int k = lane * 4 + 256 * i;
    const float4 a = *(const float4*)(alpha + k), s = *(const float4*)(shift + k);
#pragma unroll
    for (int j = 0; j < 4; ++j) {
      uint2 o; o.x = pack2(v[j][i].x * rs[j] * a.x + s.x, v[j][i].y * rs[j] * a.y + s.y); o.y = pack2(v[j][i].z * rs[j] * a.z + s.z, v[j][i].w * rs[j] * a.w + s.w);
      *(uint2*)(h0 + (size_t)j * 1024 + k) = o;
    }
  }
}
__device__ __forceinline__ void norm_rows1(const float* x0, const float* alpha, const float* shift, bf16_t* h0, int lane) {
  float4 v[4];
#pragma unroll
  for (int i = 0; i < 4; ++i) v[i] = *(const float4*)(x0 + lane * 4 + 256 * i);
  float ssq = 0.f;
#pragma unroll
  for (int i = 0; i < 4; ++i) ssq += v[i].x * v[i].x + v[i].y * v[i].y + v[i].z * v[i].z + v[i].w * v[i].w;
  const float rs = rsqrtf(wave_sum(ssq) * (1.f / DM) + EPS);
#pragma unroll
  for (int i = 0; i < 4; ++i) {
    const int k = lane * 4 + 256 * i;
    const float4 a = *(const float4*)(alpha + k), s = *(const float4*)(shift + k);
    uint2 o; o.x = pack2(v[i].x * rs * a.x + s.x, v[i].y * rs * a.y + s.y); o.y = pack2(v[i].z * rs * a.z + s.z, v[i].w * rs * a.w + s.w);
    *(uint2*)(h0 + k) = o;
  }
}
template <int NR> __device__ __forceinline__ void norm_rows_ctx(const float* x1, const float* part, const float* gate, const float* alpha, const float* shift, bf16_t* h0, int lane) {
  float4 v[NR][4];
#pragma unroll
  for (int i = 0; i < 4; ++i) {
    const int k = lane * 4 + 256 * i;
    const float4 gv = *(const float4*)(gate + k);
#pragma unroll
    for (int j = 0; j < NR; ++j) {
      const float4 xv = *(const float4*)(x1 + (size_t)j * 1024 + k);
      const float4 a = *(const float4*)(part + (size_t)j * 1024 + k), b = *(const float4*)(part + ((size_t)TC + j) * 1024 + k);
      const float4 c = *(const float4*)(part + ((size_t)2 * TC + j) * 1024 + k), d = *(const float4*)(part + ((size_t)3 * TC + j) * 1024 + k);
      v[j][i].x = xv.x + gv.x * ((a.x + b.x) + (c.x + d.x)); v[j][i].y = xv.y + gv.y * ((a.y + b.y) + (c.y + d.y));
      v[j][i].z = xv.z + gv.z * ((a.z + b.z) + (c.z + d.z)); v[j][i].w = xv.w + gv.w * ((a.w + b.w) + (c.w + d.w));
    }
  }
  float rs[NR];
#pragma unroll
  for (int j = 0; j < NR; ++j) {
    float ssq = 0.f;
#pragma unroll
    for (int i = 0; i < 4; ++i) ssq += v[j][i].x * v[j][i].x + v[j][i].y * v[j][i].y + v[j][i].z * v[j][i].z + v[j][i].w * v[j][i].w;
    rs[j] = rsqrtf(wave_sum(ssq) * (1.f / DM) + EPS);
  }
#pragma unroll
  for (int i = 0; i < 4; ++i) {
    const int k = lane * 4 + 256 * i;
    const float4 a = *(const float4*)(alpha + k), s = *(const float4*)(shift + k);
#pragma unroll
    for (int j = 0; j < NR; ++j) {
      uint2 o; o.x = pack2(v[j][i].x * rs[j] * a.x + s.x, v[j][i].y * rs[j] * a.y + s.y); o.y = pack2(v[j][i].z * rs[j] * a.z + s.z, v[j][i].w * rs[j] * a.w + s.w);
      *(uint2*)(h0 + (size_t)j * 1024 + k) = o;
    }
  }
}
__device__ __forceinline__ void phase_norm(PRef p, int layer, int which, int bid, int nb) {
  if (which == 0) wconv(p.w_in + (size_t)layer * 1024 * DIN, DIN, 0, true, p.WT, WIN_LD, 1024, WIN_LD, bid, nb);
  else if (layer == 1) {
    wconv(p.w_ff1 + (size_t)layer * 1024 * DFF, DFF, 0, false, p.WT, DFF, 1024, DFF, bid, nb);
    wconv(p.w_ff2 + (size_t)layer * DFF * 1024, 1024, 0, false, p.WT + (size_t)1024 * DFF, 1024, DFF, 1024, bid, nb);
  }
  const int lane = tidx() & 63, wave = tidx() >> 6;
  const int nrow = (which == 1 && layer == 1) ? TL : TT;
  const float* modl = p.MOD + (size_t)layer * 9 * 6144;
  const int lin = which == 0 ? layer : 1;
  const bool ctx_parts = layer == 1 && which == 0;
  if (ctx_parts) {
    for (int row = TL + bid * 4 + wave; row < TT; row += nb * 4) {
      const float* mr = modl + 8 * 6144;
      norm_rows_ctx<1>(p.XC + (size_t)(row - TL) * 1024, (const float*)(p.U + (size_t)TT * DFF) + (size_t)(row - TL) * 1024, p.MOD + 8 * 6144 + 5120,
                       mr + 1024, mr, p.P + (size_t)row * 1024, lane);
    }
  }
  const int nmain = ctx_parts ? TL : nrow / (nb * 16) * (nb * 16);
  if (!ctx_parts) {
    for (int row = nmain + bid * 4 + wave; row < nrow; row += nb * 4) {
      const float* mr = modl + modrow(row) * 6144;
      norm_rows1(xrow_in(p, lin, row), mr + (which ? 4096 : 1024), mr + (which ? 3072 : 0), p.P + (size_t)row * 1024, lane);
    }
  }
  for (int row = (bid * 4 + wave) * 4; row < nmain; row += nb * 16) {
    const float* mr = modl + modrow(row) * 6144;
    norm_rows4(xrow_in(p, lin, row), xrow_in(p, lin, row + 1), xrow_in(p, lin, row + 2), xrow_in(p, lin, row + 3),
               mr + (which ? 4096 : 1024), mr + (which ? 3072 : 0), p.P + (size_t)row * 1024, lane);
  }
}

__device__ __forceinline__ void phase_g1(PRef p, int layer, int bid, int nb, bf16_t* lds) {
  constexpr bool NSPLIT = true;
  const int nMt = TT / 256, nNt = 48;
  EPI_IDS;
  for (int ti = 0;; ++ti) {
    int mt, nt; if (!tile_next(ti, bid, nb, nMt, nNt, NSPLIT, mt, nt)) break;
    const int m0 = mt * 256, n0 = nt * 128;
    f32x4 acc[8][4]; acc_zero<4>(acc);
    gemm_main4(acc, p.P + (size_t)m0 * 1024, 1024, p.WT, WIN_LD, n0, 1024, lds);
    if (n0 < 1024) {
      const float* gain = (n0 < 512 ? p.na_q_gain : p.na_k_gain) + layer * 64;
      const float mul = n0 < 512 ? 0.125f : 1.f;
#pragma unroll
      for (int mi = 0; mi < 8; ++mi) {
        float ss = 0.f;
#pragma unroll
        for (int ni = 0; ni < 4; ++ni) ss += acc[mi][ni][0] * acc[mi][ni][0] + acc[mi][ni][1] * acc[mi][ni][1] + acc[mi][ni][2] * acc[mi][ni][2] + acc[mi][ni][3] * acc[mi][ni][3];
        ss += __shfl_xor(ss, 16); ss += __shfl_xor(ss, 32);
        const float rs = rsqrtf(ss * (1.f / 64.f) + EPS) * mul;
        const int row = m0 + 128 * wm + 16 * mi + l15;
#pragma unroll
        for (int q = 0; q < 2; ++q) {
          const int cl = 32 * q + 8 * g;
          const float4 g0 = *(const float4*)(gain + cl), g1 = *(const float4*)(gain + cl + 4);
          uint4 o;
          o.x = pack2(acc[mi][2 * q][0] * rs * g0.x, acc[mi][2 * q][1] * rs * g0.y); o.y = pack2(acc[mi][2 * q][2] * rs * g0.z, acc[mi][2 * q][3] * rs * g0.w);
          o.z = pack2(acc[mi][2 * q + 1][0] * rs * g1.x, acc[mi][2 * q + 1][1] * rs * g1.y); o.w = pack2(acc[mi][2 * q + 1][2] * rs * g1.z, acc[mi][2 * q + 1][3] * rs * g1.w);
          *(uint4*)(p.U + (size_t)row * UW + n0 + 64 * wn + cl) = o;
        }
      }
    } else {
      const bool hsec = (n0 >= 1536 && n0 < 3072) || n0 >= 4608;
      const int hcol0 = n0 < 3072 ? n0 - 1536 : n0 - 3072;
#pragma unroll
      for (int mi = 0; mi < 8; ++mi) {
        const int row = m0 + 128 * wm + 16 * mi + l15;
        const int rr = row & 63;
        const bool halo = hsec && (rr < 2 || rr >= 62);
        bf16_t* hb = p.HB + ((size_t)(row >> 6) * 4 + (rr < 2 ? rr : rr - 60)) * 3072 + hcol0 + 64 * wn + 8 * g;
#pragma unroll
        for (int q = 0; q < 2; ++q) {
          uint4 o; o.x = pack2(acc[mi][2 * q][0], acc[mi][2 * q][1]); o.y = pack2(acc[mi][2 * q][2], acc[mi][2 * q][3]);
          o.z = pack2(acc[mi][2 * q + 1][0], acc[mi][2 * q + 1][1]); o.w = pack2(acc[mi][2 * q + 1][2], acc[mi][2 * q + 1][3]);
          *(uint4*)(p.U + (size_t)row * UW + n0 + 64 * wn + 32 * q + 8 * g) = o;
          if (halo) *(uint4*)(hb + 32 * q) = o;
        }
      }
    }
  }
  const int nslots = nb >> 3, extra = (nMt * (nNt / 8)) % nslots, nlight = (nslots - extra) * 8;
  for (int mt = ((bid >> 3) - extra) * 8 + (bid & 7); mt < nMt; mt += nlight) {
    if ((bid >> 3) < extra) break;
    const int m0 = mt * 256;
    f32x4 acc[8][2]; acc_zero<2>(acc);
    gemm_main2(acc, p.P + (size_t)m0 * 1024, 1024, p.WT, WIN_LD, 6144, 1024, lds);
#pragma unroll
    for (int mi = 0; mi < 8; ++mi) {
      const int row = m0 + 128 * wm + 16 * mi + l15;
#pragma unroll
      for (int ni = 0; ni < 2; ++ni) *(f32x4*)(p.S + (size_t)row * SWD + 32 * wn + 8 * g + 4 * ni) = acc[mi][ni];
    }
  }
}

__device__ __forceinline__ void phase_g2a(PRef p, int layer, int bid, int nb, bf16_t* lds) {
  constexpr bool NSPLIT = true;
  const int nMt = (layer == 0 ? TT : TL) / 256, nNt = 24;
  EPI_IDS;
  for (int ti = 0;; ++ti) {
    int mt, nt; if (!tile_next(ti, bid, nb, nMt, nNt, NSPLIT, mt, nt)) break;
    const int m0 = mt * 256, n0 = nt * 128;
    f32x4 acc[8][4]; acc_zero<4>(acc);
    gemm_main4(acc, p.P + (size_t)m0 * 1024, 1024, p.U + U_W + (size_t)(UWR_G + 1024 * (n0 >> 10)) * UW, UW, n0 & 1023, 1024, lds);
#pragma unroll
    for (int mi = 0; mi < 8; ++mi) {
      const int row = m0 + 128 * wm + 16 * mi + l15;
#pragma unroll
      for (int q = 0; q < 2; ++q) {
        uint4 o; o.x = pack2(sigmoidf_(acc[mi][2 * q][0]), sigmoidf_(acc[mi][2 * q][1])); o.y = pack2(sigmoidf_(acc[mi][2 * q][2]), sigmoidf_(acc[mi][2 * q][3]));
        o.z = pack2(sigmoidf_(acc[mi][2 * q + 1][0]), sigmoidf_(acc[mi][2 * q + 1][1])); o.w = pack2(sigmoidf_(acc[mi][2 * q + 1][2]), sigmoidf_(acc[mi][2 * q + 1][3]));
        *(uint4*)(p.U + (size_t)row * UW + U_GATE + n0 + 64 * wn + 32 * q + 8 * g) = o;
      }
    }
  }
}
__device__ __forceinline__ void phase_g2b(PRef p, int layer, int bid, int nb, bf16_t* lds) {
  constexpr bool NSPLIT = false;
  const int nMt = (layer == 0 ? TT : TL) / 256, nNt = 16;
  EPI_IDS;
  for (int ti = 0;; ++ti) {
    int mt, nt; if (!tile_next(ti, bid, nb, nMt, nNt, NSPLIT, mt, nt)) break;
    const int m0 = mt * 256, n0 = nt * 64;
    f32x4 accm[8][2]; acc_zero<2>(accm);
#pragma unroll 1
    for (int i = 0; i < 3; ++i) {
      const int ycol = i == 0 ? U_YA : (i == 1 ? U_YB : U_YC);
      const int Ki = i == 2 ? 1024 : 512;
      const bf16_t* w = p.U + U_W + (size_t)(i == 0 ? UWR_PA : (i == 1 ? UWR_PB : UWR_PC)) * UW;
      f32x4 acc[8][2]; acc_zero<2>(acc);
      gemm_main2(acc, p.U + (size_t)m0 * UW + ycol, UW, w, UW, n0, Ki, lds);
#pragma unroll
      for (int mi = 0; mi < 8; ++mi) {
        const int row = m0 + 128 * wm + 16 * mi + l15;
        {
          const uint4 gt = *(const uint4*)(p.U + (size_t)row * UW + U_GATE + 1024 * i + n0 + 32 * wn + 8 * g);
          accm[mi][0][0] += bflo(gt.x) * acc[mi][0][0]; accm[mi][0][1] += bfhi(gt.x) * acc[mi][0][1];
          accm[mi][0][2] += bflo(gt.y) * acc[mi][0][2]; accm[mi][0][3] += bfhi(gt.y) * acc[mi][0][3];
          accm[mi][1][0] += bflo(gt.z) * acc[mi][1][0]; accm[mi][1][1] += bfhi(gt.z) * acc[mi][1][1];
          accm[mi][1][2] += bflo(gt.w) * acc[mi][1][2]; accm[mi][1][3] += bfhi(gt.w) * acc[mi][1][3];
        }
      }
    }
#pragma unroll
    for (int mi = 0; mi < 8; ++mi) {
      const int row = m0 + 128 * wm + 16 * mi + l15;
      {
        uint4 o; o.x = pack2(accm[mi][0][0], accm[mi][0][1]); o.y = pack2(accm[mi][0][2], accm[mi][0][3]); o.z = pack2(accm[mi][1][0], accm[mi][1][1]); o.w = pack2(accm[mi][1][2], accm[mi][1][3]);
        *(uint4*)(p.P + (size_t)row * 1024 + n0 + 32 * wn + 8 * g) = o;
      }
    }
  }
}
template <int NI> __device__ __forceinline__ void epi_residual(PRef p, const f32x4 (&acc)[8][NI], int layer_in, int m0, int n0, const float* gate) {
  EPI_IDS;
#pragma unroll
  for (int mi = 0; mi < 8; ++mi) {
    const int row = m0 + 128 * wm + 16 * mi + l15;
    const float* xi = xrow_in(p, layer_in, row);
    float* xo = xrow_out(p, row);
    const float* gr = gate + modrow(row) * 6144;
#pragma unroll
    for (int ni = 0; ni < NI; ++ni) {
      const int col = n0 + 16 * NI * wn + 32 * (ni >> 1) + 8 * g + 4 * (ni & 1);
      const float4 xv = *(const float4*)(xi + col);
      const float4 gv = *(const float4*)(gr + col);
      float4 o;
      o.x = xv.x + gv.x * acc[mi][ni][0]; o.y = xv.y + gv.y * acc[mi][ni][1]; o.z = xv.z + gv.z * acc[mi][ni][2]; o.w = xv.w + gv.w * acc[mi][ni][3];
      *(float4*)(xo + col) = o;
    }
  }
}
__device__ __forceinline__ void phase_g3(PRef p, int layer, int bid, int nb, bf16_t* lds) {
  constexpr bool NSPLIT = false;
  const float* modl = p.MOD + (size_t)layer * 9 * 6144;
  const bf16_t* w = p.U + U_W + (size_t)UWR_OUT * UW;
  for (int ti = 0;; ++ti) {
    int mt, nt; if (!tile_next(ti, bid, nb, TL / 256, 8, NSPLIT, mt, nt)) break;
    const int m0 = mt * 256, n0 = nt * 128;
    f32x4 acc[8][4]; acc_zero<4>(acc);
    gemm_main4(acc, p.P + (size_t)m0 * 1024, 1024, w, UW, n0, 1024, lds);
    epi_residual<4>(p, acc, layer, m0, n0, modl + 2048);
  }
  if (layer == 0) {
    for (int u = bid; u < (TC / 256) * 16; u += nb) {
      const int m0 = TL + (u >> 4) * 256, n0 = (u & 15) * 64;
      f32x4 acc[8][2]; acc_zero<2>(acc);
      gemm_main2(acc, p.P + (size_t)m0 * 1024, 1024, w, UW, n0, 1024, lds);
      epi_residual<2>(p, acc, layer, m0, n0, modl + 2048);
    }
  }
}
__device__ __forceinline__ void phase_g4(PRef p, int layer, int bid, int nb, bf16_t* lds) {
  constexpr bool NSPLIT = true;
  const int nMt = (layer == 0 ? TT : TL) / 256, nNt = 32;
  EPI_IDS;
  for (int ti = 0;; ++ti) {
    int mt, nt; if (!tile_next(ti, bid, nb, nMt, nNt, NSPLIT, mt, nt)) break;
    const int m0 = mt * 256, n0 = nt * 128;
    f32x4 acc[8][4]; acc_zero<4>(acc);
    gemm_main4(acc, p.P + (size_t)m0 * 1024, 1024, p.WT, DFF, n0, 1024, lds);
#pragma unroll
    for (int mi = 0; mi < 8; ++mi) {
      const int row = m0 + 128 * wm + 16 * mi + l15;
#pragma unroll
      for (int q = 0; q < 2; ++q) {
        float v[8];
#pragma unroll
        for (int e = 0; e < 4; ++e) { v[e] = fmaxf(acc[mi][2 * q][e], 0.f); v[4 + e] = fmaxf(acc[mi][2 * q + 1][e], 0.f); }
        uint4 o; o.x = pack2(v[0] * v[0], v[1] * v[1]); o.y = pack2(v[2] * v[2], v[3] * v[3]); o.z = pack2(v[4] * v[4], v[5] * v[5]); o.w = pack2(v[6] * v[6], v[7] * v[7]);
        *(uint4*)(p.U + (size_t)row * DFF + n0 + 64 * wn + 32 * q + 8 * g) = o;
      }
    }
  }
}
__device__ __forceinline__ void phase_g5(PRef p, int layer, int bid, int nb, bf16_t* lds) {
  constexpr bool NSPLIT = false;
  const float* modl = p.MOD + (size_t)layer * 9 * 6144;
  const bf16_t* w = p.WT + (size_t)1024 * DFF;
  for (int ti = 0;; ++ti) {
    int mt, nt; if (!tile_next(ti, bid, nb, TL / 256, 8, NSPLIT, mt, nt)) break;
    const int m0 = mt * 256, n0 = nt * 128;
    f32x4 acc[8][4]; acc_zero<4>(acc);
    gemm_main4(acc, p.U + (size_t)m0 * DFF, DFF, w, 1024, n0, DFF, lds);
    epi_residual<4>(p, acc, 1, m0, n0, modl + 5120);
  }
  if (layer == 0) {
    EPI_IDS;
    float* part = (float*)(p.U + (size_t)TT * DFF);
    for (int u = bid; u < (TC / 256) * 16 * 4; u += nb) {
      const int ks = u & 3, t = u >> 2, mrel = (t >> 4) * 256, n0 = (t & 15) * 64;
      f32x4 acc[8][2]; acc_zero<2>(acc);
      gemm_main2(acc, p.U + (size_t)(TL + mrel) * DFF + ks * 1024, DFF, w + (size_t)ks * 1024 * 1024, 1024, n0, 1024, lds);
#pragma unroll
      for (int mi = 0; mi < 8; ++mi) {
        float* pr = part + ((size_t)ks * TC + mrel + 128 * wm + 16 * mi + l15) * 1024 + n0 + 32 * wn + 8 * g;
#pragma unroll
        for (int ni = 0; ni < 2; ++ni) *(float4*)(pr + 4 * ni) = (float4){acc[mi][ni][0], acc[mi][ni][1], acc[mi][ni][2], acc[mi][ni][3]};
      }
    }
  }
}

__device__ __forceinline__ void phase_prep(PRef p, int layer, int bid, int nb, bf16_t* lds) {
  const int tid = tidx();
  for (int i = bid * 256 + tid; i < TT * 64; i += nb * 256) {
    const int c = i & 63;
    float v = p.S[i];
    if (c < 16) v = sigmoidf_(v);
    else if (c < 32) v = -expf(p.dn_a_log[layer * 16 + c - 16]) * softplusf_(v + p.dn_dt_bias[layer * 16 + c - 16]);
    else v = softplusf_(v + p.ssd_dt_bias[layer * 32 + c - 32]);
    p.S[i] = v;
  }
  const int cg = tid & 7, rA = tid >> 3;
  {
    int slab_, c0, cstep;
    if (nb == 512) { if (bid < 224) { slab_ = bid & 15; c0 = bid >> 4; cstep = 14; } else { slab_ = 16 + ((bid - 224) & 31); c0 = (bid - 224) >> 5; cstep = 9; } }
    else { slab_ = bid % 48; c0 = bid / 48; cstep = (nb + 47 - slab_) / 48; }
    asm volatile("" : "+s"(slab_));
    const int slab = slab_;
    const bool dn = slab < 24;
    const int typ = dn ? slab >> 3 : 3;
    const int ucol = (dn ? 1536 + 512 * typ + 64 * (slab & 7) : 4608 + 64 * (slab - 24)) + 8 * cg;
    const int hcol = dn ? ucol - 1536 : ucol - 3072;
    const int cch = (dn ? 512 * typ + 64 * (slab & 7) : 64 * (slab - 24)) + 8 * cg;
    const float* cw = (dn ? p.dn_conv_w : p.ssd_conv_w) + (size_t)layer * 5 * 1536 + cch;
    float w5[5][8];
#pragma unroll
    for (int j = 0; j < 5; ++j) {
      const float4 a = *(const float4*)(cw + j * 1536), b = *(const float4*)(cw + j * 1536 + 4);
      w5[j][0] = a.x; w5[j][1] = a.y; w5[j][2] = a.z; w5[j][3] = a.w; w5[j][4] = b.x; w5[j][5] = b.y; w5[j][6] = b.z; w5[j][7] = b.w;
    }
    float bias[8];
#pragma unroll
    for (int e = 0; e < 8; ++e) bias[e] = dn ? 0.f : p.ssd_conv_b[layer * 1536 + cch + e];
    bf16_t* T = lds;
    constexpr int TS_ = 72;
    uint4 pr0, pr1, pr2;
#define PREP_ROW(CHUNK, TR, DST) { \
      const int rr_ = (TR) - 2; \
      const bool lat_ = (CHUNK) < 256; const int cs_ = lat_ ? ((CHUNK) & 31) : (((CHUNK) - 256) & 3); \
      const bool first_ = cs_ == 0, last_ = lat_ ? cs_ == 31 : cs_ == 3; \
      uint4 v_ = make_uint4(0u, 0u, 0u, 0u); \
      if (rr_ < 0) { if (!first_) v_ = *(const uint4*)(p.HB + ((size_t)((CHUNK) - 1) * 4 + 4 + rr_) * 3072 + hcol); } \
      else if (rr_ >= 64) { if (!last_) v_ = *(const uint4*)(p.HB + ((size_t)((CHUNK) + 1) * 4 + rr_ - 64) * 3072 + hcol); } \
      else v_ = *(const uint4*)(p.U + (size_t)((CHUNK) * 64 + rr_) * UW + ucol); \
      DST = v_; }
#define PREP_LOAD(CHUNK) { PREP_ROW(CHUNK, rA, pr0) PREP_ROW(CHUNK, rA + 32, pr1) if (rA < 4) PREP_ROW(CHUNK, rA + 64, pr2) }
    if (c0 < 288) PREP_LOAD(c0)
    for (int chunk = c0; chunk < 288; chunk += cstep) {
      const bool lat = chunk < 256;
      const int cs = lat ? (chunk & 31) : ((chunk - 256) & 3);
      const int r0 = chunk * 64;
      __syncthreads();
      *(uint4*)(T + rA * TS_ + 8 * cg) = pr0; *(uint4*)(T + (rA + 32) * TS_ + 8 * cg) = pr1;
      if (rA < 4) *(uint4*)(T + (rA + 64) * TS_ + 8 * cg) = pr2;
      __syncthreads();
      if (chunk + cstep < 288) PREP_LOAD(chunk + cstep)
#pragma unroll
      for (int it = 0; it < 2; ++it) {
        const int rr = rA + 32 * it;
        float v[8];
#pragma unroll
        for (int e = 0; e < 8; ++e) v[e] = bias[e];
#pragma unroll
        for (int j = 0; j < 5; ++j) {
          const uint4 x = *(const uint4*)(T + (rr + j) * TS_ + 8 * cg);
          v[0] += w5[j][0] * bflo(x.x); v[1] += w5[j][1] * bfhi(x.x); v[2] += w5[j][2] * bflo(x.y); v[3] += w5[j][3] * bfhi(x.y);
          v[4] += w5[j][4] * bflo(x.z); v[5] += w5[j][5] * bfhi(x.z); v[6] += w5[j][6] * bflo(x.w); v[7] += w5[j][7] * bfhi(x.w);
        }
#pragma unroll
        for (int e = 0; e < 8; ++e) v[e] = siluf(v[e]);
        if (typ < 2) {
          float ss = 0.f;
#pragma unroll
          for (int e = 0; e < 8; ++e) ss += v[e] * v[e];
          ss += __shfl_xor(ss, 1); ss += __shfl_xor(ss, 2); ss += __shfl_xor(ss, 4);
          const float rs = rsqrtf(ss + EPS) * (typ == 0 ? 0.125f : 1.f);
          if (lat) {
            const int pos = cg < 4 ? cs : rr;
            const float* rp = p.ROPE + (pos * 16 + 8 * (cg & 1)) * 2;
            const float4 q0 = *(const float4*)rp, q1 = *(const float4*)(rp + 4), q2 = *(const float4*)(rp + 8), q3 = *(const float4*)(rp + 12);
            const float cs8[8] = {q0.x, q0.z, q1.x, q1.z, q2.x, q2.z, q3.x, q3.z}, sn8[8] = {q0.y, q0.w, q1.y, q1.w, q2.y, q2.w, q3.y, q3.w};
#pragma unroll
            for (int e = 0; e < 8; ++e) {
              const float vp = __shfl_xor(v[e], 2);
              v[e] = v[e] * cs8[e] + ((cg & 2) ? vp : -vp) * sn8[e];
            }
          }
#pragma unroll
          for (int e = 0; e < 8; ++e) v[e] *= rs;
        }
        uint4 o; o.x = pack2(v[0], v[1]); o.y = pack2(v[2], v[3]); o.z = pack2(v[4], v[5]); o.w = pack2(v[6], v[7]);
        *(uint4*)(p.U + (size_t)(r0 + rr) * UW + ucol) = o;
      }
    }
#undef PREP_LOAD
#undef PREP_ROW
  }
}

constexpr int XS = 72;
constexpr int BS2 = 136;
constexpr int SSD_LDS = (3 * 64 * XS + 3 * 64 * BS2) * 2 + 2 * 64 * 4;
__device__ __forceinline__ void phase_ssd(PRef p, int layer, int task, char* smem) {
  const int tid = tidx(), lane = tid & 63, wave = tid >> 6, g = lane >> 4, l15 = lane & 15, q4 = l15 >> 2, p4 = lane & 3;
  bf16_t* Xt = (bf16_t*)smem;
  bf16_t* Xs = Xt + 64 * XS;
  bf16_t* Wg = Xs + 64 * XS;
  bf16_t* Bt = Wg + 64 * XS;
  bf16_t* Ct = Bt + 64 * BS2;
  bf16_t* Hb = Ct + 64 * BS2;
  float* dts = (float*)(Hb + 64 * BS2);
  float* lam = dts + 64;
  {
    const int head = task & 15, b = task >> 4, grp = head >> 3;
    f32x4 hst[2][8];
#pragma unroll
    for (int d = 0; d < 2; ++d)
#pragma unroll
      for (int n = 0; n < 8; ++n) hst[d][n] = (f32x4){0.f, 0.f, 0.f, 0.f};
    const float dsk = p.ssd_d[layer * 16 + head];
    const float an0 = -__expf(p.ssd_a_log[layer * 32 + head]), an1 = -__expf(p.ssd_a_log[layer * 32 + 16 + head]);
    uint4 px0, px1, pb0, pb1, pb2, pb3, pc0, pc1, pc2, pc3; float pdt = 0.f;
#define SSD_PF_ROW_(IT, DIR) \
      const int seg_ = (IT) >= 4, ci_ = seg_ ? (IT) - 4 : (IT), nch_ = seg_ ? 32 : 4; \
      const int base_ = seg_ ? b * 2048 : TL + b * 256; \
      const int c_ = (DIR) ? nch_ - 1 - ci_ : ci_; \
      const int i_ = tid >> 2, sub_ = tid & 3; \
      const int row_ = base_ + 64 * c_ + ((DIR) ? 63 - i_ : i_); \
      const bf16_t* ur_ = p.U + (size_t)row_ * UW;
#define SSD_PF_X(IT, DIR) { SSD_PF_ROW_(IT, DIR) \
      const uint4* sx_ = (const uint4*)(ur_ + U_SX + 64 * head + 16 * sub_); px0 = sx_[0]; px1 = sx_[1]; \
      pdt = p.S[(size_t)row_ * SWD + 32 + (DIR) * 16 + head]; }
#define SSD_PF_B(IT, DIR) { SSD_PF_ROW_(IT, DIR) \
      const uint4* sb_ = (const uint4*)(ur_ + U_SB + 128 * grp + 16 * sub_); pb0 = sb_[0]; pb1 = sb_[1]; pb2 = sb_[8]; pb3 = sb_[9]; }
#define SSD_PF_C(IT, DIR) { SSD_PF_ROW_(IT, DIR) \
      const int ir_ = 16 * wave + l15; \
      const uint4* sc_ = (const uint4*)(p.U + (size_t)(base_ + 64 * c_ + ((DIR) ? 63 - ir_ : ir_)) * UW + U_SC + 128 * grp + 8 * g); pc0 = sc_[0]; pc1 = sc_[4]; pc2 = sc_[8]; pc3 = sc_[12]; }
    SSD_PF_X(0, 0) SSD_PF_B(0, 0) SSD_PF_C(0, 0)
    __builtin_amdgcn_s_waitcnt(0x0F70);
    for (int it = 0; it < 36; ++it) {
      const int seg = it >= 4, ci = seg ? it - 4 : it, nch = seg ? 32 : 4;
      const int base = seg ? b * 2048 : TL + b * 256;
      const bool want_o = seg == 1 || layer == 0;
      const bool first = ci < nch / 2;
#pragma unroll
      for (int dir = 0; dir < 2; ++dir) {
        const int c = dir ? nch - 1 - ci : ci;
        const int r0 = base + 64 * c;
        __syncthreads();
        {
          const int i = tid >> 2, sub = tid & 3;
          *(uint4*)(Xt + i * XS + 16 * sub) = px0; *(uint4*)(Xt + i * XS + 16 * sub + 8) = px1;
          *(uint4*)(Bt + i * BS2 + 16 * sub) = pb0; *(uint4*)(Bt + i * BS2 + 16 * sub + 8) = pb1; *(uint4*)(Bt + i * BS2 + 64 + 16 * sub) = pb2; *(uint4*)(Bt + i * BS2 + 64 + 16 * sub + 8) = pb3;
          if (sub == 0) dts[i] = pdt;
        }
        const bf16x8 cf0 = __builtin_bit_cast(bf16x8, pc0), cf1 = __builtin_bit_cast(bf16x8, pc1), cf2 = __builtin_bit_cast(bf16x8, pc2), cf3 = __builtin_bit_cast(bf16x8, pc3);
        const int nit = dir == 0 ? it : (it + 1 < 36 ? it + 1 : 35);
        if (dir == 0) SSD_PF_X(nit, 1) else SSD_PF_X(nit, 0)
        unsigned long long oldp[4];
        bf16_t* yrow;
        {
          const int irow_ = 16 * wave + l15;
          yrow = (want_o ? p.P + (size_t)(r0 + (dir ? 63 - irow_ : irow_)) * 1024 : (bf16_t*)p.SS + (size_t)irow_ * 1024) + 64 * head + 4 * g;
#pragma unroll
          for (int pt = 0; pt < 4; ++pt) oldp[pt] = __hip_atomic_load((unsigned long long*)(yrow + 16 * pt), __ATOMIC_RELAXED, __HIP_MEMORY_SCOPE_AGENT);
        }
        {
#pragma unroll
          for (int nt = 0; nt < 8; ++nt) {
            uint2 o; o.x = pack2(hst[dir][nt][0], hst[dir][nt][1]); o.y = pack2(hst[dir][nt][2], hst[dir][nt][3]);
            *(uint2*)(Hb + (16 * wave + l15) * BS2 + 16 * nt + 4 * g) = o;
          }
        }
        __syncthreads();
        if (dir == 0) SSD_PF_B(nit, 1) else SSD_PF_B(nit, 0)
        const float lv = wave_scan_add(dts[lane] * (dir ? an1 : an0));
        const float lam_last = __int_as_float(__builtin_amdgcn_readlane(__float_as_int(lv), 63));
        if (wave == 0) lam[lane] = lv;
        {
          const int j = tid >> 2, sub = tid & 3;
          const float lj = __shfl(lv, j & 63);
          const float sc = dts[j] * __expf(lam_last - lj);
          const uint4 a = *(const uint4*)(Xt + j * XS + 16 * sub), bq = *(const uint4*)(Xt + j * XS + 16 * sub + 8);
          uint4 oa, ob;
          oa.x = pack2(bflo(a.x) * sc, bfhi(a.x) * sc); oa.y = pack2(bflo(a.y) * sc, bfhi(a.y) * sc); oa.z = pack2(bflo(a.z) * sc, bfhi(a.z) * sc); oa.w = pack2(bflo(a.w) * sc, bfhi(a.w) * sc);
          ob.x = pack2(bflo(bq.x) * sc, bfhi(bq.x) * sc); ob.y = pack2(bflo(bq.y) * sc, bfhi(bq.y) * sc); ob.z = pack2(bflo(bq.z) * sc, bfhi(bq.z) * sc); ob.w = pack2(bflo(bq.w) * sc, bfhi(bq.w) * sc);
          *(uint4*)(Xs + j * XS + 16 * sub) = oa; *(uint4*)(Xs + j * XS + 16 * sub + 8) = ob;
        }
        __syncthreads();
        if (dir == 0) SSD_PF_C(nit, 1) else SSD_PF_C(nit, 0)
        {
          const int irow = 16 * wave + l15;
          const float li = lam[irow];
          f32x4 cw[4];
#pragma unroll
          for (int jt = 0; jt < 4; ++jt) cw[jt] = (f32x4){0.f, 0.f, 0.f, 0.f};
#pragma unroll
          for (int s2 = 0; s2 < 4; ++s2) {
            const bf16x8 af = s2 == 0 ? cf0 : s2 == 1 ? cf1 : s2 == 2 ? cf2 : cf3;
#pragma unroll
            for (int jt = 0; jt < 4; ++jt) {
              const bf16x8 bf = *(const bf16x8*)(Bt + (16 * jt + l15) * BS2 + 32 * s2 + 8 * g);
              cw[jt] = __builtin_amdgcn_mfma_f32_16x16x32_bf16(bf, af, cw[jt], 0, 0, 0);
            }
          }
#pragma unroll
          for (int jt = 0; jt < 4; ++jt) {
            const f32x4 cacc = cw[jt];
            const int j0 = 16 * jt + 4 * g;
            const float4 lj = *(const float4*)(lam + j0), dj = *(const float4*)(dts + j0);
            const float w0 = (j0 + 0 <= irow) ? cacc[0] * __expf(li - lj.x) * dj.x : 0.f;
            const float w1 = (j0 + 1 <= irow) ? cacc[1] * __expf(li - lj.y) * dj.y : 0.f;
            const float w2 = (j0 + 2 <= irow) ? cacc[2] * __expf(li - lj.z) * dj.z : 0.f;
            const float w3 = (j0 + 3 <= irow) ? cacc[3] * __expf(li - lj.w) * dj.w : 0.f;
            uint2 o; o.x = pack2(w0, w1); o.y = pack2(w2, w3);
            *(uint2*)(Wg + irow * XS + j0) = o;
          }
        }
        wave_lds_sync();
        {
          const int irow = 16 * wave + l15;
          f32x4 ai[4], ae[4];
#pragma unroll
          for (int pt = 0; pt < 4; ++pt) { ai[pt] = (f32x4){0.f, 0.f, 0.f, 0.f}; ae[pt] = (f32x4){0.f, 0.f, 0.f, 0.f}; }
#pragma unroll
          for (int s2 = 0; s2 < 2; ++s2) {
            const bf16x8 af = *(const bf16x8*)(Wg + irow * XS + 32 * s2 + 8 * g);
#pragma unroll
            for (int pt = 0; pt < 4; ++pt) {
              const bf16x8 bf = cat8(tr16(Xt + (32 * s2 + 8 * g + q4) * XS + 16 * pt + 4 * p4), tr16(Xt + (32 * s2 + 8 * g + 4 + q4) * XS + 16 * pt + 4 * p4));
              ai[pt] = __builtin_amdgcn_mfma_f32_16x16x32_bf16(bf, af, ai[pt], 0, 0, 0);
            }
          }
#pragma unroll
          for (int s2 = 0; s2 < 4; ++s2) {
            const bf16x8 af = s2 == 0 ? cf0 : s2 == 1 ? cf1 : s2 == 2 ? cf2 : cf3;
#pragma unroll
            for (int pt = 0; pt < 4; ++pt) {
              const bf16x8 bf = *(const bf16x8*)(Hb + (16 * pt + l15) * BS2 + 32 * s2 + 8 * g);
              ae[pt] = __builtin_amdgcn_mfma_f32_16x16x32_bf16(bf, af, ae[pt], 0, 0, 0);
            }
          }
          const float el = __expf(lam[irow]);
#pragma unroll
          for (int pt = 0; pt < 4; ++pt) {
            float y0 = ai[pt][0] + el * ae[pt][0], y1 = ai[pt][1] + el * ae[pt][1], y2 = ai[pt][2] + el * ae[pt][2], y3 = ai[pt][3] + el * ae[pt][3];
            if (dir == 0) {
              const uint2 xv = *(const uint2*)(Xt + irow * XS + 16 * pt + 4 * g);
              y0 += dsk * bflo(xv.x); y1 += dsk * bfhi(xv.x); y2 += dsk * bflo(xv.y); y3 += dsk * bfhi(xv.y);
            }
            unsigned long long* dst = (unsigned long long*)(yrow + 16 * pt);
            {
              const unsigned long long old = first ? 0ull : oldp[pt];
              const unsigned lo = (unsigned)old, hi = (unsigned)(old >> 32);
              y0 += bflo(lo); y1 += bfhi(lo); y2 += bflo(hi); y3 += bfhi(hi);
            }
            *dst = (unsigned long long)pack2(y0, y1) | ((unsigned long long)pack2(y2, y3) << 32);
          }
        }
        {
          const float el = __expf(lam_last);
#pragma unroll
          for (int nt = 0; nt < 8; ++nt) hst[dir][nt] *= el;
#pragma unroll
          for (int s2 = 0; s2 < 2; ++s2) {
            const bf16x8 mf = cat8(tr16(Xs + (32 * s2 + 8 * g + q4) * XS + 16 * wave + 4 * p4), tr16(Xs + (32 * s2 + 8 * g + 4 + q4) * XS + 16 * wave + 4 * p4));
#pragma unroll
            for (int nt = 0; nt < 8; ++nt) {
              const bf16x8 nf = cat8(tr16(Bt + (32 * s2 + 8 * g + q4) * BS2 + 16 * nt + 4 * p4), tr16(Bt + (32 * s2 + 8 * g + 4 + q4) * BS2 + 16 * nt + 4 * p4));
              hst[dir][nt] = __builtin_amdgcn_mfma_f32_16x16x32_bf16(nf, mf, hst[dir][nt], 0, 0, 0);
            }
          }
        }
      }
    }
  }
}


#undef SSD_PF_ROW_
#undef SSD_PF_X
#undef SSD_PF_B
#undef SSD_PF_C
constexpr int GT = 64 * XS;
constexpr int GDN_LDS = 8 * GT * 2 + 4 * 256 * 4 + 4 * 16 * 24 * 2 + 2 * 64 * 4;
__device__ __forceinline__ void phase_gdn(PRef p, int layer, int task, char* smem) {
  const int tid = tidx(), lane = tid & 63, wave = tid >> 6, g = lane >> 4, l15 = lane & 15, q4 = l15 >> 2, p4 = lane & 3;
  bf16_t* Qt = (bf16_t*)smem;
  bf16_t* Kt = Qt + GT;
  bf16_t* Vt = Kt + GT;
  bf16_t* Am = Vt + GT;
  bf16_t* Mq = Am + GT;
  bf16_t* Xw = Mq + GT;
  bf16_t* Xu = Xw + GT;
  bf16_t* St = Xu + GT;
  bf16_t* Qg = Qt; bf16_t* Vn = Vt; bf16_t* Vs = Am;
  float* Adiag = (float*)(St + GT);
  bf16_t* Db = (bf16_t*)(Adiag + 4 * 256);
  float* bet = (float*)(Db + 4 * 16 * 24);
  float* gam = bet + 64;
  const bf16x8 zero8 = (bf16x8){0, 0, 0, 0, 0, 0, 0, 0};
  {
    const int dir = task & 1, h = (task >> 1) & 7, b = task >> 4;
    bf16_t* Og = layer == 0 ? p.OG0 + (size_t)dir * TT * 512 : p.OG1 + (size_t)dir * TL * 512;
    f32x4 sst[4];
#pragma unroll
    for (int e = 0; e < 4; ++e) sst[e] = (f32x4){0.f, 0.f, 0.f, 0.f};
    __syncthreads();
    for (int i = tid; i < 64 * XS / 2; i += 256) { ((unsigned*)St)[i] = 0u; ((unsigned*)Xw)[i] = 0u; ((unsigned*)Xu)[i] = 0u; }
    uint4 pq0, pq1, pk0, pk1, pv0, pv1; float pbeta = 0.f, pgam = 0.f;
#define GDN_PF_ROW_(IT) \
      const int seg_ = (IT) >= 4, ci_ = seg_ ? (IT) - 4 : (IT), nch_ = seg_ ? 32 : 4; \
      const int base_ = seg_ ? b * 2048 : TL + b * 256; \
      const int c_ = dir ? nch_ - 1 - ci_ : ci_; \
      const int i_ = tid >> 2, sub_ = tid & 3; \
      const int row_ = base_ + 64 * c_ + (dir ? 63 - i_ : i_); \
      const bf16_t* ur_ = p.U + (size_t)row_ * UW + 64 * h + 16 * sub_;
#define GDN_PF_K(IT) { GDN_PF_ROW_(IT) pk0 = *(const uint4*)(ur_ + U_DNK); pk1 = *(const uint4*)(ur_ + U_DNK + 8); \
      pbeta = p.S[(size_t)row_ * SWD + dir * 8 + h]; pgam = p.S[(size_t)row_ * SWD + 16 + dir * 8 + h]; }
#define GDN_PF_Q(IT) { GDN_PF_ROW_(IT) const int ir_ = 16 * wave + l15; \
      const bf16_t* qr_ = p.U + (size_t)(base_ + 64 * c_ + (dir ? 63 - ir_ : ir_)) * UW + U_DNQ + 64 * h + 8 * g; pq0 = *(const uint4*)qr_; pq1 = *(const uint4*)(qr_ + 32); }
#define GDN_PF_V(IT) { GDN_PF_ROW_(IT) pv0 = *(const uint4*)(ur_ + U_DNV); pv1 = *(const uint4*)(ur_ + U_DNV + 8); }
    GDN_PF_K(0) GDN_PF_Q(0) GDN_PF_V(0)
    __builtin_amdgcn_s_waitcnt(0x0F70);
    for (int it = 0; it < 36; ++it) {
      const int seg = it >= 4, ci = seg ? it - 4 : it, nch = seg ? 32 : 4;
      const int base = seg ? b * 2048 : TL + b * 256;
      const bool want_o = seg == 1 || layer == 0;
      const int c = dir ? nch - 1 - ci : ci;
      const int r0 = base + 64 * c;
      __syncthreads();
      {
        const int i = tid >> 2, sub = tid & 3;
        *(uint4*)(Kt + i * XS + 16 * sub) = pk0; *(uint4*)(Kt + i * XS + 16 * sub + 8) = pk1;
        *(uint4*)(Vt + i * XS + 16 * sub) = pv0; *(uint4*)(Vt + i * XS + 16 * sub + 8) = pv1;
        if (sub == 0) { bet[i] = pbeta; gam[i] = pgam; }
      }
      const bf16x8 qf0 = __builtin_bit_cast(bf16x8, pq0), qf1 = __builtin_bit_cast(bf16x8, pq1);
      const int nit = it + 1 < 36 ? it + 1 : 35;
      GDN_PF_K(nit)
      __syncthreads();
      GDN_PF_Q(nit)
      const float lv = wave_scan_add(gam[lane]);
      const float gam_last = __int_as_float(__builtin_amdgcn_readlane(__float_as_int(lv), 63));
      __syncthreads();
      if (wave == 0) gam[lane] = lv;
      __syncthreads();
      {
        const int irow = 16 * wave + l15;
        const float gi = gam[irow], bi = bet[irow];
        f32x4 kkw[4], qkw[4];
#pragma unroll
        for (int jt = 0; jt < 4; ++jt) { kkw[jt] = (f32x4){0.f, 0.f, 0.f, 0.f}; qkw[jt] = (f32x4){0.f, 0.f, 0.f, 0.f}; }
#pragma unroll
        for (int s2 = 0; s2 < 2; ++s2) {
          const bf16x8 mk = *(const bf16x8*)(Kt + irow * XS + 32 * s2 + 8 * g);
          const bf16x8 mq = s2 == 0 ? qf0 : qf1;
#pragma unroll
          for (int jt = 0; jt < 4; ++jt) {
            const bf16x8 nf = *(const bf16x8*)(Kt + (16 * jt + l15) * XS + 32 * s2 + 8 * g);
            kkw[jt] = __builtin_amdgcn_mfma_f32_16x16x32_bf16(nf, mk, kkw[jt], 0, 0, 0);
            qkw[jt] = __builtin_amdgcn_mfma_f32_16x16x32_bf16(nf, mq, qkw[jt], 0, 0, 0);
          }
        }
#pragma unroll
        for (int jt = 0; jt < 4; ++jt) {
          const f32x4 kk = kkw[jt], qk = qkw[jt];
          const int j0 = 16 * jt + 4 * g;
          const float4 gj = *(const float4*)(gam + j0);
          const float gjv[4] = {gj.x, gj.y, gj.z, gj.w};
          float av[4], mv[4];
#pragma unroll
          for (int r = 0; r < 4; ++r) {
            const int j = j0 + r;
            const float dec = j <= irow ? __expf(gi - gjv[r]) : 0.f;
            av[r] = j < irow ? bi * kk[r] * dec : 0.f;
            mv[r] = qk[r] * dec;
          }
          uint2 oa; oa.x = pack2(av[0], av[1]); oa.y = pack2(av[2], av[3]);
          uint2 om; om.x = pack2(mv[0], mv[1]); om.y = pack2(mv[2], mv[3]);
          *(uint2*)(Am + irow * XS + j0) = oa;
          *(uint2*)(Mq + irow * XS + j0) = om;
          if (jt == wave) *(f32x4*)(Adiag + wave * 256 + l15 * 16 + 4 * g) = (f32x4){av[0], av[1], av[2], av[3]};
        }
      }
      __syncthreads();
      GDN_PF_V(nit)
      {
        const int cc = lane & 15;
        const float* Ad = Adiag + wave * 256;
        float dcol[16];
#pragma unroll
        for (int r = 0; r < 16; ++r) {
          float sacc = (r == cc) ? 1.f : 0.f;
#pragma unroll
          for (int j = 0; j < r; ++j) sacc -= Ad[r * 16 + j] * dcol[j];
          dcol[r] = sacc;
        }
        if (lane < 16) {
#pragma unroll
          for (int r = 0; r < 16; ++r) Db[(wave * 16 + r) * 24 + cc] = f2bf(dcol[r]);
        }
      }
      __syncthreads();
      {
        const bool isW = wave < 2;
        bf16_t* Xd = isW ? Xw : Xu;
        const bf16_t* Src = isW ? Kt : Vt;
        const int fbase = (wave & 1) * 32;
#pragma unroll
        for (int ib = 0; ib < 4; ++ib) {
          const int irow = 16 * ib + l15;
          const float sc = isW ? bet[irow] * __expf(gam[irow]) : bet[irow];
          f32x4 y[2];
#pragma unroll
          for (int fi = 0; fi < 2; ++fi) {
            const int f0 = fbase + 16 * fi;
            const uint2 rv = *(const uint2*)(Src + irow * XS + f0 + 4 * g);
            f32x4 tmp = (f32x4){0.f, 0.f, 0.f, 0.f};
#pragma unroll
            for (int s2 = 0; s2 < 2; ++s2) {
              if (32 * s2 < 16 * ib) {
                const bool half = (32 * s2 + 32) > 16 * ib;
                bf16x8 mf = *(const bf16x8*)(Am + irow * XS + 32 * s2 + 8 * g);
                if (half && g >= 2) mf = zero8;
                const bf16x8 nf = cat8(tr16(Xd + (32 * s2 + 8 * g + q4) * XS + f0 + 4 * p4), tr16(Xd + (32 * s2 + 8 * g + 4 + q4) * XS + f0 + 4 * p4));
                tmp = __builtin_amdgcn_mfma_f32_16x16x32_bf16(nf, mf, tmp, 0, 0, 0);
              }
            }
            y[fi] = (f32x4){bflo(rv.x) * sc - tmp[0], bfhi(rv.x) * sc - tmp[1], bflo(rv.y) * sc - tmp[2], bfhi(rv.y) * sc - tmp[3]};
          }
          wave_lds_sync();
#pragma unroll
          for (int fi = 0; fi < 2; ++fi) {
            uint2 o; o.x = pack2(y[fi][0], y[fi][1]); o.y = pack2(y[fi][2], y[fi][3]);
            *(uint2*)(Xd + irow * XS + fbase + 16 * fi + 4 * g) = o;
          }
          wave_lds_sync();
          bf16x8 dm = zero8;
          if (g < 2) dm = *(const bf16x8*)(Db + (ib * 16 + l15) * 24 + 8 * g);
#pragma unroll
          for (int fi = 0; fi < 2; ++fi) {
            const int f0 = fbase + 16 * fi;
            const bf16x8 nf = cat8(tr16(Xd + (16 * ib + 8 * (g & 1) + q4) * XS + f0 + 4 * p4), tr16(Xd + (16 * ib + 8 * (g & 1) + 4 + q4) * XS + f0 + 4 * p4));
            y[fi] = __builtin_amdgcn_mfma_f32_16x16x32_bf16(nf, dm, (f32x4){0.f, 0.f, 0.f, 0.f}, 0, 0, 0);
          }
          wave_lds_sync();
#pragma unroll
          for (int fi = 0; fi < 2; ++fi) {
            uint2 o; o.x = pack2(y[fi][0], y[fi][1]); o.y = pack2(y[fi][2], y[fi][3]);
            *(uint2*)(Xd + irow * XS + fbase + 16 * fi + 4 * g) = o;
          }
          wave_lds_sync();
        }
      }
      __syncthreads();
      {
        const int irow = 16 * wave + l15;
        const float dl = __expf(gam_last - gam[irow]);
        f32x4 acc[4];
#pragma unroll
        for (int et = 0; et < 4; ++et) acc[et] = (f32x4){0.f, 0.f, 0.f, 0.f};
#pragma unroll
        for (int s2 = 0; s2 < 2; ++s2) {
          const bf16x8 mf = *(const bf16x8*)(Xw + irow * XS + 32 * s2 + 8 * g);
#pragma unroll
          for (int et = 0; et < 4; ++et) {
            const bf16x8 nf = *(const bf16x8*)(St + (16 * et + l15) * XS + 32 * s2 + 8 * g);
            acc[et] = __builtin_amdgcn_mfma_f32_16x16x32_bf16(nf, mf, acc[et], 0, 0, 0);
          }
        }
#pragma unroll
        for (int et = 0; et < 4; ++et) {
          const uint2 uv = *(const uint2*)(Xu + irow * XS + 16 * et + 4 * g);
          const float v0 = bflo(uv.x) - acc[et][0], v1 = bfhi(uv.x) - acc[et][1], v2 = bflo(uv.y) - acc[et][2], v3 = bfhi(uv.y) - acc[et][3];
          uint2 o; o.x = pack2(v0, v1); o.y = pack2(v2, v3);
          *(uint2*)(Vn + irow * XS + 16 * et + 4 * g) = o;
          o.x = pack2(v0 * dl, v1 * dl); o.y = pack2(v2 * dl, v3 * dl);
          *(uint2*)(Vs + irow * XS + 16 * et + 4 * g) = o;
        }
      }
      __syncthreads();
      {
        const int irow = 16 * wave + l15;
        const float eg = __expf(gam[irow]);
        const bf16x8 qg0 = scale8(qf0, eg), qg1 = scale8(qf1, eg);
        f32x4 acc[4];
#pragma unroll
        for (int et = 0; et < 4; ++et) acc[et] = (f32x4){0.f, 0.f, 0.f, 0.f};
#pragma unroll
        for (int s2 = 0; s2 < 2; ++s2) {
          const bf16x8 mf = s2 == 0 ? qg0 : qg1;
          const bf16x8 mf2 = *(const bf16x8*)(Mq + irow * XS + 32 * s2 + 8 * g);
#pragma unroll
          for (int et = 0; et < 4; ++et) {
            const bf16x8 nf = *(const bf16x8*)(St + (16 * et + l15) * XS + 32 * s2 + 8 * g);
            acc[et] = __builtin_amdgcn_mfma_f32_16x16x32_bf16(nf, mf, acc[et], 0, 0, 0);
            const bf16x8 nf2 = cat8(tr16(Vn + (32 * s2 + 8 * g + q4) * XS + 16 * et + 4 * p4), tr16(Vn + (32 * s2 + 8 * g + 4 + q4) * XS + 16 * et + 4 * p4));
            acc[et] = __builtin_amdgcn_mfma_f32_16x16x32_bf16(nf2, mf2, acc[et], 0, 0, 0);
          }
        }
        bf16_t* orow = (want_o ? Og + (size_t)(r0 + (dir ? 63 - irow : irow)) * 512 : (bf16_t*)p.SS + 64 * 1024 + (size_t)irow * 512) + 64 * h + 4 * g;
#pragma unroll
        for (int et = 0; et < 4; ++et) {
          uint2 o; o.x = pack2(acc[et][0], acc[et][1]); o.y = pack2(acc[et][2], acc[et][3]);
          *(uint2*)(orow + 16 * et) = o;
        }
      }
      {
        const float el = __expf(gam_last);
#pragma unroll
        for (int et = 0; et < 4; ++et) sst[et] *= el;
#pragma unroll
        for (int s2 = 0; s2 < 2; ++s2) {
          const bf16x8 nf = cat8(tr16(Kt + (32 * s2 + 8 * g + q4) * XS + 16 * wave + 4 * p4), tr16(Kt + (32 * s2 + 8 * g + 4 + q4) * XS + 16 * wave + 4 * p4));
#pragma unroll
          for (int et = 0; et < 4; ++et) {
            const bf16x8 mf = cat8(tr16(Vs + (32 * s2 + 8 * g + q4) * XS + 16 * et + 4 * p4), tr16(Vs + (32 * s2 + 8 * g + 4 + q4) * XS + 16 * et + 4 * p4));
            sst[et] = __builtin_amdgcn_mfma_f32_16x16x32_bf16(nf, mf, sst[et], 0, 0, 0);
          }
        }
      }
      __syncthreads();
#pragma unroll
      for (int et = 0; et < 4; ++et) {
        uint2 o; o.x = pack2(sst[et][0], sst[et][1]); o.y = pack2(sst[et][2], sst[et][3]);
        *(uint2*)(St + (16 * et + l15) * XS + 16 * wave + 4 * g) = o;
      }
    }
  }
}


#undef GDN_PF_ROW_
#undef GDN_PF_K
#undef GDN_PF_Q
#undef GDN_PF_V
constexpr int NA_VS = 72;
constexpr int NA_LDS_WAVE = 2 * 32 * NA_VS * 2;
__device__ __forceinline__ void phase_na(PRef p, int layer, unsigned* ctr, char* smem) {
  const int lane = tidx() & 63, wave = tidx() >> 6, g = lane >> 4, l15 = lane & 15, q4 = l15 >> 2, p4 = lane & 3;
  bf16_t* Vl = (bf16_t*)(smem + wave * NA_LDS_WAVE);
  const int ntask = layer == 0 ? 8192 + 1024 : 8192;
  const float* rpb = p.na_rpb + (size_t)layer * 8 * 15 * 31;
  for (;;) {
    int w0 = 0;
    if (lane == 0) w0 = (int)atomicAdd(ctr, 1u);
    const int task = __builtin_amdgcn_readfirstlane(__shfl(w0, 0));
    if (task >= ntask) break;
    const bool lat = task < 8192;
    int b, h, r = 0, cb = 0, qtok0, R0 = 0, C0 = 0;
    if (lat) { cb = task & 3; r = (task >> 2) & 31; h = (task >> 7) & 7; b = task >> 10; qtok0 = b * 2048 + r * 64 + 16 * cb; R0 = min(max(r - 4, 0), 24); C0 = min(max(16 * cb - 8, 0), 32); }
    else { const int t2 = task - 8192; const int qb = t2 & 15; h = (t2 >> 4) & 7; b = t2 >> 7; qtok0 = TL + b * 256 + 16 * qb; }
    const int tau0 = lat ? 0 : 16;
    const int wtok0 = b * 2048 + R0 * 64 + C0, ctok0 = TL + b * 256;
#define tile_tok(tau) ((tau) < 16 ? wtok0 + ((tau) >> 1) * 64 + 16 * ((tau) & 1) : ctok0 + 16 * ((tau) - 16))
    const bf16_t* qp = p.U + (size_t)(qtok0 + l15) * UW + U_NAQ + 64 * h + 8 * g;
    const bf16x8 qf0 = *(const bf16x8*)qp, qf1 = *(const bf16x8*)(qp + 32);
    f32x4 sc[32];
#pragma unroll
    for (int tau = 0; tau < 32; ++tau) {
      sc[tau] = (f32x4){-INFINITY, -INFINITY, -INFINITY, -INFINITY};
      if (tau >= tau0) {
        const bf16_t* kp = p.U + (size_t)(tile_tok(tau) + l15) * UW + U_NAK + 64 * h + 8 * g;
        const bf16x8 kf0 = *(const bf16x8*)kp, kf1 = *(const bf16x8*)(kp + 32);
        f32x4 a = (f32x4){0.f, 0.f, 0.f, 0.f};
        a = __builtin_amdgcn_mfma_f32_16x16x32_bf16(kf0, qf0, a, 0, 0, 0);
        a = __builtin_amdgcn_mfma_f32_16x16x32_bf16(kf1, qf1, a, 0, 0, 0);
        if (tau < 16) {
          const int qcol = 16 * cb + l15, ws = min(max(qcol - 8, 0), 48);
          const int dr = R0 + (tau >> 1) - r + 7;
#pragma unroll
          for (int rg = 0; rg < 4; ++rg) {
            const int kcol = C0 + 16 * (tau & 1) + 4 * g + rg;
            const bool ok = kcol >= ws && kcol < ws + 16;
            const float bias = ok ? rpb[(h * 15 + dr) * 31 + (kcol - qcol + 15)] : 0.f;
            a[rg] = ok ? a[rg] + bias : -INFINITY;
          }
        }
        sc[tau] = a;
      }
    }
    float mx = -INFINITY;
#pragma unroll
    for (int tau = 0; tau < 32; ++tau) mx = fmaxf(mx, fmaxf(fmaxf(sc[tau][0], sc[tau][1]), fmaxf(sc[tau][2], sc[tau][3])));
    mx = fmaxf(mx, __shfl_xor(mx, 16)); mx = fmaxf(mx, __shfl_xor(mx, 32));
    const float mxl = -mx * 1.4426950408889634f;
    float sum = 0.f;
#pragma unroll
    for (int tau = 0; tau < 32; ++tau) {
#pragma unroll
      for (int rg = 0; rg < 4; ++rg) { const float e = __builtin_amdgcn_exp2f(fmaf(sc[tau][rg], 1.4426950408889634f, mxl)); sc[tau][rg] = e; sum += e; }
    }
    sum += __shfl_xor(sum, 16); sum += __shfl_xor(sum, 32);
    f32x4 oacc[4];
#pragma unroll
    for (int dt = 0; dt < 4; ++dt) oacc[dt] = (f32x4){0.f, 0.f, 0.f, 0.f};
    uint4 va0, va1, va2, va3, vb0, vb1, vb2, vb3;
#define NA_VLOAD(KAP, R0_, R1_, R2_, R3_) { \
      const int kk0_ = lane >> 3, cc_ = lane & 7; \
      const bf16_t* vb_ = p.U + U_NAV + 64 * h + 8 * cc_; \
      R0_ = *(const uint4*)(vb_ + (size_t)(tile_tok(2 * (KAP)) + kk0_) * UW); \
      R1_ = *(const uint4*)(vb_ + (size_t)(tile_tok(2 * (KAP)) + kk0_ + 8) * UW); \
      R2_ = *(const uint4*)(vb_ + (size_t)(tile_tok(2 * (KAP) + 1) + kk0_) * UW); \
      R3_ = *(const uint4*)(vb_ + (size_t)(tile_tok(2 * (KAP) + 1) + kk0_ + 8) * UW); }
#define NA_PVSTEP(kap, R0_, R1_, R2_, R3_) { \
        bf16_t* Vb = Vl + ((kap) & 1) * 32 * NA_VS; \
        { \
          const int kk0_ = lane >> 3, cc_ = lane & 7; \
          *(uint4*)(Vb + kk0_ * NA_VS + 8 * cc_) = R0_; *(uint4*)(Vb + (kk0_ + 8) * NA_VS + 8 * cc_) = R1_; \
          *(uint4*)(Vb + (kk0_ + 16) * NA_VS + 8 * cc_) = R2_; *(uint4*)(Vb + (kk0_ + 24) * NA_VS + 8 * cc_) = R3_; \
        } \
        if ((kap) + 2 < 16) NA_VLOAD((kap) + 2, R0_, R1_, R2_, R3_) \
        __builtin_amdgcn_fence(__ATOMIC_RELEASE, "workgroup"); __builtin_amdgcn_wave_barrier(); __builtin_amdgcn_fence(__ATOMIC_ACQUIRE, "workgroup"); \
        bf16x8 pf; \
        { \
          const unsigned w0_ = pack2(sc[2 * (kap)][0], sc[2 * (kap)][1]), w1_ = pack2(sc[2 * (kap)][2], sc[2 * (kap)][3]); \
          const unsigned w2_ = pack2(sc[2 * (kap) + 1][0], sc[2 * (kap) + 1][1]), w3_ = pack2(sc[2 * (kap) + 1][2], sc[2 * (kap) + 1][3]); \
          pf = (bf16x8){(short)(w0_ & 0xffff), (short)(w0_ >> 16), (short)(w1_ & 0xffff), (short)(w1_ >> 16), (short)(w2_ & 0xffff), (short)(w2_ >> 16), (short)(w3_ & 0xffff), (short)(w3_ >> 16)}; \
        } \
        _Pragma("unroll") \
        for (int dt = 0; dt < 4; ++dt) { \
          const bf16x8 vf = cat8(tr16(Vb + (4 * g + q4) * NA_VS + 16 * dt + 4 * p4), tr16(Vb + (16 + 4 * g + q4) * NA_VS + 16 * dt + 4 * p4)); \
          oacc[dt] = __builtin_amdgcn_mfma_f32_16x16x32_bf16(vf, pf, oacc[dt], 0, 0, 0); \
        } }
    if (lat) {
      NA_VLOAD(0, va0, va1, va2, va3)
      NA_VLOAD(1, vb0, vb1, vb2, vb3)
#pragma unroll
      for (int kap = 0; kap < 8; kap += 2) { NA_PVSTEP(kap, va0, va1, va2, va3) NA_PVSTEP(kap + 1, vb0, vb1, vb2, vb3) }
    } else {
      NA_VLOAD(8, va0, va1, va2, va3)
      NA_VLOAD(9, vb0, vb1, vb2, vb3)
    }
#pragma unroll
    for (int kap = 8; kap < 16; kap += 2) { NA_PVSTEP(kap, va0, va1, va2, va3) NA_PVSTEP(kap + 1, vb0, vb1, vb2, vb3) }
#undef NA_PVSTEP
#undef NA_VLOAD
#undef tile_tok
    const float inv = 1.f / sum;
    bf16_t* op = p.U + (size_t)(qtok0 + l15) * UW + U_YA + 64 * h + 4 * g;
#pragma unroll
    for (int dt = 0; dt < 4; ++dt) {
      uint2 o; o.x = pack2(oacc[dt][0] * inv, oacc[dt][1] * inv); o.y = pack2(oacc[dt][2] * inv, oacc[dt][3] * inv);
      *(uint2*)(op + 16 * dt) = o;
    }
  }
}

__device__ __forceinline__ void norm_row(const float* xr, float rs, const float* alpha, const float* shift, bf16_t* hrow, int lane) {
#pragma unroll
  for (int i = 0; i < 4; ++i) {
    const int k = lane * 4 + 256 * i;
    const float4 v = *(const float4*)(xr + k), a = *(const float4*)(alpha + k), s = *(const float4*)(shift + k);
    uint2 o; o.x = pack2(v.x * rs * a.x + s.x, v.y * rs * a.y + s.y); o.y = pack2(v.z * rs * a.z + s.z, v.w * rs * a.w + s.w);
    *(uint2*)(hrow + k) = o;
  }
}
constexpr int TKW = 2;
__device__ __forceinline__ void phase_fin(PRef p, int layer, int bid, int nb) {
  {
    bf16_t* uw = p.U + U_W;
#pragma unroll 1
    for (int i = 0; i < 3; ++i) wconv(p.w_in + (size_t)layer * 1024 * DIN, DIN, 6208 + 1024 * i, false, uw + (size_t)(UWR_G + 1024 * i) * UW, UW, 1024, 1024, bid, nb);
    wconv(p.w_pa + (size_t)layer * 512 * 1024, 1024, 0, false, uw + (size_t)UWR_PA * UW, UW, 512, 1024, bid, nb);
    wconv(p.w_pb + (size_t)layer * 512 * 1024, 1024, 0, false, uw + (size_t)UWR_PB * UW, UW, 512, 1024, bid, nb);
    wconv(p.w_pc + (size_t)layer * 1024 * 1024, 1024, 0, false, uw + (size_t)UWR_PC * UW, UW, 1024, 1024, bid, nb);
    wconv(p.w_out + (size_t)layer * 1024 * 1024, 1024, 0, false, uw + (size_t)UWR_OUT * UW, UW, 1024, 1024, bid, nb);
  }
  const int lane = tidx() & 63, wave = tidx() >> 6;
  const int ntok = layer == 0 ? TT : TL;
  const bf16_t* ogf = layer == 0 ? p.OG0 : p.OG1;
  const bf16_t* ogb = ogf + (size_t)(layer == 0 ? TT : TL) * 512;
  const float* gnd = p.dn_o_gain + layer * 64 + 8 * (lane & 7);
  const float* gns = p.ssd_o_gain + layer * 1024 + 16 * lane;
  const float* xlat = layer == 0 ? p.x : p.out;
  const float* xctx = layer == 0 ? p.ctx : p.XC;
  for (int tok0 = (bid * 4 + wave) * TKW; tok0 < ntok; tok0 += nb * 4 * TKW) {
    uint4 a[TKW], bq[TKW], zd[TKW], pa[TKW][2], zs[TKW][2];
    float4 xv[TKW][4];
#pragma unroll
    for (int j = 0; j < TKW; ++j)
#pragma unroll
      for (int i = 0; i < 4; ++i) xv[j][i] = *(const float4*)((tok0 < TL ? xlat + (size_t)(tok0 + j) * DM : xctx + (size_t)(tok0 + j - TL) * DM) + lane * 4 + 256 * i);
#pragma unroll
    for (int j = 0; j < TKW; ++j) {
      const int tok = tok0 + j;
      const bf16_t* ur = p.U + (size_t)tok * UW;
      a[j] = *(const uint4*)(ogf + (size_t)tok * 512 + 8 * lane); bq[j] = *(const uint4*)(ogb + (size_t)tok * 512 + 8 * lane); zd[j] = *(const uint4*)(ur + U_DNZ + 8 * lane);
      pa[j][0] = *(const uint4*)(p.P + (size_t)tok * 1024 + 16 * lane); pa[j][1] = *(const uint4*)(p.P + (size_t)tok * 1024 + 16 * lane + 8);
      zs[j][0] = *(const uint4*)(ur + U_SZ + 16 * lane); zs[j][1] = *(const uint4*)(ur + U_SZ + 16 * lane + 8);
    }
#pragma unroll
    for (int j = 0; j < TKW; ++j) {
      bf16_t* ur = p.U + (size_t)(tok0 + j) * UW;
      {
        float o[8] = {bflo(a[j].x) + bflo(bq[j].x), bfhi(a[j].x) + bfhi(bq[j].x), bflo(a[j].y) + bflo(bq[j].y), bfhi(a[j].y) + bfhi(bq[j].y),
                      bflo(a[j].z) + bflo(bq[j].z), bfhi(a[j].z) + bfhi(bq[j].z), bflo(a[j].w) + bflo(bq[j].w), bfhi(a[j].w) + bfhi(bq[j].w)};
        const float zz[8] = {bflo(zd[j].x), bfhi(zd[j].x), bflo(zd[j].y), bfhi(zd[j].y), bflo(zd[j].z), bfhi(zd[j].z), bflo(zd[j].w), bfhi(zd[j].w)};
        float ss = 0.f;
#pragma unroll
        for (int i = 0; i < 8; ++i) ss += o[i] * o[i];
        ss += __shfl_xor(ss, 1); ss += __shfl_xor(ss, 2); ss += __shfl_xor(ss, 4);
        const float rs = rsqrtf(ss * (1.f / 64.f) + EPS);
#pragma unroll
        for (int i = 0; i < 8; ++i) o[i] = o[i] * rs * gnd[i] * siluf(zz[i]);
        uint4 w; w.x = pack2(o[0], o[1]); w.y = pack2(o[2], o[3]); w.z = pack2(o[4], o[5]); w.w = pack2(o[6], o[7]);
        *(uint4*)(ur + U_YB + 8 * lane) = w;
      }
      {
        float yv[16];
        float ss = 0.f;
#pragma unroll
        for (int hf = 0; hf < 2; ++hf) {
          const uint4 av4 = pa[j][hf], z = zs[j][hf];
          const float av[8] = {bflo(av4.x), bfhi(av4.x), bflo(av4.y), bfhi(av4.y), bflo(av4.z), bfhi(av4.z), bflo(av4.w), bfhi(av4.w)};
          const float zz[8] = {bflo(z.x), bfhi(z.x), bflo(z.y), bfhi(z.y), bflo(z.z), bfhi(z.z), bflo(z.w), bfhi(z.w)};
#pragma unroll
          for (int i = 0; i < 8; ++i) { const float v = av[i] * siluf(zz[i]); yv[8 * hf + i] = v; ss += v * v; }
        }
        ss += __shfl_xor(ss, 1); ss += __shfl_xor(ss, 2); ss += __shfl_xor(ss, 4); ss += __shfl_xor(ss, 8); ss += __shfl_xor(ss, 16);
        const float rs = rsqrtf(ss * (1.f / 512.f) + EPS);
#pragma unroll
        for (int hf = 0; hf < 2; ++hf) {
          uint4 w;
          w.x = pack2(yv[8 * hf + 0] * rs * gns[8 * hf + 0], yv[8 * hf + 1] * rs * gns[8 * hf + 1]);
          w.y = pack2(yv[8 * hf + 2] * rs * gns[8 * hf + 2], yv[8 * hf + 3] * rs * gns[8 * hf + 3]);
          w.z = pack2(yv[8 * hf + 4] * rs * gns[8 * hf + 4], yv[8 * hf + 5] * rs * gns[8 * hf + 5]);
          w.w = pack2(yv[8 * hf + 6] * rs * gns[8 * hf + 6], yv[8 * hf + 7] * rs * gns[8 * hf + 7]);
          *(uint4*)(ur + U_YC + 16 * lane + 8 * hf) = w;
        }
      }
    }
    {
      __builtin_amdgcn_s_waitcnt(0x0F70);
      const float* mr = p.MOD + (size_t)layer * 9 * 6144 + modrow(tok0) * 6144;
      float rs[TKW];
#pragma unroll
      for (int j = 0; j < TKW; ++j) {
        float ssq = 0.f;
#pragma unroll
        for (int i = 0; i < 4; ++i) ssq += xv[j][i].x * xv[j][i].x + xv[j][i].y * xv[j][i].y + xv[j][i].z * xv[j][i].z + xv[j][i].w * xv[j][i].w;
        rs[j] = rsqrtf(wave_sum(ssq) * (1.f / DM) + EPS);
      }
#pragma unroll
      for (int i = 0; i < 4; ++i) {
        const int k = lane * 4 + 256 * i;
        const float4 al = *(const float4*)(mr + 1024 + k), sh = *(const float4*)(mr + k);
#pragma unroll
        for (int j = 0; j < TKW; ++j) {
          uint2 o; o.x = pack2(xv[j][i].x * rs[j] * al.x + sh.x, xv[j][i].y * rs[j] * al.y + sh.y); o.y = pack2(xv[j][i].z * rs[j] * al.z + sh.z, xv[j][i].w * rs[j] * al.w + sh.w);
          *(uint2*)(p.P + (size_t)(tok0 + j) * 1024 + k) = o;
        }
      }
    }
  }
}

#define XB_TMO      128
#define XB_XCNT(j)  (256  + 64 * (j))
#define XB_XSUB(j)  (1280 + 64 * (j))
#define XB_XGEN(j)  (2304 + 64 * (j))
#define XB_TOP      3328
#define XB_TOPGEN   3392
#define XCD_BAR_WORDS 3456
#define XB_SPIN_CAP (1u << 20)
__device__ __forceinline__ unsigned xb_ld(unsigned* p)              { return __hip_atomic_load(p, __ATOMIC_RELAXED, __HIP_MEMORY_SCOPE_AGENT); }
__device__ __forceinline__ unsigned xb_add(unsigned* p, unsigned v) { return __hip_atomic_fetch_add(p, v, __ATOMIC_RELAXED, __HIP_MEMORY_SCOPE_AGENT); }
__device__ __forceinline__ unsigned xb_xcc_id() { return (unsigned)__builtin_amdgcn_s_getreg((3 << 11) | 20) & 0xFu; }
#define XB_SPIN(cond, bar) do { unsigned _sp = 0; while (cond) { __builtin_amdgcn_s_sleep(1); \
    if ((++_sp & 255u) == 0u) { if (xb_ld(&(bar)[XB_TMO])) break; if (_sp > XB_SPIN_CAP) { atomicAdd(&(bar)[XB_TMO], 1u); break; } } } } while (0)
struct XcdBarrier { unsigned* bar; unsigned x; volatile LDS_AS unsigned* st; };
__device__ __forceinline__ XcdBarrier xcd_barrier_post(unsigned* bar, volatile LDS_AS unsigned* st) {
  XcdBarrier b; b.bar = bar; b.x = xb_xcc_id(); b.st = st;
  if (threadIdx.x == 0) (void)xb_add(&bar[XB_XCNT(b.x)], 1u);
  return b;
}
__device__ __forceinline__ void xcd_barrier_complete(unsigned* bar, unsigned x, unsigned& nloc, unsigned& nx) {
  const unsigned G = gridDim.x * gridDim.y * gridDim.z;
  unsigned sum, cnt, mine, sp = 0u;
  for (;;) {
    sum = 0u; cnt = 0u; mine = 0u;
#pragma unroll
    for (unsigned j = 0; j < 16; ++j) { const unsigned c = xb_ld(&bar[XB_XCNT(j)]); sum += c; cnt += (c > 0u) ? 1u : 0u; mine = (j == x) ? c : mine; }
    if (sum == G) break;
    __builtin_amdgcn_s_sleep(1);
    if ((++sp & 255u) == 0u) { if (xb_ld(&bar[XB_TMO])) break; if (sp > XB_SPIN_CAP) { atomicAdd(&bar[XB_TMO], 1u); break; } }
  }
  nloc = mine > 0u ? mine : 1u; nx = cnt > 0u ? cnt : 1u;
}
__device__ __forceinline__ void xcd_barrier(const XcdBarrier& b0) {
  asm volatile("s_waitcnt vmcnt(0)" ::: "memory");
  __syncthreads();
  if (threadIdx.x == 0) {
    XcdBarrier b = b0; b.x = xb_xcc_id();
    unsigned* bar = b.bar;
    __builtin_amdgcn_s_waitcnt(0);
    unsigned nloc = b.st[0], nx = b.st[1];
    if (nloc == 0u) { xcd_barrier_complete(bar, b.x, nloc, nx); b.st[0] = nloc; b.st[1] = nx; }
    const unsigned old = xb_add(&bar[XB_XSUB(b.x)], 1u);
    const unsigned gen = old / nloc;
    if (old + 1u == (gen + 1u) * nloc) {
      __builtin_amdgcn_fence(__ATOMIC_RELEASE, "agent");
      asm volatile("s_waitcnt vmcnt(0)" ::: "memory");
      const unsigned og = xb_add(&bar[XB_TOP], 1u);
      const unsigned tg = og / nx;
      if (og + 1u == (tg + 1u) * nx) xb_add(&bar[XB_TOPGEN], 1u);
      else XB_SPIN(xb_ld(&bar[XB_TOPGEN]) == tg, bar);
      __builtin_amdgcn_fence(__ATOMIC_ACQUIRE, "agent");
      xb_add(&bar[XB_XGEN(b.x)], 1u);
      asm volatile("s_waitcnt vmcnt(0)" ::: "memory");
    } else {
      XB_SPIN(xb_ld(&bar[XB_XGEN(b.x)]) == gen, bar);
      __builtin_amdgcn_fence(__ATOMIC_ACQUIRE, "agent");
      asm volatile("s_waitcnt vmcnt(0)" ::: "memory");
    }
  }
  __syncthreads();
}

namespace cg = cooperative_groups;
constexpr int MEGA_LDS = GDN_LDS > SSD_LDS ? GDN_LDS : SSD_LDS;
static_assert(MEGA_LDS <= 81408 && GEMM_LDS_BYTES <= MEGA_LDS && 4 * NA_LDS_WAVE <= MEGA_LDS, "LDS budget");
__global__ void __launch_bounds__(256, 2) k_mega(Params p_unused) {
  const AS4 Params* kp = (const AS4 Params*)__builtin_amdgcn_kernarg_segment_ptr();
#define PP (*p_launder(kp))
  cg::grid_group grid = cg::this_grid();
  __shared__ __attribute__((aligned(16))) char smem[MEGA_LDS];
  const int bid = blockIdx.x, nb = gridDim.x;
  __shared__ uint4 xb_words;
  if (threadIdx.x == 0) xb_words = make_uint4(0u, 0u, 0u, 0u);
  __syncthreads();
  const XcdBarrier xb = xcd_barrier_post(PP.BAR, (volatile LDS_AS unsigned*)&xb_words);
  phase_pro(PP, bid, nb);
  phase_modp(PP, bid, nb, (float*)smem);
  if (nb == 0x7fffffff) grid.sync();
  xcd_barrier(xb);
  phase_modfin(PP, bid, nb);
  xcd_barrier(xb);
  phase_norm(PP, 0, 0, bid, nb);
  xcd_barrier(xb);
#pragma unroll 1
  for (int layer = 0; layer < 2; ++layer) {
    phase_g1(PP, layer, bid, nb, (bf16_t*)smem);
    xcd_barrier(xb);
    phase_prep(PP, layer, bid, nb, (bf16_t*)smem);
    xcd_barrier(xb);
    {
      __shared__ int s_role;
      unsigned* chain_ctr = PP.CTR + 8 + layer;
      if (threadIdx.x == 0) {
        const unsigned key = (((unsigned)__builtin_amdgcn_s_getreg((3 << 11) | 20) & 0xFu) << 8) | (((unsigned)__builtin_amdgcn_s_getreg(63492) >> 8) & 0xffu);
        const unsigned slot = nb > 256 ? atomicAdd(PP.CTR + 64 + 2048 * layer + key, 1u) : 0u;
        s_role = slot == 0 ? (int)atomicAdd(chain_ctr, 1u) : 1 << 20;
      }
      __syncthreads();
      int c = s_role;
      __syncthreads();
      if (c < 128) phase_gdn(PP, layer, c, smem); else if (c < 256) phase_ssd(PP, layer, c - 128, smem);
      __syncthreads();
      phase_na(PP, layer, PP.CTR + layer, smem);
      for (;;) {
        __syncthreads();
        if (threadIdx.x == 0) s_role = (int)atomicAdd(chain_ctr, 1u);
        __syncthreads();
        c = s_role;
        if (c >= 256) break;
        if (c < 128) phase_gdn(PP, layer, c, smem); else phase_ssd(PP, layer, c - 128, smem);
      }
      if (layer == 0) {
        for (;;) {
          __syncthreads();
          if (threadIdx.x == 0) s_role = (int)atomicAdd(PP.CTR + 12, 1u);
          __syncthreads();
          const int u = s_role;
          if (u >= 512) break;
          wconv(PP.w_ff1, DFF, 0, false, PP.WT, DFF, 1024, DFF, u, 512);
          wconv(PP.w_ff2, 1024, 0, false, PP.WT + (size_t)1024 * DFF, 1024, DFF, 1024, u, 512);
        }
      }
    }
    xcd_barrier(xb);
    phase_fin(PP, layer, bid, nb);
    xcd_barrier(xb);
    phase_g2a(PP, layer, bid, nb, (bf16_t*)smem);
    xcd_barrier(xb);
    phase_g2b(PP, layer, bid, nb, (bf16_t*)smem);
    xcd_barrier(xb);
    phase_g3(PP, layer, bid, nb, (bf16_t*)smem);
    xcd_barrier(xb);
    phase_norm(PP, layer, 1, bid, nb);
    xcd_barrier(xb);
    phase_g4(PP, layer, bid, nb, (bf16_t*)smem);
    xcd_barrier(xb);
    phase_g5(PP, layer, bid, nb, (bf16_t*)smem);
    if (layer == 0) { xcd_barrier(xb); phase_norm(PP, 1, 0, bid, nb); xcd_barrier(xb); }
  }
#undef PP
}

extern "C" void kernel_launch(void* const* d_in, const int* in_sizes, int n_in, void* d_out, int out_size, void* d_ws, size_t ws_size,
                              hipStream_t stream) {
  Params p{};
  const float** fp = (const float**)&p;
  for (int i = 0; i < 28; ++i) fp[i] = (const float*)d_in[i];
  p.out = (float*)d_out;
  char* ws = (char*)d_ws;
  size_t off = 0;
  auto take = [&](size_t bytes) { char* r = ws + off; off += (bytes + 255) & ~(size_t)255; return r; };
  p.U = (bf16_t*)take((size_t)TT * UW * 2);
  p.S = (float*)take((size_t)TT * SWD * 4);
  p.MOD = (float*)take((size_t)2 * 9 * 6144 * 4);
  p.SS = (float*)take((size_t)4 * TT * 4);
  p.ROPE = (float*)take(64 * 16 * 2 * 4);
  p.BAR = (unsigned*)take((size_t)XCD_BAR_WORDS * 4 + (64 + 2 * 2048) * 4);
  p.CTR = p.BAR + XCD_BAR_WORDS;
  p.P = (bf16_t*)take((size_t)TT * 1024 * 2);
  p.XC = (float*)take((size_t)TC * 1024 * 4);
  p.WT = (bf16_t*)(ws + off);
  p.HB = (bf16_t*)p.XC;
  p.OG0 = (bf16_t*)d_out;
  p.OG1 = (bf16_t*)((char*)p.P + (size_t)TL * 1024 * 2);
  size_t need = (size_t)((char*)p.OG1 - ws) + (size_t)2 * TL * 512 * 2;
  { const size_t need2 = off + (size_t)2 * 1024 * DFF * 2; if (need2 > need) need = need2; }
  if (need > ws_size) { fprintf(stderr, "workspace too small: need %zu have %zu\n", need, ws_size); return; }
  static int grid_blocks = 0;
  if (!grid_blocks) {
    int dev = 0, cus = 0, per_cu = 0;
    hipGetDevice(&dev);
    hipDeviceGetAttribute(&cus, hipDeviceAttributeMultiprocessorCount, dev);
    hipOccupancyMaxActiveBlocksPerMultiprocessor(&per_cu, k_mega, 256, 0);
    if (per_cu > 2) per_cu = 2;
    grid_blocks = cus * per_cu;
  }
  hipMemsetAsync(p.BAR, 0, (size_t)XCD_BAR_WORDS * 4 + (64 + 2 * 2048) * 4, stream);
  void* args[] = {&p};
  hipError_t e = hipLaunchCooperativeKernel((void*)k_mega, dim3(grid_blocks), dim3(256), args, 0, stream);
  if (e != hipSuccess) fprintf(stderr, "cooperative launch failed: %s (grid %d)\n", hipGetErrorString(e), grid_blocks);
}
```
